# Optimizing an MI355X kernel written in HIP

```python
import math
import jax, jax.numpy as jnp
from jax import lax
import numpy as np

D_MODEL = 1024
BATCH = 4
SEQ = 8192
DEPTH = 1

MEM_LEN = 256
XA_HEADS = 4
XA_HEAD_DIM = 128
DIFF_HEADS = 4
DIFF_QK_DIM = 64
DIFF_V_DIM = 2 * DIFF_QK_DIM
DSA_HEADS = 8
DSA_HEAD_DIM = 64
IDX_HEADS = 8
IDX_DIM = 64
TOPK_MAX = 256
ROPE_THETA = 500000.0
ROPE_FRACTION = 4
Q_BLOCK = 128
N_BRANCH = 3
N_GROUPS = 4
EXPERTS_PER_GROUP = 4
N_EXPERTS = N_GROUPS * EXPERTS_PER_GROUP
TOP_K_EXPERTS = 2
D_EXPERT = 512
EPS = 1e-6

W_DIFF_QK = DIFF_HEADS * 2 * DIFF_QK_DIM
W_DIFF_V = DIFF_HEADS * DIFF_V_DIM
W_DSA = DSA_HEADS * DSA_HEAD_DIM
W_IDX_Q = IDX_HEADS * IDX_DIM
W_IDX_K = IDX_DIM
W_IDX_W = IDX_HEADS
W_MEM_Q = XA_HEADS * XA_HEAD_DIM
W_GATES = N_BRANCH * D_MODEL
WIDTHS = (W_DIFF_QK, W_DIFF_QK, W_DIFF_V, W_DSA, W_DSA, W_DSA,
          W_IDX_Q, W_IDX_K, W_IDX_W, W_MEM_Q, W_GATES)
D_IN_PROJ = sum(WIDTHS)
SPLIT_POINTS = tuple(sum(WIDTHS[:i + 1]) for i in range(len(WIDTHS) - 1))

kernel_name = "hybrid_gated_diffattn_dsa_memxattn_hiermoe"


def rmsnorm(x, g):
    xf = x.astype(jnp.float32)
    y = xf * lax.rsqrt(jnp.mean(xf * xf, axis=-1, keepdims=True) + EPS)
    return (y * g.astype(jnp.float32)).astype(x.dtype)


def partial_rope(x, pos):
    d = x.shape[-1]
    rot = d // ROPE_FRACTION
    half = rot // 2
    inv_freq = ROPE_THETA ** (-jnp.arange(0, rot, 2, dtype=jnp.float32) / rot)
    ang = pos.astype(jnp.float32)[..., None] * inv_freq
    shape = ang.shape[:2] + (1,) * (x.ndim - 3) + (half,)
    cos = jnp.cos(ang).reshape(shape)
    sin = jnp.sin(ang).reshape(shape)
    xf = x.astype(jnp.float32)
    x1, x2, rest = xf[..., :half], xf[..., half:rot], xf[..., rot:]
    out = jnp.concatenate([x1 * cos - x2 * sin, x2 * cos + x1 * sin, rest], axis=-1)
    return out.astype(x.dtype)


def to_blocks(a):
    b, s = a.shape[:2]
    return a.reshape((b, s // Q_BLOCK, Q_BLOCK) + a.shape[2:]).swapaxes(0, 1)


def from_blocks(a):
    a = a.swapaxes(0, 1)
    return a.reshape((a.shape[0], a.shape[1] * a.shape[2]) + a.shape[3:])


def diff_attention(q1, q2, k1, k2, v, lam, g_sub, lam_init):
    b, s, h, dq = q1.shape
    scale = dq ** -0.5
    key_pos = jnp.arange(s)

    def block(args):
        i, q1b, q2b = args
        q_pos = i * Q_BLOCK + jnp.arange(Q_BLOCK)
        causal = (key_pos[None, :] <= q_pos[:, None])[None, None]
        s1 = jnp.einsum('bqhd,bkhd->bhqk', q1b, k1).astype(jnp.float32) * scale
        s2 = jnp.einsum('bqhd,bkhd->bhqk', q2b, k2).astype(jnp.float32) * scale
        p1 = jax.nn.softmax(jnp.where(causal, s1, -jnp.inf), axis=-1)
        p2 = jax.nn.softmax(jnp.where(causal, s2, -jnp.inf), axis=-1)
        a = p1 - lam * p2
        return jnp.einsum('bhqk,bkhd->bqhd', a.astype(v.dtype), v)

    nb = s // Q_BLOCK
    out = from_blocks(lax.map(block, (jnp.arange(nb), to_blocks(q1), to_blocks(q2))))
    out = rmsnorm(out, g_sub) * (1.0 - lam_init)
    return out.reshape(b, s, h * v.shape[-1])


def dsa_attention(q, k, v, q_idx, k_idx, w_idx, top_k):
    b, s, h, dh = q.shape
    key_pos = jnp.arange(s)
    idx_scale = IDX_DIM ** -0.5
    head_scale = IDX_HEADS ** -0.5
    att_scale = dh ** -0.5
    gather_rows = jax.vmap(lambda arr, sel: arr[sel])

    def block(args):
        i, qb, qib, wib = args
        q_pos = i * Q_BLOCK + jnp.arange(Q_BLOCK)
        causal = key_pos[None, :] <= q_pos[:, None]
        logits = jnp.einsum('bqhd,bkd->bqhk', qib, k_idx).astype(jnp.float32) * idx_scale
        score = jnp.einsum('bqh,bqhk->bqk', wib.astype(jnp.float32) * head_scale,
                           jax.nn.relu(logits))
        score = jnp.where(causal[None], score, -jnp.inf)
        _, sel = lax.top_k(score, top_k)
        valid = sel <= q_pos[None, :, None]
        ks = gather_rows(k, sel)
        vs = gather_rows(v, sel)
        sc = jnp.einsum('bqhd,bqkhd->bhqk', qb, ks).astype(jnp.float32) * att_scale
        sc = jnp.where(valid[:, None], sc, -jnp.inf)
        p = jax.nn.softmax(sc, axis=-1)
        return jnp.einsum('bhqk,bqkhd->bqhd', p.astype(v.dtype), vs)

    nb = s // Q_BLOCK
    out = from_blocks(lax.map(block, (jnp.arange(nb), to_blocks(q), to_blocks(q_idx), to_blocks(w_idx))))
    return out.reshape(b, s, h * dh)


def memory_attention(q, mk, mv):
    b, s, h, d = q.shape
    sc = jnp.einsum('bqhd,bmhd->bhqm', q, mk).astype(jnp.float32) * (d ** -0.5)
    p = jax.nn.softmax(sc, axis=-1)
    out = jnp.einsum('bhqm,bmhd->bqhd', p.astype(mv.dtype), mv)
    return out.reshape(b, s, h * d)


def hier_moe(xn, w_rg, b_rg, w_re, b_re, w_e_in, w_e_out):
    b, s, d = xn.shape
    t = xn.reshape(b * s, d)
    n_tok = t.shape[0]
    g_logits = (t @ w_rg).astype(jnp.float32) + b_rg.astype(jnp.float32)
    g_prob = jax.nn.softmax(g_logits, axis=-1)
    grp = jnp.argmax(g_logits, axis=-1)
    p_grp = jnp.take_along_axis(g_prob, grp[:, None], axis=-1)
    e_logits = ((t @ w_re).astype(jnp.float32) + b_re.astype(jnp.float32)).reshape(
        n_tok, N_GROUPS, EXPERTS_PER_GROUP)
    e_logits = jnp.take_along_axis(e_logits, grp[:, None, None], axis=1)[:, 0]
    e_prob = jax.nn.softmax(e_logits, axis=-1)
    top_w, top_i = lax.top_k(e_prob, TOP_K_EXPERTS)
    top_w = top_w / jnp.sum(top_w, axis=-1, keepdims=True)
    expert_id = grp[:, None] * EXPERTS_PER_GROUP + top_i
    combine = p_grp * top_w
    cw = jnp.sum(jax.nn.one_hot(expert_id, N_EXPERTS, dtype=jnp.float32) * combine[..., None], axis=1)
    y = jnp.zeros((n_tok, d), jnp.float32)
    for e in range(N_EXPERTS):
        gu = t @ w_e_in[e]
        hid = jax.nn.silu(gu[:, :D_EXPERT]) * gu[:, D_EXPERT:]
        y = y + cw[:, e:e + 1] * (hid @ w_e_out[e]).astype(jnp.float32)
    return y.astype(xn.dtype).reshape(b, s, d)


def setup_inputs(seed: int = 0) -> dict:
    key = jax.random.key(seed)
    ks = jax.random.split(key, 32)
    f32 = jnp.float32
    L, D = DEPTH, D_MODEL

    def nrm(k, shape, scale):
        return jax.random.normal(k, shape, f32) * scale

    x = jax.random.normal(ks[0], (BATCH, SEQ, D), f32)
    offsets = jax.random.randint(ks[1], (BATCH, 1), 0, 4096, dtype=jnp.int32)
    positions = offsets + jnp.arange(SEQ, dtype=jnp.int32)[None, :]
    mem = jax.random.normal(ks[2], (BATCH, MEM_LEN, D), f32)
    return {
        "x": x,
        "positions": positions,
        "mem": mem,
        "g_mix": 1.0 + nrm(ks[3], (L, D), 0.02),
        "w_in": nrm(ks[4], (L, D, D_IN_PROJ), D ** -0.5),
        "b_gate": nrm(ks[5], (L, W_GATES), 0.1),
        "lambda_q1": nrm(ks[6], (L, DIFF_QK_DIM), 0.1),
        "lambda_k1": nrm(ks[7], (L, DIFF_QK_DIM), 0.1),
        "lambda_q2": nrm(ks[8], (L, DIFF_QK_DIM), 0.1),
        "lambda_k2": nrm(ks[9], (L, DIFF_QK_DIM), 0.1),
        "g_diff_sub": 1.0 + nrm(ks[10], (L, DIFF_V_DIM), 0.02),
        "g_mem": 1.0 + nrm(ks[11], (L, D), 0.02),
        "w_mem_kv": nrm(ks[12], (L, D, 2 * W_MEM_Q), D ** -0.5),
        "w_br_diff": nrm(ks[13], (L, W_DIFF_V, D), W_DIFF_V ** -0.5),
        "w_br_dsa": nrm(ks[14], (L, W_DSA, D), W_DSA ** -0.5),
        "w_br_mem": nrm(ks[15], (L, W_MEM_Q, D), W_MEM_Q ** -0.5),
        "w_out": nrm(ks[16], (L, D, D), D ** -0.5),
        "g_ffn": 1.0 + nrm(ks[17], (L, D), 0.02),
        "w_route_group": nrm(ks[18], (L, D, N_GROUPS), D ** -0.5),
        "b_route_group": nrm(ks[19], (L, N_GROUPS), 0.01),
        "w_route_expert": nrm(ks[20], (L, D, N_EXPERTS), D ** -0.5),
        "b_route_expert": nrm(ks[21], (L, N_EXPERTS), 0.01),
        "w_exp_in": nrm(ks[22], (L, N_EXPERTS, D, 2 * D_EXPERT), D ** -0.5),
        "w_exp_out": nrm(ks[23], (L, N_EXPERTS, D_EXPERT, D), D_EXPERT ** -0.5),
        "g_final": 1.0 + nrm(ks[24], (D,), 0.02),
    }


def reference(x, positions, mem, g_mix, w_in, b_gate, lambda_q1, lambda_k1, lambda_q2, lambda_k2,
              g_diff_sub, g_mem, w_mem_kv, w_br_diff, w_br_dsa, w_br_mem, w_out, g_ffn,
              w_route_group, b_route_group, w_route_expert, b_route_expert, w_exp_in, w_exp_out,
              g_final):
    b, s, d = x.shape
    m = mem.shape[1]
    top_k = min(TOPK_MAX, s // 4)
    h = x
    for l in range(DEPTH):
        lam_init = 0.8 - 0.6 * math.exp(-0.3 * l)
        n = rmsnorm(h, g_mix[l])
        proj = n @ w_in[l]
        dq, dk, dv, sq, sk, sv, iq, ik, iw, mq, gl = jnp.split(proj, SPLIT_POINTS, axis=-1)

        dq = partial_rope(dq.reshape(b, s, DIFF_HEADS, 2, DIFF_QK_DIM), positions)
        dk = partial_rope(dk.reshape(b, s, DIFF_HEADS, 2, DIFF_QK_DIM), positions)
        dv = dv.reshape(b, s, DIFF_HEADS, DIFF_V_DIM)
        lam = (jnp.exp(jnp.sum(lambda_q1[l].astype(jnp.float32) * lambda_k1[l].astype(jnp.float32)))
               - jnp.exp(jnp.sum(lambda_q2[l].astype(jnp.float32) * lambda_k2[l].astype(jnp.float32)))
               + lam_init)
        y_diff = diff_attention(dq[..., 0, :], dq[..., 1, :], dk[..., 0, :], dk[..., 1, :], dv,
                                lam, g_diff_sub[l], lam_init)

        sq = partial_rope(sq.reshape(b, s, DSA_HEADS, DSA_HEAD_DIM), positions)
        sk = partial_rope(sk.reshape(b, s, DSA_HEADS, DSA_HEAD_DIM), positions)
        sv = sv.reshape(b, s, DSA_HEADS, DSA_HEAD_DIM)
        iq = partial_rope(iq.reshape(b, s, IDX_HEADS, IDX_DIM), positions)
        ik = partial_rope(ik, positions)
        y_dsa = dsa_attention(sq, sk, sv, iq, ik, iw, top_k)

        mkv = rmsnorm(mem, g_mem[l]) @ w_mem_kv[l]
        mk = mkv[..., :W_MEM_Q].reshape(b, m, XA_HEADS, XA_HEAD_DIM)
        mv = mkv[..., W_MEM_Q:].reshape(b, m, XA_HEADS, XA_HEAD_DIM)
        y_mem = memory_attention(mq.reshape(b, s, XA_HEADS, XA_HEAD_DIM), mk, mv)

        gates = jax.nn.sigmoid((gl + b_gate[l]).astype(jnp.float32)).astype(h.dtype).reshape(b, s, N_BRANCH, d)
        merged = (gates[:, :, 0] * (y_diff @ w_br_diff[l])
                  + gates[:, :, 1] * (y_dsa @ w_br_dsa[l])
                  + gates[:, :, 2] * (y_mem @ w_br_mem[l]))
        h = h + merged @ w_out[l]

        h = h + hier_moe(rmsnorm(h, g_ffn[l]), w_route_group[l], b_route_group[l],
                         w_route_expert[l], b_route_expert[l], w_exp_in[l], w_exp_out[l])
    return rmsnorm(h, g_final)
```

```cpp
#include <hip/hip_runtime.h>
#include <stdint.h>
#include <type_traits>

typedef unsigned short bf16_t;

#define S_LEN 8192
#define NBATCH 4
#define T_TOK 32768
#define DM 1024
#define DPROJ 7240
#define LIST_CAP 32768

__device__ __forceinline__ float bf2f(bf16_t v) { return __uint_as_float(((unsigned)v) << 16); }
__device__ __forceinline__ bf16_t f2bf(float f) { unsigned u = __float_as_uint(f); u += 0x7fffu + ((u >> 16) & 1u); return (bf16_t)(u >> 16); }

__device__ __forceinline__ float xhalf_max(float x) {
    const auto r = __builtin_amdgcn_permlane32_swap(__float_as_uint(x), __float_as_uint(x), false, false);
    float m; asm("v_max_f32 %0, %1, %2" : "=v"(m) : "v"(r[0]), "v"(r[1])); return m;
}
__device__ __forceinline__ float xhalf_sum(float x) {
    const auto r = __builtin_amdgcn_permlane32_swap(__float_as_uint(x), __float_as_uint(x), false, false);
    return __uint_as_float(r[0]) + __uint_as_float(r[1]);
}
template <int CTRL> __device__ __forceinline__ float dpp_movf(float v) { return __int_as_float(__builtin_amdgcn_update_dpp(0, __float_as_int(v), CTRL, 0xF, 0xF, true)); }
template <int CTRL> __device__ __forceinline__ int dpp_movi(int v) { return __builtin_amdgcn_update_dpp(0, v, CTRL, 0xF, 0xF, true); }
__device__ __forceinline__ float wave_sum(float v) {
    v += dpp_movf<0xB1>(v); v += dpp_movf<0x4E>(v); v += dpp_movf<0x141>(v); v += dpp_movf<0x140>(v);
    { const auto r = __builtin_amdgcn_permlane16_swap(__float_as_uint(v), __float_as_uint(v), false, false); v = __uint_as_float(r[0]) + __uint_as_float(r[1]); }
    { const auto r = __builtin_amdgcn_permlane32_swap(__float_as_uint(v), __float_as_uint(v), false, false); v = __uint_as_float(r[0]) + __uint_as_float(r[1]); }
    return v;
}
__device__ __forceinline__ float wave_max(float v) {
    v = fmaxf(v, dpp_movf<0xB1>(v)); v = fmaxf(v, dpp_movf<0x4E>(v)); v = fmaxf(v, dpp_movf<0x141>(v)); v = fmaxf(v, dpp_movf<0x140>(v));
    { const auto r = __builtin_amdgcn_permlane16_swap(__float_as_uint(v), __float_as_uint(v), false, false); v = fmaxf(__uint_as_float(r[0]), __uint_as_float(r[1])); }
    { const auto r = __builtin_amdgcn_permlane32_swap(__float_as_uint(v), __float_as_uint(v), false, false); v = fmaxf(__uint_as_float(r[0]), __uint_as_float(r[1])); }
    return v;
}
__device__ __forceinline__ int wave_sum_i(int v) {
    v += dpp_movi<0xB1>(v); v += dpp_movi<0x4E>(v); v += dpp_movi<0x141>(v); v += dpp_movi<0x140>(v);
    { const auto r = __builtin_amdgcn_permlane16_swap((unsigned)v, (unsigned)v, false, false); v = (int)(r[0] + r[1]); }
    { const auto r = __builtin_amdgcn_permlane32_swap((unsigned)v, (unsigned)v, false, false); v = (int)(r[0] + r[1]); }
    return v;
}
__device__ __forceinline__ float block_sum(float v, float* red) {
    v = wave_sum(v);
    __syncthreads();
    if ((threadIdx.x & 63) == 0) red[threadIdx.x >> 6] = v;
    __syncthreads();
    return red[0] + red[1] + red[2] + red[3];
}
__device__ __forceinline__ int block_sum_i(int v, int* red) {
    v = wave_sum_i(v);
    __syncthreads();
    if ((threadIdx.x & 63) == 0) red[threadIdx.x >> 6] = v;
    __syncthreads();
    return red[0] + red[1] + red[2] + red[3];
}

struct Route { int e0, e1; float c0, c1; };
#define XB_TMO      128
#define XB_XCNT(j)  (256  + 64 * (j))
#define XB_XSUB(j)  (1280 + 64 * (j))
#define XB_XGEN(j)  (2304 + 64 * (j))
#define XB_TOP      3328
#define XB_TOPGEN   3392
#define XCD_BAR_WORDS 3456
#define XB_SPIN_CAP (1u << 18)
#define LAS __attribute__((address_space(3)))

__device__ __forceinline__ unsigned xb_ld(unsigned* p)              { return __hip_atomic_load(p, __ATOMIC_RELAXED, __HIP_MEMORY_SCOPE_AGENT); }
__device__ __forceinline__ unsigned xb_add(unsigned* p, unsigned v) { return __hip_atomic_fetch_add(p, v, __ATOMIC_RELAXED, __HIP_MEMORY_SCOPE_AGENT); }
__device__ __forceinline__ unsigned xb_xcc_id() { return (unsigned)__builtin_amdgcn_s_getreg((3 << 11) | 20) & 0xFu; }
#define XB_SPIN(cond, bar) do { unsigned _sp = 0; while (cond) { __builtin_amdgcn_s_sleep(1); \
    if ((++_sp & 255u) == 0u) { if (xb_ld(&(bar)[XB_TMO])) break; if (_sp > XB_SPIN_CAP) { atomicAdd(&(bar)[XB_TMO], 1u); break; } } } } while (0)

struct XcdBarrier {
    unsigned* bar; unsigned x;
    volatile LAS unsigned* st;
};

__device__ __forceinline__ XcdBarrier xcd_barrier_post(unsigned* bar, volatile LAS unsigned* st) {
    XcdBarrier b; b.bar = bar; b.x = xb_xcc_id(); b.st = st;
    if (threadIdx.x == 0) (void)xb_add(&bar[XB_XCNT(b.x)], 1u);
    return b;
}
__device__ __forceinline__ void xcd_barrier_complete(unsigned* bar, unsigned x, unsigned& nloc, unsigned& nx) {
    const unsigned G = gridDim.x * gridDim.y * gridDim.z;
    unsigned sum, cnt, mine, sp = 0u;
    for (;;) {
        sum = 0u; cnt = 0u; mine = 0u;
#pragma unroll
        for (unsigned j = 0; j < 16; ++j) { const unsigned c = xb_ld(&bar[XB_XCNT(j)]); sum += c; cnt += (c > 0u) ? 1u : 0u; mine = (j == x) ? c : mine; }
        if (sum == G) break;
        __builtin_amdgcn_s_sleep(1);
        if ((++sp & 255u) == 0u) { if (xb_ld(&bar[XB_TMO])) break; if (sp > XB_SPIN_CAP) { atomicAdd(&bar[XB_TMO], 1u); break; } }
    }
    nloc = mine > 0u ? mine : 1u; nx = cnt > 0u ? cnt : 1u;
}

__device__ __forceinline__ void xcd_barrier(const XcdBarrier& b) {
    asm volatile("s_waitcnt vmcnt(0)" ::: "memory");
    __syncthreads();
    if (threadIdx.x == 0) {
        unsigned* bar = b.bar;
        __builtin_amdgcn_s_waitcnt(0);
        unsigned nloc = b.st[0], nx = b.st[1];
        if (nloc == 0u) { xcd_barrier_complete(bar, b.x, nloc, nx); b.st[0] = nloc; b.st[1] = nx; }
        const unsigned old = xb_add(&bar[XB_XSUB(b.x)], 1u);
        const unsigned gen = old / nloc;
        if (old + 1u == (gen + 1u) * nloc) {
            __builtin_amdgcn_fence(__ATOMIC_RELEASE, "agent");
            asm volatile("s_waitcnt vmcnt(0)" ::: "memory");
            const unsigned og = xb_add(&bar[XB_TOP], 1u);
            const unsigned tg = og / nx;
            if (og + 1u == (tg + 1u) * nx) xb_add(&bar[XB_TOPGEN], 1u);
            else XB_SPIN(xb_ld(&bar[XB_TOPGEN]) == tg, bar);
            __builtin_amdgcn_fence(__ATOMIC_ACQUIRE, "agent");
            xb_add(&bar[XB_XGEN(b.x)], 1u);
            asm volatile("s_waitcnt vmcnt(0)" ::: "memory");
        } else {
            XB_SPIN(xb_ld(&bar[XB_XGEN(b.x)]) == gen, bar);
            __builtin_amdgcn_fence(__ATOMIC_ACQUIRE, "agent");
            asm volatile("s_waitcnt vmcnt(0)" ::: "memory");
        }
    }
    __syncthreads();
}


#define XB_SPLIT 4096
__device__ __forceinline__ void xcd_split_arrive(const XcdBarrier& b) {
    asm volatile("s_waitcnt vmcnt(0)" ::: "memory");
    __syncthreads();
    if (threadIdx.x == 0) {
        __builtin_amdgcn_s_waitcnt(0);
        __builtin_amdgcn_fence(__ATOMIC_RELEASE, "agent");
        asm volatile("s_waitcnt vmcnt(0)" ::: "memory");
        (void)xb_add(&b.bar[XB_SPLIT], 1u);
    }
}
__device__ __forceinline__ void xcd_split_wait(const XcdBarrier& b) {
    __syncthreads();
    if (threadIdx.x == 0) {
        const unsigned G = gridDim.x * gridDim.y * gridDim.z;
        XB_SPIN(xb_ld(&b.bar[XB_SPLIT]) < G, b.bar);
        __builtin_amdgcn_fence(__ATOMIC_ACQUIRE, "agent");
        asm volatile("s_waitcnt vmcnt(0)" ::: "memory");
    }
    __syncthreads();
}
typedef __attribute__((ext_vector_type(8))) __bf16 bf16x8;
typedef __attribute__((ext_vector_type(16))) float f32x16;
typedef __attribute__((ext_vector_type(4))) float f32x4;
#define NTHR 256
#define LDSK 72
#define SMEM_BYTES 81920

struct P {
    const float* x; const int* pos; const float* mem; const float* g_mix; const float* w_in; const float* b_gate;
    const float* lq1; const float* lk1; const float* lq2; const float* lk2; const float* g_sub; const float* g_mem; const float* w_mkv;
    const float* w_br0; const float* w_br1; const float* w_br2; const float* w_out; const float* g_ffn;
    const float* w_rg; const float* b_rg; const float* w_re; const float* b_re; const float* w_ei; const float* w_eo; const float* g_fin;
    float* out;
    unsigned* bar; int* CNT;
    bf16_t* NBUF; bf16_t* DQ; bf16_t* DK; bf16_t* DVT; bf16_t* SQ; bf16_t* SK; bf16_t* SVT; bf16_t* IQ; bf16_t* MQ; bf16_t* IK; float* IW; unsigned* MASK;
    bf16_t* MK; bf16_t* MVT; bf16_t* MEMN; float* ROPEC; float* ROPES;
    bf16_t* WIN; bf16_t* WBR; bf16_t* WOUT; bf16_t* WMKV; bf16_t* WEI; bf16_t* WEO;
    bf16_t* YD; bf16_t* YS; bf16_t* YM; bf16_t* MERGED; bf16_t* HID; bf16_t* YMOE; Route* ROUTE; int* LIST; unsigned* SGS; int* XC; bf16_t* HB;
};

__device__ __forceinline__ int opaque_tid() { int t = threadIdx.x; asm volatile("" : "+v"(t)); return t; }
typedef __bf16 bf16x2v_t __attribute__((ext_vector_type(2)));
typedef float f32x2c_t __attribute__((ext_vector_type(2)));
__device__ __forceinline__ unsigned cvt_pk_bf16_ord(float lo, float hi) { unsigned r; asm volatile("s_nop 0\n\tv_cvt_pk_bf16_f32 %0, %1, %2" : "=v"(r) : "v"(lo), "v"(hi)); return r; }
__device__ __forceinline__ unsigned cvt_pk_bf16(float lo, float hi) { const f32x2c_t v = {lo, hi}; const bf16x2v_t r = __builtin_convertvector(v, bf16x2v_t); return __builtin_bit_cast(unsigned, r); }

template <int MAP> __device__ __forceinline__ int colmap(int n) {
    if (MAP == 1) return n < 3584 ? n : n < 4096 ? n + 72 : n < 4168 ? n - 512 : n < 4224 ? -1 : n - 56;
    if (MAP == 2) { const int c = n >> 6, j = n & 63; return j < 32 ? 32 * c + j : 512 + 32 * c + (j - 32); }
    return n;
}
template <int MAP, int NTL> __device__ __forceinline__ void tconv_tile(const float* __restrict__ src, int ld, int K, bf16_t* __restrict__ dst, int tile, float* tl) {
    const int n0 = (tile % NTL) * 64, k0 = (tile / NTL) * 64;
    const int t = opaque_tid(); const int nn = (t & 15) * 4; const int c = colmap<MAP>(n0 + nn);
#pragma unroll
    for (int i = 0; i < 4; ++i) { const int kk = (t >> 4) + 16 * i;
        const float4 v = c >= 0 ? *(const float4*)(src + (size_t)(k0 + kk) * ld + c) : make_float4(0.f, 0.f, 0.f, 0.f);
        tl[kk * 65 + nn] = v.x; tl[kk * 65 + nn + 1] = v.y; tl[kk * 65 + nn + 2] = v.z; tl[kk * 65 + nn + 3] = v.w; }
    __syncthreads();
#pragma unroll
    for (int i = 0; i < 2; ++i) { const int cc = t + 256 * i; const int n2 = cc >> 3, kc = (cc & 7) * 8;
        uint4 o; o.x = cvt_pk_bf16(tl[(kc + 0) * 65 + n2], tl[(kc + 1) * 65 + n2]); o.y = cvt_pk_bf16(tl[(kc + 2) * 65 + n2], tl[(kc + 3) * 65 + n2]);
        o.z = cvt_pk_bf16(tl[(kc + 4) * 65 + n2], tl[(kc + 5) * 65 + n2]); o.w = cvt_pk_bf16(tl[(kc + 6) * 65 + n2], tl[(kc + 7) * 65 + n2]);
        *(uint4*)(dst + (size_t)(n0 + n2) * K + k0 + kc) = o; }
    __syncthreads();
}
#define TC_WIN 1824
#define TC_WBR (TC_WIN + 384)
#define TC_WOUT (TC_WBR + 256)
#define TC_WMKV (TC_WOUT + 256)
#define TC_WEI (TC_WMKV + 4096)
#define TC_WEO (TC_WEI + 2048)
__device__ void phase_prologue(const P& p, char* smem, int bid, int nblk) {
    float* tl = (float*)smem;
    const int tidp = opaque_tid();
    for (int g = bid; g < TC_WEO; g += nblk) {
        if (g < TC_WIN) tconv_tile<1, 114>(p.w_in, DPROJ, 1024, p.WIN, g, tl);
        else if (g < TC_WBR) { const int j = (g - TC_WIN) >> 7; const float* s = j == 0 ? p.w_br0 : j == 1 ? p.w_br1 : p.w_br2; tconv_tile<0, 16>(s, 1024, 512, p.WBR + (size_t)j * 1024 * 512, (g - TC_WIN) & 127, tl); }
        else if (g < TC_WOUT) tconv_tile<0, 16>(p.w_out, 1024, 1024, p.WOUT, g - TC_WBR, tl);
        else if (g < TC_WMKV) tconv_tile<0, 16>(p.w_mkv, 1024, 1024, p.WMKV, g - TC_WOUT, tl);
        else if (g < TC_WEI) { const int e = (g - TC_WMKV) >> 8; tconv_tile<2, 16>(p.w_ei + (size_t)e * 1024 * 1024, 1024, 1024, p.WEI + (size_t)e * 1024 * 1024, (g - TC_WMKV) & 255, tl); }
        else { const int e = (g - TC_WEI) >> 7; tconv_tile<0, 16>(p.w_eo + (size_t)e * 512 * 1024, 1024, 512, p.WEO + (size_t)e * 1024 * 512, (g - TC_WEI) & 127, tl); }
    }
    const int lane = tidp & 63; const int gw = bid * 4 + (tidp >> 6), nw = nblk * 4;
    for (int row = gw; row < T_TOK + 1024; row += nw) {
        const float* src; const float* g; bf16_t* dst;
        if (row < T_TOK) { src = p.x + (size_t)row * DM; g = p.g_mix; dst = p.NBUF + (size_t)row * DM; }
        else { src = p.mem + (size_t)(row - T_TOK) * DM; g = p.g_mem; dst = p.MEMN + (size_t)(row - T_TOK) * DM; }
        float4 v[4]; float ss = 0.f;
#pragma unroll
        for (int i = 0; i < 4; ++i) { v[i] = *(const float4*)(src + i * 256 + lane * 4); ss += v[i].x * v[i].x + v[i].y * v[i].y + v[i].z * v[i].z + v[i].w * v[i].w; }
        ss = wave_sum(ss);
        const float r = rsqrtf(ss * (1.0f / DM) + 1e-6f);
#pragma unroll
        for (int i = 0; i < 4; ++i) { const float4 gg = *(const float4*)(g + i * 256 + lane * 4);
            uint2 o; o.x = cvt_pk_bf16(v[i].x * r * gg.x, v[i].y * r * gg.y); o.y = cvt_pk_bf16(v[i].z * r * gg.z, v[i].w * r * gg.w);
            *(uint2*)(dst + i * 256 + lane * 4) = o; }
    }
    for (int i = bid * NTHR + tidp; i < T_TOK * 8; i += nblk * NTHR) {
        const float inv = powf(500000.0f, -(float)(i & 7) / 8.0f);
        const float ang = (float)p.pos[i >> 3] * inv;
        float sn, cs; sincosf(ang, &sn, &cs);
        p.ROPEC[i] = cs; p.ROPES[i] = sn;
    }
    if (bid == 0 && tidp < 16) p.CNT[tidp] = 0;
}


struct Sched { int x, j; };
struct XOrder {
    int x, j, J, nblk, bid;
    __device__ __forceinline__ XOrder(int bid_, int nblk_, const Sched& s) : x(s.x), j(s.j), J(nblk_ >> 3), nblk(nblk_), bid(bid_) {}
    __device__ __forceinline__ bool round(int r, int N, int& u) const {
        if ((nblk & 7) != 0) { u = r * nblk + bid; if (r * nblk >= N) return false; if (u >= N) u = -1; return true; }
        const int c = r * 8 + x; if (r * 8 * J >= N) return false; u = c * J + j; if (u >= N) u = -1; return true;
    }
};
__device__ __forceinline__ void tile_mn(int u, int NT, int& mt, int& nt) { const int g = u / (8 * NT), rem = u - g * 8 * NT; nt = rem >> 3; mt = g * 8 + (rem & 7); }

__device__ __forceinline__ int gl_row(int tid, int q) { return (tid >> 6) * 32 + q * 8 + ((tid & 63) >> 3); }
__device__ __forceinline__ unsigned gl_col(int tid, int row) { return (unsigned)(((tid & 7) ^ ((row >> 1) & 7)) * 8); }
__device__ __forceinline__ void gemm_mainloop(const bf16_t* __restrict__ Rb, unsigned or0, unsigned or1, unsigned or2, unsigned or3,
                                              const bf16_t* __restrict__ Lb, unsigned ol0, unsigned ol1, unsigned ol2, unsigned ol3, int K, f32x16 (&acc)[2][2], bf16_t* As, bf16_t* Bs) {
    const int tid = opaque_tid(), lane = tid & 63, wid = tid >> 6, wr = wid >> 1, wc = wid & 1;
    const int nk = K >> 6;
    LAS unsigned* ldsA = (LAS unsigned*)(As + wid * 32 * 64);
    LAS unsigned* ldsB = (LAS unsigned*)(Bs + wid * 32 * 64);
    const int sw = (lane >> 1) & 7;
    const bf16_t* ard = As + (wr * 64 + (lane & 31)) * 64;
    const bf16_t* brd = Bs + (wc * 64 + (lane & 31)) * 64;
    const int lh = lane >> 5;
#define GLDS_TILE(stage_, ko_) { \
    __builtin_amdgcn_global_load_lds((const unsigned*)(Rb + or0 + (ko_)), (LAS unsigned*)((LAS char*)ldsA + (stage_) * 32768), 16, 0, 0); \
    __builtin_amdgcn_global_load_lds((const unsigned*)(Rb + or1 + (ko_)), (LAS unsigned*)((LAS char*)ldsA + (stage_) * 32768 + 1024), 16, 0, 0); \
    __builtin_amdgcn_global_load_lds((const unsigned*)(Rb + or2 + (ko_)), (LAS unsigned*)((LAS char*)ldsA + (stage_) * 32768 + 2048), 16, 0, 0); \
    __builtin_amdgcn_global_load_lds((const unsigned*)(Rb + or3 + (ko_)), (LAS unsigned*)((LAS char*)ldsA + (stage_) * 32768 + 3072), 16, 0, 0); \
    __builtin_amdgcn_global_load_lds((const unsigned*)(Lb + ol0 + (ko_)), (LAS unsigned*)((LAS char*)ldsB + (stage_) * 32768), 16, 0, 0); \
    __builtin_amdgcn_global_load_lds((const unsigned*)(Lb + ol1 + (ko_)), (LAS unsigned*)((LAS char*)ldsB + (stage_) * 32768 + 1024), 16, 0, 0); \
    __builtin_amdgcn_global_load_lds((const unsigned*)(Lb + ol2 + (ko_)), (LAS unsigned*)((LAS char*)ldsB + (stage_) * 32768 + 2048), 16, 0, 0); \
    __builtin_amdgcn_global_load_lds((const unsigned*)(Lb + ol3 + (ko_)), (LAS unsigned*)((LAS char*)ldsB + (stage_) * 32768 + 3072), 16, 0, 0); }
    __syncthreads();
    GLDS_TILE(0, 0u)
    __syncthreads();
    for (int kt = 0; kt < nk; ++kt) {
        const int cur = (kt & 1) * 16384;
        if (kt + 1 < nk) { if (kt & 1) GLDS_TILE(0, (unsigned)(kt + 1) * 64u) else GLDS_TILE(1, (unsigned)(kt + 1) * 64u) }
#pragma unroll
        for (int ks = 0; ks < 4; ++ks) {
            const int cc = ((2 * ks + lh) ^ sw) * 8;
            const bf16x8 fa0 = *(const bf16x8*)(ard + cur + cc), fa1 = *(const bf16x8*)(ard + cur + 32 * 64 + cc);
            const bf16x8 fb0 = *(const bf16x8*)(brd + cur + cc), fb1 = *(const bf16x8*)(brd + cur + 32 * 64 + cc);
            acc[0][0] = __builtin_amdgcn_mfma_f32_32x32x16_bf16(fa0, fb0, acc[0][0], 0, 0, 0);
            acc[0][1] = __builtin_amdgcn_mfma_f32_32x32x16_bf16(fa0, fb1, acc[0][1], 0, 0, 0);
            acc[1][0] = __builtin_amdgcn_mfma_f32_32x32x16_bf16(fa1, fb0, acc[1][0], 0, 0, 0);
            acc[1][1] = __builtin_amdgcn_mfma_f32_32x32x16_bf16(fa1, fb1, acc[1][1], 0, 0, 0);
        }
        __syncthreads();
    }
#undef GLDS_TILE
}
#define ZERO_ACC(acc) { _Pragma("unroll") for (int i_ = 0; i_ < 2; ++i_) _Pragma("unroll") for (int j_ = 0; j_ < 2; ++j_) _Pragma("unroll") for (int r_ = 0; r_ < 16; ++r_) acc[i_][j_][r_] = 0.f; }
#define CSTR 136
__device__ __forceinline__ void cimg_write(const f32x16 (&acc)[2][2], bf16_t* Cs, int wr, int wc, int l31, int lh) {
#pragma unroll
    for (int i = 0; i < 2; ++i)
#pragma unroll
        for (int j = 0; j < 2; ++j)
#pragma unroll
            for (int g = 0; g < 4; ++g) { uint2 o; o.x = cvt_pk_bf16(acc[i][j][4 * g], acc[i][j][4 * g + 1]); o.y = cvt_pk_bf16(acc[i][j][4 * g + 2], acc[i][j][4 * g + 3]);
                *(uint2*)(Cs + (64 * wc + 32 * j + l31) * CSTR + 64 * wr + 32 * i + 8 * g + 4 * lh) = o; }
}

template <int NOEPI> __device__ void phase_inproj(const P& p, char* smem, int bid, int nblk, const Sched& sc) {
    bf16_t* As = (bf16_t*)smem; bf16_t* Bs = As + 128 * 64; bf16_t* Cs = (bf16_t*)smem;
    const int tid = opaque_tid(), lane = tid & 63, wid = tid >> 6, wr = wid >> 1, wc = wid & 1;
    const int l31 = lane & 31, lh = lane >> 5;
    const int NT = 33, NMAIN = 256 * NT;
    const XOrder xo(bid, nblk, sc);
    const bool xaware = false;
    for (int rr = 0; ; ++rr) {
        bool main_t; int mt, nt;
        if (xaware) {
            if (rr < 16) { main_t = true; mt = ((sc.x >> 2) * 16 + rr) * 8 + (sc.j & 7); nt = (sc.x & 3) * 8 + (sc.j >> 3); }
            else if (rr == 16) { if (bid >= 320) break; main_t = bid < 256; mt = main_t ? bid : (bid - 256) >> 3; nt = main_t ? 32 : (bid - 256) & 7; }
            else break;
        } else {
            int t; if (!xo.round(rr, NMAIN + 64, t)) break; if (t < 0) continue;
            main_t = t < NMAIN;
            if (main_t) tile_mn(t, NT, mt, nt); else { mt = (t - NMAIN) >> 3; nt = (t - NMAIN) & 7; }
        }
        const bf16_t* X = main_t ? p.NBUF : p.MEMN; const bf16_t* W = main_t ? p.WIN : p.WMKV;
        const int grp = main_t ? (nt >> 2) : (nt < 4 ? 7 : 2);
        const bool transposed = grp == 2 || grp == 5;
        const int g0 = gl_row(tid, 0); const unsigned to = (unsigned)g0 * 1024u + gl_col(tid, g0);
        const unsigned t1 = (unsigned)(g0 + 8) * 1024u + gl_col(tid, g0 + 8), t2 = (unsigned)(g0 + 16) * 1024u + gl_col(tid, g0 + 16), t3 = (unsigned)(g0 + 24) * 1024u + gl_col(tid, g0 + 24);
        const bf16_t* Xt = X + (size_t)mt * 128 * 1024; const bf16_t* Wt = W + (size_t)nt * 128 * 1024;
        f32x16 acc[2][2]; ZERO_ACC(acc);
        gemm_mainloop(transposed ? Xt : Wt, to, t1, t2, t3, transposed ? Wt : Xt, to, t1, t2, t3, 1024, acc, As, Bs);
        if (NOEPI) { float s_ = 0.f; for (int i_ = 0; i_ < 2; ++i_) for (int j_ = 0; j_ < 2; ++j_) for (int r_ = 0; r_ < 16; ++r_) s_ += acc[i_][j_][r_]; if (s_ == 1.2345e30f) p.IW[0] = s_; continue; }
        const int tok0 = mt * 128;
        if (main_t && !transposed && grp != 7) {
            if (grp != 8 || wr == 0) {
#pragma unroll
                for (int j = 0; j < 2; ++j) { const int tok = tok0 + 64 * wc + 32 * j + l31;
                    const float4 c4 = *(const float4*)(p.ROPEC + (size_t)tok * 8 + 4 * lh), s4 = *(const float4*)(p.ROPES + (size_t)tok * 8 + 4 * lh);
                    const float cc[4] = {c4.x, c4.y, c4.z, c4.w}, ss[4] = {s4.x, s4.y, s4.z, s4.w};
#pragma unroll
                    for (int r = 0; r < 4; ++r) { const float x1 = acc[0][j][r], x2 = acc[0][j][r + 4]; acc[0][j][r] = x1 * cc[r] - x2 * ss[r]; acc[0][j][r + 4] = x2 * cc[r] + x1 * ss[r]; } }
            }
        }
        if (grp == 8 && wr == 1) {
#pragma unroll
            for (int j = 0; j < 2; ++j) { const int tok = tok0 + 64 * wc + 32 * j + l31; *(float4*)(p.IW + (size_t)tok * 8 + 4 * lh) = make_float4(acc[0][j][0], acc[0][j][1], acc[0][j][2], acc[0][j][3]); }
        }
        __syncthreads();
        cimg_write(acc, Cs, wr, wc, l31, lh);
        __syncthreads();
        bf16_t* dbase; size_t dstride; int nch = 16;
        if (!main_t) {
            if (nt < 4) { dbase = p.MK + (size_t)tok0 * 512 + nt * 128; dstride = 512; }
            else { dbase = p.MVT + ((size_t)((mt >> 1) * 4 + (nt - 4)) * 128) * 256 + (mt & 1) * 128; dstride = 256; }
        } else if (grp == 2) { dbase = p.DVT + ((size_t)((mt >> 6) * 4 + (nt - 8)) * 128) * S_LEN + (mt & 63) * 128; dstride = S_LEN; }
        else if (grp == 5) { dbase = p.SVT + ((size_t)((mt >> 6) * 8 + (nt - 20) * 2) * 64) * S_LEN + (mt & 63) * 128; dstride = S_LEN; }
        else if (grp == 8) { dbase = p.IK + (size_t)tok0 * 64; dstride = 64; nch = 8; }
        else { bf16_t* d = grp == 0 ? p.DQ : grp == 1 ? p.DK : grp == 3 ? p.SQ : grp == 4 ? p.SK : grp == 6 ? p.IQ : p.MQ; dbase = d + (size_t)tok0 * 512 + (nt & 3) * 128; dstride = 512; }
        int te_ = tid; asm volatile("" : "+v"(te_));
#pragma unroll
        for (int k = 0; k < 8; ++k) { const int c = te_ + 256 * k; const int lrow = c >> 4, ch = c & 15;
            if (ch < nch) { const uint4 v = *(const uint4*)(Cs + lrow * CSTR + ch * 8); *(uint4*)(dbase + (size_t)lrow * dstride + ch * 8) = v; } }
    }
}
template <int REPS = 1> __device__ void phase_merge(const P& p, char* smem, int bid, int nblk, const Sched& sc) {
    bf16_t* As = (bf16_t*)smem; bf16_t* Bs = As + 128 * 64; bf16_t* Cs = (bf16_t*)smem;
    const int tid = opaque_tid(), lane = tid & 63, wid = tid >> 6, wr = wid >> 1, wc = wid & 1;
    const int l31 = lane & 31, lh = lane >> 5;
    const XOrder xo(bid, nblk, sc);
    const bool xaware = false;
#pragma unroll 1
    for (int rep = 0; rep < REPS; ++rep)
    for (int rr = 0; ; ++rr) {
        int mt, nt;
        if (xaware) { if (rr >= 4) break; nt = sc.x; mt = rr * 64 + sc.j; }
        else { int t; if (!xo.round(rr, 256 * 8, t)) break; if (t < 0) continue; tile_mn(t, 8, mt, nt); }
        f32x16 mg[2][2]; ZERO_ACC(mg);
#pragma unroll 1
        for (int br = 0; br < 3; ++br) {
            int tl_ = tid; asm volatile("" : "+v"(tl_));
            unsigned sgr[8][4];
            {
                const int g0 = gl_row(tl_, 0);
                const unsigned to = (unsigned)g0 * 1024u + gl_col(tl_, g0), t1 = (unsigned)(g0 + 8) * 1024u + gl_col(tl_, g0 + 8), t2 = (unsigned)(g0 + 16) * 1024u + gl_col(tl_, g0 + 16), t3 = (unsigned)(g0 + 24) * 1024u + gl_col(tl_, g0 + 24);
                f32x16 acc[2][2]; ZERO_ACC(acc);
                gemm_mainloop(p.WIN + (size_t)(4224 + br * 1024 + nt * 128) * 1024, to, t1, t2, t3, p.NBUF + (size_t)mt * 128 * 1024, to, t1, t2, t3, 1024, acc, As, Bs);
#pragma unroll
                for (int i = 0; i < 2; ++i)
#pragma unroll
                    for (int g = 0; g < 4; ++g) { const float4 b4 = *(const float4*)(p.b_gate + br * 1024 + nt * 128 + 64 * wr + 32 * i + 8 * g + 4 * lh);
                        const float bb[4] = {b4.x, b4.y, b4.z, b4.w};
#pragma unroll
                        for (int j = 0; j < 2; ++j) { float s[4];
#pragma unroll
                            for (int r = 0; r < 4; ++r) s[r] = __builtin_amdgcn_rcpf(1.0f + __expf(-(acc[i][j][4 * g + r] + bb[r])));
                            acc[i][j][4 * g] = __uint_as_float(cvt_pk_bf16_ord(s[0], s[1])); acc[i][j][4 * g + 1] = __uint_as_float(cvt_pk_bf16_ord(s[2], s[3])); } }
#pragma unroll
                for (int i = 0; i < 2; ++i)
#pragma unroll
                    for (int j = 0; j < 2; ++j)
#pragma unroll
                        for (int h2 = 0; h2 < 2; ++h2) {
                            sgr[(i * 2 + j) * 2 + h2][0] = __float_as_uint(acc[i][j][8 * h2]); sgr[(i * 2 + j) * 2 + h2][1] = __float_as_uint(acc[i][j][8 * h2 + 1]);
                            sgr[(i * 2 + j) * 2 + h2][2] = __float_as_uint(acc[i][j][8 * h2 + 4]); sgr[(i * 2 + j) * 2 + h2][3] = __float_as_uint(acc[i][j][8 * h2 + 5]); }
                asm volatile("" ::: "memory");
            }
            {
                const bf16_t* Y = br == 0 ? p.YD : br == 1 ? p.YS : p.YM;
                int tl2_ = tid; asm volatile("" : "+v"(tl2_));
                const int g0 = gl_row(tl2_, 0);
                const unsigned to = (unsigned)g0 * 512u + gl_col(tl2_, g0), t1 = (unsigned)(g0 + 8) * 512u + gl_col(tl2_, g0 + 8), t2 = (unsigned)(g0 + 16) * 512u + gl_col(tl2_, g0 + 16), t3 = (unsigned)(g0 + 24) * 512u + gl_col(tl2_, g0 + 24);
                f32x16 acc[2][2]; ZERO_ACC(acc);
                gemm_mainloop(p.WBR + (size_t)br * 1024 * 512 + (size_t)nt * 128 * 512, to, t1, t2, t3, Y + (size_t)mt * 128 * 512, to, t1, t2, t3, 512, acc, As, Bs);
                asm volatile("" ::: "memory");
#pragma unroll
                for (int i = 0; i < 2; ++i)
#pragma unroll
                    for (int j = 0; j < 2; ++j)
#pragma unroll
                        for (int h2 = 0; h2 < 2; ++h2) { const unsigned ww[4] = {sgr[(i * 2 + j) * 2 + h2][0], sgr[(i * 2 + j) * 2 + h2][1], sgr[(i * 2 + j) * 2 + h2][2], sgr[(i * 2 + j) * 2 + h2][3]};
#pragma unroll
                            for (int q = 0; q < 2; ++q) {
                                const int g = 2 * h2 + q;
                                mg[i][j][4 * g] += __uint_as_float(ww[2 * q] << 16) * acc[i][j][4 * g];
                                mg[i][j][4 * g + 1] += __uint_as_float(ww[2 * q] & 0xffff0000u) * acc[i][j][4 * g + 1];
                                mg[i][j][4 * g + 2] += __uint_as_float(ww[2 * q + 1] << 16) * acc[i][j][4 * g + 2];
                                mg[i][j][4 * g + 3] += __uint_as_float(ww[2 * q + 1] & 0xffff0000u) * acc[i][j][4 * g + 3]; } }
            }
        }
        __syncthreads();
        cimg_write(mg, Cs, wr, wc, l31, lh);
        __syncthreads();
        bf16_t* dbase = p.MERGED + (size_t)mt * 128 * 1024 + nt * 128;
        int te_ = tid; asm volatile("" : "+v"(te_));
#pragma unroll
        for (int k = 0; k < 8; ++k) { const int c = te_ + 256 * k; const int lrow = c >> 4, ch = c & 15;
            const uint4 v = *(const uint4*)(Cs + lrow * CSTR + ch * 8); *(uint4*)(dbase + (size_t)lrow * 1024 + ch * 8) = v; }
    }
}

#define CFS 132
__device__ void phase_outproj(const P& p, char* smem, int bid, int nblk, const Sched& sc) {
    bf16_t* As = (bf16_t*)smem; bf16_t* Bs = As + 128 * 64;
    const int tid = opaque_tid(), lane = tid & 63, wid = tid >> 6, wr = wid >> 1, wc = wid & 1;
    const int l31 = lane & 31, lh = lane >> 5;
    const XOrder xo(bid, nblk, sc);
    for (int rr = 0; ; ++rr) {
        int t; if (!xo.round(rr, 256 * 8, t)) break; if (t < 0) continue;
        int mt, nt; tile_mn(t, 8, mt, nt);
        const int g0 = gl_row(tid, 0);
        const unsigned to = (unsigned)g0 * 1024u + gl_col(tid, g0), t1 = (unsigned)(g0 + 8) * 1024u + gl_col(tid, g0 + 8), t2 = (unsigned)(g0 + 16) * 1024u + gl_col(tid, g0 + 16), t3 = (unsigned)(g0 + 24) * 1024u + gl_col(tid, g0 + 24);
        f32x16 acc[2][2]; ZERO_ACC(acc);
        gemm_mainloop(p.WOUT + (size_t)nt * 128 * 1024, to, t1, t2, t3, p.MERGED + (size_t)mt * 128 * 1024, to, t1, t2, t3, 1024, acc, As, Bs);
        float* Cf = (float*)smem;
#pragma unroll
        for (int i = 0; i < 2; ++i)
#pragma unroll
            for (int j = 0; j < 2; ++j)
#pragma unroll
                for (int g = 0; g < 4; ++g)
                    *(float4*)(Cf + (64 * wc + 32 * j + l31) * CFS + 64 * wr + 32 * i + 8 * g + 4 * lh) = make_float4(acc[i][j][4 * g], acc[i][j][4 * g + 1], acc[i][j][4 * g + 2], acc[i][j][4 * g + 3]);
        __syncthreads();
        int to_ = tid; asm volatile("" : "+v"(to_));
#pragma unroll
        for (int k = 0; k < 8; ++k) { const int c = to_ + 256 * k; const int lrow = c >> 4, ch = c & 15;
            const float4 a0 = *(const float4*)(Cf + lrow * CFS + ch * 8), a1 = *(const float4*)(Cf + lrow * CFS + ch * 8 + 4);
            const size_t go = (size_t)(mt * 128 + lrow) * 1024 + nt * 128 + ch * 8;
            const float4 x0 = *(const float4*)(p.x + go), x1 = *(const float4*)(p.x + go + 4);
            uint4 o; o.x = cvt_pk_bf16(x0.x + a0.x, x0.y + a0.y); o.y = cvt_pk_bf16(x0.z + a0.z, x0.w + a0.w); o.z = cvt_pk_bf16(x1.x + a1.x, x1.y + a1.y); o.w = cvt_pk_bf16(x1.z + a1.z, x1.w + a1.w);
            *(uint4*)(p.HB + go) = o; }
    }
}

template <int VAR = 0> __device__ void phase_route(const P& p, char* smem, int bid, int nblk) {
    float4* wrg = (float4*)smem;
    const int tidp = opaque_tid();
    for (int i = tidp; i < 1024; i += NTHR) wrg[i] = *(const float4*)(p.w_rg + i * 4);
    __syncthreads();
    const int lane = tidp & 63; const int gw = bid * 4 + (tidp >> 6), nw = nblk * 4;
    for (int tok = gw; tok < T_TOK; tok += nw) {
        const bf16_t* src = p.HB + (size_t)tok * DM;
        float tv[16]; float ss = 0.f;
#pragma unroll
        for (int i = 0; i < 4; ++i) { const uint2 u = *(const uint2*)(src + i * 256 + lane * 4);
            float4 v; v.x = __uint_as_float(u.x << 16); v.y = __uint_as_float(u.x & 0xffff0000u); v.z = __uint_as_float(u.y << 16); v.w = __uint_as_float(u.y & 0xffff0000u);
            tv[4 * i] = v.x; tv[4 * i + 1] = v.y; tv[4 * i + 2] = v.z; tv[4 * i + 3] = v.w; ss += v.x * v.x + v.y * v.y + v.z * v.z + v.w * v.w; }
        ss = wave_sum(ss);
        const float r = rsqrtf(ss * (1.0f / DM) + 1e-6f);
        float g0 = 0.f, g1 = 0.f, g2 = 0.f, g3 = 0.f;
#pragma unroll
        for (int i = 0; i < 4; ++i) { const float4 gg = *(const float4*)(p.g_ffn + i * 256 + lane * 4);
            tv[4 * i] *= r * gg.x; tv[4 * i + 1] *= r * gg.y; tv[4 * i + 2] *= r * gg.z; tv[4 * i + 3] *= r * gg.w;
            uint2 o; o.x = cvt_pk_bf16(tv[4 * i], tv[4 * i + 1]); o.y = cvt_pk_bf16(tv[4 * i + 2], tv[4 * i + 3]);
            *(uint2*)((VAR ? (bf16_t*)p.SGS + (size_t)8 * 1024 * 1024 + (size_t)(tok & 16383) * DM : p.NBUF + (size_t)tok * DM) + i * 256 + lane * 4) = o;
#pragma unroll
            for (int j = 0; j < 4; ++j) { const float4 w = wrg[i * 256 + lane * 4 + j]; const float x = tv[4 * i + j]; g0 += x * w.x; g1 += x * w.y; g2 += x * w.z; g3 += x * w.w; } }
        g0 = wave_sum(g0) + p.b_rg[0]; g1 = wave_sum(g1) + p.b_rg[1]; g2 = wave_sum(g2) + p.b_rg[2]; g3 = wave_sum(g3) + p.b_rg[3];
        int grp = 0; float gm = g0;
        if (g1 > gm) { gm = g1; grp = 1; } if (g2 > gm) { gm = g2; grp = 2; } if (g3 > gm) { gm = g3; grp = 3; }
        const float pg = 1.0f / (expf(g0 - gm) + expf(g1 - gm) + expf(g2 - gm) + expf(g3 - gm));
        float e0 = 0.f, e1 = 0.f, e2 = 0.f, e3 = 0.f;
#pragma unroll
        for (int i = 0; i < 4; ++i)
#pragma unroll
            for (int j = 0; j < 4; ++j) { const float4 w = *(const float4*)(p.w_re + (size_t)(i * 256 + lane * 4 + j) * 16 + grp * 4); const float x = tv[4 * i + j]; e0 += x * w.x; e1 += x * w.y; e2 += x * w.z; e3 += x * w.w; }
        float el[4];
        el[0] = wave_sum(e0) + p.b_re[grp * 4]; el[1] = wave_sum(e1) + p.b_re[grp * 4 + 1]; el[2] = wave_sum(e2) + p.b_re[grp * 4 + 2]; el[3] = wave_sum(e3) + p.b_re[grp * 4 + 3];
        if (lane == 0 && VAR == 0) {
            int i0 = 0; float m0 = el[0];
            if (el[1] > m0) { m0 = el[1]; i0 = 1; } if (el[2] > m0) { m0 = el[2]; i0 = 2; } if (el[3] > m0) { m0 = el[3]; i0 = 3; }
            int i1 = -1; float m1 = -INFINITY;
            if (i0 != 0 && el[0] > m1) { m1 = el[0]; i1 = 0; } if (i0 != 1 && el[1] > m1) { m1 = el[1]; i1 = 1; }
            if (i0 != 2 && el[2] > m1) { m1 = el[2]; i1 = 2; } if (i0 != 3 && el[3] > m1) { m1 = el[3]; i1 = 3; }
            const float p1 = expf(m1 - m0);
            Route rt; rt.e0 = grp * 4 + i0; rt.e1 = grp * 4 + i1; rt.c0 = pg / (1.0f + p1); rt.c1 = pg * p1 / (1.0f + p1);
            p.ROUTE[tok] = rt;
            int q = atomicAdd(&p.CNT[rt.e0], 1); p.LIST[rt.e0 * LIST_CAP + q] = tok * 2;
            q = atomicAdd(&p.CNT[rt.e1], 1); p.LIST[rt.e1 * LIST_CAP + q] = tok * 2 + 1;
        }
    }
}

template <int DOWN> __device__ void phase_moe(const P& p, char* smem, int bid, int nblk, const Sched& sc) {
    bf16_t* As = (bf16_t*)smem; bf16_t* Bs = As + 128 * 64; bf16_t* Cs = (bf16_t*)smem;
    int* ents = (int*)(smem + 73728); float* cws = (float*)(ents + 128);
    const int tid = opaque_tid(), lane = tid & 63, wid = tid >> 6, wr = wid >> 1, wc = wid & 1;
    const int l31 = lane & 31, lh = lane >> 5;
    int cnt[16]; int total = 0;
#pragma unroll
    for (int e = 0; e < 16; ++e) { cnt[e] = p.CNT[e]; total += ((cnt[e] + 127) >> 7) * 8; }
    const XOrder xo(bid, nblk, sc);
    for (int rr = 0; ; ++rr) {
        int u; if (!xo.round(rr, total, u)) break; if (u < 0) continue;
        int e = 0, base = 0, ce = 0;
#pragma unroll
        for (int k = 0; k < 16; ++k) { const int n = ((cnt[k] + 127) >> 7) * 8; if (u >= base + n && k == e) { base += n; e = k + 1; } if (k == e) ce = cnt[k]; }
        const int loc = u - base; const int mt = loc >> 3, nt = loc & 7;
        const int nrows = min(128, ce - mt * 128);
        __syncthreads();
        if (tid < 128) { const int ent = p.LIST[e * LIST_CAP + mt * 128 + (tid < nrows ? tid : 0)]; ents[tid] = ent;
            if (DOWN) { const Route rt = p.ROUTE[ent >> 1]; cws[tid] = (ent & 1) ? rt.c1 : rt.c0; } }
        __syncthreads();
        const int KK = DOWN ? 512 : 1024;
        const bf16_t* Xb = DOWN ? p.HID : p.NBUF;
        int tu_ = tid; asm volatile("" : "+v"(tu_));
        const int g0 = gl_row(tu_, 0);
        const unsigned ol0 = (unsigned)(DOWN ? ents[g0] : ents[g0] >> 1) * (unsigned)KK + gl_col(tu_, g0), ol1 = (unsigned)(DOWN ? ents[g0 + 8] : ents[g0 + 8] >> 1) * (unsigned)KK + gl_col(tu_, g0 + 8);
        const unsigned ol2 = (unsigned)(DOWN ? ents[g0 + 16] : ents[g0 + 16] >> 1) * (unsigned)KK + gl_col(tu_, g0 + 16), ol3 = (unsigned)(DOWN ? ents[g0 + 24] : ents[g0 + 24] >> 1) * (unsigned)KK + gl_col(tu_, g0 + 24);
        const bf16_t* Wb = (DOWN ? p.WEO + (size_t)e * 1024 * 512 : p.WEI + (size_t)e * 1024 * 1024) + (size_t)nt * 128 * KK;
        const unsigned w0 = (unsigned)g0 * (unsigned)KK + gl_col(tu_, g0), w1 = (unsigned)(g0 + 8) * (unsigned)KK + gl_col(tu_, g0 + 8), w2 = (unsigned)(g0 + 16) * (unsigned)KK + gl_col(tu_, g0 + 16), w3 = (unsigned)(g0 + 24) * (unsigned)KK + gl_col(tu_, g0 + 24);
        f32x16 acc[2][2]; ZERO_ACC(acc);
        gemm_mainloop(Wb, w0, w1, w2, w3, Xb, ol0, ol1, ol2, ol3, KK, acc, As, Bs);
        if (DOWN) {
#pragma unroll
            for (int j = 0; j < 2; ++j) { const float c = cws[64 * wc + 32 * j + l31];
#pragma unroll
                for (int i = 0; i < 2; ++i)
#pragma unroll
                    for (int r = 0; r < 16; ++r) acc[i][j][r] *= c; }
        } else {
#pragma unroll
            for (int j = 0; j < 2; ++j)
#pragma unroll
                for (int r = 0; r < 16; ++r) { const float g = acc[0][j][r]; acc[0][j][r] = g * __builtin_amdgcn_rcpf(1.0f + __expf(-g)) * acc[1][j][r]; }
        }
        __syncthreads();
        if (DOWN) cimg_write(acc, Cs, wr, wc, l31, lh);
        else {
#pragma unroll
            for (int j = 0; j < 2; ++j)
#pragma unroll
                for (int g = 0; g < 4; ++g) { uint2 o; o.x = cvt_pk_bf16(acc[0][j][4 * g], acc[0][j][4 * g + 1]); o.y = cvt_pk_bf16(acc[0][j][4 * g + 2], acc[0][j][4 * g + 3]);
                    *(uint2*)(Cs + (64 * wc + 32 * j + l31) * CSTR + 32 * wr + 8 * g + 4 * lh) = o; }
        }
        __syncthreads();
        int te_ = tid; asm volatile("" : "+v"(te_));
        if (DOWN) {
#pragma unroll
            for (int k = 0; k < 8; ++k) { const int c = te_ + 256 * k; const int lrow = c >> 4, ch = c & 15;
                if (lrow < nrows) { const uint4 v = *(const uint4*)(Cs + lrow * CSTR + ch * 8); *(uint4*)(p.YMOE + (size_t)ents[lrow] * 1024 + nt * 128 + ch * 8) = v; } }
        } else {
#pragma unroll
            for (int k = 0; k < 4; ++k) { const int c = te_ + 256 * k; const int lrow = c >> 3, ch = c & 7;
                if (lrow < nrows) { const uint4 v = *(const uint4*)(Cs + lrow * CSTR + ch * 8); *(uint4*)(p.HID + (size_t)ents[lrow] * 512 + nt * 64 + ch * 8) = v; } }
        }
    }
}

template <int VAR = 0> __device__ void phase_final(const P& p, int bid, int nblk) {
    const int tidp = opaque_tid();
    const int lane = tidp & 63; const int gw = bid * 4 + (tidp >> 6), nw = nblk * 4;
    for (int tok = gw; tok < T_TOK; tok += nw) {
        float* hp = p.out + (size_t)tok * DM; const bf16_t* hb = p.HB + (size_t)tok * DM; const bf16_t* y0 = p.YMOE + (size_t)tok * 2 * DM; const bf16_t* y1 = y0 + DM;
        float4 v[4]; float ss = 0.f;
#pragma unroll
        for (int i = 0; i < 4; ++i) { const uint2 hu = *(const uint2*)(hb + i * 256 + lane * 4);
            v[i].x = __uint_as_float(hu.x << 16); v[i].y = __uint_as_float(hu.x & 0xffff0000u); v[i].z = __uint_as_float(hu.y << 16); v[i].w = __uint_as_float(hu.y & 0xffff0000u);
            const uint2 a = *(const uint2*)(y0 + i * 256 + lane * 4), b = *(const uint2*)(y1 + i * 256 + lane * 4);
            v[i].x += __uint_as_float(a.x << 16) + __uint_as_float(b.x << 16); v[i].y += __uint_as_float(a.x & 0xffff0000u) + __uint_as_float(b.x & 0xffff0000u);
            v[i].z += __uint_as_float(a.y << 16) + __uint_as_float(b.y << 16); v[i].w += __uint_as_float(a.y & 0xffff0000u) + __uint_as_float(b.y & 0xffff0000u);
            ss += v[i].x * v[i].x + v[i].y * v[i].y + v[i].z * v[i].z + v[i].w * v[i].w; }
        ss = wave_sum(ss);
        const float r = rsqrtf(ss * (1.0f / DM) + 1e-6f);
#pragma unroll
        for (int i = 0; i < 4; ++i) { const float4 gg = *(const float4*)(p.g_fin + i * 256 + lane * 4);
            float4 o; o.x = v[i].x * r * gg.x; o.y = v[i].y * r * gg.y; o.z = v[i].z * r * gg.z; o.w = v[i].w * r * gg.w;
            *(float4*)((VAR ? (float*)p.SGS + (size_t)4 * 1024 * 1024 + (size_t)(tok & 8191) * DM : hp) + i * 256 + lane * 4) = o; }
    }
}
__device__ __forceinline__ float fast_exp2(float x) { return __builtin_amdgcn_exp2f(x); }
typedef float f32x2v __attribute__((ext_vector_type(2)));
template <int KIND, int VAR = 0> __device__ void phase_attn(const P& p, char* smem, int bid, int nblk, const Sched& sc) {
    constexpr int NM = 1, NMAPS = KIND == 0 ? 2 : 1, DQK = KIND == 2 ? 128 : 64, DV = KIND == 1 ? 64 : 128;
    constexpr int KROW = DQK, QROW = NMAPS * DQK, KSTR = KROW + 8, VSTR = 72, NDT = DV / 32, NKS = DQK / 16;
    constexpr int KCH = 64 * KROW / 8 / NTHR, VCH = DV * 8 / NTHR;
    constexpr int NH = KIND == 1 ? 8 : 4;
    constexpr int NUNITS = NBATCH * NH * 64;
    constexpr bool DB = KIND != 2;
    bf16_t* Ks = (bf16_t*)smem; bf16_t* Vs = Ks + (DB ? 2 : 1) * 64 * KSTR;
    const int tid = opaque_tid(), lane = tid & 63, wid = tid >> 6, l31 = lane & 31, lh = lane >> 5;
    const float c = (KIND == 2 ? 0.08838834764831845f : 0.125f) * 1.4426950408889634f;
    float lam = 0.f;
    if (KIND == 0) { float d1 = 0.f, d2 = 0.f; for (int i = 0; i < 64; ++i) { d1 += p.lq1[i] * p.lk1[i]; d2 += p.lq2[i] * p.lk2[i]; } lam = expf(d1) - expf(d2) + 0.2f; }
    const bf16_t* Qb = KIND == 0 ? p.DQ : KIND == 1 ? p.SQ : p.MQ;
    const bf16_t* Kb = KIND == 0 ? p.DK : KIND == 1 ? p.SK : p.MK;
    const bf16_t* Vb = KIND == 0 ? p.DVT : KIND == 1 ? p.SVT : p.MVT;
    bf16_t* Yb = VAR != 0 ? (bf16_t*)p.SGS + (size_t)16 * 1024 * 1024 : KIND == 0 ? p.YD : KIND == 1 ? p.YS : p.YM;
    constexpr int VLEN = KIND == 2 ? 256 : S_LEN;
    const bool xaware = false;
    for (int rnd = 0; xaware ? (rnd < NBATCH * NH / 8) : (rnd * nblk < NUNITS); ++rnd) {
        int qt, bh;
        if (xaware) { bh = sc.x * (NBATCH * NH / 8) + rnd; qt = (rnd & 1) ? sc.j : 63 - sc.j; }
        else { const int rank = rnd * nblk + ((rnd & 1) ? nblk - 1 - bid : bid); if (rank >= NUNITS) continue;
               qt = KIND == 2 ? rank % 64 : 63 - rank / (NBATCH * NH); bh = KIND == 2 ? rank / 64 : rank % (NBATCH * NH); }
        const int b = bh / NH, h = bh % NH;
        const int q0 = qt * 128, qw = q0 + 32 * wid;
        const int nkt = KIND == 2 ? 4 : 2 * (qt + 1);
        unsigned o1pk[NDT][8];
#pragma unroll 1
        for (int map = 0; map < NMAPS; ++map) {
        bf16x8 qf[NM][NKS];
        const bf16_t* qp = Qb + ((size_t)(b * S_LEN + qw + l31)) * 512 + h * QROW + map * DQK + lh * 8;
        if (KIND != 2) {
#pragma unroll
            for (int m = 0; m < NM; ++m)
#pragma unroll
                for (int ks = 0; ks < NKS; ++ks) qf[m][ks] = *(const bf16x8*)(qp + m * DQK + ks * 16);
        }
        f32x16 o[NM][NDT];
#pragma unroll
        for (int m = 0; m < NM; ++m)
#pragma unroll
            for (int dt = 0; dt < NDT; ++dt)
#pragma unroll
                for (int r = 0; r < 16; ++r) o[m][dt][r] = 0.f;
        float mrow[NM], lrow[NM];
#pragma unroll
        for (int m = 0; m < NM; ++m) { mrow[m] = -INFINITY; lrow[m] = 0.f; }
        int tid_l = tid; asm volatile("" : "+v"(tid_l));
        const bf16_t* ksrc = Kb + ((size_t)(KIND == 2 ? b * 256 : b * S_LEN) + (tid_l >> (KROW == 128 ? 4 : 3))) * 512 + h * QROW + map * DQK + (tid_l & (KROW / 8 - 1)) * 8;
        constexpr int KROWS_PER_PASS = NTHR / (KROW / 8);
        const int krow_ = tid_l >> (KROW == 128 ? 4 : 3);
        bf16_t* kdst = Ks + ((krow_ & ~12) | ((krow_ & 4) << 1) | ((krow_ & 8) >> 1)) * KSTR + (tid_l & (KROW / 8 - 1)) * 8;
        const bf16_t* vsrc = Vb + ((size_t)(bh * DV + (tid_l >> 3))) * VLEN + (tid_l & 7) * 8;
        bf16_t* vdst = Vs + (tid_l >> 3) * VSTR + (tid_l & 7) * 8;
        uint4 rk0, rk1, rk2 = make_uint4(0,0,0,0), rk3 = make_uint4(0,0,0,0), rv0, rv1, rv2 = make_uint4(0,0,0,0), rv3 = make_uint4(0,0,0,0);
        { const bf16_t* s_ = ksrc + (size_t)(0) * 512; rk0 = *(const uint4*)(s_); rk1 = *(const uint4*)(s_ + (size_t)KROWS_PER_PASS * 512); if (KCH > 2) { rk2 = *(const uint4*)(s_ + (size_t)2 * KROWS_PER_PASS * 512); rk3 = *(const uint4*)(s_ + (size_t)3 * KROWS_PER_PASS * 512); } }
        { const bf16_t* s_ = vsrc + ((size_t)0); rv0 = *(const uint4*)(s_); rv1 = *(const uint4*)(s_ + (size_t)32 * VLEN); if (VCH > 2) { rv2 = *(const uint4*)(s_ + (size_t)64 * VLEN); rv3 = *(const uint4*)(s_ + (size_t)96 * VLEN); } }
        __syncthreads();
        { *(uint4*)(kdst) = rk0; *(uint4*)(kdst + KROWS_PER_PASS * KSTR) = rk1; if (KCH > 2) { *(uint4*)(kdst + 2 * KROWS_PER_PASS * KSTR) = rk2; *(uint4*)(kdst + 3 * KROWS_PER_PASS * KSTR) = rk3; } }
        { *(uint4*)(vdst) = rv0; *(uint4*)(vdst + 32 * VSTR) = rv1; if (VCH > 2) { *(uint4*)(vdst + 64 * VSTR) = rv2; *(uint4*)(vdst + 96 * VSTR) = rv3; } }
        __syncthreads();
        if (!DB && nkt > 1) { const bf16_t* s_ = ksrc + (size_t)(64) * 512; rk0 = *(const uint4*)(s_); rk1 = *(const uint4*)(s_ + (size_t)KROWS_PER_PASS * 512); if (KCH > 2) { rk2 = *(const uint4*)(s_ + (size_t)2 * KROWS_PER_PASS * 512); rk3 = *(const uint4*)(s_ + (size_t)3 * KROWS_PER_PASS * 512); } }
        uint2 mwn = make_uint2(0u, 0u);
        if (KIND == 1) mwn = *(const uint2*)(p.MASK + ((size_t)(b * S_LEN + qw + l31)) * 256);
        for (int kt = 0; kt < nkt; ++kt) {
            const bool active = KIND == 2 ? true : (kt * 64 <= qw + 31);
            const bf16_t* Kc = Ks + (DB ? (kt & 1) * 64 * KSTR : 0); const bf16_t* Vc = Vs + (DB ? (kt & 1) * DV * VSTR : 0);
            if (DB && kt + 1 < nkt && VAR != 6 && VAR != 7) {
                { const bf16_t* s_ = ksrc + (size_t)((kt + 1) * 64) * 512; rk0 = *(const uint4*)(s_); rk1 = *(const uint4*)(s_ + (size_t)KROWS_PER_PASS * 512); if (KCH > 2) { rk2 = *(const uint4*)(s_ + (size_t)2 * KROWS_PER_PASS * 512); rk3 = *(const uint4*)(s_ + (size_t)3 * KROWS_PER_PASS * 512); } }
                { const bf16_t* s_ = vsrc + ((size_t)(kt + 1) * 64); rv0 = *(const uint4*)(s_); rv1 = *(const uint4*)(s_ + (size_t)32 * VLEN); if (VCH > 2) { rv2 = *(const uint4*)(s_ + (size_t)64 * VLEN); rv3 = *(const uint4*)(s_ + (size_t)96 * VLEN); } }
            }
            __builtin_amdgcn_sched_barrier(0);
            unsigned pk[NM][2][2][4];
            if (active) {
                uint2 mw = mwn;
                if (KIND == 1) { mw.x >>= 8 * lh; mw.y >>= 8 * lh; if (kt + 1 < nkt) mwn = *(const uint2*)(p.MASK + ((size_t)(b * S_LEN + qw + l31)) * 256 + (kt + 1) * 2); }
#pragma unroll
                for (int m = 0; m < NM; ++m) {
                    f32x16 s[2];
#pragma unroll
                    for (int r = 0; r < 16; ++r) { s[0][r] = 0.f; s[1][r] = 0.f; }
#pragma unroll
                    for (int ks = 0; ks < NKS; ks += 2) {
                        const bf16x8 a00 = *(const bf16x8*)(Kc + l31 * KSTR + m * DQK + ks * 16 + lh * 8);
                        const bf16x8 a10 = *(const bf16x8*)(Kc + (32 + l31) * KSTR + m * DQK + ks * 16 + lh * 8);
                        const bf16x8 a01 = *(const bf16x8*)(Kc + l31 * KSTR + m * DQK + (ks + 1) * 16 + lh * 8);
                        const bf16x8 a11 = *(const bf16x8*)(Kc + (32 + l31) * KSTR + m * DQK + (ks + 1) * 16 + lh * 8);
                        const bf16x8 q0_ = KIND == 2 ? *(const bf16x8*)(qp + ks * 16) : qf[m][ks];
                        const bf16x8 q1_ = KIND == 2 ? *(const bf16x8*)(qp + (ks + 1) * 16) : qf[m][ks + 1];
                        __builtin_amdgcn_sched_barrier(0);
                        if (VAR != 5) {
                        s[0] = __builtin_amdgcn_mfma_f32_32x32x16_bf16(a00, q0_, s[0], 0, 0, 0);
                        s[1] = __builtin_amdgcn_mfma_f32_32x32x16_bf16(a10, q0_, s[1], 0, 0, 0);
                        s[0] = __builtin_amdgcn_mfma_f32_32x32x16_bf16(a01, q1_, s[0], 0, 0, 0);
                        s[1] = __builtin_amdgcn_mfma_f32_32x32x16_bf16(a11, q1_, s[1], 0, 0, 0);
                        } else { asm volatile("" :: "v"(a00), "v"(a10), "v"(a01), "v"(a11)); }
                    }
                    if (KIND == 0 && kt * 64 + 63 > qw) {
                        const int qi = qw + l31 - kt * 64 - 8 * lh;
#pragma unroll
                        for (int t = 0; t < 2; ++t)
#pragma unroll
                            for (int r = 0; r < 16; ++r) if (32 * t + (r & 7) + 16 * (r >> 3) > qi) s[t][r] = -INFINITY;
                    }
                    float mx = s[0][0];
#pragma unroll
                    for (int r = 1; r < 16; ++r) mx = fmaxf(mx, s[0][r]);
#pragma unroll
                    for (int r = 0; r < 16; ++r) mx = fmaxf(mx, s[1][r]);
                    mx = xhalf_max(mx);
                    const float mnew = fmaxf(mrow[m], mx * c);
                    const float corr = fast_exp2(mrow[m] - mnew);
                    mrow[m] = mnew;
                    f32x2v ps2 = {0.f, 0.f}; const f32x2v c2 = {c, c}, nm2 = {-mnew, -mnew};
#pragma unroll
                    for (int t = 0; t < 2; ++t)
#pragma unroll
                        for (int r = 0; r < 16; r += 2) {
                            const f32x2v sv = {s[t][r], s[t][r + 1]};
                            const f32x2v y = VAR == 3 ? sv : sv * c2 + nm2;
                            f32x2v pv = {(VAR == 1 || VAR == 3) ? y.x : fast_exp2(y.x), (VAR == 1 || VAR == 3) ? y.y : fast_exp2(y.y)};
                            if (KIND == 1) { int m0 = __builtin_amdgcn_sbfe((int)(t ? mw.y : mw.x), (r & 7) + 16 * (r >> 3), 1), m1 = __builtin_amdgcn_sbfe((int)(t ? mw.y : mw.x), ((r + 1) & 7) + 16 * ((r + 1) >> 3), 1);
                                             asm("" : "+v"(m0), "+v"(m1));
                                             pv.x = __uint_as_float(__float_as_uint(pv.x) & (unsigned)m0); pv.y = __uint_as_float(__float_as_uint(pv.y) & (unsigned)m1); }
                            ps2 += pv; s[t][r] = pv.x; s[t][r + 1] = pv.y;
                        }
                    const float psum = ps2.x + ps2.y;
                    lrow[m] = lrow[m] * corr + psum;
#pragma unroll
                    for (int t = 0; t < 2; ++t)
#pragma unroll
                        for (int s2 = 0; s2 < 2; ++s2)
#pragma unroll
                            for (int j = 0; j < 4; ++j) pk[m][t][s2][j] = cvt_pk_bf16(s[t][8 * s2 + 2 * j], s[t][8 * s2 + 2 * j + 1]);
                    if (__any(corr != 1.0f)) {
#pragma unroll
                        for (int dt = 0; dt < NDT; ++dt)
#pragma unroll
                            for (int r = 0; r < 16; ++r) o[m][dt][r] *= corr;
                    }
                }
            }
            if (!DB) {
            __syncthreads();
            if (kt + 1 < nkt) {
                { *(uint4*)(kdst) = rk0; *(uint4*)(kdst + KROWS_PER_PASS * KSTR) = rk1; if (KCH > 2) { *(uint4*)(kdst + 2 * KROWS_PER_PASS * KSTR) = rk2; *(uint4*)(kdst + 3 * KROWS_PER_PASS * KSTR) = rk3; } }
                { const bf16_t* s_ = vsrc + ((size_t)(kt + 1) * 64); rv0 = *(const uint4*)(s_); rv1 = *(const uint4*)(s_ + (size_t)32 * VLEN); if (VCH > 2) { rv2 = *(const uint4*)(s_ + (size_t)64 * VLEN); rv3 = *(const uint4*)(s_ + (size_t)96 * VLEN); } }
            }
            }
            if (active) {
                constexpr int GS = NDT == 4 ? 1 : 2;
#pragma unroll
                for (int ks2 = 0; ks2 < 4; ks2 += GS) {
                    bf16x8 va[GS][NDT];
#pragma unroll
                    for (int g = 0; g < GS; ++g)
#pragma unroll
                        for (int dt = 0; dt < NDT; ++dt) {
                            va[g][dt] = *(const bf16x8*)(Vc + (32 * dt + l31) * VSTR + 16 * (ks2 + g) + 8 * lh);
                        }
                    __builtin_amdgcn_sched_barrier(0);
#pragma unroll
                    for (int g = 0; g < GS; ++g)
#pragma unroll
                        for (int dt = 0; dt < NDT; ++dt)
#pragma unroll
                            for (int m = 0; m < NM; ++m) {
                                const int k2 = ks2 + g;
                                const uint4 pu = make_uint4(pk[m][k2 >> 1][k2 & 1][0], pk[m][k2 >> 1][k2 & 1][1], pk[m][k2 >> 1][k2 & 1][2], pk[m][k2 >> 1][k2 & 1][3]);
                                if (VAR != 2) o[m][dt] = __builtin_amdgcn_mfma_f32_32x32x16_bf16(va[g][dt], *(const bf16x8*)&pu, o[m][dt], 0, 0, 0); else { o[m][dt][0] += __uint_as_float(pu.x); asm volatile("" :: "v"(va[g][dt])); }
                            }
                }
            }
            if (DB) {
                if (kt + 1 < nkt && VAR != 6 && VAR != 7) {
                    bf16_t* kd = kdst + ((kt + 1) & 1) * 64 * KSTR; bf16_t* vd = vdst + ((kt + 1) & 1) * DV * VSTR;
                    { *(uint4*)(kd) = rk0; *(uint4*)(kd + KROWS_PER_PASS * KSTR) = rk1; if (KCH > 2) { *(uint4*)(kd + 2 * KROWS_PER_PASS * KSTR) = rk2; *(uint4*)(kd + 3 * KROWS_PER_PASS * KSTR) = rk3; } }
                    { *(uint4*)(vd) = rv0; *(uint4*)(vd + 32 * VSTR) = rv1; if (VCH > 2) { *(uint4*)(vd + 64 * VSTR) = rv2; *(uint4*)(vd + 96 * VSTR) = rv3; } }
                }
                if (VAR != 7) __syncthreads();
            } else {
            __syncthreads();
            if (kt + 1 < nkt) {
                { *(uint4*)(vdst) = rv0; *(uint4*)(vdst + 32 * VSTR) = rv1; if (VCH > 2) { *(uint4*)(vdst + 64 * VSTR) = rv2; *(uint4*)(vdst + 96 * VSTR) = rv3; } }
                if (kt + 2 < nkt) { const bf16_t* s_ = ksrc + (size_t)((kt + 2) * 64) * 512; rk0 = *(const uint4*)(s_); rk1 = *(const uint4*)(s_ + (size_t)KROWS_PER_PASS * 512); if (KCH > 2) { rk2 = *(const uint4*)(s_ + (size_t)2 * KROWS_PER_PASS * 512); rk3 = *(const uint4*)(s_ + (size_t)3 * KROWS_PER_PASS * 512); } }
            }
            }
        }
#pragma unroll
        for (int m = 0; m < NM; ++m) lrow[m] = xhalf_sum(lrow[m]);
        bf16_t* yp = Yb + ((size_t)(b * S_LEN + qw + l31)) * 512 + h * DV + 4 * lh;
        if (KIND == 0) {
            if (map == 0) {
                const float i1 = 1.0f / lrow[0];
#pragma unroll
                for (int dt = 0; dt < NDT; ++dt)
#pragma unroll
                    for (int j = 0; j < 8; ++j) o1pk[dt][j] = cvt_pk_bf16(o[0][dt][2 * j] * i1, o[0][dt][2 * j + 1] * i1);
            } else {
            const float i2 = lam / lrow[0];
            float ss = 0.f;
#pragma unroll
            for (int dt = 0; dt < NDT; ++dt)
#pragma unroll
                for (int r = 0; r < 16; ++r) { const float o1 = (r & 1) ? __uint_as_float(o1pk[dt][r >> 1] & 0xffff0000u) : __uint_as_float(o1pk[dt][r >> 1] << 16);
                    const float v = o1 - o[0][dt][r] * i2; o[0][dt][r] = v; ss += v * v; }
            ss = xhalf_sum(ss);
            const float rn = rsqrtf(ss * (1.0f / 128.0f) + 1e-6f) * 0.8f;
#pragma unroll
            for (int dt = 0; dt < NDT; ++dt)
#pragma unroll
                for (int g = 0; g < 4; ++g) { const int dv = 32 * dt + 8 * g + 4 * lh; const float4 gs = *(const float4*)(p.g_sub + dv);
                    uint2 w; w.x = cvt_pk_bf16(o[0][dt][4 * g] * rn * gs.x, o[0][dt][4 * g + 1] * rn * gs.y); w.y = cvt_pk_bf16(o[0][dt][4 * g + 2] * rn * gs.z, o[0][dt][4 * g + 3] * rn * gs.w);
                    *(uint2*)(yp + 32 * dt + 8 * g) = w; }
            }
        } else {
            const float i1 = 1.0f / lrow[0];
#pragma unroll
            for (int dt = 0; dt < NDT; ++dt)
#pragma unroll
                for (int g = 0; g < 4; ++g) {
                    uint2 w; w.x = cvt_pk_bf16(o[0][dt][4 * g] * i1, o[0][dt][4 * g + 1] * i1); w.y = cvt_pk_bf16(o[0][dt][4 * g + 2] * i1, o[0][dt][4 * g + 3] * i1);
                    *(uint2*)(yp + 32 * dt + 8 * g) = w; }
        }
        }
    }
}
template <int KIND> __device__ void phase_attn2(const P& p, char* smem, int bid, int nblk, const Sched& sc) {
    constexpr int NMAPS = KIND == 0 ? 2 : 1, DQK = 64, DV = KIND == 1 ? 64 : 128;
    constexpr int QROW = NMAPS * DQK, KSTR = 72, VSTR = 72, NDT = DV / 32, NKS = 4;
    constexpr int VCH = DV * 8 / NTHR;
    constexpr int NH = KIND == 1 ? 8 : 4;
    constexpr int NUNITS = NBATCH * NH * 64;
    bf16_t* Ks = (bf16_t*)smem; bf16_t* Vs = Ks + 2 * 64 * KSTR;
    const int tid = opaque_tid(), lane = tid & 63, wid = tid >> 6, l31 = lane & 31, lh = lane >> 5;
    const float c = 0.125f * 1.4426950408889634f;
    float lam = 0.f;
    if (KIND == 0) { float d1 = 0.f, d2 = 0.f; for (int i = 0; i < 64; ++i) { d1 += p.lq1[i] * p.lk1[i]; d2 += p.lq2[i] * p.lk2[i]; } lam = expf(d1) - expf(d2) + 0.2f; }
    const bf16_t* Qb = KIND == 0 ? p.DQ : p.SQ;
    const bf16_t* Kb = KIND == 0 ? p.DK : p.SK;
    const bf16_t* Vb = KIND == 0 ? p.DVT : p.SVT;
    bf16_t* Yb = KIND == 0 ? p.YD : p.YS;
    const bool xaware = false;
    for (int rnd = 0; xaware ? (rnd < NBATCH * NH / 8) : (rnd * nblk < NUNITS); ++rnd) {
        int qt, bh;
        if (xaware) { bh = sc.x * (NBATCH * NH / 8) + rnd; qt = (rnd & 1) ? sc.j : 63 - sc.j; }
        else { const int rank = rnd * nblk + ((rnd & 1) ? nblk - 1 - bid : bid); if (rank >= NUNITS) continue; qt = 63 - rank / (NBATCH * NH); bh = rank % (NBATCH * NH); }
        const int b = bh / NH, h = bh % NH;
        const int q0 = qt * 128, qw = q0 + 32 * wid;
        const int nkt = 2 * (qt + 1);
        const int last_act = min(nkt - 1, (qw + 31) >> 6);
#pragma unroll 1
        for (int map = 0; map < NMAPS; ++map) {
        bf16x8 qf[NKS];
        { const bf16_t* qp = Qb + ((size_t)(b * S_LEN + qw + l31)) * 512 + h * QROW + map * DQK + lh * 8;
#pragma unroll
          for (int ks = 0; ks < NKS; ++ks) qf[ks] = *(const bf16x8*)(qp + ks * 16); }
        f32x16 o[NDT];
#pragma unroll
        for (int dt = 0; dt < NDT; ++dt)
#pragma unroll
            for (int r = 0; r < 16; ++r) o[dt][r] = 0.f;
        float mrow = -INFINITY, lrow = 0.f;
        int tl_ = tid; asm volatile("" : "+v"(tl_));
        const bf16_t* ksrc = Kb + ((size_t)b * S_LEN + (tl_ >> 3)) * 512 + h * QROW + map * DQK + (tl_ & 7) * 8;
        bf16_t* kdst = Ks + (tl_ >> 3) * KSTR + (tl_ & 7) * 8;
        const bf16_t* vsrc = Vb + ((size_t)(bh * DV + (tl_ >> 3))) * S_LEN + (tl_ & 7) * 8;
        bf16_t* vdst = Vs + (tl_ >> 3) * VSTR + (tl_ & 7) * 8;
        uint4 rk0, rk1, rv0, rv1, rv2 = make_uint4(0, 0, 0, 0), rv3 = make_uint4(0, 0, 0, 0);
#define LDK(kt_) { const bf16_t* s_ = ksrc + (size_t)((kt_) * 64) * 512; rk0 = *(const uint4*)(s_); rk1 = *(const uint4*)(s_ + (size_t)32 * 512); }
#define LDV(kt_) { const bf16_t* s_ = vsrc + (size_t)(kt_) * 64; rv0 = *(const uint4*)(s_); rv1 = *(const uint4*)(s_ + (size_t)32 * S_LEN); if (VCH > 2) { rv2 = *(const uint4*)(s_ + (size_t)64 * S_LEN); rv3 = *(const uint4*)(s_ + (size_t)96 * S_LEN); } }
#define STK(buf_) { bf16_t* d_ = kdst + (buf_) * 64 * KSTR; *(uint4*)(d_) = rk0; *(uint4*)(d_ + 32 * KSTR) = rk1; }
#define STV(buf_) { bf16_t* d_ = vdst + (buf_) * DV * VSTR; *(uint4*)(d_) = rv0; *(uint4*)(d_ + 32 * VSTR) = rv1; if (VCH > 2) { *(uint4*)(d_ + 64 * VSTR) = rv2; *(uint4*)(d_ + 96 * VSTR) = rv3; } }
        LDK(0) LDV(0)
        __syncthreads();
        STK(0) STV(0)
        LDK(1)
        STK(1)
        __syncthreads();
        f32x16 s[2];
        auto qk = [&](int kt) {
            const bf16_t* Kc = Ks + (kt & 1) * 64 * KSTR;
#pragma unroll
            for (int r = 0; r < 16; ++r) { s[0][r] = 0.f; s[1][r] = 0.f; }
#pragma unroll
            for (int ks = 0; ks < NKS; ks += 2) {
                const bf16x8 a00 = *(const bf16x8*)(Kc + l31 * KSTR + ks * 16 + lh * 8), a10 = *(const bf16x8*)(Kc + (32 + l31) * KSTR + ks * 16 + lh * 8);
                const bf16x8 a01 = *(const bf16x8*)(Kc + l31 * KSTR + (ks + 1) * 16 + lh * 8), a11 = *(const bf16x8*)(Kc + (32 + l31) * KSTR + (ks + 1) * 16 + lh * 8);
                s[0] = __builtin_amdgcn_mfma_f32_32x32x16_bf16(a00, qf[ks], s[0], 0, 0, 0);
                s[1] = __builtin_amdgcn_mfma_f32_32x32x16_bf16(a10, qf[ks], s[1], 0, 0, 0);
                s[0] = __builtin_amdgcn_mfma_f32_32x32x16_bf16(a01, qf[ks + 1], s[0], 0, 0, 0);
                s[1] = __builtin_amdgcn_mfma_f32_32x32x16_bf16(a11, qf[ks + 1], s[1], 0, 0, 0);
            }
        };
        unsigned pkp[2][2][4], pkn[2][2][4];
        float corr = 1.0f;
        uint2 mw = make_uint2(0u, 0u);
        auto softmax = [&](int kt) {
            if (KIND == 0 && kt * 64 + 63 > qw) {
                const int qi = qw + l31 - kt * 64 - 4 * lh;
#pragma unroll
                for (int t = 0; t < 2; ++t)
#pragma unroll
                    for (int r = 0; r < 16; ++r) if (32 * t + (r & 3) + 8 * (r >> 2) > qi) s[t][r] = -INFINITY;
            }
            float mx = s[0][0];
#pragma unroll
            for (int r = 1; r < 16; ++r) mx = fmaxf(mx, s[0][r]);
#pragma unroll
            for (int r = 0; r < 16; ++r) mx = fmaxf(mx, s[1][r]);
            mx = xhalf_max(mx);
            const float mnew = fmaxf(mrow, mx * c);
            corr = fast_exp2(mrow - mnew);
            mrow = mnew;
            f32x2v ps2 = {0.f, 0.f}; const f32x2v c2 = {c, c}, nm2 = {-mnew, -mnew};
#pragma unroll
            for (int t = 0; t < 2; ++t)
#pragma unroll
                for (int r = 0; r < 16; r += 2) {
                    const f32x2v sv = {s[t][r], s[t][r + 1]};
                    const f32x2v y = sv * c2 + nm2;
                    f32x2v pv = {fast_exp2(y.x), fast_exp2(y.y)};
                    if (KIND == 1) { pv.x = __uint_as_float(__float_as_uint(pv.x) & (unsigned)__builtin_amdgcn_sbfe((int)(t ? mw.y : mw.x), (r & 3) + 8 * (r >> 2), 1));
                                     pv.y = __uint_as_float(__float_as_uint(pv.y) & (unsigned)__builtin_amdgcn_sbfe((int)(t ? mw.y : mw.x), ((r + 1) & 3) + 8 * ((r + 1) >> 2), 1)); }
                    ps2 += pv;
                    pkn[t][r >> 3][(r >> 1) & 3] = cvt_pk_bf16(pv.x, pv.y);
                }
            lrow = lrow * corr + (ps2.x + ps2.y);
        };
        auto pv_mma = [&](int kt) {
            const bf16_t* Vc = Vs + (kt % 3) * DV * VSTR;
            constexpr int GS = NDT == 4 ? 1 : 2;
#pragma unroll
            for (int ks2 = 0; ks2 < 4; ks2 += GS) {
                bf16x8 va[GS][NDT];
#pragma unroll
                for (int g = 0; g < GS; ++g)
#pragma unroll
                    for (int dt = 0; dt < NDT; ++dt) {
                        const bf16_t* vp = Vc + (32 * dt + l31) * VSTR + 16 * (ks2 + g) + 4 * lh;
                        const uint2 lo = *(const uint2*)vp, hi = *(const uint2*)(vp + 8);
                        const uint4 vv = make_uint4(lo.x, lo.y, hi.x, hi.y);
                        va[g][dt] = *(const bf16x8*)&vv;
                    }
#pragma unroll
                for (int g = 0; g < GS; ++g)
#pragma unroll
                    for (int dt = 0; dt < NDT; ++dt) {
                        const int k2 = ks2 + g;
                        const uint4 pu = make_uint4(pkp[k2 >> 1][k2 & 1][0], pkp[k2 >> 1][k2 & 1][1], pkp[k2 >> 1][k2 & 1][2], pkp[k2 >> 1][k2 & 1][3]);
                        o[dt] = __builtin_amdgcn_mfma_f32_32x32x16_bf16(va[g][dt], *(const bf16x8*)&pu, o[dt], 0, 0, 0);
                    }
            }
        };
        uint2 mwn = make_uint2(0u, 0u);
        if (KIND == 1) mwn = *(const uint2*)(p.MASK + ((size_t)(b * S_LEN + qw + l31)) * 256);
        qk(0);
        for (int kt = 0; kt <= nkt; ++kt) {
            if (kt + 2 < nkt) LDK(kt + 2)
            if (kt + 1 < nkt) LDV(kt + 1)
            const bool do_sm = kt <= last_act, do_pv = kt >= 1 && kt - 1 <= last_act;
            if (do_sm && KIND == 1) { mw = mwn; mw.x >>= 4 * lh; mw.y >>= 4 * lh; if (kt + 1 <= last_act) mwn = *(const uint2*)(p.MASK + ((size_t)(b * S_LEN + qw + l31)) * 256 + (kt + 1) * 2); }
            if (do_sm && do_pv) {
                softmax(kt); pv_mma(kt - 1);
            } else if (do_sm) softmax(kt);
            else if (do_pv) pv_mma(kt - 1);
            if (do_sm) {
                if (__any(corr != 1.0f)) {
#pragma unroll
                    for (int dt = 0; dt < NDT; ++dt)
#pragma unroll
                        for (int r = 0; r < 16; ++r) o[dt][r] *= corr;
                }
#pragma unroll
                for (int t = 0; t < 2; ++t)
#pragma unroll
                    for (int s2 = 0; s2 < 2; ++s2)
#pragma unroll
                        for (int j = 0; j < 4; ++j) pkp[t][s2][j] = pkn[t][s2][j];
            }
            if (kt + 1 <= last_act) qk(kt + 1);
            if (kt + 2 < nkt) STK(kt & 1)
            if (kt + 1 < nkt) STV((kt + 1) % 3)
            __syncthreads();
        }
#undef LDK
#undef LDV
#undef STK
#undef STV
        int te_ = tid; asm volatile("" : "+v"(te_));
        uint4* park = (uint4*)p.SGS + (size_t)bid * 2048 + te_;
        lrow = xhalf_sum(lrow);
        bf16_t* yp = Yb + ((size_t)(b * S_LEN + qw + l31)) * 512 + h * DV + 4 * lh;
        if (KIND == 0) {
            if (map == 0) {
                const float i1 = 1.0f / lrow;
#pragma unroll
                for (int dt = 0; dt < NDT; ++dt)
#pragma unroll
                    for (int h2 = 0; h2 < 2; ++h2)
                        park[(size_t)(dt * 2 + h2) * 256] = make_uint4(cvt_pk_bf16(o[dt][8 * h2] * i1, o[dt][8 * h2 + 1] * i1), cvt_pk_bf16(o[dt][8 * h2 + 2] * i1, o[dt][8 * h2 + 3] * i1),
                                                                      cvt_pk_bf16(o[dt][8 * h2 + 4] * i1, o[dt][8 * h2 + 5] * i1), cvt_pk_bf16(o[dt][8 * h2 + 6] * i1, o[dt][8 * h2 + 7] * i1));
                asm volatile("" ::: "memory");
            } else {
                const float i2 = lam / lrow;
                float ss = 0.f;
#pragma unroll
                for (int dt = 0; dt < NDT; ++dt)
#pragma unroll
                    for (int h2 = 0; h2 < 2; ++h2) { const uint4 w = park[(size_t)(dt * 2 + h2) * 256]; const unsigned ww[4] = {w.x, w.y, w.z, w.w};
#pragma unroll
                        for (int j = 0; j < 4; ++j) {
                            const float v0 = __uint_as_float(ww[j] << 16) - o[dt][8 * h2 + 2 * j] * i2, v1 = __uint_as_float(ww[j] & 0xffff0000u) - o[dt][8 * h2 + 2 * j + 1] * i2;
                            o[dt][8 * h2 + 2 * j] = v0; o[dt][8 * h2 + 2 * j + 1] = v1; ss += v0 * v0 + v1 * v1; } }
                ss = xhalf_sum(ss);
                const float rn = rsqrtf(ss * (1.0f / 128.0f) + 1e-6f) * 0.8f;
#pragma unroll
                for (int dt = 0; dt < NDT; ++dt)
#pragma unroll
                    for (int g = 0; g < 4; ++g) { const int dv = 32 * dt + 8 * g + 4 * lh; const float4 gs = *(const float4*)(p.g_sub + dv);
                        uint2 w; w.x = cvt_pk_bf16(o[dt][4 * g] * rn * gs.x, o[dt][4 * g + 1] * rn * gs.y); w.y = cvt_pk_bf16(o[dt][4 * g + 2] * rn * gs.z, o[dt][4 * g + 3] * rn * gs.w);
                        *(uint2*)(yp + 32 * dt + 8 * g) = w; }
            }
        } else {
            const float i1 = 1.0f / lrow;
#pragma unroll
            for (int dt = 0; dt < NDT; ++dt)
#pragma unroll
                for (int g = 0; g < 4; ++g) {
                    uint2 w; w.x = cvt_pk_bf16(o[dt][4 * g] * i1, o[dt][4 * g + 1] * i1); w.y = cvt_pk_bf16(o[dt][4 * g + 2] * i1, o[dt][4 * g + 3] * i1);
                    *(uint2*)(yp + 32 * dt + 8 * g) = w; }
        }
        }
    }
}
#define IDX_M 23
__device__ __forceinline__ float med3f(float a, float b, float c) { return __builtin_amdgcn_fmed3f(a, b, c); }
__device__ void phase_indexer(const P& p, char* smem, int bid, int nblk, const Sched& sc_) {
    bf16_t* Kb = (bf16_t*)smem;
    unsigned* mimg = (unsigned*)(smem + 18432);
    const int tid = opaque_tid(), lane = tid & 63, wid = tid >> 6, l31 = lane & 31, lh = lane >> 5;
    constexpr int NUNITS = NBATCH * 256;
    const bool xaware = false;
    for (int rnd = 0; xaware ? (rnd < 2) : (rnd * nblk < NUNITS); ++rnd) {
        int qu, b;
        if (xaware) { b = sc_.x >> 1; const int k = rnd == 0 ? 127 - sc_.j : sc_.j; qu = 2 * k + (sc_.x & 1); }
        else { const int rank = rnd * nblk + ((rnd & 1) ? nblk - 1 - bid : bid); if (rank >= NUNITS) continue; qu = 255 - (rank >> 2); b = rank & 3; }
        const int q0 = qu * 32;
        const size_t tok0 = (size_t)b * S_LEN + q0;
        if (q0 < 256) {
#pragma unroll 1
            for (int i = 0; i < 32; ++i) { const int q = q0 + i; const int w0 = tid * 32;
                p.MASK[(tok0 + i) * 256 + tid] = q >= w0 + 31 ? 0xffffffffu : (q < w0 ? 0u : ((2u << (q - w0)) - 1u)); }
            continue;
        }
        const int nkt = (q0 + 95) >> 6;
        const int qb = q0 + 8 * wid;
        bf16x8 aq[2][4]; float wq[2][2][8]; int qv[2][2];
#pragma unroll
        for (int rt = 0; rt < 2; ++rt) {
            const int qa = qb + 4 * rt + 2 * ((l31 >> 2) & 1) + (l31 >> 4), ha = 4 * ((l31 >> 3) & 1) + (l31 & 3);
            const bf16_t* ap = p.IQ + ((size_t)b * S_LEN + qa) * 512 + ha * 64 + lh * 8;
#pragma unroll
            for (int ks = 0; ks < 4; ++ks) aq[rt][ks] = *(const bf16x8*)(ap + ks * 16);
#pragma unroll
            for (int e = 0; e < 2; ++e) { const float* wp = p.IW + ((size_t)b * S_LEN + qb + 4 * rt + 2 * lh + e) * 8;
                const float4 w0 = *(const float4*)wp, w1 = *(const float4*)(wp + 4); const float sc = 0.125f * 0.35355339059327373f;
                wq[rt][e][0] = w0.x * sc; wq[rt][e][1] = w0.y * sc; wq[rt][e][2] = w0.z * sc; wq[rt][e][3] = w0.w * sc;
                wq[rt][e][4] = w1.x * sc; wq[rt][e][5] = w1.y * sc; wq[rt][e][6] = w1.z * sc; wq[rt][e][7] = w1.w * sc;
                qv[rt][e] = qb + 4 * rt + 2 * lh + e; }
        }
        const bf16_t* ksrc = p.IK + ((size_t)b * S_LEN + (tid >> 3)) * 64 + (tid & 7) * 8;
        bf16_t* kdst = Kb + (tid >> 3) * 72 + (tid & 7) * 8;
        auto tile_scores = [&](const bf16_t* kbuf, int t, float (&sc)[2][2]) {
            f32x16 acc[2];
#pragma unroll
            for (int r = 0; r < 16; ++r) { acc[0][r] = 0.f; acc[1][r] = 0.f; }
#pragma unroll
            for (int ks = 0; ks < 4; ++ks) {
                const bf16x8 kf = *(const bf16x8*)(kbuf + (32 * t + l31) * 72 + ks * 16 + lh * 8);
                acc[0] = __builtin_amdgcn_mfma_f32_32x32x16_bf16(aq[0][ks], kf, acc[0], 0, 0, 0);
                acc[1] = __builtin_amdgcn_mfma_f32_32x32x16_bf16(aq[1][ks], kf, acc[1], 0, 0, 0);
            }
#pragma unroll
            for (int rt = 0; rt < 2; ++rt)
#pragma unroll
                for (int e = 0; e < 2; ++e) { float s = 0.f;
#pragma unroll
                    for (int hd = 0; hd < 8; ++hd) s = __builtin_fmaf(wq[rt][e][hd], __int_as_float(max(__float_as_int(acc[rt][8 * e + hd]), 0)), s);
                    sc[rt][e] = s; }
        };
        float T[2][2]; int need[2][2];
        {
            float L[2][2][IDX_M];
#pragma unroll
            for (int rt = 0; rt < 2; ++rt)
#pragma unroll
                for (int e = 0; e < 2; ++e)
#pragma unroll
                    for (int i = 0; i < IDX_M; ++i) L[rt][e][i] = -INFINITY;
            __syncthreads();
            uint4 r0 = *(const uint4*)(ksrc), r1 = *(const uint4*)(ksrc + 32 * 64);
            *(uint4*)(kdst) = r0; *(uint4*)(kdst + 32 * 72) = r1;
            __syncthreads();
            for (int kt = 0; kt < nkt; ++kt) {
                const bf16_t* kbuf = Kb + (kt & 1) * 64 * 72;
                if (kt + 1 < nkt) { r0 = *(const uint4*)(ksrc + (size_t)(kt + 1) * 64 * 64); r1 = *(const uint4*)(ksrc + (size_t)(kt + 1) * 64 * 64 + 32 * 64); }
                __builtin_amdgcn_sched_barrier(0);
                const bool interior = kt * 64 + 63 <= qb;
#pragma unroll 1
                for (int t = 0; t < 2; ++t) {
                    float sc[2][2]; tile_scores(kbuf, t, sc);
                    const int key = kt * 64 + 32 * t + l31;
#pragma unroll
                    for (int rt = 0; rt < 2; ++rt)
#pragma unroll
                        for (int e = 0; e < 2; ++e) {
                            const float v = (interior || key <= qv[rt][e]) ? sc[rt][e] : -INFINITY;
#pragma unroll
                            for (int i = IDX_M - 1; i >= 1; --i) L[rt][e][i] = med3f(L[rt][e][i - 1], L[rt][e][i], v);
                            asm("v_max_f32 %0, %1, %2" : "=v"(L[rt][e][0]) : "v"(L[rt][e][0]), "v"(v));
                        }
                }
                if (kt + 1 < nkt) { bf16_t* d = kdst + ((kt + 1) & 1) * 64 * 72; *(uint4*)(d) = r0; *(uint4*)(d + 32 * 72) = r1; }
                __syncthreads();
            }
#pragma unroll
            for (int rt = 0; rt < 2; ++rt)
#pragma unroll
                for (int e = 0; e < 2; ++e) {
                    unsigned U[IDX_M];
#pragma unroll
                    for (int i = 0; i < IDX_M; ++i) { const unsigned bts = __float_as_uint(L[rt][e][i]); U[i] = bts ^ ((unsigned)((int)bts >> 31) | 0x80000000u); }
                    unsigned pre = 0u;
#pragma unroll 1
                    for (int bit = 31; bit >= 0; --bit) {
                        const unsigned cand = pre | (1u << bit);
                        int c0 = 0, c1 = 0;
#pragma unroll
                        for (int i = 0; i < IDX_M; ++i) { const unsigned long long m = __builtin_amdgcn_ballot_w64(U[i] >= cand); c0 += __popc((unsigned)m); c1 += __popc((unsigned)(m >> 32)); }
                        if ((lh ? c1 : c0) >= 256) pre = cand;
                    }
                    int g0 = 0, g1 = 0;
#pragma unroll
                    for (int i = 0; i < IDX_M; ++i) { const unsigned long long m = __builtin_amdgcn_ballot_w64(U[i] > pre); g0 += __popc((unsigned)m); g1 += __popc((unsigned)(m >> 32)); }
                    need[rt][e] = 256 - (lh ? g1 : g0);
                    T[rt][e] = __uint_as_float((pre & 0x80000000u) ? (pre ^ 0x80000000u) : ~pre);
                }
        }
        {
            int tcnt[2][2];
#pragma unroll
            for (int rt = 0; rt < 2; ++rt)
#pragma unroll
                for (int e = 0; e < 2; ++e) tcnt[rt][e] = 0;
            __syncthreads();
            uint4 r0 = *(const uint4*)(ksrc), r1 = *(const uint4*)(ksrc + 32 * 64);
#pragma unroll 1
            for (int i = tid; i < 32 * 256 / 4; i += NTHR) ((uint4*)mimg)[i] = make_uint4(0u, 0u, 0u, 0u);
            *(uint4*)(kdst) = r0; *(uint4*)(kdst + 32 * 72) = r1;
            __syncthreads();
            for (int kt = 0; kt < nkt; ++kt) {
                const bf16_t* kbuf = Kb + (kt & 1) * 64 * 72;
                if (kt + 1 < nkt) { r0 = *(const uint4*)(ksrc + (size_t)(kt + 1) * 64 * 64); r1 = *(const uint4*)(ksrc + (size_t)(kt + 1) * 64 * 64 + 32 * 64); }
                __builtin_amdgcn_sched_barrier(0);
                const bool interior = kt * 64 + 63 <= qb;
#pragma unroll 1
                for (int t = 0; t < 2; ++t) {
                    float sc[2][2]; tile_scores(kbuf, t, sc);
                    const int key = kt * 64 + 32 * t + l31;
#pragma unroll
                    for (int rt = 0; rt < 2; ++rt)
#pragma unroll
                        for (int e = 0; e < 2; ++e) {
                            const float sv = (interior || key <= qv[rt][e]) ? sc[rt][e] : -INFINITY;
                            unsigned long long bal = __builtin_amdgcn_ballot_w64(sv > T[rt][e]);
                            const unsigned long long tb = __builtin_amdgcn_ballot_w64(sv == T[rt][e]);
                            if (tb != 0ull) {
                                const unsigned half = (unsigned)(tb >> (32 * lh));
                                const int rk = tcnt[rt][e] + __popc(half & ((1u << l31) - 1u));
                                bal |= __builtin_amdgcn_ballot_w64(sv == T[rt][e] && rk < need[rt][e]);
                                tcnt[rt][e] += __popc(half);
                            }
                            if (l31 == 0) mimg[(8 * wid + 4 * rt + 2 * lh + e) * 256 + kt * 2 + t] = (unsigned)(bal >> (32 * lh));
                        }
                }
                if (kt + 1 < nkt) { bf16_t* d = kdst + ((kt + 1) & 1) * 64 * 72; *(uint4*)(d) = r0; *(uint4*)(d + 32 * 72) = r1; }
                __syncthreads();
            }
        }
#pragma unroll 1
        for (int i = tid; i < 32 * 64; i += NTHR) { const int row = i >> 6, c4 = i & 63; *(uint4*)(p.MASK + (tok0 + row) * 256 + c4 * 4) = ((const uint4*)mimg)[row * 64 + c4]; }
    }
}
#ifndef PROBE_REP
#define PROBE_REP -1
#endif
#define RUNPH(idx, call) { _Pragma("unroll 1") for (int rep_ = 0; rep_ < ((PROBE_REP == idx) ? 2 : 1); ++rep_) { call; if (rep_ == 0 && PROBE_REP == idx) xcd_barrier(bar); } }

__global__ void __launch_bounds__(NTHR, 2) k_forward(P p) {
    __shared__ __attribute__((aligned(16))) char smem[SMEM_BYTES];
    volatile LAS unsigned* xbw = (volatile LAS unsigned*)(smem + SMEM_BYTES - 16);
    if (threadIdx.x == 0) { xbw[0] = 0u; xbw[1] = 0u; xbw[2] = 0u; xbw[3] = 0u; }
    __syncthreads();
    XcdBarrier bar = xcd_barrier_post(p.bar, xbw);
    const int bid = blockIdx.x, nblk = gridDim.x;
    volatile LAS int* sw = (volatile LAS int*)(smem + SMEM_BYTES - 32);
    if (threadIdx.x == 0) { const int hx = (int)(xb_xcc_id() & 7u); sw[0] = hx; sw[1] = atomicAdd(&p.XC[hx * 64], 1); }
    RUNPH(0, phase_prologue(p, smem, bid, nblk))
    xcd_barrier(bar);
    Sched sc;
    {
        bool even = (nblk & 7) == 0;
#pragma unroll
        for (int i = 0; i < 8; ++i) even = even && (__hip_atomic_load(&p.XC[i * 64], __ATOMIC_RELAXED, __HIP_MEMORY_SCOPE_AGENT) == (nblk >> 3));
        sc.x = even ? sw[0] : (bid & 7); sc.j = even ? sw[1] : (bid >> 3);
        sc.x = __builtin_amdgcn_readfirstlane(sc.x); sc.j = __builtin_amdgcn_readfirstlane(sc.j);
    }
    RUNPH(1, phase_inproj<0>(p, smem, bid, nblk, sc))
    xcd_barrier(bar);
    RUNPH(2, phase_indexer(p, smem, bid, nblk, sc))
    xcd_split_arrive(bar);
    RUNPH(3, phase_attn<0>(p, smem, bid, nblk, sc))
    RUNPH(4, phase_attn<2>(p, smem, bid, nblk, sc))
    xcd_split_wait(bar);
    RUNPH(5, phase_attn<1>(p, smem, bid, nblk, sc))
    xcd_barrier(bar);
    RUNPH(6, phase_merge<1>(p, smem, bid, nblk, sc))
    xcd_barrier(bar);
    RUNPH(7, phase_outproj(p, smem, bid, nblk, sc))
    xcd_barrier(bar);
#if PROBE_REP == 10
    phase_route<1>(p, smem, bid, nblk);
    xcd_barrier(bar);
#endif
    phase_route<0>(p, smem, bid, nblk);
    xcd_barrier(bar);
    RUNPH(8, phase_moe<0>(p, smem, bid, nblk, sc))
    xcd_barrier(bar);
    RUNPH(9, phase_moe<1>(p, smem, bid, nblk, sc))
    xcd_barrier(bar);
#if PROBE_REP == 11
    phase_final<1>(p, bid, nblk);
    xcd_barrier(bar);
#endif
    phase_final<0>(p, bid, nblk);
}

#define MBYTES(x) ((size_t)(x) << 20)
extern "C" void kernel_launch(void* const* d_in, const int* in_sizes, int n_in, void* d_out, int out_size, void* d_ws, size_t ws_size, hipStream_t stream) {
    P p{};
    p.x = (const float*)d_in[0]; p.pos = (const int*)d_in[1]; p.mem = (const float*)d_in[2];
    p.g_mix = (const float*)d_in[3]; p.w_in = (const float*)d_in[4]; p.b_gate = (const float*)d_in[5];
    p.lq1 = (const float*)d_in[6]; p.lk1 = (const float*)d_in[7]; p.lq2 = (const float*)d_in[8]; p.lk2 = (const float*)d_in[9];
    p.g_sub = (const float*)d_in[10]; p.g_mem = (const float*)d_in[11]; p.w_mkv = (const float*)d_in[12];
    p.w_br0 = (const float*)d_in[13]; p.w_br1 = (const float*)d_in[14]; p.w_br2 = (const float*)d_in[15];
    p.w_out = (const float*)d_in[16]; p.g_ffn = (const float*)d_in[17];
    p.w_rg = (const float*)d_in[18]; p.b_rg = (const float*)d_in[19]; p.w_re = (const float*)d_in[20]; p.b_re = (const float*)d_in[21];
    p.w_ei = (const float*)d_in[22]; p.w_eo = (const float*)d_in[23]; p.g_fin = (const float*)d_in[24];
    char* ws = (char*)d_ws; p.out = (float*)d_out;
    p.bar = (unsigned*)ws; p.CNT = (int*)(ws + 65536); p.XC = (int*)(ws + 131072);
    p.NBUF = (bf16_t*)(ws + MBYTES(1));
    p.DQ = (bf16_t*)(ws + MBYTES(65)); p.DK = (bf16_t*)(ws + MBYTES(97)); p.MERGED = (bf16_t*)(ws + MBYTES(65));
    p.SQ = (bf16_t*)(ws + MBYTES(129)); p.SK = (bf16_t*)(ws + MBYTES(161)); p.HID = (bf16_t*)(ws + MBYTES(129));
    p.DVT = (bf16_t*)(ws + MBYTES(193)); p.SVT = (bf16_t*)(ws + MBYTES(225)); p.IQ = (bf16_t*)(ws + MBYTES(257)); p.MQ = (bf16_t*)(ws + MBYTES(289));
    p.YMOE = (bf16_t*)(ws + MBYTES(193));
    p.IK = (bf16_t*)(ws + MBYTES(321)); p.IW = (float*)(ws + MBYTES(325)); p.MASK = (unsigned*)(ws + MBYTES(326));
    p.MK = (bf16_t*)(ws + MBYTES(358)); p.MVT = (bf16_t*)(ws + MBYTES(359)); p.MEMN = (bf16_t*)(ws + MBYTES(360));
    p.ROPEC = (float*)(ws + MBYTES(362)); p.ROPES = (float*)(ws + MBYTES(363));
    p.ROUTE = (Route*)(ws + MBYTES(365)); p.LIST = (int*)(ws + MBYTES(366));
    p.WIN = (bf16_t*)(ws + MBYTES(368)); p.WMKV = (bf16_t*)(ws + MBYTES(383));
    p.WBR = (bf16_t*)(ws + MBYTES(385)); p.WOUT = (bf16_t*)(ws + MBYTES(388)); p.WEI = (bf16_t*)(ws + MBYTES(390)); p.WEO = (bf16_t*)(ws + MBYTES(422));
    p.SGS = (unsigned*)(ws + MBYTES(440));
    p.HB = (bf16_t*)(ws + MBYTES(440));
    p.YD = (bf16_t*)d_out; p.YS = p.YD + (size_t)T_TOK * 512; p.YM = p.YS + (size_t)T_TOK * 512;
    static int grid = 0;
    if (!grid) {
        int dev = 0, cus = 0, per_cu = 0;
        (void)hipGetDevice(&dev);
        (void)hipDeviceGetAttribute(&cus, hipDeviceAttributeMultiprocessorCount, dev);
        (void)hipOccupancyMaxActiveBlocksPerMultiprocessor(&per_cu, k_forward, NTHR, 0);
        if (cus <= 0) cus = 256;
        if (per_cu < 1) per_cu = 1;
        grid = cus * (per_cu < 2 ? per_cu : 2);
    }
    (void)hipMemsetAsync(p.bar, 0, 262144, stream);
    k_forward<<<grid, NTHR, 0, stream>>>(p);
}
```

```cpp
#include <hip/hip_runtime.h>
#include <stdint.h>
#include <type_traits>

typedef unsigned short bf16_t;

#define S_LEN 8192
#define NBATCH 4
#define T_TOK 32768
#define DM 1024
#define DPROJ 7240
#define LIST_CAP 32768

__device__ __forceinline__ float bf2f(bf16_t v) { return __uint_as_float(((unsigned)v) << 16); }
__device__ __forceinline__ bf16_t f2bf(float f) { unsigned u = __float_as_uint(f); u += 0x7fffu + ((u >> 16) & 1u); return (bf16_t)(u >> 16); }

__device__ __forceinline__ float xhalf_max(float x) {
    const auto r = __builtin_amdgcn_permlane32_swap(__float_as_uint(x), __float_as_uint(x), false, false);
    float m; asm("v_max_f32 %0, %1, %2" : "=v"(m) : "v"(r[0]), "v"(r[1])); return m;
}
__device__ __forceinline__ float xhalf_sum(float x) {
    const auto r = __builtin_amdgcn_permlane32_swap(__float_as_uint(x), __float_as_uint(x), false, false);
    return __uint_as_float(r[0]) + __uint_as_float(r[1]);
}
template <int CTRL> __device__ __forceinline__ float dpp_movf(float v) { return __int_as_float(__builtin_amdgcn_update_dpp(0, __float_as_int(v), CTRL, 0xF, 0xF, true)); }
template <int CTRL> __device__ __forceinline__ int dpp_movi(int v) { return __builtin_amdgcn_update_dpp(0, v, CTRL, 0xF, 0xF, true); }
__device__ __forceinline__ float wave_sum(float v) {
    v += dpp_movf<0xB1>(v); v += dpp_movf<0x4E>(v); v += dpp_movf<0x141>(v); v += dpp_movf<0x140>(v);
    { const auto r = __builtin_amdgcn_permlane16_swap(__float_as_uint(v), __float_as_uint(v), false, false); v = __uint_as_float(r[0]) + __uint_as_float(r[1]); }
    { const auto r = __builtin_amdgcn_permlane32_swap(__float_as_uint(v), __float_as_uint(v), false, false); v = __uint_as_float(r[0]) + __uint_as_float(r[1]); }
    return v;
}
__device__ __forceinline__ float wave_max(float v) {
    v = fmaxf(v, dpp_movf<0xB1>(v)); v = fmaxf(v, dpp_movf<0x4E>(v)); v = fmaxf(v, dpp_movf<0x141>(v)); v = fmaxf(v, dpp_movf<0x140>(v));
    { const auto r = __builtin_amdgcn_permlane16_swap(__float_as_uint(v), __float_as_uint(v), false, false); v = fmaxf(__uint_as_float(r[0]), __uint_as_float(r[1])); }
    { const auto r = __builtin_amdgcn_permlane32_swap(__float_as_uint(v), __float_as_uint(v), false, false); v = fmaxf(__uint_as_float(r[0]), __uint_as_float(r[1])); }
    return v;
}
__device__ __forceinline__ int wave_sum_i(int v) {
    v += dpp_movi<0xB1>(v); v += dpp_movi<0x4E>(v); v += dpp_movi<0x141>(v); v += dpp_movi<0x140>(v);
    { const auto r = __builtin_amdgcn_permlane16_swap((unsigned)v, (unsigned)v, false, false); v = (int)(r[0] + r[1]); }
    { const auto r = __builtin_amdgcn_permlane32_swap((unsigned)v, (unsigned)v, false, false); v = (int)(r[0] + r[1]); }
    return v;
}
__device__ __forceinline__ float block_sum(float v, float* red) {
    v = wave_sum(v);
    __syncthreads();
    if ((threadIdx.x & 63) == 0) red[threadIdx.x >> 6] = v;
    __syncthreads();
    return red[0] + red[1] + red[2] + red[3];
}
__device__ __forceinline__ int block_sum_i(int v, int* red) {
    v = wave_sum_i(v);
    __syncthreads();
    if ((threadIdx.x & 63) == 0) red[threadIdx.x >> 6] = v;
    __syncthreads();
    return red[0] + red[1] + red[2] + red[3];
}

struct Route { int e0, e1; float c0, c1; };
#define XB_TMO      128
#define XB_XCNT(j)  (256  + 64 * (j))
#define XB_XSUB(j)  (1280 + 64 * (j))
#define XB_XGEN(j)  (2304 + 64 * (j))
#define XB_TOP      3328
#define XB_TOPGEN   3392
#define XCD_BAR_WORDS 3456
#define XB_SPIN_CAP (1u << 18)
#define LAS __attribute__((address_space(3)))

__device__ __forceinline__ unsigned xb_ld(unsigned* p)              { return __hip_atomic_load(p, __ATOMIC_RELAXED, __HIP_MEMORY_SCOPE_AGENT); }
__device__ __forceinline__ unsigned xb_add(unsigned* p, unsigned v) { return __hip_atomic_fetch_add(p, v, __ATOMIC_RELAXED, __HIP_MEMORY_SCOPE_AGENT); }
__device__ __forceinline__ unsigned xb_xcc_id() { return (unsigned)__builtin_amdgcn_s_getreg((3 << 11) | 20) & 0xFu; }
#define XB_SPIN(cond, bar) do { unsigned _sp = 0; while (cond) { __builtin_amdgcn_s_sleep(1); \
    if ((++_sp & 255u) == 0u) { if (xb_ld(&(bar)[XB_TMO])) break; if (_sp > XB_SPIN_CAP) { atomicAdd(&(bar)[XB_TMO], 1u); break; } } } } while (0)

struct XcdBarrier {
    unsigned* bar; unsigned x;
    volatile LAS unsigned* st;
};

__device__ __forceinline__ XcdBarrier xcd_barrier_post(unsigned* bar, volatile LAS unsigned* st) {
    XcdBarrier b; b.bar = bar; b.x = xb_xcc_id(); b.st = st;
    if (threadIdx.x == 0) (void)xb_add(&bar[XB_XCNT(b.x)], 1u);
    return b;
}
__device__ __forceinline__ void xcd_barrier_complete(unsigned* bar, unsigned x, unsigned& nloc, unsigned& nx) {
    const unsigned G = gridDim.x * gridDim.y * gridDim.z;
    unsigned sum, cnt, mine, sp = 0u;
    for (;;) {
        sum = 0u; cnt = 0u; mine = 0u;
#pragma unroll
        for (unsigned j = 0; j < 16; ++j) { const unsigned c = xb_ld(&bar[XB_XCNT(j)]); sum += c; cnt += (c > 0u) ? 1u : 0u; mine = (j == x) ? c : mine; }
        if (sum == G) break;
        __builtin_amdgcn_s_sleep(1);
        if ((++sp & 255u) == 0u) { if (xb_ld(&bar[XB_TMO])) break; if (sp > XB_SPIN_CAP) { atomicAdd(&bar[XB_TMO], 1u); break; } }
    }
    nloc = mine > 0u ? mine : 1u; nx = cnt > 0u ? cnt : 1u;
}

__device__ __forceinline__ void xcd_barrier(const XcdBarrier& b) {
    asm volatile("s_waitcnt vmcnt(0)" ::: "memory");
    __syncthreads();
    if (threadIdx.x == 0) {
        unsigned* bar = b.bar;
        __builtin_amdgcn_s_waitcnt(0);
        unsigned nloc = b.st[0], nx = b.st[1];
        if (nloc == 0u) { xcd_barrier_complete(bar, b.x, nloc, nx); b.st[0] = nloc; b.st[1] = nx; }
        const unsigned old = xb_add(&bar[XB_XSUB(b.x)], 1u);
        const unsigned gen = old / nloc;
        if (old + 1u == (gen + 1u) * nloc) {
            __builtin_amdgcn_fence(__ATOMIC_RELEASE, "agent");
            asm volatile("s_waitcnt vmcnt(0)" ::: "memory");
            const unsigned og = xb_add(&bar[XB_TOP], 1u);
            const unsigned tg = og / nx;
            if (og + 1u == (tg + 1u) * nx) xb_add(&bar[XB_TOPGEN], 1u);
            else XB_SPIN(xb_ld(&bar[XB_TOPGEN]) == tg, bar);
            __builtin_amdgcn_fence(__ATOMIC_ACQUIRE, "agent");
            xb_add(&bar[XB_XGEN(b.x)], 1u);
            asm volatile("s_waitcnt vmcnt(0)" ::: "memory");
        } else {
            XB_SPIN(xb_ld(&bar[XB_XGEN(b.x)]) == gen, bar);
            __builtin_amdgcn_fence(__ATOMIC_ACQUIRE, "agent");
            asm volatile("s_waitcnt vmcnt(0)" ::: "memory");
        }
    }
    __syncthreads();
}


#define XB_SPLIT 4096
__device__ __forceinline__ void xcd_split_arrive(const XcdBarrier& b) {
    asm volatile("s_waitcnt vmcnt(0)" ::: "memory");
    __syncthreads();
    if (threadIdx.x == 0) {
        __builtin_amdgcn_s_waitcnt(0);
        __builtin_amdgcn_fence(__ATOMIC_RELEASE, "agent");
        asm volatile("s_waitcnt vmcnt(0)" ::: "memory");
        (void)xb_add(&b.bar[XB_SPLIT], 1u);
    }
}
__device__ __forceinline__ void xcd_split_wait(const XcdBarrier& b) {
    __syncthreads();
    if (threadIdx.x == 0) {
        const unsigned G = gridDim.x * gridDim.y * gridDim.z;
        XB_SPIN(xb_ld(&b.bar[XB_SPLIT]) < G, b.bar);
        __builtin_amdgcn_fence(__ATOMIC_ACQUIRE, "agent");
        asm volatile("s_waitcnt vmcnt(0)" ::: "memory");
    }
    __syncthreads();
}
typedef __attribute__((ext_vector_type(8))) __bf16 bf16x8;
typedef __attribute__((ext_vector_type(16))) float f32x16;
typedef __attribute__((ext_vector_type(4))) float f32x4;
#define NTHR 256
#define LDSK 72
#define SMEM_BYTES 81920

struct P {
    const float* x; const int* pos; const float* mem; const float* g_mix; const float* w_in; const float* b_gate;
    const float* lq1; const float* lk1; const float* lq2; const float* lk2; const float* g_sub; const float* g_mem; const float* w_mkv;
    const float* w_br0; const float* w_br1; const float* w_br2; const float* w_out; const float* g_ffn;
    const float* w_rg; const float* b_rg; const float* w_re; const float* b_re; const float* w_ei; const float* w_eo; const float* g_fin;
    float* out;
    unsigned* bar; int* CNT;
    bf16_t* NBUF; bf16_t* DQ; bf16_t* DK; bf16_t* DVT; bf16_t* SQ; bf16_t* SK; bf16_t* SVT; bf16_t* IQ; bf16_t* MQ; bf16_t* IK; float* IW; unsigned* MASK;
    bf16_t* MK; bf16_t* MVT; bf16_t* MEMN; float* ROPEC; float* ROPES;
    bf16_t* WIN; bf16_t* WBR; bf16_t* WOUT; bf16_t* WMKV; bf16_t* WEI; bf16_t* WEO;
    bf16_t* YD; bf16_t* YS; bf16_t* YM; bf16_t* MERGED; bf16_t* HID; bf16_t* YMOE; Route* ROUTE; int* LIST; unsigned* SGS; int* XC; bf16_t* HB;
};

__device__ __forceinline__ int opaque_tid() { int t = threadIdx.x; asm volatile("" : "+v"(t)); return t; }
typedef __bf16 bf16x2v_t __attribute__((ext_vector_type(2)));
typedef float f32x2c_t __attribute__((ext_vector_type(2)));
__device__ __forceinline__ unsigned cvt_pk_bf16_ord(float lo, float hi) { unsigned r; asm volatile("s_nop 0\n\tv_cvt_pk_bf16_f32 %0, %1, %2" : "=v"(r) : "v"(lo), "v"(hi)); return r; }
__device__ __forceinline__ unsigned cvt_pk_bf16(float lo, float hi) { const f32x2c_t v = {lo, hi}; const bf16x2v_t r = __builtin_convertvector(v, bf16x2v_t); return __builtin_bit_cast(unsigned, r); }

template <int MAP> __device__ __forceinline__ int colmap(int n) {
    if (MAP == 1) return n < 3584 ? n : n < 4096 ? n + 72 : n < 4168 ? n - 512 : n < 4224 ? -1 : n - 56;
    if (MAP == 2) { const int c = n >> 6, j = n & 63; return j < 32 ? 32 * c + j : 512 + 32 * c + (j - 32); }
    return n;
}
template <int MAP, int NTL> __device__ __forceinline__ void tconv_tile(const float* __restrict__ src, int ld, int K, bf16_t* __restrict__ dst, int tile, float* tl) {
    const int n0 = (tile % NTL) * 64, k0 = (tile / NTL) * 64;
    const int t = opaque_tid(); const int nn = (t & 15) * 4; const int c = colmap<MAP>(n0 + nn);
#pragma unroll
    for (int i = 0; i < 4; ++i) { const int kk = (t >> 4) + 16 * i;
        const float4 v = c >= 0 ? *(const float4*)(src + (size_t)(k0 + kk) * ld + c) : make_float4(0.f, 0.f, 0.f, 0.f);
        tl[kk * 65 + nn] = v.x; tl[kk * 65 + nn + 1] = v.y; tl[kk * 65 + nn + 2] = v.z; tl[kk * 65 + nn + 3] = v.w; }
    __syncthreads();
#pragma unroll
    for (int i = 0; i < 2; ++i) { const int cc = t + 256 * i; const int n2 = cc >> 3, kc = (cc & 7) * 8;
        uint4 o; o.x = cvt_pk_bf16(tl[(kc + 0) * 65 + n2], tl[(kc + 1) * 65 + n2]); o.y = cvt_pk_bf16(tl[(kc + 2) * 65 + n2], tl[(kc + 3) * 65 + n2]);
        o.z = cvt_pk_bf16(tl[(kc + 4) * 65 + n2], tl[(kc + 5) * 65 + n2]); o.w = cvt_pk_bf16(tl[(kc + 6) * 65 + n2], tl[(kc + 7) * 65 + n2]);
        *(uint4*)(dst + (size_t)(n0 + n2) * K + k0 + kc) = o; }
    __syncthreads();
}
#define TC_WIN 1824
#define TC_WBR (TC_WIN + 384)
#define TC_WOUT (TC_WBR + 256)
#define TC_WMKV (TC_WOUT + 256)
#define TC_WEI (TC_WMKV + 4096)
#define TC_WEO (TC_WEI + 2048)
__device__ void phase_prologue(const P& p, char* smem, int bid, int nblk) {
    float* tl = (float*)smem;
    const int tidp = opaque_tid();
    for (int g = bid; g < TC_WEO; g += nblk) {
        if (g < TC_WIN) tconv_tile<1, 114>(p.w_in, DPROJ, 1024, p.WIN, g, tl);
        else if (g < TC_WBR) { const int j = (g - TC_WIN) >> 7; const float* s = j == 0 ? p.w_br0 : j == 1 ? p.w_br1 : p.w_br2; tconv_tile<0, 16>(s, 1024, 512, p.WBR + (size_t)j * 1024 * 512, (g - TC_WIN) & 127, tl); }
        else if (g < TC_WOUT) tconv_tile<0, 16>(p.w_out, 1024, 1024, p.WOUT, g - TC_WBR, tl);
        else if (g < TC_WMKV) tconv_tile<0, 16>(p.w_mkv, 1024, 1024, p.WMKV, g - TC_WOUT, tl);
        else if (g < TC_WEI) { const int e = (g - TC_WMKV) >> 8; tconv_tile<2, 16>(p.w_ei + (size_t)e * 1024 * 1024, 1024, 1024, p.WEI + (size_t)e * 1024 * 1024, (g - TC_WMKV) & 255, tl); }
        else { const int e = (g - TC_WEI) >> 7; tconv_tile<0, 16>(p.w_eo + (size_t)e * 512 * 1024, 1024, 512, p.WEO + (size_t)e * 1024 * 512, (g - TC_WEI) & 127, tl); }
    }
    const int lane = tidp & 63; const int gw = bid * 4 + (tidp >> 6), nw = nblk * 4;
    for (int row = gw; row < T_TOK + 1024; row += nw) {
        const float* src; const float* g; bf16_t* dst;
        if (row < T_TOK) { src = p.x + (size_t)row * DM; g = p.g_mix; dst = p.NBUF + (size_t)row * DM; }
        else { src = p.mem + (size_t)(row - T_TOK) * DM; g = p.g_mem; dst = p.MEMN + (size_t)(row - T_TOK) * DM; }
        float4 v[4]; float ss = 0.f;
#pragma unroll
        for (int i = 0; i < 4; ++i) { v[i] = *(const float4*)(src + i * 256 + lane * 4); ss += v[i].x * v[i].x + v[i].y * v[i].y + v[i].z * v[i].z + v[i].w * v[i].w; }
        ss = wave_sum(ss);
        const float r = rsqrtf(ss * (1.0f / DM) + 1e-6f);
#pragma unroll
        for (int i = 0; i < 4; ++i) { const float4 gg = *(const float4*)(g + i * 256 + lane * 4);
            uint2 o; o.x = cvt_pk_bf16(v[i].x * r * gg.x, v[i].y * r * gg.y); o.y = cvt_pk_bf16(v[i].z * r * gg.z, v[i].w * r * gg.w);
            *(uint2*)(dst + i * 256 + lane * 4) = o; }
    }
    for (int i = bid * NTHR + tidp; i < T_TOK * 8; i += nblk * NTHR) {
        const float inv = powf(500000.0f, -(float)(i & 7) / 8.0f);
        const float ang = (float)p.pos[i >> 3] * inv;
        float sn, cs; sincosf(ang, &sn, &cs);
        p.ROPEC[i] = cs; p.ROPES[i] = sn;
    }
    if (bid == 0 && tidp < 16) p.CNT[tidp] = 0;
}


struct Sched { int x, j; };
struct XOrder {
    int x, j, J, nblk, bid;
    __device__ __forceinline__ XOrder(int bid_, int nblk_, const Sched& s) : x(s.x), j(s.j), J(nblk_ >> 3), nblk(nblk_), bid(bid_) {}
    __device__ __forceinline__ bool round(int r, int N, int& u) const {
        if ((nblk & 7) != 0) { u = r * nblk + bid; if (r * nblk >= N) return false; if (u >= N) u = -1; return true; }
        const int c = r * 8 + x; if (r * 8 * J >= N) return false; u = c * J + j; if (u >= N) u = -1; return true;
    }
};
__device__ __forceinline__ void tile_mn(int u, int NT, int& mt, int& nt) { const int g = u / (8 * NT), rem = u - g * 8 * NT; nt = rem >> 3; mt = g * 8 + (rem & 7); }

__device__ __forceinline__ int gl_row(int tid, int q) { return (tid >> 6) * 32 + q * 8 + ((tid & 63) >> 3); }
__device__ __forceinline__ unsigned gl_col(int tid, int row) { return (unsigned)(((tid & 7) ^ ((row >> 1) & 7)) * 8); }
__device__ __forceinline__ void gemm_mainloop(const bf16_t* __restrict__ Rb, unsigned or0, unsigned or1, unsigned or2, unsigned or3,
                                              const bf16_t* __restrict__ Lb, unsigned ol0, unsigned ol1, unsigned ol2, unsigned ol3, int K, f32x16 (&acc)[2][2], bf16_t* As, bf16_t* Bs) {
    const int tid = opaque_tid(), lane = tid & 63, wid = tid >> 6, wr = wid >> 1, wc = wid & 1;
    const int nk = K >> 6;
    LAS unsigned* ldsA = (LAS unsigned*)(As + wid * 32 * 64);
    LAS unsigned* ldsB = (LAS unsigned*)(Bs + wid * 32 * 64);
    const int sw = (lane >> 1) & 7;
    const bf16_t* ard = As + (wr * 64 + (lane & 31)) * 64;
    const bf16_t* brd = Bs + (wc * 64 + (lane & 31)) * 64;
    const int lh = lane >> 5;
#define GLDS_TILE(stage_, ko_) { \
    __builtin_amdgcn_global_load_lds((const unsigned*)(Rb + or0 + (ko_)), (LAS unsigned*)((LAS char*)ldsA + (stage_) * 32768), 16, 0, 0); \
    __builtin_amdgcn_global_load_lds((const unsigned*)(Rb + or1 + (ko_)), (LAS unsigned*)((LAS char*)ldsA + (stage_) * 32768 + 1024), 16, 0, 0); \
    __builtin_amdgcn_global_load_lds((const unsigned*)(Rb + or2 + (ko_)), (LAS unsigned*)((LAS char*)ldsA + (stage_) * 32768 + 2048), 16, 0, 0); \
    __builtin_amdgcn_global_load_lds((const unsigned*)(Rb + or3 + (ko_)), (LAS unsigned*)((LAS char*)ldsA + (stage_) * 32768 + 3072), 16, 0, 0); \
    __builtin_amdgcn_global_load_lds((const unsigned*)(Lb + ol0 + (ko_)), (LAS unsigned*)((LAS char*)ldsB + (stage_) * 32768), 16, 0, 0); \
    __builtin_amdgcn_global_load_lds((const unsigned*)(Lb + ol1 + (ko_)), (LAS unsigned*)((LAS char*)ldsB + (stage_) * 32768 + 1024), 16, 0, 0); \
    __builtin_amdgcn_global_load_lds((const unsigned*)(Lb + ol2 + (ko_)), (LAS unsigned*)((LAS char*)ldsB + (stage_) * 32768 + 2048), 16, 0, 0); \
    __builtin_amdgcn_global_load_lds((const unsigned*)(Lb + ol3 + (ko_)), (LAS unsigned*)((LAS char*)ldsB + (stage_) * 32768 + 3072), 16, 0, 0); }
    __syncthreads();
    GLDS_TILE(0, 0u)
    __syncthreads();
    for (int kt = 0; kt < nk; ++kt) {
        const int cur = (kt & 1) * 16384;
        if (kt + 1 < nk) { if (kt & 1) GLDS_TILE(0, (unsigned)(kt + 1) * 64u) else GLDS_TILE(1, (unsigned)(kt + 1) * 64u) }
#pragma unroll
        for (int ks = 0; ks < 4; ++ks) {
            const int cc = ((2 * ks + lh) ^ sw) * 8;
            const bf16x8 fa0 = *(const bf16x8*)(ard + cur + cc), fa1 = *(const bf16x8*)(ard + cur + 32 * 64 + cc);
            const bf16x8 fb0 = *(const bf16x8*)(brd + cur + cc), fb1 = *(const bf16x8*)(brd + cur + 32 * 64 + cc);
            acc[0][0] = __builtin_amdgcn_mfma_f32_32x32x16_bf16(fa0, fb0, acc[0][0], 0, 0, 0);
            acc[0][1] = __builtin_amdgcn_mfma_f32_32x32x16_bf16(fa0, fb1, acc[0][1], 0, 0, 0);
            acc[1][0] = __builtin_amdgcn_mfma_f32_32x32x16_bf16(fa1, fb0, acc[1][0], 0, 0, 0);
            acc[1][1] = __builtin_amdgcn_mfma_f32_32x32x16_bf16(fa1, fb1, acc[1][1], 0, 0, 0);
        }
        __syncthreads();
    }
#undef GLDS_TILE
}
#define ZERO_ACC(acc) { _Pragma("unroll") for (int i_ = 0; i_ < 2; ++i_) _Pragma("unroll") for (int j_ = 0; j_ < 2; ++j_) _Pragma("unroll") for (int r_ = 0; r_ < 16; ++r_) acc[i_][j_][r_] = 0.f; }
#define CSTR 136
__device__ __forceinline__ void cimg_write(const f32x16 (&acc)[2][2], bf16_t* Cs, int wr, int wc, int l31, int lh) {
#pragma unroll
    for (int i = 0; i < 2; ++i)
#pragma unroll
        for (int j = 0; j < 2; ++j)
#pragma unroll
            for (int g = 0; g < 4; ++g) { uint2 o; o.x = cvt_pk_bf16(acc[i][j][4 * g], acc[i][j][4 * g + 1]); o.y = cvt_pk_bf16(acc[i][j][4 * g + 2], acc[i][j][4 * g + 3]);
                *(uint2*)(Cs + (64 * wc + 32 * j + l31) * CSTR + 64 * wr + 32 * i + 8 * g + 4 * lh) = o; }
}

template <int NOEPI> __device__ void phase_inproj(const P& p, char* smem, int bid, int nblk, const Sched& sc) {
    bf16_t* As = (bf16_t*)smem; bf16_t* Bs = As + 128 * 64; bf16_t* Cs = (bf16_t*)smem;
    const int tid = opaque_tid(), lane = tid & 63, wid = tid >> 6, wr = wid >> 1, wc = wid & 1;
    const int l31 = lane & 31, lh = lane >> 5;
    const int NT = 33, NMAIN = 256 * NT;
    const XOrder xo(bid, nblk, sc);
    const bool xaware = false;
    for (int rr = 0; ; ++rr) {
        bool main_t; int mt, nt;
        if (xaware) {
            if (rr < 16) { main_t = true; mt = ((sc.x >> 2) * 16 + rr) * 8 + (sc.j & 7); nt = (sc.x & 3) * 8 + (sc.j >> 3); }
            else if (rr == 16) { if (bid >= 320) break; main_t = bid < 256; mt = main_t ? bid : (bid - 256) >> 3; nt = main_t ? 32 : (bid - 256) & 7; }
            else break;
        } else {
            int t; if (!xo.round(rr, NMAIN + 64, t)) break; if (t < 0) continue;
            main_t = t < NMAIN;
            if (main_t) tile_mn(t, NT, mt, nt); else { mt = (t - NMAIN) >> 3; nt = (t - NMAIN) & 7; }
        }
        const bf16_t* X = main_t ? p.NBUF : p.MEMN; const bf16_t* W = main_t ? p.WIN : p.WMKV;
        const int grp = main_t ? (nt >> 2) : (nt < 4 ? 7 : 2);
        const bool transposed = grp == 2 || grp == 5;
        const int g0 = gl_row(tid, 0); const unsigned to = (unsigned)g0 * 1024u + gl_col(tid, g0);
        const unsigned t1 = (unsigned)(g0 + 8) * 1024u + gl_col(tid, g0 + 8), t2 = (unsigned)(g0 + 16) * 1024u + gl_col(tid, g0 + 16), t3 = (unsigned)(g0 + 24) * 1024u + gl_col(tid, g0 + 24);
        const bf16_t* Xt = X + (size_t)mt * 128 * 1024; const bf16_t* Wt = W + (size_t)nt * 128 * 1024;
        f32x16 acc[2][2]; ZERO_ACC(acc);
        gemm_mainloop(transposed ? Xt : Wt, to, t1, t2, t3, transposed ? Wt : Xt, to, t1, t2, t3, 1024, acc, As, Bs);
        if (NOEPI) { float s_ = 0.f; for (int i_ = 0; i_ < 2; ++i_) for (int j_ = 0; j_ < 2; ++j_) for (int r_ = 0; r_ < 16; ++r_) s_ += acc[i_][j_][r_]; if (s_ == 1.2345e30f) p.IW[0] = s_; continue; }
        const int tok0 = mt * 128;
        if (main_t && !transposed && grp != 7) {
            if (grp != 8 || wr == 0) {
#pragma unroll
                for (int j = 0; j < 2; ++j) { const int tok = tok0 + 64 * wc + 32 * j + l31;
                    const float4 c4 = *(const float4*)(p.ROPEC + (size_t)tok * 8 + 4 * lh), s4 = *(const float4*)(p.ROPES + (size_t)tok * 8 + 4 * lh);
                    const float cc[4] = {c4.x, c4.y, c4.z, c4.w}, ss[4] = {s4.x, s4.y, s4.z, s4.w};
#pragma unroll
                    for (int r = 0; r < 4; ++r) { const float x1 = acc[0][j][r], x2 = acc[0][j][r + 4]; acc[0][j][r] = x1 * cc[r] - x2 * ss[r]; acc[0][j][r + 4] = x2 * cc[r] + x1 * ss[r]; } }
            }
        }
        if (grp == 8 && wr == 1) {
#pragma unroll
            for (int j = 0; j < 2; ++j) { const int tok = tok0 + 64 * wc + 32 * j + l31; *(float4*)(p.IW + (size_t)tok * 8 + 4 * lh) = make_float4(acc[0][j][0], acc[0][j][1], acc[0][j][2], acc[0][j][3]); }
        }
        __syncthreads();
        cimg_write(acc, Cs, wr, wc, l31, lh);
        __syncthreads();
        bf16_t* dbase; size_t dstride; int nch = 16;
        if (!main_t) {
            if (nt < 4) { dbase = p.MK + (size_t)tok0 * 512 + nt * 128; dstride = 512; }
            else { dbase = p.MVT + ((size_t)((mt >> 1) * 4 + (nt - 4)) * 128) * 256 + (mt & 1) * 128; dstride = 256; }
        } else if (grp == 2) { dbase = p.DVT + ((size_t)((mt >> 6) * 4 + (nt - 8)) * 128) * S_LEN + (mt & 63) * 128; dstride = S_LEN; }
        else if (grp == 5) { dbase = p.SVT + ((size_t)((mt >> 6) * 8 + (nt - 20) * 2) * 64) * S_LEN + (mt & 63) * 128; dstride = S_LEN; }
        else if (grp == 8) { dbase = p.IK + (size_t)tok0 * 64; dstride = 64; nch = 8; }
        else { bf16_t* d = grp == 0 ? p.DQ : grp == 1 ? p.DK : grp == 3 ? p.SQ : grp == 4 ? p.SK : grp == 6 ? p.IQ : p.MQ; dbase = d + (size_t)tok0 * 512 + (nt & 3) * 128; dstride = 512; }
        int te_ = tid; asm volatile("" : "+v"(te_));
#pragma unroll
        for (int k = 0; k < 8; ++k) { const int c = te_ + 256 * k; const int lrow = c >> 4, ch = c & 15;
            if (ch < nch) { const uint4 v = *(const uint4*)(Cs + lrow * CSTR + ch * 8); *(uint4*)(dbase + (size_t)lrow * dstride + ch * 8) = v; } }
    }
}
template <int REPS = 1> __device__ void phase_merge(const P& p, char* smem, int bid, int nblk, const Sched& sc) {
    bf16_t* As = (bf16_t*)smem; bf16_t* Bs = As + 128 * 64; bf16_t* Cs = (bf16_t*)smem;
    const int tid = opaque_tid(), lane = tid & 63, wid = tid >> 6, wr = wid >> 1, wc = wid & 1;
    const int l31 = lane & 31, lh = lane >> 5;
    const XOrder xo(bid, nblk, sc);
    const bool xaware = false;
#pragma unroll 1
    for (int rep = 0; rep < REPS; ++rep)
    for (int rr = 0; ; ++rr) {
        int mt, nt;
        if (xaware) { if (rr >= 4) break; nt = sc.x; mt = rr * 64 + sc.j; }
        else { int t; if (!xo.round(rr, 256 * 8, t)) break; if (t < 0) continue; tile_mn(t, 8, mt, nt); }
        f32x16 mg[2][2]; ZERO_ACC(mg);
#pragma unroll 1
        for (int br = 0; br < 3; ++br) {
            int tl_ = tid; asm volatile("" : "+v"(tl_));
            unsigned sgr[8][4];
            {
                const int g0 = gl_row(tl_, 0);
                const unsigned to = (unsigned)g0 * 1024u + gl_col(tl_, g0), t1 = (unsigned)(g0 + 8) * 1024u + gl_col(tl_, g0 + 8), t2 = (unsigned)(g0 + 16) * 1024u + gl_col(tl_, g0 + 16), t3 = (unsigned)(g0 + 24) * 1024u + gl_col(tl_, g0 + 24);
                f32x16 acc[2][2]; ZERO_ACC(acc);
                gemm_mainloop(p.WIN + (size_t)(4224 + br * 1024 + nt * 128) * 1024, to, t1, t2, t3, p.NBUF + (size_t)mt * 128 * 1024, to, t1, t2, t3, 1024, acc, As, Bs);
#pragma unroll
                for (int i = 0; i < 2; ++i)
#pragma unroll
                    for (int g = 0; g < 4; ++g) { const float4 b4 = *(const float4*)(p.b_gate + br * 1024 + nt * 128 + 64 * wr + 32 * i + 8 * g + 4 * lh);
                        const float bb[4] = {b4.x, b4.y, b4.z, b4.w};
#pragma unroll
                        for (int j = 0; j < 2; ++j) { float s[4];
#pragma unroll
                            for (int r = 0; r < 4; ++r) s[r] = __builtin_amdgcn_rcpf(1.0f + __expf(-(acc[i][j][4 * g + r] + bb[r])));
                            acc[i][j][4 * g] = __uint_as_float(cvt_pk_bf16_ord(s[0], s[1])); acc[i][j][4 * g + 1] = __uint_as_float(cvt_pk_bf16_ord(s[2], s[3])); } }
#pragma unroll
                for (int i = 0; i < 2; ++i)
#pragma unroll
                    for (int j = 0; j < 2; ++j)
#pragma unroll
                        for (int h2 = 0; h2 < 2; ++h2) {
                            sgr[(i * 2 + j) * 2 + h2][0] = __float_as_uint(acc[i][j][8 * h2]); sgr[(i * 2 + j) * 2 + h2][1] = __float_as_uint(acc[i][j][8 * h2 + 1]);
                            sgr[(i * 2 + j) * 2 + h2][2] = __float_as_uint(acc[i][j][8 * h2 + 4]); sgr[(i * 2 + j) * 2 + h2][3] = __float_as_uint(acc[i][j][8 * h2 + 5]); }
                asm volatile("" ::: "memory");
            }
            {
                const bf16_t* Y = br == 0 ? p.YD : br == 1 ? p.YS : p.YM;
                int tl2_ = tid; asm volatile("" : "+v"(tl2_));
                const int g0 = gl_row(tl2_, 0);
                const unsigned to = (unsigned)g0 * 512u + gl_col(tl2_, g0), t1 = (unsigned)(g0 + 8) * 512u + gl_col(tl2_, g0 + 8), t2 = (unsigned)(g0 + 16) * 512u + gl_col(tl2_, g0 + 16), t3 = (unsigned)(g0 + 24) * 512u + gl_col(tl2_, g0 + 24);
                f32x16 acc[2][2]; ZERO_ACC(acc);
                gemm_mainloop(p.WBR + (size_t)br * 1024 * 512 + (size_t)nt * 128 * 512, to, t1, t2, t3, Y + (size_t)mt * 128 * 512, to, t1, t2, t3, 512, acc, As, Bs);
                asm volatile("" ::: "memory");
#pragma unroll
                for (int i = 0; i < 2; ++i)
#pragma unroll
                    for (int j = 0; j < 2; ++j)
#pragma unroll
                        for (int h2 = 0; h2 < 2; ++h2) { const unsigned ww[4] = {sgr[(i * 2 + j) * 2 + h2][0], sgr[(i * 2 + j) * 2 + h2][1], sgr[(i * 2 + j) * 2 + h2][2], sgr[(i * 2 + j) * 2 + h2][3]};
#pragma unroll
                            for (int q = 0; q < 2; ++q) {
                                const int g = 2 * h2 + q;
                                mg[i][j][4 * g] += __uint_as_float(ww[2 * q] << 16) * acc[i][j][4 * g];
                                mg[i][j][4 * g + 1] += __uint_as_float(ww[2 * q] & 0xffff0000u) * acc[i][j][4 * g + 1];
                                mg[i][j][4 * g + 2] += __uint_as_float(ww[2 * q + 1] << 16) * acc[i][j][4 * g + 2];
                                mg[i][j][4 * g + 3] += __uint_as_float(ww[2 * q + 1] & 0xffff0000u) * acc[i][j][4 * g + 3]; } }
            }
        }
        __syncthreads();
        cimg_write(mg, Cs, wr, wc, l31, lh);
        __syncthreads();
        bf16_t* dbase = p.MERGED + (size_t)mt * 128 * 1024 + nt * 128;
        int te_ = tid; asm volatile("" : "+v"(te_));
#pragma unroll
        for (int k = 0; k < 8; ++k) { const int c = te_ + 256 * k; const int lrow = c >> 4, ch = c & 15;
            const uint4 v = *(const uint4*)(Cs + lrow * CSTR + ch * 8); *(uint4*)(dbase + (size_t)lrow * 1024 + ch * 8) = v; }
    }
}

#define CFS 132
__device__ void phase_outproj(const P& p, char* smem, int bid, int nblk, const Sched& sc) {
    bf16_t* As = (bf16_t*)smem; bf16_t* Bs = As + 128 * 64;
    const int tid = opaque_tid(), lane = tid & 63, wid = tid >> 6, wr = wid >> 1, wc = wid & 1;
    const int l31 = lane & 31, lh = lane >> 5;
    const XOrder xo(bid, nblk, sc);
    for (int rr = 0; ; ++rr) {
        int t; if (!xo.round(rr, 256 * 8, t)) break; if (t < 0) continue;
        int mt, nt; tile_mn(t, 8, mt, nt);
        const int g0 = gl_row(tid, 0);
        const unsigned to = (unsigned)g0 * 1024u + gl_col(tid, g0), t1 = (unsigned)(g0 + 8) * 1024u + gl_col(tid, g0 + 8), t2 = (unsigned)(g0 + 16) * 1024u + gl_col(tid, g0 + 16), t3 = (unsigned)(g0 + 24) * 1024u + gl_col(tid, g0 + 24);
        f32x16 acc[2][2]; ZERO_ACC(acc);
        gemm_mainloop(p.WOUT + (size_t)nt * 128 * 1024, to, t1, t2, t3, p.MERGED + (size_t)mt * 128 * 1024, to, t1, t2, t3, 1024, acc, As, Bs);
        float* Cf = (float*)smem;
#pragma unroll
        for (int i = 0; i < 2; ++i)
#pragma unroll
            for (int j = 0; j < 2; ++j)
#pragma unroll
                for (int g = 0; g < 4; ++g)
                    *(float4*)(Cf + (64 * wc + 32 * j + l31) * CFS + 64 * wr + 32 * i + 8 * g + 4 * lh) = make_float4(acc[i][j][4 * g], acc[i][j][4 * g + 1], acc[i][j][4 * g + 2], acc[i][j][4 * g + 3]);
        __syncthreads();
        int to_ = tid; asm volatile("" : "+v"(to_));
#pragma unroll
        for (int k = 0; k < 8; ++k) { const int c = to_ + 256 * k; const int lrow = c >> 4, ch = c & 15;
            const float4 a0 = *(const float4*)(Cf + lrow * CFS + ch * 8), a1 = *(const float4*)(Cf + lrow * CFS + ch * 8 + 4);
            const size_t go = (size_t)(mt * 128 + lrow) * 1024 + nt * 128 + ch * 8;
            const float4 x0 = *(const float4*)(p.x + go), x1 = *(const float4*)(p.x + go + 4);
            uint4 o; o.x = cvt_pk_bf16(x0.x + a0.x, x0.y + a0.y); o.y = cvt_pk_bf16(x0.z + a0.z, x0.w + a0.w); o.z = cvt_pk_bf16(x1.x + a1.x, x1.y + a1.y); o.w = cvt_pk_bf16(x1.z + a1.z, x1.w + a1.w);
            *(uint4*)(p.HB + go) = o; }
    }
}

template <int VAR = 0> __device__ void phase_route(const P& p, char* smem, int bid, int nblk) {
    float4* wrg = (float4*)smem;
    const int tidp = opaque_tid();
    for (int i = tidp; i < 1024; i += NTHR) wrg[i] = *(const float4*)(p.w_rg + i * 4);
    __syncthreads();
    const int lane = tidp & 63; const int gw = bid * 4 + (tidp >> 6), nw = nblk * 4;
    int pend_e = -1, pend_q = 0, pend_v = 0;
    for (int tok = gw; tok < T_TOK; tok += nw) {
        const bf16_t* src = p.HB + (size_t)tok * DM;
        float tv[16]; float ss = 0.f;
#pragma unroll
        for (int i = 0; i < 4; ++i) { const uint2 u = *(const uint2*)(src + i * 256 + lane * 4);
            float4 v; v.x = __uint_as_float(u.x << 16); v.y = __uint_as_float(u.x & 0xffff0000u); v.z = __uint_as_float(u.y << 16); v.w = __uint_as_float(u.y & 0xffff0000u);
            tv[4 * i] = v.x; tv[4 * i + 1] = v.y; tv[4 * i + 2] = v.z; tv[4 * i + 3] = v.w; ss += v.x * v.x + v.y * v.y + v.z * v.z + v.w * v.w; }
        ss = wave_sum(ss);
        const float r = rsqrtf(ss * (1.0f / DM) + 1e-6f);
        float g0 = 0.f, g1 = 0.f, g2 = 0.f, g3 = 0.f;
#pragma unroll
        for (int i = 0; i < 4; ++i) { const float4 gg = *(const float4*)(p.g_ffn + i * 256 + lane * 4);
            tv[4 * i] *= r * gg.x; tv[4 * i + 1] *= r * gg.y; tv[4 * i + 2] *= r * gg.z; tv[4 * i + 3] *= r * gg.w;
            uint2 o; o.x = cvt_pk_bf16(tv[4 * i], tv[4 * i + 1]); o.y = cvt_pk_bf16(tv[4 * i + 2], tv[4 * i + 3]);
            *(uint2*)((VAR ? (bf16_t*)p.SGS + (size_t)8 * 1024 * 1024 + (size_t)(tok & 16383) * DM : p.NBUF + (size_t)tok * DM) + i * 256 + lane * 4) = o;
#pragma unroll
            for (int j = 0; j < 4; ++j) { const float4 w = wrg[i * 256 + lane * 4 + j]; const float x = tv[4 * i + j]; g0 += x * w.x; g1 += x * w.y; g2 += x * w.z; g3 += x * w.w; } }
        g0 = wave_sum(g0) + p.b_rg[0]; g1 = wave_sum(g1) + p.b_rg[1]; g2 = wave_sum(g2) + p.b_rg[2]; g3 = wave_sum(g3) + p.b_rg[3];
        int grp = 0; float gm = g0;
        if (g1 > gm) { gm = g1; grp = 1; } if (g2 > gm) { gm = g2; grp = 2; } if (g3 > gm) { gm = g3; grp = 3; }
        const float pg = 1.0f / (expf(g0 - gm) + expf(g1 - gm) + expf(g2 - gm) + expf(g3 - gm));
        float e0 = 0.f, e1 = 0.f, e2 = 0.f, e3 = 0.f;
#pragma unroll
        for (int i = 0; i < 4; ++i)
#pragma unroll
            for (int j = 0; j < 4; ++j) { const float4 w = *(const float4*)(p.w_re + (size_t)(i * 256 + lane * 4 + j) * 16 + grp * 4); const float x = tv[4 * i + j]; e0 += x * w.x; e1 += x * w.y; e2 += x * w.z; e3 += x * w.w; }
        float el[4];
        el[0] = wave_sum(e0) + p.b_re[grp * 4]; el[1] = wave_sum(e1) + p.b_re[grp * 4 + 1]; el[2] = wave_sum(e2) + p.b_re[grp * 4 + 2]; el[3] = wave_sum(e3) + p.b_re[grp * 4 + 3];
        if (lane < 2 && VAR == 0) {
            int i0 = 0; float m0 = el[0];
            if (el[1] > m0) { m0 = el[1]; i0 = 1; } if (el[2] > m0) { m0 = el[2]; i0 = 2; } if (el[3] > m0) { m0 = el[3]; i0 = 3; }
            int i1 = -1; float m1 = -INFINITY;
            if (i0 != 0 && el[0] > m1) { m1 = el[0]; i1 = 0; } if (i0 != 1 && el[1] > m1) { m1 = el[1]; i1 = 1; }
            if (i0 != 2 && el[2] > m1) { m1 = el[2]; i1 = 2; } if (i0 != 3 && el[3] > m1) { m1 = el[3]; i1 = 3; }
            const float p1 = expf(m1 - m0);
            Route rt; rt.e0 = grp * 4 + i0; rt.e1 = grp * 4 + i1; rt.c0 = pg / (1.0f + p1); rt.c1 = pg * p1 / (1.0f + p1);
            if (lane == 0) p.ROUTE[tok] = rt;
            if (pend_e >= 0) p.LIST[pend_e * LIST_CAP + pend_q] = pend_v;
            pend_e = lane == 0 ? rt.e0 : rt.e1; pend_v = tok * 2 + lane;
            pend_q = atomicAdd(&p.CNT[pend_e], 1);
        }
    }
    if (lane < 2 && VAR == 0 && pend_e >= 0) p.LIST[pend_e * LIST_CAP + pend_q] = pend_v;
}

template <int DOWN> __device__ void phase_moe(const P& p, char* smem, int bid, int nblk, const Sched& sc) {
    bf16_t* As = (bf16_t*)smem; bf16_t* Bs = As + 128 * 64; bf16_t* Cs = (bf16_t*)smem;
    int* ents = (int*)(smem + 73728); float* cws = (float*)(ents + 128);
    const int tid = opaque_tid(), lane = tid & 63, wid = tid >> 6, wr = wid >> 1, wc = wid & 1;
    const int l31 = lane & 31, lh = lane >> 5;
    int cnt[16]; int total = 0;
#pragma unroll
    for (int e = 0; e < 16; ++e) { cnt[e] = p.CNT[e]; total += ((cnt[e] + 127) >> 7) * 8; }
    const XOrder xo(bid, nblk, sc);
    for (int rr = 0; ; ++rr) {
        int u; if (!xo.round(rr, total, u)) break; if (u < 0) continue;
        int e = 0, base = 0, ce = 0;
#pragma unroll
        for (int k = 0; k < 16; ++k) { const int n = ((cnt[k] + 127) >> 7) * 8; if (u >= base + n && k == e) { base += n; e = k + 1; } if (k == e) ce = cnt[k]; }
        const int loc = u - base; const int mt = loc >> 3, nt = loc & 7;
        const int nrows = min(128, ce - mt * 128);
        __syncthreads();
        if (tid < 128) { const int ent = p.LIST[e * LIST_CAP + mt * 128 + (tid < nrows ? tid : 0)]; ents[tid] = ent;
            if (DOWN) { const Route rt = p.ROUTE[ent >> 1]; cws[tid] = (ent & 1) ? rt.c1 : rt.c0; } }
        __syncthreads();
        const int KK = DOWN ? 512 : 1024;
        const bf16_t* Xb = DOWN ? p.HID : p.NBUF;
        int tu_ = tid; asm volatile("" : "+v"(tu_));
        const int g0 = gl_row(tu_, 0);
        const unsigned ol0 = (unsigned)(DOWN ? ents[g0] : ents[g0] >> 1) * (unsigned)KK + gl_col(tu_, g0), ol1 = (unsigned)(DOWN ? ents[g0 + 8] : ents[g0 + 8] >> 1) * (unsigned)KK + gl_col(tu_, g0 + 8);
        const unsigned ol2 = (unsigned)(DOWN ? ents[g0 + 16] : ents[g0 + 16] >> 1) * (unsigned)KK + gl_col(tu_, g0 + 16), ol3 = (unsigned)(DOWN ? ents[g0 + 24] : ents[g0 + 24] >> 1) * (unsigned)KK + gl_col(tu_, g0 + 24);
        const bf16_t* Wb = (DOWN ? p.WEO + (size_t)e * 1024 * 512 : p.WEI + (size_t)e * 1024 * 1024) + (size_t)nt * 128 * KK;
        const unsigned w0 = (unsigned)g0 * (unsigned)KK + gl_col(tu_, g0), w1 = (unsigned)(g0 + 8) * (unsigned)KK + gl_col(tu_, g0 + 8), w2 = (unsigned)(g0 + 16) * (unsigned)KK + gl_col(tu_, g0 + 16), w3 = (unsigned)(g0 + 24) * (unsigned)KK + gl_col(tu_, g0 + 24);
        f32x16 acc[2][2]; ZERO_ACC(acc);
        gemm_mainloop(Wb, w0, w1, w2, w3, Xb, ol0, ol1, ol2, ol3, KK, acc, As, Bs);
        if (DOWN) {
#pragma unroll
            for (int j = 0; j < 2; ++j) { const float c = cws[64 * wc + 32 * j + l31];
#pragma unroll
                for (int i = 0; i < 2; ++i)
#pragma unroll
                    for (int r = 0; r < 16; ++r) acc[i][j][r] *= c; }
        } else {
#pragma unroll
            for (int j = 0; j < 2; ++j)
#pragma unroll
                for (int r = 0; r < 16; ++r) { const float g = acc[0][j][r]; acc[0][j][r] = g * __builtin_amdgcn_rcpf(1.0f + __expf(-g)) * acc[1][j][r]; }
        }
        __syncthreads();
        if (DOWN) cimg_write(acc, Cs, wr, wc, l31, lh);
        else {
#pragma unroll
            for (int j = 0; j < 2; ++j)
#pragma unroll
                for (int g = 0; g < 4; ++g) { uint2 o; o.x = cvt_pk_bf16(acc[0][j][4 * g], acc[0][j][4 * g + 1]); o.y = cvt_pk_bf16(acc[0][j][4 * g + 2], acc[0][j][4 * g + 3]);
                    *(uint2*)(Cs + (64 * wc + 32 * j + l31) * CSTR + 32 * wr + 8 * g + 4 * lh) = o; }
        }
        __syncthreads();
        int te_ = tid; asm volatile("" : "+v"(te_));
        if (DOWN) {
#pragma unroll
            for (int k = 0; k < 8; ++k) { const int c = te_ + 256 * k; const int lrow = c >> 4, ch = c & 15;
                if (lrow < nrows) { const uint4 v = *(const uint4*)(Cs + lrow * CSTR + ch * 8); *(uint4*)(p.YMOE + (size_t)ents[lrow] * 1024 + nt * 128 + ch * 8) = v; } }
        } else {
#pragma unroll
            for (int k = 0; k < 4; ++k) { const int c = te_ + 256 * k; const int lrow = c >> 3, ch = c & 7;
                if (lrow < nrows) { const uint4 v = *(const uint4*)(Cs + lrow * CSTR + ch * 8); *(uint4*)(p.HID + (size_t)ents[lrow] * 512 + nt * 64 + ch * 8) = v; } }
        }
    }
}

template <int VAR = 0> __device__ void phase_final(const P& p, int bid, int nblk) {
    const int tidp = opaque_tid();
    const int lane = tidp & 63; const int gw = bid * 4 + (tidp >> 6), nw = nblk * 4;
    for (int tok = gw; tok < T_TOK; tok += nw) {
        float* hp = p.out + (size_t)tok * DM; const bf16_t* hb = p.HB + (size_t)tok * DM; const bf16_t* y0 = p.YMOE + (size_t)tok * 2 * DM; const bf16_t* y1 = y0 + DM;
        float4 v[4]; float ss = 0.f;
#pragma unroll
        for (int i = 0; i < 4; ++i) { const uint2 hu = *(const uint2*)(hb + i * 256 + lane * 4);
            v[i].x = __uint_as_float(hu.x << 16); v[i].y = __uint_as_float(hu.x & 0xffff0000u); v[i].z = __uint_as_float(hu.y << 16); v[i].w = __uint_as_float(hu.y & 0xffff0000u);
            const uint2 a = *(const uint2*)(y0 + i * 256 + lane * 4), b = *(const uint2*)(y1 + i * 256 + lane * 4);
            v[i].x += __uint_as_float(a.x << 16) + __uint_as_float(b.x << 16); v[i].y += __uint_as_float(a.x & 0xffff0000u) + __uint_as_float(b.x & 0xffff0000u);
            v[i].z += __uint_as_float(a.y << 16) + __uint_as_float(b.y << 16); v[i].w += __uint_as_float(a.y & 0xffff0000u) + __uint_as_float(b.y & 0xffff0000u);
            ss += v[i].x * v[i].x + v[i].y * v[i].y + v[i].z * v[i].z + v[i].w * v[i].w; }
        ss = wave_sum(ss);
        const float r = rsqrtf(ss * (1.0f / DM) + 1e-6f);
#pragma unroll
        for (int i = 0; i < 4; ++i) { const float4 gg = *(const float4*)(p.g_fin + i * 256 + lane * 4);
            float4 o; o.x = v[i].x * r * gg.x; o.y = v[i].y * r * gg.y; o.z = v[i].z * r * gg.z; o.w = v[i].w * r * gg.w;
            *(float4*)((VAR ? (float*)p.SGS + (size_t)4 * 1024 * 1024 + (size_t)(tok & 8191) * DM : hp) + i * 256 + lane * 4) = o; }
    }
}
__device__ __forceinline__ float fast_exp2(float x) { return __builtin_amdgcn_exp2f(x); }
typedef float f32x2v __attribute__((ext_vector_type(2)));
template <int KIND, int VAR = 0> __device__ void phase_attn(const P& p, char* smem, int bid, int nblk, const Sched& sc) {
    constexpr int NM = 1, NMAPS = KIND == 0 ? 2 : 1, DQK = KIND == 2 ? 128 : 64, DV = KIND == 1 ? 64 : 128;
    constexpr int KROW = DQK, QROW = NMAPS * DQK, KSTR = KROW + 8, VSTR = 72, NDT = DV / 32, NKS = DQK / 16;
    constexpr int KCH = 64 * KROW / 8 / NTHR, VCH = DV * 8 / NTHR;
    constexpr int NH = KIND == 1 ? 8 : 4;
    constexpr int NUNITS = NBATCH * NH * 64;
    constexpr bool DB = KIND != 2;
    bf16_t* Ks = (bf16_t*)smem; bf16_t* Vs = Ks + (DB ? 2 : 1) * 64 * KSTR;
    const int tid = opaque_tid(), lane = tid & 63, wid = tid >> 6, l31 = lane & 31, lh = lane >> 5;
    const float c = (KIND == 2 ? 0.08838834764831845f : 0.125f) * 1.4426950408889634f;
    float lam = 0.f;
    if (KIND == 0) { float d1 = 0.f, d2 = 0.f; for (int i = 0; i < 64; ++i) { d1 += p.lq1[i] * p.lk1[i]; d2 += p.lq2[i] * p.lk2[i]; } lam = expf(d1) - expf(d2) + 0.2f; }
    const bf16_t* Qb = KIND == 0 ? p.DQ : KIND == 1 ? p.SQ : p.MQ;
    const bf16_t* Kb = KIND == 0 ? p.DK : KIND == 1 ? p.SK : p.MK;
    const bf16_t* Vb = KIND == 0 ? p.DVT : KIND == 1 ? p.SVT : p.MVT;
    bf16_t* Yb = VAR != 0 ? (bf16_t*)p.SGS + (size_t)16 * 1024 * 1024 : KIND == 0 ? p.YD : KIND == 1 ? p.YS : p.YM;
    constexpr int VLEN = KIND == 2 ? 256 : S_LEN;
    const bool xaware = false;
    for (int rnd = 0; xaware ? (rnd < NBATCH * NH / 8) : (rnd * nblk < NUNITS); ++rnd) {
        int qt, bh;
        if (xaware) { bh = sc.x * (NBATCH * NH / 8) + rnd; qt = (rnd & 1) ? sc.j : 63 - sc.j; }
        else { const int rank = rnd * nblk + ((rnd & 1) ? nblk - 1 - bid : bid); if (rank >= NUNITS) continue;
               qt = KIND == 2 ? rank % 64 : 63 - rank / (NBATCH * NH); bh = KIND == 2 ? rank / 64 : rank % (NBATCH * NH); }
        const int b = bh / NH, h = bh % NH;
        const int q0 = qt * 128, qw = q0 + 32 * wid;
        const int nkt = KIND == 2 ? 4 : 2 * (qt + 1);
        unsigned o1pk[NDT][8];
#pragma unroll 1
        for (int map = 0; map < NMAPS; ++map) {
        bf16x8 qf[NM][NKS];
        const bf16_t* qp = Qb + ((size_t)(b * S_LEN + qw + l31)) * 512 + h * QROW + map * DQK + lh * 8;
        if (KIND != 2) {
#pragma unroll
            for (int m = 0; m < NM; ++m)
#pragma unroll
                for (int ks = 0; ks < NKS; ++ks) qf[m][ks] = *(const bf16x8*)(qp + m * DQK + ks * 16);
        }
        f32x16 o[NM][NDT];
#pragma unroll
        for (int m = 0; m < NM; ++m)
#pragma unroll
            for (int dt = 0; dt < NDT; ++dt)
#pragma unroll
                for (int r = 0; r < 16; ++r) o[m][dt][r] = 0.f;
        float mrow[NM], lrow[NM];
#pragma unroll
        for (int m = 0; m < NM; ++m) { mrow[m] = -INFINITY; lrow[m] = 0.f; }
        int tid_l = tid; asm volatile("" : "+v"(tid_l));
        const bf16_t* ksrc = Kb + ((size_t)(KIND == 2 ? b * 256 : b * S_LEN) + (tid_l >> (KROW == 128 ? 4 : 3))) * 512 + h * QROW + map * DQK + (tid_l & (KROW / 8 - 1)) * 8;
        constexpr int KROWS_PER_PASS = NTHR / (KROW / 8);
        const int krow_ = tid_l >> (KROW == 128 ? 4 : 3);
        bf16_t* kdst = Ks + ((krow_ & ~12) | ((krow_ & 4) << 1) | ((krow_ & 8) >> 1)) * KSTR + (tid_l & (KROW / 8 - 1)) * 8;
        const bf16_t* vsrc = Vb + ((size_t)(bh * DV + (tid_l >> 3))) * VLEN + (tid_l & 7) * 8;
        bf16_t* vdst = Vs + (tid_l >> 3) * VSTR + (tid_l & 7) * 8;
        uint4 rk0, rk1, rk2 = make_uint4(0,0,0,0), rk3 = make_uint4(0,0,0,0), rv0, rv1, rv2 = make_uint4(0,0,0,0), rv3 = make_uint4(0,0,0,0);
        { const bf16_t* s_ = ksrc + (size_t)(0) * 512; rk0 = *(const uint4*)(s_); rk1 = *(const uint4*)(s_ + (size_t)KROWS_PER_PASS * 512); if (KCH > 2) { rk2 = *(const uint4*)(s_ + (size_t)2 * KROWS_PER_PASS * 512); rk3 = *(const uint4*)(s_ + (size_t)3 * KROWS_PER_PASS * 512); } }
        { const bf16_t* s_ = vsrc + ((size_t)0); rv0 = *(const uint4*)(s_); rv1 = *(const uint4*)(s_ + (size_t)32 * VLEN); if (VCH > 2) { rv2 = *(const uint4*)(s_ + (size_t)64 * VLEN); rv3 = *(const uint4*)(s_ + (size_t)96 * VLEN); } }
        __syncthreads();
        { *(uint4*)(kdst) = rk0; *(uint4*)(kdst + KROWS_PER_PASS * KSTR) = rk1; if (KCH > 2) { *(uint4*)(kdst + 2 * KROWS_PER_PASS * KSTR) = rk2; *(uint4*)(kdst + 3 * KROWS_PER_PASS * KSTR) = rk3; } }
        { *(uint4*)(vdst) = rv0; *(uint4*)(vdst + 32 * VSTR) = rv1; if (VCH > 2) { *(uint4*)(vdst + 64 * VSTR) = rv2; *(uint4*)(vdst + 96 * VSTR) = rv3; } }
        __syncthreads();
        if (!DB && nkt > 1) { const bf16_t* s_ = ksrc + (size_t)(64) * 512; rk0 = *(const uint4*)(s_); rk1 = *(const uint4*)(s_ + (size_t)KROWS_PER_PASS * 512); if (KCH > 2) { rk2 = *(const uint4*)(s_ + (size_t)2 * KROWS_PER_PASS * 512); rk3 = *(const uint4*)(s_ + (size_t)3 * KROWS_PER_PASS * 512); } }
        uint2 mwn = make_uint2(0u, 0u);
        if (KIND == 1) mwn = *(const uint2*)(p.MASK + ((size_t)(b * S_LEN + qw + l31)) * 256);
        for (int kt = 0; kt < nkt; ++kt) {
            const bool active = KIND == 2 ? true : (kt * 64 <= qw + 31);
            const bf16_t* Kc = Ks + (DB ? (kt & 1) * 64 * KSTR : 0); const bf16_t* Vc = Vs + (DB ? (kt & 1) * DV * VSTR : 0);
            if (DB && kt + 1 < nkt && VAR != 6 && VAR != 7) {
                { const bf16_t* s_ = ksrc + (size_t)((kt + 1) * 64) * 512; rk0 = *(const uint4*)(s_); rk1 = *(const uint4*)(s_ + (size_t)KROWS_PER_PASS * 512); if (KCH > 2) { rk2 = *(const uint4*)(s_ + (size_t)2 * KROWS_PER_PASS * 512); rk3 = *(const uint4*)(s_ + (size_t)3 * KROWS_PER_PASS * 512); } }
                { const bf16_t* s_ = vsrc + ((size_t)(kt + 1) * 64); rv0 = *(const uint4*)(s_); rv1 = *(const uint4*)(s_ + (size_t)32 * VLEN); if (VCH > 2) { rv2 = *(const uint4*)(s_ + (size_t)64 * VLEN); rv3 = *(const uint4*)(s_ + (size_t)96 * VLEN); } }
            }
            __builtin_amdgcn_sched_barrier(0);
            unsigned pk[NM][2][2][4];
            if (active) {
                uint2 mw = mwn;
                if (KIND == 1) { mw.x >>= 8 * lh; mw.y >>= 8 * lh; if (kt + 1 < nkt) mwn = *(const uint2*)(p.MASK + ((size_t)(b * S_LEN + qw + l31)) * 256 + (kt + 1) * 2); }
#pragma unroll
                for (int m = 0; m < NM; ++m) {
                    f32x16 s[2];
#pragma unroll
                    for (int r = 0; r < 16; ++r) { s[0][r] = 0.f; s[1][r] = 0.f; }
#pragma unroll
                    for (int ks = 0; ks < NKS; ks += 2) {
                        const bf16x8 a00 = *(const bf16x8*)(Kc + l31 * KSTR + m * DQK + ks * 16 + lh * 8);
                        const bf16x8 a10 = *(const bf16x8*)(Kc + (32 + l31) * KSTR + m * DQK + ks * 16 + lh * 8);
                        const bf16x8 a01 = *(const bf16x8*)(Kc + l31 * KSTR + m * DQK + (ks + 1) * 16 + lh * 8);
                        const bf16x8 a11 = *(const bf16x8*)(Kc + (32 + l31) * KSTR + m * DQK + (ks + 1) * 16 + lh * 8);
                        const bf16x8 q0_ = KIND == 2 ? *(const bf16x8*)(qp + ks * 16) : qf[m][ks];
                        const bf16x8 q1_ = KIND == 2 ? *(const bf16x8*)(qp + (ks + 1) * 16) : qf[m][ks + 1];
                        __builtin_amdgcn_sched_barrier(0);
                        if (VAR != 5) {
                        s[0] = __builtin_amdgcn_mfma_f32_32x32x16_bf16(a00, q0_, s[0], 0, 0, 0);
                        s[1] = __builtin_amdgcn_mfma_f32_32x32x16_bf16(a10, q0_, s[1], 0, 0, 0);
                        s[0] = __builtin_amdgcn_mfma_f32_32x32x16_bf16(a01, q1_, s[0], 0, 0, 0);
                        s[1] = __builtin_amdgcn_mfma_f32_32x32x16_bf16(a11, q1_, s[1], 0, 0, 0);
                        } else { asm volatile("" :: "v"(a00), "v"(a10), "v"(a01), "v"(a11)); }
                    }
                    if (KIND == 0 && kt * 64 + 63 > qw) {
                        const int qi = qw + l31 - kt * 64 - 8 * lh;
#pragma unroll
                        for (int t = 0; t < 2; ++t)
#pragma unroll
                            for (int r = 0; r < 16; ++r) if (32 * t + (r & 7) + 16 * (r >> 3) > qi) s[t][r] = -INFINITY;
                    }
                    float mx = s[0][0];
#pragma unroll
                    for (int r = 1; r < 16; ++r) mx = fmaxf(mx, s[0][r]);
#pragma unroll
                    for (int r = 0; r < 16; ++r) mx = fmaxf(mx, s[1][r]);
                    mx = xhalf_max(mx);
                    const float mnew = fmaxf(mrow[m], mx * c);
                    const float corr = fast_exp2(mrow[m] - mnew);
                    mrow[m] = mnew;
                    f32x2v ps2 = {0.f, 0.f}; const f32x2v c2 = {c, c}, nm2 = {-mnew, -mnew};
#pragma unroll
                    for (int t = 0; t < 2; ++t)
#pragma unroll
                        for (int r = 0; r < 16; r += 2) {
                            const f32x2v sv = {s[t][r], s[t][r + 1]};
                            const f32x2v y = VAR == 3 ? sv : sv * c2 + nm2;
                            f32x2v pv = {(VAR == 1 || VAR == 3) ? y.x : fast_exp2(y.x), (VAR == 1 || VAR == 3) ? y.y : fast_exp2(y.y)};
                            if (KIND == 1) { int m0 = __builtin_amdgcn_sbfe((int)(t ? mw.y : mw.x), (r & 7) + 16 * (r >> 3), 1), m1 = __builtin_amdgcn_sbfe((int)(t ? mw.y : mw.x), ((r + 1) & 7) + 16 * ((r + 1) >> 3), 1);
                                             asm("" : "+v"(m0), "+v"(m1));
                                             pv.x = __uint_as_float(__float_as_uint(pv.x) & (unsigned)m0); pv.y = __uint_as_float(__float_as_uint(pv.y) & (unsigned)m1); }
                            ps2 += pv; s[t][r] = pv.x; s[t][r + 1] = pv.y;
                        }
                    const float psum = ps2.x + ps2.y;
                    lrow[m] = lrow[m] * corr + psum;
#pragma unroll
                    for (int t = 0; t < 2; ++t)
#pragma unroll
                        for (int s2 = 0; s2 < 2; ++s2)
#pragma unroll
                            for (int j = 0; j < 4; ++j) pk[m][t][s2][j] = cvt_pk_bf16(s[t][8 * s2 + 2 * j], s[t][8 * s2 + 2 * j + 1]);
                    if (__any(corr != 1.0f)) {
#pragma unroll
                        for (int dt = 0; dt < NDT; ++dt)
#pragma unroll
                            for (int r = 0; r < 16; ++r) o[m][dt][r] *= corr;
                    }
                }
            }
            if (!DB) {
            __syncthreads();
            if (kt + 1 < nkt) {
                { *(uint4*)(kdst) = rk0; *(uint4*)(kdst + KROWS_PER_PASS * KSTR) = rk1; if (KCH > 2) { *(uint4*)(kdst + 2 * KROWS_PER_PASS * KSTR) = rk2; *(uint4*)(kdst + 3 * KROWS_PER_PASS * KSTR) = rk3; } }
                { const bf16_t* s_ = vsrc + ((size_t)(kt + 1) * 64); rv0 = *(const uint4*)(s_); rv1 = *(const uint4*)(s_ + (size_t)32 * VLEN); if (VCH > 2) { rv2 = *(const uint4*)(s_ + (size_t)64 * VLEN); rv3 = *(const uint4*)(s_ + (size_t)96 * VLEN); } }
            }
            }
            if (active) {
                constexpr int GS = NDT == 4 ? 1 : 2;
#pragma unroll
                for (int ks2 = 0; ks2 < 4; ks2 += GS) {
                    bf16x8 va[GS][NDT];
#pragma unroll
                    for (int g = 0; g < GS; ++g)
#pragma unroll
                        for (int dt = 0; dt < NDT; ++dt) {
                            va[g][dt] = *(const bf16x8*)(Vc + (32 * dt + l31) * VSTR + 16 * (ks2 + g) + 8 * lh);
                        }
                    __builtin_amdgcn_sched_barrier(0);
#pragma unroll
                    for (int g = 0; g < GS; ++g)
#pragma unroll
                        for (int dt = 0; dt < NDT; ++dt)
#pragma unroll
                            for (int m = 0; m < NM; ++m) {
                                const int k2 = ks2 + g;
                                const uint4 pu = make_uint4(pk[m][k2 >> 1][k2 & 1][0], pk[m][k2 >> 1][k2 & 1][1], pk[m][k2 >> 1][k2 & 1][2], pk[m][k2 >> 1][k2 & 1][3]);
                                if (VAR != 2) o[m][dt] = __builtin_amdgcn_mfma_f32_32x32x16_bf16(va[g][dt], *(const bf16x8*)&pu, o[m][dt], 0, 0, 0); else { o[m][dt][0] += __uint_as_float(pu.x); asm volatile("" :: "v"(va[g][dt])); }
                            }
                }
            }
            if (DB) {
                if (kt + 1 < nkt && VAR != 6 && VAR != 7) {
                    bf16_t* kd = kdst + ((kt + 1) & 1) * 64 * KSTR; bf16_t* vd = vdst + ((kt + 1) & 1) * DV * VSTR;
                    { *(uint4*)(kd) = rk0; *(uint4*)(kd + KROWS_PER_PASS * KSTR) = rk1; if (KCH > 2) { *(uint4*)(kd + 2 * KROWS_PER_PASS * KSTR) = rk2; *(uint4*)(kd + 3 * KROWS_PER_PASS * KSTR) = rk3; } }
                    { *(uint4*)(vd) = rv0; *(uint4*)(vd + 32 * VSTR) = rv1; if (VCH > 2) { *(uint4*)(vd + 64 * VSTR) = rv2; *(uint4*)(vd + 96 * VSTR) = rv3; } }
                }
                if (VAR != 7) __syncthreads();
            } else {
            __syncthreads();
            if (kt + 1 < nkt) {
                { *(uint4*)(vdst) = rv0; *(uint4*)(vdst + 32 * VSTR) = rv1; if (VCH > 2) { *(uint4*)(vdst + 64 * VSTR) = rv2; *(uint4*)(vdst + 96 * VSTR) = rv3; } }
                if (kt + 2 < nkt) { const bf16_t* s_ = ksrc + (size_t)((kt + 2) * 64) * 512; rk0 = *(const uint4*)(s_); rk1 = *(const uint4*)(s_ + (size_t)KROWS_PER_PASS * 512); if (KCH > 2) { rk2 = *(const uint4*)(s_ + (size_t)2 * KROWS_PER_PASS * 512); rk3 = *(const uint4*)(s_ + (size_t)3 * KROWS_PER_PASS * 512); } }
            }
            }
        }
#pragma unroll
        for (int m = 0; m < NM; ++m) lrow[m] = xhalf_sum(lrow[m]);
        bf16_t* yp = Yb + ((size_t)(b * S_LEN + qw + l31)) * 512 + h * DV + 4 * lh;
        if (KIND == 0) {
            if (map == 0) {
                const float i1 = 1.0f / lrow[0];
#pragma unroll
                for (int dt = 0; dt < NDT; ++dt)
#pragma unroll
                    for (int j = 0; j < 8; ++j) o1pk[dt][j] = cvt_pk_bf16(o[0][dt][2 * j] * i1, o[0][dt][2 * j + 1] * i1);
            } else {
            const float i2 = lam / lrow[0];
            float ss = 0.f;
#pragma unroll
            for (int dt = 0; dt < NDT; ++dt)
#pragma unroll
                for (int r = 0; r < 16; ++r) { const float o1 = (r & 1) ? __uint_as_float(o1pk[dt][r >> 1] & 0xffff0000u) : __uint_as_float(o1pk[dt][r >> 1] << 16);
                    const float v = o1 - o[0][dt][r] * i2; o[0][dt][r] = v; ss += v * v; }
            ss = xhalf_sum(ss);
            const float rn = rsqrtf(ss * (1.0f / 128.0f) + 1e-6f) * 0.8f;
#pragma unroll
            for (int dt = 0; dt < NDT; ++dt)
#pragma unroll
                for (int g = 0; g < 4; ++g) { const int dv = 32 * dt + 8 * g + 4 * lh; const float4 gs = *(const float4*)(p.g_sub + dv);
                    uint2 w; w.x = cvt_pk_bf16(o[0][dt][4 * g] * rn * gs.x, o[0][dt][4 * g + 1] * rn * gs.y); w.y = cvt_pk_bf16(o[0][dt][4 * g + 2] * rn * gs.z, o[0][dt][4 * g + 3] * rn * gs.w);
                    *(uint2*)(yp + 32 * dt + 8 * g) = w; }
            }
        } else {
            const float i1 = 1.0f / lrow[0];
#pragma unroll
            for (int dt = 0; dt < NDT; ++dt)
#pragma unroll
                for (int g = 0; g < 4; ++g) {
                    uint2 w; w.x = cvt_pk_bf16(o[0][dt][4 * g] * i1, o[0][dt][4 * g + 1] * i1); w.y = cvt_pk_bf16(o[0][dt][4 * g + 2] * i1, o[0][dt][4 * g + 3] * i1);
                    *(uint2*)(yp + 32 * dt + 8 * g) = w; }
        }
        }
    }
}
template <int KIND> __device__ void phase_attn2(const P& p, char* smem, int bid, int nblk, const Sched& sc) {
    constexpr int NMAPS = KIND == 0 ? 2 : 1, DQK = 64, DV = KIND == 1 ? 64 : 128;
    constexpr int QROW = NMAPS * DQK, KSTR = 72, VSTR = 72, NDT = DV / 32, NKS = 4;
    constexpr int VCH = DV * 8 / NTHR;
    constexpr int NH = KIND == 1 ? 8 : 4;
    constexpr int NUNITS = NBATCH * NH * 64;
    bf16_t* Ks = (bf16_t*)smem; bf16_t* Vs = Ks + 2 * 64 * KSTR;
    const int tid = opaque_tid(), lane = tid & 63, wid = tid >> 6, l31 = lane & 31, lh = lane >> 5;
    const float c = 0.125f * 1.4426950408889634f;
    float lam = 0.f;
    if (KIND == 0) { float d1 = 0.f, d2 = 0.f; for (int i = 0; i < 64; ++i) { d1 += p.lq1[i] * p.lk1[i]; d2 += p.lq2[i] * p.lk2[i]; } lam = expf(d1) - expf(d2) + 0.2f; }
    const bf16_t* Qb = KIND == 0 ? p.DQ : p.SQ;
    const bf16_t* Kb = KIND == 0 ? p.DK : p.SK;
    const bf16_t* Vb = KIND == 0 ? p.DVT : p.SVT;
    bf16_t* Yb = KIND == 0 ? p.YD : p.YS;
    const bool xaware = false;
    for (int rnd = 0; xaware ? (rnd < NBATCH * NH / 8) : (rnd * nblk < NUNITS); ++rnd) {
        int qt, bh;
        if (xaware) { bh = sc.x * (NBATCH * NH / 8) + rnd; qt = (rnd & 1) ? sc.j : 63 - sc.j; }
        else { const int rank = rnd * nblk + ((rnd & 1) ? nblk - 1 - bid : bid); if (rank >= NUNITS) continue; qt = 63 - rank / (NBATCH * NH); bh = rank % (NBATCH * NH); }
        const int b = bh / NH, h = bh % NH;
        const int q0 = qt * 128, qw = q0 + 32 * wid;
        const int nkt = 2 * (qt + 1);
        const int last_act = min(nkt - 1, (qw + 31) >> 6);
#pragma unroll 1
        for (int map = 0; map < NMAPS; ++map) {
        bf16x8 qf[NKS];
        { const bf16_t* qp = Qb + ((size_t)(b * S_LEN + qw + l31)) * 512 + h * QROW + map * DQK + lh * 8;
#pragma unroll
          for (int ks = 0; ks < NKS; ++ks) qf[ks] = *(const bf16x8*)(qp + ks * 16); }
        f32x16 o[NDT];
#pragma unroll
        for (int dt = 0; dt < NDT; ++dt)
#pragma unroll
            for (int r = 0; r < 16; ++r) o[dt][r] = 0.f;
        float mrow = -INFINITY, lrow = 0.f;
        int tl_ = tid; asm volatile("" : "+v"(tl_));
        const bf16_t* ksrc = Kb + ((size_t)b * S_LEN + (tl_ >> 3)) * 512 + h * QROW + map * DQK + (tl_ & 7) * 8;
        bf16_t* kdst = Ks + (tl_ >> 3) * KSTR + (tl_ & 7) * 8;
        const bf16_t* vsrc = Vb + ((size_t)(bh * DV + (tl_ >> 3))) * S_LEN + (tl_ & 7) * 8;
        bf16_t* vdst = Vs + (tl_ >> 3) * VSTR + (tl_ & 7) * 8;
        uint4 rk0, rk1, rv0, rv1, rv2 = make_uint4(0, 0, 0, 0), rv3 = make_uint4(0, 0, 0, 0);
#define LDK(kt_) { const bf16_t* s_ = ksrc + (size_t)((kt_) * 64) * 512; rk0 = *(const uint4*)(s_); rk1 = *(const uint4*)(s_ + (size_t)32 * 512); }
#define LDV(kt_) { const bf16_t* s_ = vsrc + (size_t)(kt_) * 64; rv0 = *(const uint4*)(s_); rv1 = *(const uint4*)(s_ + (size_t)32 * S_LEN); if (VCH > 2) { rv2 = *(const uint4*)(s_ + (size_t)64 * S_LEN); rv3 = *(const uint4*)(s_ + (size_t)96 * S_LEN); } }
#define STK(buf_) { bf16_t* d_ = kdst + (buf_) * 64 * KSTR; *(uint4*)(d_) = rk0; *(uint4*)(d_ + 32 * KSTR) = rk1; }
#define STV(buf_) { bf16_t* d_ = vdst + (buf_) * DV * VSTR; *(uint4*)(d_) = rv0; *(uint4*)(d_ + 32 * VSTR) = rv1; if (VCH > 2) { *(uint4*)(d_ + 64 * VSTR) = rv2; *(uint4*)(d_ + 96 * VSTR) = rv3; } }
        LDK(0) LDV(0)
        __syncthreads();
        STK(0) STV(0)
        LDK(1)
        STK(1)
        __syncthreads();
        f32x16 s[2];
        auto qk = [&](int kt) {
            const bf16_t* Kc = Ks + (kt & 1) * 64 * KSTR;
#pragma unroll
            for (int r = 0; r < 16; ++r) { s[0][r] = 0.f; s[1][r] = 0.f; }
#pragma unroll
            for (int ks = 0; ks < NKS; ks += 2) {
                const bf16x8 a00 = *(const bf16x8*)(Kc + l31 * KSTR + ks * 16 + lh * 8), a10 = *(const bf16x8*)(Kc + (32 + l31) * KSTR + ks * 16 + lh * 8);
                const bf16x8 a01 = *(const bf16x8*)(Kc + l31 * KSTR + (ks + 1) * 16 + lh * 8), a11 = *(const bf16x8*)(Kc + (32 + l31) * KSTR + (ks + 1) * 16 + lh * 8);
                s[0] = __builtin_amdgcn_mfma_f32_32x32x16_bf16(a00, qf[ks], s[0], 0, 0, 0);
                s[1] = __builtin_amdgcn_mfma_f32_32x32x16_bf16(a10, qf[ks], s[1], 0, 0, 0);
                s[0] = __builtin_amdgcn_mfma_f32_32x32x16_bf16(a01, qf[ks + 1], s[0], 0, 0, 0);
                s[1] = __builtin_amdgcn_mfma_f32_32x32x16_bf16(a11, qf[ks + 1], s[1], 0, 0, 0);
            }
        };
        unsigned pkp[2][2][4], pkn[2][2][4];
        float corr = 1.0f;
        uint2 mw = make_uint2(0u, 0u);
        auto softmax = [&](int kt) {
            if (KIND == 0 && kt * 64 + 63 > qw) {
                const int qi = qw + l31 - kt * 64 - 4 * lh;
#pragma unroll
                for (int t = 0; t < 2; ++t)
#pragma unroll
                    for (int r = 0; r < 16; ++r) if (32 * t + (r & 3) + 8 * (r >> 2) > qi) s[t][r] = -INFINITY;
            }
            float mx = s[0][0];
#pragma unroll
            for (int r = 1; r < 16; ++r) mx = fmaxf(mx, s[0][r]);
#pragma unroll
            for (int r = 0; r < 16; ++r) mx = fmaxf(mx, s[1][r]);
            mx = xhalf_max(mx);
            const float mnew = fmaxf(mrow, mx * c);
            corr = fast_exp2(mrow - mnew);
            mrow = mnew;
            f32x2v ps2 = {0.f, 0.f}; const f32x2v c2 = {c, c}, nm2 = {-mnew, -mnew};
#pragma unroll
            for (int t = 0; t < 2; ++t)
#pragma unroll
                for (int r = 0; r < 16; r += 2) {
                    const f32x2v sv = {s[t][r], s[t][r + 1]};
                    const f32x2v y = sv * c2 + nm2;
                    f32x2v pv = {fast_exp2(y.x), fast_exp2(y.y)};
                    if (KIND == 1) { pv.x = __uint_as_float(__float_as_uint(pv.x) & (unsigned)__builtin_amdgcn_sbfe((int)(t ? mw.y : mw.x), (r & 3) + 8 * (r >> 2), 1));
                                     pv.y = __uint_as_float(__float_as_uint(pv.y) & (unsigned)__builtin_amdgcn_sbfe((int)(t ? mw.y : mw.x), ((r + 1) & 3) + 8 * ((r + 1) >> 2), 1)); }
                    ps2 += pv;
                    pkn[t][r >> 3][(r >> 1) & 3] = cvt_pk_bf16(pv.x, pv.y);
                }
            lrow = lrow * corr + (ps2.x + ps2.y);
        };
        auto pv_mma = [&](int kt) {
            const bf16_t* Vc = Vs + (kt % 3) * DV * VSTR;
            constexpr int GS = NDT == 4 ? 1 : 2;
#pragma unroll
            for (int ks2 = 0; ks2 < 4; ks2 += GS) {
                bf16x8 va[GS][NDT];
#pragma unroll
                for (int g = 0; g < GS; ++g)
#pragma unroll
                    for (int dt = 0; dt < NDT; ++dt) {
                        const bf16_t* vp = Vc + (32 * dt + l31) * VSTR + 16 * (ks2 + g) + 4 * lh;
                        const uint2 lo = *(const uint2*)vp, hi = *(const uint2*)(vp + 8);
                        const uint4 vv = make_uint4(lo.x, lo.y, hi.x, hi.y);
                        va[g][dt] = *(const bf16x8*)&vv;
                    }
#pragma unroll
                for (int g = 0; g < GS; ++g)
#pragma unroll
                    for (int dt = 0; dt < NDT; ++dt) {
                        const int k2 = ks2 + g;
                        const uint4 pu = make_uint4(pkp[k2 >> 1][k2 & 1][0], pkp[k2 >> 1][k2 & 1][1], pkp[k2 >> 1][k2 & 1][2], pkp[k2 >> 1][k2 & 1][3]);
                        o[dt] = __builtin_amdgcn_mfma_f32_32x32x16_bf16(va[g][dt], *(const bf16x8*)&pu, o[dt], 0, 0, 0);
                    }
            }
        };
        uint2 mwn = make_uint2(0u, 0u);
        if (KIND == 1) mwn = *(const uint2*)(p.MASK + ((size_t)(b * S_LEN + qw + l31)) * 256);
        qk(0);
        for (int kt = 0; kt <= nkt; ++kt) {
            if (kt + 2 < nkt) LDK(kt + 2)
            if (kt + 1 < nkt) LDV(kt + 1)
            const bool do_sm = kt <= last_act, do_pv = kt >= 1 && kt - 1 <= last_act;
            if (do_sm && KIND == 1) { mw = mwn; mw.x >>= 4 * lh; mw.y >>= 4 * lh; if (kt + 1 <= last_act) mwn = *(const uint2*)(p.MASK + ((size_t)(b * S_LEN + qw + l31)) * 256 + (kt + 1) * 2); }
            if (do_sm && do_pv) {
                softmax(kt); pv_mma(kt - 1);
            } else if (do_sm) softmax(kt);
            else if (do_pv) pv_mma(kt - 1);
            if (do_sm) {
                if (__any(corr != 1.0f)) {
#pragma unroll
                    for (int dt = 0; dt < NDT; ++dt)
#pragma unroll
                        for (int r = 0; r < 16; ++r) o[dt][r] *= corr;
                }
#pragma unroll
                for (int t = 0; t < 2; ++t)
#pragma unroll
                    for (int s2 = 0; s2 < 2; ++s2)
#pragma unroll
                        for (int j = 0; j < 4; ++j) pkp[t][s2][j] = pkn[t][s2][j];
            }
            if (kt + 1 <= last_act) qk(kt + 1);
            if (kt + 2 < nkt) STK(kt & 1)
            if (kt + 1 < nkt) STV((kt + 1) % 3)
            __syncthreads();
        }
#undef LDK
#undef LDV
#undef STK
#undef STV
        int te_ = tid; asm volatile("" : "+v"(te_));
        uint4* park = (uint4*)p.SGS + (size_t)bid * 2048 + te_;
        lrow = xhalf_sum(lrow);
        bf16_t* yp = Yb + ((size_t)(b * S_LEN + qw + l31)) * 512 + h * DV + 4 * lh;
        if (KIND == 0) {
            if (map == 0) {
                const float i1 = 1.0f / lrow;
#pragma unroll
                for (int dt = 0; dt < NDT; ++dt)
#pragma unroll
                    for (int h2 = 0; h2 < 2; ++h2)
                        park[(size_t)(dt * 2 + h2) * 256] = make_uint4(cvt_pk_bf16(o[dt][8 * h2] * i1, o[dt][8 * h2 + 1] * i1), cvt_pk_bf16(o[dt][8 * h2 + 2] * i1, o[dt][8 * h2 + 3] * i1),
                                                                      cvt_pk_bf16(o[dt][8 * h2 + 4] * i1, o[dt][8 * h2 + 5] * i1), cvt_pk_bf16(o[dt][8 * h2 + 6] * i1, o[dt][8 * h2 + 7] * i1));
                asm volatile("" ::: "memory");
            } else {
                const float i2 = lam / lrow;
                float ss = 0.f;
#pragma unroll
                for (int dt = 0; dt < NDT; ++dt)
#pragma unroll
                    for (int h2 = 0; h2 < 2; ++h2) { const uint4 w = park[(size_t)(dt * 2 + h2) * 256]; const unsigned ww[4] = {w.x, w.y, w.z, w.w};
#pragma unroll
                        for (int j = 0; j < 4; ++j) {
                            const float v0 = __uint_as_float(ww[j] << 16) - o[dt][8 * h2 + 2 * j] * i2, v1 = __uint_as_float(ww[j] & 0xffff0000u) - o[dt][8 * h2 + 2 * j + 1] * i2;
                            o[dt][8 * h2 + 2 * j] = v0; o[dt][8 * h2 + 2 * j + 1] = v1; ss += v0 * v0 + v1 * v1; } }
                ss = xhalf_sum(ss);
                const float rn = rsqrtf(ss * (1.0f / 128.0f) + 1e-6f) * 0.8f;
#pragma unroll
                for (int dt = 0; dt < NDT; ++dt)
#pragma unroll
                    for (int g = 0; g < 4; ++g) { const int dv = 32 * dt + 8 * g + 4 * lh; const float4 gs = *(const float4*)(p.g_sub + dv);
                        uint2 w; w.x = cvt_pk_bf16(o[dt][4 * g] * rn * gs.x, o[dt][4 * g + 1] * rn * gs.y); w.y = cvt_pk_bf16(o[dt][4 * g + 2] * rn * gs.z, o[dt][4 * g + 3] * rn * gs.w);
                        *(uint2*)(yp + 32 * dt + 8 * g) = w; }
            }
        } else {
            const float i1 = 1.0f / lrow;
#pragma unroll
            for (int dt = 0; dt < NDT; ++dt)
#pragma unroll
                for (int g = 0; g < 4; ++g) {
                    uint2 w; w.x = cvt_pk_bf16(o[dt][4 * g] * i1, o[dt][4 * g + 1] * i1); w.y = cvt_pk_bf16(o[dt][4 * g + 2] * i1, o[dt][4 * g + 3] * i1);
                    *(uint2*)(yp + 32 * dt + 8 * g) = w; }
        }
        }
    }
}
#define IDX_M 23
__device__ __forceinline__ float med3f(float a, float b, float c) { return __builtin_amdgcn_fmed3f(a, b, c); }
__device__ void phase_indexer(const P& p, char* smem, int bid, int nblk, const Sched& sc_) {
    bf16_t* Kb = (bf16_t*)smem;
    unsigned* mimg = (unsigned*)(smem + 18432);
    const int tid = opaque_tid(), lane = tid & 63, wid = tid >> 6, l31 = lane & 31, lh = lane >> 5;
    constexpr int NUNITS = NBATCH * 256;
    const bool xaware = false;
    for (int rnd = 0; xaware ? (rnd < 2) : (rnd * nblk < NUNITS); ++rnd) {
        int qu, b;
        if (xaware) { b = sc_.x >> 1; const int k = rnd == 0 ? 127 - sc_.j : sc_.j; qu = 2 * k + (sc_.x & 1); }
        else { const int rank = rnd * nblk + ((rnd & 1) ? nblk - 1 - bid : bid); if (rank >= NUNITS) continue; qu = 255 - (rank >> 2); b = rank & 3; }
        const int q0 = qu * 32;
        const size_t tok0 = (size_t)b * S_LEN + q0;
        if (q0 < 256) {
#pragma unroll 1
            for (int i = 0; i < 32; ++i) { const int q = q0 + i; const int w0 = tid * 32;
                p.MASK[(tok0 + i) * 256 + tid] = q >= w0 + 31 ? 0xffffffffu : (q < w0 ? 0u : ((2u << (q - w0)) - 1u)); }
            continue;
        }
        const int nkt = (q0 + 95) >> 6;
        const int qb = q0 + 8 * wid;
        bf16x8 aq[2][4]; float wq[2][2][8]; int qv[2][2];
#pragma unroll
        for (int rt = 0; rt < 2; ++rt) {
            const int qa = qb + 4 * rt + 2 * ((l31 >> 2) & 1) + (l31 >> 4), ha = 4 * ((l31 >> 3) & 1) + (l31 & 3);
            const bf16_t* ap = p.IQ + ((size_t)b * S_LEN + qa) * 512 + ha * 64 + lh * 8;
#pragma unroll
            for (int ks = 0; ks < 4; ++ks) aq[rt][ks] = *(const bf16x8*)(ap + ks * 16);
#pragma unroll
            for (int e = 0; e < 2; ++e) { const float* wp = p.IW + ((size_t)b * S_LEN + qb + 4 * rt + 2 * lh + e) * 8;
                const float4 w0 = *(const float4*)wp, w1 = *(const float4*)(wp + 4); const float sc = 0.125f * 0.35355339059327373f;
                wq[rt][e][0] = w0.x * sc; wq[rt][e][1] = w0.y * sc; wq[rt][e][2] = w0.z * sc; wq[rt][e][3] = w0.w * sc;
                wq[rt][e][4] = w1.x * sc; wq[rt][e][5] = w1.y * sc; wq[rt][e][6] = w1.z * sc; wq[rt][e][7] = w1.w * sc;
                qv[rt][e] = qb + 4 * rt + 2 * lh + e; }
        }
        const bf16_t* ksrc = p.IK + ((size_t)b * S_LEN + (tid >> 3)) * 64 + (tid & 7) * 8;
        bf16_t* kdst = Kb + (tid >> 3) * 72 + (tid & 7) * 8;
        auto tile_scores = [&](const bf16_t* kbuf, int t, float (&sc)[2][2]) {
            f32x16 acc[2];
#pragma unroll
            for (int r = 0; r < 16; ++r) { acc[0][r] = 0.f; acc[1][r] = 0.f; }
#pragma unroll
            for (int ks = 0; ks < 4; ++ks) {
                const bf16x8 kf = *(const bf16x8*)(kbuf + (32 * t + l31) * 72 + ks * 16 + lh * 8);
                acc[0] = __builtin_amdgcn_mfma_f32_32x32x16_bf16(aq[0][ks], kf, acc[0], 0, 0, 0);
                acc[1] = __builtin_amdgcn_mfma_f32_32x32x16_bf16(aq[1][ks], kf, acc[1], 0, 0, 0);
            }
#pragma unroll
            for (int rt = 0; rt < 2; ++rt)
#pragma unroll
                for (int e = 0; e < 2; ++e) { float s = 0.f;
#pragma unroll
                    for (int hd = 0; hd < 8; ++hd) s = __builtin_fmaf(wq[rt][e][hd], __int_as_float(max(__float_as_int(acc[rt][8 * e + hd]), 0)), s);
                    sc[rt][e] = s; }
        };
        float T[2][2]; int need[2][2];
        {
            float L[2][2][IDX_M];
#pragma unroll
            for (int rt = 0; rt < 2; ++rt)
#pragma unroll
                for (int e = 0; e < 2; ++e)
#pragma unroll
                    for (int i = 0; i < IDX_M; ++i) L[rt][e][i] = -INFINITY;
            __syncthreads();
            uint4 r0 = *(const uint4*)(ksrc), r1 = *(const uint4*)(ksrc + 32 * 64);
            *(uint4*)(kdst) = r0; *(uint4*)(kdst + 32 * 72) = r1;
            __syncthreads();
            for (int kt = 0; kt < nkt; ++kt) {
                const bf16_t* kbuf = Kb + (kt & 1) * 64 * 72;
                if (kt + 1 < nkt) { r0 = *(const uint4*)(ksrc + (size_t)(kt + 1) * 64 * 64); r1 = *(const uint4*)(ksrc + (size_t)(kt + 1) * 64 * 64 + 32 * 64); }
                __builtin_amdgcn_sched_barrier(0);
                const bool interior = kt * 64 + 63 <= qb;
#pragma unroll 1
                for (int t = 0; t < 2; ++t) {
                    float sc[2][2]; tile_scores(kbuf, t, sc);
                    const int key = kt * 64 + 32 * t + l31;
#pragma unroll
                    for (int rt = 0; rt < 2; ++rt)
#pragma unroll
                        for (int e = 0; e < 2; ++e) {
                            const float v = (interior || key <= qv[rt][e]) ? sc[rt][e] : -INFINITY;
#pragma unroll
                            for (int i = IDX_M - 1; i >= 1; --i) L[rt][e][i] = med3f(L[rt][e][i - 1], L[rt][e][i], v);
                            asm("v_max_f32 %0, %1, %2" : "=v"(L[rt][e][0]) : "v"(L[rt][e][0]), "v"(v));
                        }
                }
                if (kt + 1 < nkt) { bf16_t* d = kdst + ((kt + 1) & 1) * 64 * 72; *(uint4*)(d) = r0; *(uint4*)(d + 32 * 72) = r1; }
                __syncthreads();
            }
#pragma unroll
            for (int rt = 0; rt < 2; ++rt)
#pragma unroll
                for (int e = 0; e < 2; ++e) {
                    unsigned U[IDX_M];
#pragma unroll
                    for (int i = 0; i < IDX_M; ++i) { const unsigned bts = __float_as_uint(L[rt][e][i]); U[i] = bts ^ ((unsigned)((int)bts >> 31) | 0x80000000u); }
                    unsigned pre = 0u;
#pragma unroll 1
                    for (int bit = 31; bit >= 0; --bit) {
                        const unsigned cand = pre | (1u << bit);
                        int c0 = 0, c1 = 0;
#pragma unroll
                        for (int i = 0; i < IDX_M; ++i) { const unsigned long long m = __builtin_amdgcn_ballot_w64(U[i] >= cand); c0 += __popc((unsigned)m); c1 += __popc((unsigned)(m >> 32)); }
                        if ((lh ? c1 : c0) >= 256) pre = cand;
                    }
                    int g0 = 0, g1 = 0;
#pragma unroll
                    for (int i = 0; i < IDX_M; ++i) { const unsigned long long m = __builtin_amdgcn_ballot_w64(U[i] > pre); g0 += __popc((unsigned)m); g1 += __popc((unsigned)(m >> 32)); }
                    need[rt][e] = 256 - (lh ? g1 : g0);
                    T[rt][e] = __uint_as_float((pre & 0x80000000u) ? (pre ^ 0x80000000u) : ~pre);
                }
        }
        {
            int tcnt[2][2];
#pragma unroll
            for (int rt = 0; rt < 2; ++rt)
#pragma unroll
                for (int e = 0; e < 2; ++e) tcnt[rt][e] = 0;
            __syncthreads();
            uint4 r0 = *(const uint4*)(ksrc), r1 = *(const uint4*)(ksrc + 32 * 64);
#pragma unroll 1
            for (int i = tid; i < 32 * 256 / 4; i += NTHR) ((uint4*)mimg)[i] = make_uint4(0u, 0u, 0u, 0u);
            *(uint4*)(kdst) = r0; *(uint4*)(kdst + 32 * 72) = r1;
            __syncthreads();
            for (int kt = 0; kt < nkt; ++kt) {
                const bf16_t* kbuf = Kb + (kt & 1) * 64 * 72;
                if (kt + 1 < nkt) { r0 = *(const uint4*)(ksrc + (size_t)(kt + 1) * 64 * 64); r1 = *(const uint4*)(ksrc + (size_t)(kt + 1) * 64 * 64 + 32 * 64); }
                __builtin_amdgcn_sched_barrier(0);
                const bool interior = kt * 64 + 63 <= qb;
#pragma unroll 1
                for (int t = 0; t < 2; ++t) {
                    float sc[2][2]; tile_scores(kbuf, t, sc);
                    const int key = kt * 64 + 32 * t + l31;
#pragma unroll
                    for (int rt = 0; rt < 2; ++rt)
#pragma unroll
                        for (int e = 0; e < 2; ++e) {
                            const float sv = (interior || key <= qv[rt][e]) ? sc[rt][e] : -INFINITY;
                            unsigned long long bal = __builtin_amdgcn_ballot_w64(sv > T[rt][e]);
                            const unsigned long long tb = __builtin_amdgcn_ballot_w64(sv == T[rt][e]);
                            if (tb != 0ull) {
                                const unsigned half = (unsigned)(tb >> (32 * lh));
                                const int rk = tcnt[rt][e] + __popc(half & ((1u << l31) - 1u));
                                bal |= __builtin_amdgcn_ballot_w64(sv == T[rt][e] && rk < need[rt][e]);
                                tcnt[rt][e] += __popc(half);
                            }
                            if (l31 == 0) mimg[(8 * wid + 4 * rt + 2 * lh + e) * 256 + kt * 2 + t] = (unsigned)(bal >> (32 * lh));
                        }
                }
                if (kt + 1 < nkt) { bf16_t* d = kdst + ((kt + 1) & 1) * 64 * 72; *(uint4*)(d) = r0; *(uint4*)(d + 32 * 72) = r1; }
                __syncthreads();
            }
        }
#pragma unroll 1
        for (int i = tid; i < 32 * 64; i += NTHR) { const int row = i >> 6, c4 = i & 63; *(uint4*)(p.MASK + (tok0 + row) * 256 + c4 * 4) = ((const uint4*)mimg)[row * 64 + c4]; }
    }
}
#ifndef PROBE_REP
#define PROBE_REP -1
#endif
#define RUNPH(idx, call) { _Pragma("unroll 1") for (int rep_ = 0; rep_ < ((PROBE_REP == idx) ? 2 : 1); ++rep_) { call; if (rep_ == 0 && PROBE_REP == idx) xcd_barrier(bar); } }

__global__ void __launch_bounds__(NTHR, 2) k_forward(P p) {
    __shared__ __attribute__((aligned(16))) char smem[SMEM_BYTES];
    volatile LAS unsigned* xbw = (volatile LAS unsigned*)(smem + SMEM_BYTES - 16);
    if (threadIdx.x == 0) { xbw[0] = 0u; xbw[1] = 0u; xbw[2] = 0u; xbw[3] = 0u; }
    __syncthreads();
    XcdBarrier bar = xcd_barrier_post(p.bar, xbw);
    const int bid = blockIdx.x, nblk = gridDim.x;
    volatile LAS int* sw = (volatile LAS int*)(smem + SMEM_BYTES - 32);
    if (threadIdx.x == 0) { const int hx = (int)(xb_xcc_id() & 7u); sw[0] = hx; sw[1] = atomicAdd(&p.XC[hx * 64], 1); }
    RUNPH(0, phase_prologue(p, smem, bid, nblk))
    xcd_barrier(bar);
    Sched sc;
    {
        bool even = (nblk & 7) == 0;
#pragma unroll
        for (int i = 0; i < 8; ++i) even = even && (__hip_atomic_load(&p.XC[i * 64], __ATOMIC_RELAXED, __HIP_MEMORY_SCOPE_AGENT) == (nblk >> 3));
        sc.x = even ? sw[0] : (bid & 7); sc.j = even ? sw[1] : (bid >> 3);
        sc.x = __builtin_amdgcn_readfirstlane(sc.x); sc.j = __builtin_amdgcn_readfirstlane(sc.j);
    }
    RUNPH(1, phase_inproj<0>(p, smem, bid, nblk, sc))
    xcd_barrier(bar);
    RUNPH(2, phase_indexer(p, smem, bid, nblk, sc))
    xcd_split_arrive(bar);
    RUNPH(3, phase_attn<0>(p, smem, bid, nblk, sc))
    RUNPH(4, phase_attn<2>(p, smem, bid, nblk, sc))
    xcd_split_wait(bar);
    RUNPH(5, phase_attn<1>(p, smem, bid, nblk, sc))
    xcd_barrier(bar);
    RUNPH(6, phase_merge<1>(p, smem, bid, nblk, sc))
    xcd_barrier(bar);
    RUNPH(7, phase_outproj(p, smem, bid, nblk, sc))
    xcd_barrier(bar);
#if PROBE_REP == 10
    phase_route<1>(p, smem, bid, nblk);
    xcd_barrier(bar);
#endif
    phase_route<0>(p, smem, bid, nblk);
    xcd_barrier(bar);
    RUNPH(8, phase_moe<0>(p, smem, bid, nblk, sc))
    xcd_barrier(bar);
    RUNPH(9, phase_moe<1>(p, smem, bid, nblk, sc))
    xcd_barrier(bar);
#if PROBE_REP == 11
    phase_final<1>(p, bid, nblk);
    xcd_barrier(bar);
#endif
    phase_final<0>(p, bid, nblk);
}

#define MBYTES(x) ((size_t)(x) << 20)
extern "C" void kernel_launch(void* const* d_in, const int* in_sizes, int n_in, void* d_out, int out_size, void* d_ws, size_t ws_size, hipStream_t stream) {
    P p{};
    p.x = (const float*)d_in[0]; p.pos = (const int*)d_in[1]; p.mem = (const float*)d_in[2];
    p.g_mix = (const float*)d_in[3]; p.w_in = (const float*)d_in[4]; p.b_gate = (const float*)d_in[5];
    p.lq1 = (const float*)d_in[6]; p.lk1 = (const float*)d_in[7]; p.lq2 = (const float*)d_in[8]; p.lk2 = (const float*)d_in[9];
    p.g_sub = (const float*)d_in[10]; p.g_mem = (const float*)d_in[11]; p.w_mkv = (const float*)d_in[12];
    p.w_br0 = (const float*)d_in[13]; p.w_br1 = (const float*)d_in[14]; p.w_br2 = (const float*)d_in[15];
    p.w_out = (const float*)d_in[16]; p.g_ffn = (const float*)d_in[17];
    p.w_rg = (const float*)d_in[18]; p.b_rg = (const float*)d_in[19]; p.w_re = (const float*)d_in[20]; p.b_re = (const float*)d_in[21];
    p.w_ei = (const float*)d_in[22]; p.w_eo = (const float*)d_in[23]; p.g_fin = (const float*)d_in[24];
    char* ws = (char*)d_ws; p.out = (float*)d_out;
    p.bar = (unsigned*)ws; p.CNT = (int*)(ws + 65536); p.XC = (int*)(ws + 131072);
    p.NBUF = (bf16_t*)(ws + MBYTES(1));
    p.DQ = (bf16_t*)(ws + MBYTES(65)); p.DK = (bf16_t*)(ws + MBYTES(97)); p.MERGED = (bf16_t*)(ws + MBYTES(65));
    p.SQ = (bf16_t*)(ws + MBYTES(129)); p.SK = (bf16_t*)(ws + MBYTES(161)); p.HID = (bf16_t*)(ws + MBYTES(129));
    p.DVT = (bf16_t*)(ws + MBYTES(193)); p.SVT = (bf16_t*)(ws + MBYTES(225)); p.IQ = (bf16_t*)(ws + MBYTES(257)); p.MQ = (bf16_t*)(ws + MBYTES(289));
    p.YMOE = (bf16_t*)(ws + MBYTES(193));
    p.IK = (bf16_t*)(ws + MBYTES(321)); p.IW = (float*)(ws + MBYTES(325)); p.MASK = (unsigned*)(ws + MBYTES(326));
    p.MK = (bf16_t*)(ws + MBYTES(358)); p.MVT = (bf16_t*)(ws + MBYTES(359)); p.MEMN = (bf16_t*)(ws + MBYTES(360));
    p.ROPEC = (float*)(ws + MBYTES(362)); p.ROPES = (float*)(ws + MBYTES(363));
    p.ROUTE = (Route*)(ws + MBYTES(365)); p.LIST = (int*)(ws + MBYTES(366));
    p.WIN = (bf16_t*)(ws + MBYTES(368)); p.WMKV = (bf16_t*)(ws + MBYTES(383));
    p.WBR = (bf16_t*)(ws + MBYTES(385)); p.WOUT = (bf16_t*)(ws + MBYTES(388)); p.WEI = (bf16_t*)(ws + MBYTES(390)); p.WEO = (bf16_t*)(ws + MBYTES(422));
    p.SGS = (unsigned*)(ws + MBYTES(440));
    p.HB = (bf16_t*)(ws + MBYTES(440));
    p.YD = (bf16_t*)d_out; p.YS = p.YD + (size_t)T_TOK * 512; p.YM = p.YS + (size_t)T_TOK * 512;
    static int grid = 0;
    if (!grid) {
        int dev = 0, cus = 0, per_cu = 0;
        (void)hipGetDevice(&dev);
        (void)hipDeviceGetAttribute(&cus, hipDeviceAttributeMultiprocessorCount, dev);
        (void)hipOccupancyMaxActiveBlocksPerMultiprocessor(&per_cu, k_forward, NTHR, 0);
        if (cus <= 0) cus = 256;
        if (per_cu < 1) per_cu = 1;
        grid = cus * (per_cu < 2 ? per_cu : 2);
    }
    (void)hipMemsetAsync(p.bar, 0, 262144, stream);
    k_forward<<<grid, NTHR, 0, stream>>>(p);
}
```

```cpp
#include <hip/hip_runtime.h>
#include <stdint.h>
#include <type_traits>

typedef unsigned short bf16_t;

#define S_LEN 8192
#define NBATCH 4
#define T_TOK 32768
#define DM 1024
#define DPROJ 7240
#define LIST_CAP 32768

__device__ __forceinline__ float bf2f(bf16_t v) { return __uint_as_float(((unsigned)v) << 16); }
__device__ __forceinline__ bf16_t f2bf(float f) { unsigned u = __float_as_uint(f); u += 0x7fffu + ((u >> 16) & 1u); return (bf16_t)(u >> 16); }

__device__ __forceinline__ float xhalf_max(float x) {
    const auto r = __builtin_amdgcn_permlane32_swap(__float_as_uint(x), __float_as_uint(x), false, false);
    float m; asm("v_max_f32 %0, %1, %2" : "=v"(m) : "v"(r[0]), "v"(r[1])); return m;
}
__device__ __forceinline__ float xhalf_sum(float x) {
    const auto r = __builtin_amdgcn_permlane32_swap(__float_as_uint(x), __float_as_uint(x), false, false);
    return __uint_as_float(r[0]) + __uint_as_float(r[1]);
}
template <int CTRL> __device__ __forceinline__ float dpp_movf(float v) { return __int_as_float(__builtin_amdgcn_update_dpp(0, __float_as_int(v), CTRL, 0xF, 0xF, true)); }
template <int CTRL> __device__ __forceinline__ int dpp_movi(int v) { return __builtin_amdgcn_update_dpp(0, v, CTRL, 0xF, 0xF, true); }
__device__ __forceinline__ float wave_sum(float v) {
    v += dpp_movf<0xB1>(v); v += dpp_movf<0x4E>(v); v += dpp_movf<0x141>(v); v += dpp_movf<0x140>(v);
    { const auto r = __builtin_amdgcn_permlane16_swap(__float_as_uint(v), __float_as_uint(v), false, false); v = __uint_as_float(r[0]) + __uint_as_float(r[1]); }
    { const auto r = __builtin_amdgcn_permlane32_swap(__float_as_uint(v), __float_as_uint(v), false, false); v = __uint_as_float(r[0]) + __uint_as_float(r[1]); }
    return v;
}
__device__ __forceinline__ float wave_max(float v) {
    v = fmaxf(v, dpp_movf<0xB1>(v)); v = fmaxf(v, dpp_movf<0x4E>(v)); v = fmaxf(v, dpp_movf<0x141>(v)); v = fmaxf(v, dpp_movf<0x140>(v));
    { const auto r = __builtin_amdgcn_permlane16_swap(__float_as_uint(v), __float_as_uint(v), false, false); v = fmaxf(__uint_as_float(r[0]), __uint_as_float(r[1])); }
    { const auto r = __builtin_amdgcn_permlane32_swap(__float_as_uint(v), __float_as_uint(v), false, false); v = fmaxf(__uint_as_float(r[0]), __uint_as_float(r[1])); }
    return v;
}
__device__ __forceinline__ int wave_sum_i(int v) {
    v += dpp_movi<0xB1>(v); v += dpp_movi<0x4E>(v); v += dpp_movi<0x141>(v); v += dpp_movi<0x140>(v);
    { const auto r = __builtin_amdgcn_permlane16_swap((unsigned)v, (unsigned)v, false, false); v = (int)(r[0] + r[1]); }
    { const auto r = __builtin_amdgcn_permlane32_swap((unsigned)v, (unsigned)v, false, false); v = (int)(r[0] + r[1]); }
    return v;
}
__device__ __forceinline__ float block_sum(float v, float* red) {
    v = wave_sum(v);
    __syncthreads();
    if ((threadIdx.x & 63) == 0) red[threadIdx.x >> 6] = v;
    __syncthreads();
    return red[0] + red[1] + red[2] + red[3];
}
__device__ __forceinline__ int block_sum_i(int v, int* red) {
    v = wave_sum_i(v);
    __syncthreads();
    if ((threadIdx.x & 63) == 0) red[threadIdx.x >> 6] = v;
    __syncthreads();
    return red[0] + red[1] + red[2] + red[3];
}

struct Route { int e0, e1; float c0, c1; };
#define XB_TMO      128
#define XB_XCNT(j)  (256  + 64 * (j))
#define XB_XSUB(j)  (1280 + 64 * (j))
#define XB_XGEN(j)  (2304 + 64 * (j))
#define XB_TOP      3328
#define XB_TOPGEN   3392
#define XCD_BAR_WORDS 3456
#define XB_SPIN_CAP (1u << 18)
#define LAS __attribute__((address_space(3)))

__device__ __forceinline__ unsigned xb_ld(unsigned* p)              { return __hip_atomic_load(p, __ATOMIC_RELAXED, __HIP_MEMORY_SCOPE_AGENT); }
__device__ __forceinline__ unsigned xb_add(unsigned* p, unsigned v) { return __hip_atomic_fetch_add(p, v, __ATOMIC_RELAXED, __HIP_MEMORY_SCOPE_AGENT); }
__device__ __forceinline__ unsigned xb_xcc_id() { return (unsigned)__builtin_amdgcn_s_getreg((3 << 11) | 20) & 0xFu; }
#define XB_SPIN(cond, bar) do { unsigned _sp = 0; while (cond) { __builtin_amdgcn_s_sleep(1); \
    if ((++_sp & 255u) == 0u) { if (xb_ld(&(bar)[XB_TMO])) break; if (_sp > XB_SPIN_CAP) { atomicAdd(&(bar)[XB_TMO], 1u); break; } } } } while (0)

struct XcdBarrier {
    unsigned* bar; unsigned x;
    volatile LAS unsigned* st;
};

__device__ __forceinline__ XcdBarrier xcd_barrier_post(unsigned* bar, volatile LAS unsigned* st) {
    XcdBarrier b; b.bar = bar; b.x = xb_xcc_id(); b.st = st;
    if (threadIdx.x == 0) (void)xb_add(&bar[XB_XCNT(b.x)], 1u);
    return b;
}
__device__ __forceinline__ void xcd_barrier_complete(unsigned* bar, unsigned x, unsigned& nloc, unsigned& nx) {
    const unsigned G = gridDim.x * gridDim.y * gridDim.z;
    unsigned sum, cnt, mine, sp = 0u;
    for (;;) {
        sum = 0u; cnt = 0u; mine = 0u;
#pragma unroll
        for (unsigned j = 0; j < 16; ++j) { const unsigned c = xb_ld(&bar[XB_XCNT(j)]); sum += c; cnt += (c > 0u) ? 1u : 0u; mine = (j == x) ? c : mine; }
        if (sum == G) break;
        __builtin_amdgcn_s_sleep(1);
        if ((++sp & 255u) == 0u) { if (xb_ld(&bar[XB_TMO])) break; if (sp > XB_SPIN_CAP) { atomicAdd(&bar[XB_TMO], 1u); break; } }
    }
    nloc = mine > 0u ? mine : 1u; nx = cnt > 0u ? cnt : 1u;
}

__device__ __forceinline__ void xcd_barrier(const XcdBarrier& b) {
    asm volatile("s_waitcnt vmcnt(0)" ::: "memory");
    __syncthreads();
    if (threadIdx.x == 0) {
        unsigned* bar = b.bar;
        __builtin_amdgcn_s_waitcnt(0);
        unsigned nloc = b.st[0], nx = b.st[1];
        if (nloc == 0u) { xcd_barrier_complete(bar, b.x, nloc, nx); b.st[0] = nloc; b.st[1] = nx; }
        const unsigned old = xb_add(&bar[XB_XSUB(b.x)], 1u);
        const unsigned gen = old / nloc;
        if (old + 1u == (gen + 1u) * nloc) {
            __builtin_amdgcn_fence(__ATOMIC_RELEASE, "agent");
            asm volatile("s_waitcnt vmcnt(0)" ::: "memory");
            const unsigned og = xb_add(&bar[XB_TOP], 1u);
            const unsigned tg = og / nx;
            if (og + 1u == (tg + 1u) * nx) xb_add(&bar[XB_TOPGEN], 1u);
            else XB_SPIN(xb_ld(&bar[XB_TOPGEN]) == tg, bar);
            __builtin_amdgcn_fence(__ATOMIC_ACQUIRE, "agent");
            xb_add(&bar[XB_XGEN(b.x)], 1u);
            asm volatile("s_waitcnt vmcnt(0)" ::: "memory");
        } else {
            XB_SPIN(xb_ld(&bar[XB_XGEN(b.x)]) == gen, bar);
            __builtin_amdgcn_fence(__ATOMIC_ACQUIRE, "agent");
            asm volatile("s_waitcnt vmcnt(0)" ::: "memory");
        }
    }
    __syncthreads();
}


#define XB_SPLIT 4096
__device__ __forceinline__ void xcd_split_arrive(const XcdBarrier& b) {
    asm volatile("s_waitcnt vmcnt(0)" ::: "memory");
    __syncthreads();
    if (threadIdx.x == 0) {
        __builtin_amdgcn_s_waitcnt(0);
        __builtin_amdgcn_fence(__ATOMIC_RELEASE, "agent");
        asm volatile("s_waitcnt vmcnt(0)" ::: "memory");
        (void)xb_add(&b.bar[XB_SPLIT], 1u);
    }
}
__device__ __forceinline__ void xcd_split_wait(const XcdBarrier& b) {
    __syncthreads();
    if (threadIdx.x == 0) {
        const unsigned G = gridDim.x * gridDim.y * gridDim.z;
        XB_SPIN(xb_ld(&b.bar[XB_SPLIT]) < G, b.bar);
        __builtin_amdgcn_fence(__ATOMIC_ACQUIRE, "agent");
        asm volatile("s_waitcnt vmcnt(0)" ::: "memory");
    }
    __syncthreads();
}
typedef __attribute__((ext_vector_type(8))) __bf16 bf16x8;
typedef __attribute__((ext_vector_type(16))) float f32x16;
typedef __attribute__((ext_vector_type(4))) float f32x4;
#define NTHR 256
#define LDSK 72
#define SMEM_BYTES 81920

struct P {
    const float* x; const int* pos; const float* mem; const float* g_mix; const float* w_in; const float* b_gate;
    const float* lq1; const float* lk1; const float* lq2; const float* lk2; const float* g_sub; const float* g_mem; const float* w_mkv;
    const float* w_br0; const float* w_br1; const float* w_br2; const float* w_out; const float* g_ffn;
    const float* w_rg; const float* b_rg; const float* w_re; const float* b_re; const float* w_ei; const float* w_eo; const float* g_fin;
    float* out;
    unsigned* bar; int* CNT;
    bf16_t* NBUF; bf16_t* DQ; bf16_t* DK; bf16_t* DVT; bf16_t* SQ; bf16_t* SK; bf16_t* SVT; bf16_t* IQ; bf16_t* MQ; bf16_t* IK; float* IW; unsigned* MASK;
    bf16_t* MK; bf16_t* MVT; bf16_t* MEMN; float* ROPEC; float* ROPES;
    bf16_t* WIN; bf16_t* WBR; bf16_t* WOUT; bf16_t* WMKV; bf16_t* WEI; bf16_t* WEO;
    bf16_t* YD; bf16_t* YS; bf16_t* YM; bf16_t* MERGED; bf16_t* HID; bf16_t* YMOE; Route* ROUTE; int* LIST; unsigned* SGS; int* XC; bf16_t* HB;
};

__device__ __forceinline__ int opaque_tid() { int t = threadIdx.x; asm volatile("" : "+v"(t)); return t; }
typedef __bf16 bf16x2v_t __attribute__((ext_vector_type(2)));
typedef float f32x2c_t __attribute__((ext_vector_type(2)));
__device__ __forceinline__ unsigned cvt_pk_bf16_ord(float lo, float hi) { unsigned r; asm volatile("s_nop 0\n\tv_cvt_pk_bf16_f32 %0, %1, %2" : "=v"(r) : "v"(lo), "v"(hi)); return r; }
__device__ __forceinline__ unsigned cvt_pk_bf16(float lo, float hi) { const f32x2c_t v = {lo, hi}; const bf16x2v_t r = __builtin_convertvector(v, bf16x2v_t); return __builtin_bit_cast(unsigned, r); }

template <int MAP> __device__ __forceinline__ int colmap(int n) {
    if (MAP == 1) return n < 3584 ? n : n < 4096 ? n + 72 : n < 4168 ? n - 512 : n < 4224 ? -1 : n - 56;
    if (MAP == 2) { const int c = n >> 6, j = n & 63; return j < 32 ? 32 * c + j : 512 + 32 * c + (j - 32); }
    return n;
}
template <int MAP, int NTL> __device__ __forceinline__ void tconv_tile(const float* __restrict__ src, int ld, int K, bf16_t* __restrict__ dst, int tile, float* tl) {
    const int n0 = (tile % NTL) * 64, k0 = (tile / NTL) * 64;
    const int t = opaque_tid(); const int nn = (t & 15) * 4; const int c = colmap<MAP>(n0 + nn);
#pragma unroll
    for (int i = 0; i < 4; ++i) { const int kk = (t >> 4) + 16 * i;
        const float4 v = c >= 0 ? *(const float4*)(src + (size_t)(k0 + kk) * ld + c) : make_float4(0.f, 0.f, 0.f, 0.f);
        tl[kk * 65 + nn] = v.x; tl[kk * 65 + nn + 1] = v.y; tl[kk * 65 + nn + 2] = v.z; tl[kk * 65 + nn + 3] = v.w; }
    __syncthreads();
#pragma unroll
    for (int i = 0; i < 2; ++i) { const int cc = t + 256 * i; const int n2 = cc >> 3, kc = (cc & 7) * 8;
        uint4 o; o.x = cvt_pk_bf16(tl[(kc + 0) * 65 + n2], tl[(kc + 1) * 65 + n2]); o.y = cvt_pk_bf16(tl[(kc + 2) * 65 + n2], tl[(kc + 3) * 65 + n2]);
        o.z = cvt_pk_bf16(tl[(kc + 4) * 65 + n2], tl[(kc + 5) * 65 + n2]); o.w = cvt_pk_bf16(tl[(kc + 6) * 65 + n2], tl[(kc + 7) * 65 + n2]);
        *(uint4*)(dst + (size_t)(n0 + n2) * K + k0 + kc) = o; }
    __syncthreads();
}
#define TC_WIN 1824
#define TC_WBR (TC_WIN + 384)
#define TC_WOUT (TC_WBR + 256)
#define TC_WMKV (TC_WOUT + 256)
#define TC_WEI (TC_WMKV + 4096)
#define TC_WEO (TC_WEI + 2048)
__device__ void phase_prologue(const P& p, char* smem, int bid, int nblk) {
    float* tl = (float*)smem;
    const int tidp = opaque_tid();
    for (int g = bid; g < TC_WEO; g += nblk) {
        if (g < TC_WIN) tconv_tile<1, 114>(p.w_in, DPROJ, 1024, p.WIN, g, tl);
        else if (g < TC_WBR) { const int j = (g - TC_WIN) >> 7; const float* s = j == 0 ? p.w_br0 : j == 1 ? p.w_br1 : p.w_br2; tconv_tile<0, 16>(s, 1024, 512, p.WBR + (size_t)j * 1024 * 512, (g - TC_WIN) & 127, tl); }
        else if (g < TC_WOUT) tconv_tile<0, 16>(p.w_out, 1024, 1024, p.WOUT, g - TC_WBR, tl);
        else if (g < TC_WMKV) tconv_tile<0, 16>(p.w_mkv, 1024, 1024, p.WMKV, g - TC_WOUT, tl);
        else if (g < TC_WEI) { const int e = (g - TC_WMKV) >> 8; tconv_tile<2, 16>(p.w_ei + (size_t)e * 1024 * 1024, 1024, 1024, p.WEI + (size_t)e * 1024 * 1024, (g - TC_WMKV) & 255, tl); }
        else { const int e = (g - TC_WEI) >> 7; tconv_tile<0, 16>(p.w_eo + (size_t)e * 512 * 1024, 1024, 512, p.WEO + (size_t)e * 1024 * 512, (g - TC_WEI) & 127, tl); }
    }
    const int lane = tidp & 63; const int gw = bid * 4 + (tidp >> 6), nw = nblk * 4;
    for (int row = gw; row < T_TOK + 1024; row += nw) {
        const float* src; const float* g; bf16_t* dst;
        if (row < T_TOK) { src = p.x + (size_t)row * DM; g = p.g_mix; dst = p.NBUF + (size_t)row * DM; }
        else { src = p.mem + (size_t)(row - T_TOK) * DM; g = p.g_mem; dst = p.MEMN + (size_t)(row - T_TOK) * DM; }
        float4 v[4]; float ss = 0.f;
#pragma unroll
        for (int i = 0; i < 4; ++i) { v[i] = *(const float4*)(src + i * 256 + lane * 4); ss += v[i].x * v[i].x + v[i].y * v[i].y + v[i].z * v[i].z + v[i].w * v[i].w; }
        ss = wave_sum(ss);
        const float r = rsqrtf(ss * (1.0f / DM) + 1e-6f);
#pragma unroll
        for (int i = 0; i < 4; ++i) { const float4 gg = *(const float4*)(g + i * 256 + lane * 4);
            uint2 o; o.x = cvt_pk_bf16(v[i].x * r * gg.x, v[i].y * r * gg.y); o.y = cvt_pk_bf16(v[i].z * r * gg.z, v[i].w * r * gg.w);
            *(uint2*)(dst + i * 256 + lane * 4) = o; }
    }
    for (int i = bid * NTHR + tidp; i < T_TOK * 8; i += nblk * NTHR) {
        const float inv = powf(500000.0f, -(float)(i & 7) / 8.0f);
        const float ang = (float)p.pos[i >> 3] * inv;
        float sn, cs; sincosf(ang, &sn, &cs);
        p.ROPEC[i] = cs; p.ROPES[i] = sn;
    }
    if (bid == 0 && tidp < 16) p.CNT[tidp] = 0;
}


struct Sched { int x, j; };
struct XOrder {
    int x, j, J, nblk, bid;
    __device__ __forceinline__ XOrder(int bid_, int nblk_, const Sched& s) : x(s.x), j(s.j), J(nblk_ >> 3), nblk(nblk_), bid(bid_) {}
    __device__ __forceinline__ bool round(int r, int N, int& u) const {
        if ((nblk & 7) != 0) { u = r * nblk + bid; if (r * nblk >= N) return false; if (u >= N) u = -1; return true; }
        const int c = r * 8 + x; if (r * 8 * J >= N) return false; u = c * J + j; if (u >= N) u = -1; return true;
    }
};
__device__ __forceinline__ void tile_mn(int u, int NT, int& mt, int& nt) { const int g = u / (8 * NT), rem = u - g * 8 * NT; nt = rem >> 3; mt = g * 8 + (rem & 7); }

__device__ __forceinline__ int gl_row(int tid, int q) { return (tid >> 6) * 32 + q * 8 + ((tid & 63) >> 3); }
__device__ __forceinline__ unsigned gl_col(int tid, int row) { return (unsigned)(((tid & 7) ^ ((row >> 1) & 7)) * 8); }
__device__ __forceinline__ void gemm_mainloop(const bf16_t* __restrict__ Rb, unsigned or0, unsigned or1, unsigned or2, unsigned or3,
                                              const bf16_t* __restrict__ Lb, unsigned ol0, unsigned ol1, unsigned ol2, unsigned ol3, int K, f32x16 (&acc)[2][2], bf16_t* As, bf16_t* Bs) {
    const int tid = opaque_tid(), lane = tid & 63, wid = tid >> 6, wr = wid >> 1, wc = wid & 1;
    const int nk = K >> 6;
    LAS unsigned* ldsA = (LAS unsigned*)(As + wid * 32 * 64);
    LAS unsigned* ldsB = (LAS unsigned*)(Bs + wid * 32 * 64);
    const int sw = (lane >> 1) & 7;
    const bf16_t* ard = As + (wr * 64 + (lane & 31)) * 64;
    const bf16_t* brd = Bs + (wc * 64 + (lane & 31)) * 64;
    const int lh = lane >> 5;
#define GLDS_TILE(stage_, ko_) { \
    __builtin_amdgcn_global_load_lds((const unsigned*)(Rb + or0 + (ko_)), (LAS unsigned*)((LAS char*)ldsA + (stage_) * 32768), 16, 0, 0); \
    __builtin_amdgcn_global_load_lds((const unsigned*)(Rb + or1 + (ko_)), (LAS unsigned*)((LAS char*)ldsA + (stage_) * 32768 + 1024), 16, 0, 0); \
    __builtin_amdgcn_global_load_lds((const unsigned*)(Rb + or2 + (ko_)), (LAS unsigned*)((LAS char*)ldsA + (stage_) * 32768 + 2048), 16, 0, 0); \
    __builtin_amdgcn_global_load_lds((const unsigned*)(Rb + or3 + (ko_)), (LAS unsigned*)((LAS char*)ldsA + (stage_) * 32768 + 3072), 16, 0, 0); \
    __builtin_amdgcn_global_load_lds((const unsigned*)(Lb + ol0 + (ko_)), (LAS unsigned*)((LAS char*)ldsB + (stage_) * 32768), 16, 0, 0); \
    __builtin_amdgcn_global_load_lds((const unsigned*)(Lb + ol1 + (ko_)), (LAS unsigned*)((LAS char*)ldsB + (stage_) * 32768 + 1024), 16, 0, 0); \
    __builtin_amdgcn_global_load_lds((const unsigned*)(Lb + ol2 + (ko_)), (LAS unsigned*)((LAS char*)ldsB + (stage_) * 32768 + 2048), 16, 0, 0); \
    __builtin_amdgcn_global_load_lds((const unsigned*)(Lb + ol3 + (ko_)), (LAS unsigned*)((LAS char*)ldsB + (stage_) * 32768 + 3072), 16, 0, 0); }
    __syncthreads();
    GLDS_TILE(0, 0u)
    __syncthreads();
    for (int kt = 0; kt < nk; ++kt) {
        const int cur = (kt & 1) * 16384;
        if (kt + 1 < nk) { if (kt & 1) GLDS_TILE(0, (unsigned)(kt + 1) * 64u) else GLDS_TILE(1, (unsigned)(kt + 1) * 64u) }
#pragma unroll
        for (int ks = 0; ks < 4; ++ks) {
            const int cc = ((2 * ks + lh) ^ sw) * 8;
            const bf16x8 fa0 = *(const bf16x8*)(ard + cur + cc), fa1 = *(const bf16x8*)(ard + cur + 32 * 64 + cc);
            const bf16x8 fb0 = *(const bf16x8*)(brd + cur + cc), fb1 = *(const bf16x8*)(brd + cur + 32 * 64 + cc);
            acc[0][0] = __builtin_amdgcn_mfma_f32_32x32x16_bf16(fa0, fb0, acc[0][0], 0, 0, 0);
            acc[0][1] = __builtin_amdgcn_mfma_f32_32x32x16_bf16(fa0, fb1, acc[0][1], 0, 0, 0);
            acc[1][0] = __builtin_amdgcn_mfma_f32_32x32x16_bf16(fa1, fb0, acc[1][0], 0, 0, 0);
            acc[1][1] = __builtin_amdgcn_mfma_f32_32x32x16_bf16(fa1, fb1, acc[1][1], 0, 0, 0);
        }
        __syncthreads();
    }
#undef GLDS_TILE
}
#define ZERO_ACC(acc) { _Pragma("unroll") for (int i_ = 0; i_ < 2; ++i_) _Pragma("unroll") for (int j_ = 0; j_ < 2; ++j_) _Pragma("unroll") for (int r_ = 0; r_ < 16; ++r_) acc[i_][j_][r_] = 0.f; }
#define CSTR 136
__device__ __forceinline__ void cimg_write(const f32x16 (&acc)[2][2], bf16_t* Cs, int wr, int wc, int l31, int lh) {
#pragma unroll
    for (int i = 0; i < 2; ++i)
#pragma unroll
        for (int j = 0; j < 2; ++j)
#pragma unroll
            for (int g = 0; g < 4; ++g) { uint2 o; o.x = cvt_pk_bf16(acc[i][j][4 * g], acc[i][j][4 * g + 1]); o.y = cvt_pk_bf16(acc[i][j][4 * g + 2], acc[i][j][4 * g + 3]);
                *(uint2*)(Cs + (64 * wc + 32 * j + l31) * CSTR + 64 * wr + 32 * i + 8 * g + 4 * lh) = o; }
}

template <int NOEPI> __device__ void phase_inproj(const P& p, char* smem, int bid, int nblk, const Sched& sc) {
    bf16_t* As = (bf16_t*)smem; bf16_t* Bs = As + 128 * 64; bf16_t* Cs = (bf16_t*)smem;
    const int tid = opaque_tid(), lane = tid & 63, wid = tid >> 6, wr = wid >> 1, wc = wid & 1;
    const int l31 = lane & 31, lh = lane >> 5;
    const int NT = 33, NMAIN = 256 * NT;
    const XOrder xo(bid, nblk, sc);
    const bool xaware = false;
    for (int rr = 0; ; ++rr) {
        bool main_t; int mt, nt;
        if (xaware) {
            if (rr < 16) { main_t = true; mt = ((sc.x >> 2) * 16 + rr) * 8 + (sc.j & 7); nt = (sc.x & 3) * 8 + (sc.j >> 3); }
            else if (rr == 16) { if (bid >= 320) break; main_t = bid < 256; mt = main_t ? bid : (bid - 256) >> 3; nt = main_t ? 32 : (bid - 256) & 7; }
            else break;
        } else {
            int t; if (!xo.round(rr, NMAIN + 64, t)) break; if (t < 0) continue;
            main_t = t < NMAIN;
            if (main_t) tile_mn(t, NT, mt, nt); else { mt = (t - NMAIN) >> 3; nt = (t - NMAIN) & 7; }
        }
        const bf16_t* X = main_t ? p.NBUF : p.MEMN; const bf16_t* W = main_t ? p.WIN : p.WMKV;
        const int grp = main_t ? (nt >> 2) : (nt < 4 ? 7 : 2);
        const bool transposed = grp == 2 || grp == 5;
        const int g0 = gl_row(tid, 0); const unsigned to = (unsigned)g0 * 1024u + gl_col(tid, g0);
        const unsigned t1 = (unsigned)(g0 + 8) * 1024u + gl_col(tid, g0 + 8), t2 = (unsigned)(g0 + 16) * 1024u + gl_col(tid, g0 + 16), t3 = (unsigned)(g0 + 24) * 1024u + gl_col(tid, g0 + 24);
        const bf16_t* Xt = X + (size_t)mt * 128 * 1024; const bf16_t* Wt = W + (size_t)nt * 128 * 1024;
        f32x16 acc[2][2]; ZERO_ACC(acc);
        gemm_mainloop(transposed ? Xt : Wt, to, t1, t2, t3, transposed ? Wt : Xt, to, t1, t2, t3, 1024, acc, As, Bs);
        if (NOEPI) { float s_ = 0.f; for (int i_ = 0; i_ < 2; ++i_) for (int j_ = 0; j_ < 2; ++j_) for (int r_ = 0; r_ < 16; ++r_) s_ += acc[i_][j_][r_]; if (s_ == 1.2345e30f) p.IW[0] = s_; continue; }
        const int tok0 = mt * 128;
        if (main_t && !transposed && grp != 7) {
            if (grp != 8 || wr == 0) {
#pragma unroll
                for (int j = 0; j < 2; ++j) { const int tok = tok0 + 64 * wc + 32 * j + l31;
                    const float4 c4 = *(const float4*)(p.ROPEC + (size_t)tok * 8 + 4 * lh), s4 = *(const float4*)(p.ROPES + (size_t)tok * 8 + 4 * lh);
                    const float cc[4] = {c4.x, c4.y, c4.z, c4.w}, ss[4] = {s4.x, s4.y, s4.z, s4.w};
#pragma unroll
                    for (int r = 0; r < 4; ++r) { const float x1 = acc[0][j][r], x2 = acc[0][j][r + 4]; acc[0][j][r] = x1 * cc[r] - x2 * ss[r]; acc[0][j][r + 4] = x2 * cc[r] + x1 * ss[r]; } }
            }
        }
        if (grp == 8 && wr == 1) {
#pragma unroll
            for (int j = 0; j < 2; ++j) { const int tok = tok0 + 64 * wc + 32 * j + l31; *(float4*)(p.IW + (size_t)tok * 8 + 4 * lh) = make_float4(acc[0][j][0], acc[0][j][1], acc[0][j][2], acc[0][j][3]); }
        }
        __syncthreads();
        cimg_write(acc, Cs, wr, wc, l31, lh);
        __syncthreads();
        bf16_t* dbase; size_t dstride; int nch = 16;
        if (!main_t) {
            if (nt < 4) { dbase = p.MK + (size_t)tok0 * 512 + nt * 128; dstride = 512; }
            else { dbase = p.MVT + ((size_t)((mt >> 1) * 4 + (nt - 4)) * 128) * 256 + (mt & 1) * 128; dstride = 256; }
        } else if (grp == 2) { dbase = p.DVT + ((size_t)((mt >> 6) * 4 + (nt - 8)) * 128) * S_LEN + (mt & 63) * 128; dstride = S_LEN; }
        else if (grp == 5) { dbase = p.SVT + ((size_t)((mt >> 6) * 8 + (nt - 20) * 2) * 64) * S_LEN + (mt & 63) * 128; dstride = S_LEN; }
        else if (grp == 8) { dbase = p.IK + (size_t)tok0 * 64; dstride = 64; nch = 8; }
        else { bf16_t* d = grp == 0 ? p.DQ : grp == 1 ? p.DK : grp == 3 ? p.SQ : grp == 4 ? p.SK : grp == 6 ? p.IQ : p.MQ; dbase = d + (size_t)tok0 * 512 + (nt & 3) * 128; dstride = 512; }
        int te_ = tid; asm volatile("" : "+v"(te_));
#pragma unroll
        for (int k = 0; k < 8; ++k) { const int c = te_ + 256 * k; const int lrow = c >> 4, ch = c & 15;
            if (ch < nch) { const uint4 v = *(const uint4*)(Cs + lrow * CSTR + ch * 8); *(uint4*)(dbase + (size_t)lrow * dstride + ch * 8) = v; } }
    }
}
template <int REPS = 1> __device__ void phase_merge(const P& p, char* smem, int bid, int nblk, const Sched& sc) {
    bf16_t* As = (bf16_t*)smem; bf16_t* Bs = As + 128 * 64; bf16_t* Cs = (bf16_t*)smem;
    const int tid = opaque_tid(), lane = tid & 63, wid = tid >> 6, wr = wid >> 1, wc = wid & 1;
    const int l31 = lane & 31, lh = lane >> 5;
    const XOrder xo(bid, nblk, sc);
    const bool xaware = false;
#pragma unroll 1
    for (int rep = 0; rep < REPS; ++rep)
    for (int rr = 0; ; ++rr) {
        int mt, nt;
        if (xaware) { if (rr >= 4) break; nt = sc.x; mt = rr * 64 + sc.j; }
        else { int t; if (!xo.round(rr, 256 * 8, t)) break; if (t < 0) continue; tile_mn(t, 8, mt, nt); }
        f32x16 mg[2][2]; ZERO_ACC(mg);
#pragma unroll 1
        for (int br = 0; br < 3; ++br) {
            int tl_ = tid; asm volatile("" : "+v"(tl_));
            unsigned sgr[8][4];
            {
                const int g0 = gl_row(tl_, 0);
                const unsigned to = (unsigned)g0 * 1024u + gl_col(tl_, g0), t1 = (unsigned)(g0 + 8) * 1024u + gl_col(tl_, g0 + 8), t2 = (unsigned)(g0 + 16) * 1024u + gl_col(tl_, g0 + 16), t3 = (unsigned)(g0 + 24) * 1024u + gl_col(tl_, g0 + 24);
                f32x16 acc[2][2]; ZERO_ACC(acc);
                gemm_mainloop(p.WIN + (size_t)(4224 + br * 1024 + nt * 128) * 1024, to, t1, t2, t3, p.NBUF + (size_t)mt * 128 * 1024, to, t1, t2, t3, 1024, acc, As, Bs);
#pragma unroll
                for (int i = 0; i < 2; ++i)
#pragma unroll
                    for (int g = 0; g < 4; ++g) { const float4 b4 = *(const float4*)(p.b_gate + br * 1024 + nt * 128 + 64 * wr + 32 * i + 8 * g + 4 * lh);
                        const float bb[4] = {b4.x, b4.y, b4.z, b4.w};
#pragma unroll
                        for (int j = 0; j < 2; ++j) { float s[4];
#pragma unroll
                            for (int r = 0; r < 4; ++r) s[r] = __builtin_amdgcn_rcpf(1.0f + __expf(-(acc[i][j][4 * g + r] + bb[r])));
                            acc[i][j][4 * g] = __uint_as_float(cvt_pk_bf16_ord(s[0], s[1])); acc[i][j][4 * g + 1] = __uint_as_float(cvt_pk_bf16_ord(s[2], s[3])); } }
#pragma unroll
                for (int i = 0; i < 2; ++i)
#pragma unroll
                    for (int j = 0; j < 2; ++j)
#pragma unroll
                        for (int h2 = 0; h2 < 2; ++h2) {
                            sgr[(i * 2 + j) * 2 + h2][0] = __float_as_uint(acc[i][j][8 * h2]); sgr[(i * 2 + j) * 2 + h2][1] = __float_as_uint(acc[i][j][8 * h2 + 1]);
                            sgr[(i * 2 + j) * 2 + h2][2] = __float_as_uint(acc[i][j][8 * h2 + 4]); sgr[(i * 2 + j) * 2 + h2][3] = __float_as_uint(acc[i][j][8 * h2 + 5]); }
                asm volatile("" ::: "memory");
            }
            {
                const bf16_t* Y = br == 0 ? p.YD : br == 1 ? p.YS : p.YM;
                int tl2_ = tid; asm volatile("" : "+v"(tl2_));
                const int g0 = gl_row(tl2_, 0);
                const unsigned to = (unsigned)g0 * 512u + gl_col(tl2_, g0), t1 = (unsigned)(g0 + 8) * 512u + gl_col(tl2_, g0 + 8), t2 = (unsigned)(g0 + 16) * 512u + gl_col(tl2_, g0 + 16), t3 = (unsigned)(g0 + 24) * 512u + gl_col(tl2_, g0 + 24);
                f32x16 acc[2][2]; ZERO_ACC(acc);
                gemm_mainloop(p.WBR + (size_t)br * 1024 * 512 + (size_t)nt * 128 * 512, to, t1, t2, t3, Y + (size_t)mt * 128 * 512, to, t1, t2, t3, 512, acc, As, Bs);
                asm volatile("" ::: "memory");
#pragma unroll
                for (int i = 0; i < 2; ++i)
#pragma unroll
                    for (int j = 0; j < 2; ++j)
#pragma unroll
                        for (int h2 = 0; h2 < 2; ++h2) { const unsigned ww[4] = {sgr[(i * 2 + j) * 2 + h2][0], sgr[(i * 2 + j) * 2 + h2][1], sgr[(i * 2 + j) * 2 + h2][2], sgr[(i * 2 + j) * 2 + h2][3]};
#pragma unroll
                            for (int q = 0; q < 2; ++q) {
                                const int g = 2 * h2 + q;
                                mg[i][j][4 * g] += __uint_as_float(ww[2 * q] << 16) * acc[i][j][4 * g];
                                mg[i][j][4 * g + 1] += __uint_as_float(ww[2 * q] & 0xffff0000u) * acc[i][j][4 * g + 1];
                                mg[i][j][4 * g + 2] += __uint_as_float(ww[2 * q + 1] << 16) * acc[i][j][4 * g + 2];
                                mg[i][j][4 * g + 3] += __uint_as_float(ww[2 * q + 1] & 0xffff0000u) * acc[i][j][4 * g + 3]; } }
            }
        }
        __syncthreads();
        cimg_write(mg, Cs, wr, wc, l31, lh);
        __syncthreads();
        bf16_t* dbase = p.MERGED + (size_t)mt * 128 * 1024 + nt * 128;
        int te_ = tid; asm volatile("" : "+v"(te_));
#pragma unroll
        for (int k = 0; k < 8; ++k) { const int c = te_ + 256 * k; const int lrow = c >> 4, ch = c & 15;
            const uint4 v = *(const uint4*)(Cs + lrow * CSTR + ch * 8); *(uint4*)(dbase + (size_t)lrow * 1024 + ch * 8) = v; }
    }
}

#define CFS 132
__device__ void phase_outproj(const P& p, char* smem, int bid, int nblk, const Sched& sc) {
    bf16_t* As = (bf16_t*)smem; bf16_t* Bs = As + 128 * 64;
    const int tid = opaque_tid(), lane = tid & 63, wid = tid >> 6, wr = wid >> 1, wc = wid & 1;
    const int l31 = lane & 31, lh = lane >> 5;
    const XOrder xo(bid, nblk, sc);
    for (int rr = 0; ; ++rr) {
        int t; if (!xo.round(rr, 256 * 8, t)) break; if (t < 0) continue;
        int mt, nt; tile_mn(t, 8, mt, nt);
        const int g0 = gl_row(tid, 0);
        const unsigned to = (unsigned)g0 * 1024u + gl_col(tid, g0), t1 = (unsigned)(g0 + 8) * 1024u + gl_col(tid, g0 + 8), t2 = (unsigned)(g0 + 16) * 1024u + gl_col(tid, g0 + 16), t3 = (unsigned)(g0 + 24) * 1024u + gl_col(tid, g0 + 24);
        f32x16 acc[2][2]; ZERO_ACC(acc);
        gemm_mainloop(p.WOUT + (size_t)nt * 128 * 1024, to, t1, t2, t3, p.MERGED + (size_t)mt * 128 * 1024, to, t1, t2, t3, 1024, acc, As, Bs);
        float* Cf = (float*)smem;
#pragma unroll
        for (int i = 0; i < 2; ++i)
#pragma unroll
            for (int j = 0; j < 2; ++j)
#pragma unroll
                for (int g = 0; g < 4; ++g)
                    *(float4*)(Cf + (64 * wc + 32 * j + l31) * CFS + 64 * wr + 32 * i + 8 * g + 4 * lh) = make_float4(acc[i][j][4 * g], acc[i][j][4 * g + 1], acc[i][j][4 * g + 2], acc[i][j][4 * g + 3]);
        __syncthreads();
        int to_ = tid; asm volatile("" : "+v"(to_));
#pragma unroll
        for (int k = 0; k < 8; ++k) { const int c = to_ + 256 * k; const int lrow = c >> 4, ch = c & 15;
            const float4 a0 = *(const float4*)(Cf + lrow * CFS + ch * 8), a1 = *(const float4*)(Cf + lrow * CFS + ch * 8 + 4);
            const size_t go = (size_t)(mt * 128 + lrow) * 1024 + nt * 128 + ch * 8;
            const float4 x0 = *(const float4*)(p.x + go), x1 = *(const float4*)(p.x + go + 4);
            uint4 o; o.x = cvt_pk_bf16(x0.x + a0.x, x0.y + a0.y); o.y = cvt_pk_bf16(x0.z + a0.z, x0.w + a0.w); o.z = cvt_pk_bf16(x1.x + a1.x, x1.y + a1.y); o.w = cvt_pk_bf16(x1.z + a1.z, x1.w + a1.w);
            *(uint4*)(p.HB + go) = o; }
    }
}

template <int VAR = 0> __device__ void phase_route(const P& p, char* smem, int bid, int nblk) {
    float4* wrg = (float4*)smem;
    const int tidp = opaque_tid();
    for (int i = tidp; i < 1024; i += NTHR) wrg[i] = *(const float4*)(p.w_rg + i * 4);
    constexpr int RCH = 64;
    int* lcnt = (int*)(smem + 16384); int* lbase = lcnt + 16; int* ent_e = lcnt + 32; int* ent_s = ent_e + 4 * RCH * 2; int* ent_v = ent_s + 4 * RCH * 2;
    const int lane = tidp & 63; const int wv = tidp >> 6; const int gw = bid * 4 + wv, nw = nblk * 4;
    const int tb = bid * 4;
    const int kmax = tb < T_TOK ? (T_TOK - tb + nw - 1) / nw : 0;
    for (int k0 = 0; k0 < kmax; k0 += RCH) {
    __syncthreads();
    if (tidp < 16) lcnt[tidp] = 0;
    __syncthreads();
    for (int kk = 0; kk < RCH && k0 + kk < kmax; ++kk) {
        const int tok = tb + wv + (k0 + kk) * nw;
        if (tok >= T_TOK) break;
        const bf16_t* src = p.HB + (size_t)tok * DM;
        float tv[16]; float ss = 0.f;
#pragma unroll
        for (int i = 0; i < 4; ++i) { const uint2 u = *(const uint2*)(src + i * 256 + lane * 4);
            float4 v; v.x = __uint_as_float(u.x << 16); v.y = __uint_as_float(u.x & 0xffff0000u); v.z = __uint_as_float(u.y << 16); v.w = __uint_as_float(u.y & 0xffff0000u);
            tv[4 * i] = v.x; tv[4 * i + 1] = v.y; tv[4 * i + 2] = v.z; tv[4 * i + 3] = v.w; ss += v.x * v.x + v.y * v.y + v.z * v.z + v.w * v.w; }
        ss = wave_sum(ss);
        const float r = rsqrtf(ss * (1.0f / DM) + 1e-6f);
        float g0 = 0.f, g1 = 0.f, g2 = 0.f, g3 = 0.f;
#pragma unroll
        for (int i = 0; i < 4; ++i) { const float4 gg = *(const float4*)(p.g_ffn + i * 256 + lane * 4);
            tv[4 * i] *= r * gg.x; tv[4 * i + 1] *= r * gg.y; tv[4 * i + 2] *= r * gg.z; tv[4 * i + 3] *= r * gg.w;
            uint2 o; o.x = cvt_pk_bf16(tv[4 * i], tv[4 * i + 1]); o.y = cvt_pk_bf16(tv[4 * i + 2], tv[4 * i + 3]);
            *(uint2*)((VAR ? (bf16_t*)p.SGS + (size_t)8 * 1024 * 1024 + (size_t)(tok & 16383) * DM : p.NBUF + (size_t)tok * DM) + i * 256 + lane * 4) = o;
#pragma unroll
            for (int j = 0; j < 4; ++j) { const float4 w = wrg[i * 256 + lane * 4 + j]; const float x = tv[4 * i + j]; g0 += x * w.x; g1 += x * w.y; g2 += x * w.z; g3 += x * w.w; } }
        g0 = wave_sum(g0) + p.b_rg[0]; g1 = wave_sum(g1) + p.b_rg[1]; g2 = wave_sum(g2) + p.b_rg[2]; g3 = wave_sum(g3) + p.b_rg[3];
        int grp = 0; float gm = g0;
        if (g1 > gm) { gm = g1; grp = 1; } if (g2 > gm) { gm = g2; grp = 2; } if (g3 > gm) { gm = g3; grp = 3; }
        const float pg = 1.0f / (expf(g0 - gm) + expf(g1 - gm) + expf(g2 - gm) + expf(g3 - gm));
        float e0 = 0.f, e1 = 0.f, e2 = 0.f, e3 = 0.f;
#pragma unroll
        for (int i = 0; i < 4; ++i)
#pragma unroll
            for (int j = 0; j < 4; ++j) { const float4 w = *(const float4*)(p.w_re + (size_t)(i * 256 + lane * 4 + j) * 16 + grp * 4); const float x = tv[4 * i + j]; e0 += x * w.x; e1 += x * w.y; e2 += x * w.z; e3 += x * w.w; }
        float el[4];
        el[0] = wave_sum(e0) + p.b_re[grp * 4]; el[1] = wave_sum(e1) + p.b_re[grp * 4 + 1]; el[2] = wave_sum(e2) + p.b_re[grp * 4 + 2]; el[3] = wave_sum(e3) + p.b_re[grp * 4 + 3];
        if (lane < 2 && VAR == 0) {
            int i0 = 0; float m0 = el[0];
            if (el[1] > m0) { m0 = el[1]; i0 = 1; } if (el[2] > m0) { m0 = el[2]; i0 = 2; } if (el[3] > m0) { m0 = el[3]; i0 = 3; }
            int i1 = -1; float m1 = -INFINITY;
            if (i0 != 0 && el[0] > m1) { m1 = el[0]; i1 = 0; } if (i0 != 1 && el[1] > m1) { m1 = el[1]; i1 = 1; }
            if (i0 != 2 && el[2] > m1) { m1 = el[2]; i1 = 2; } if (i0 != 3 && el[3] > m1) { m1 = el[3]; i1 = 3; }
            const float p1 = expf(m1 - m0);
            Route rt; rt.e0 = grp * 4 + i0; rt.e1 = grp * 4 + i1; rt.c0 = pg / (1.0f + p1); rt.c1 = pg * p1 / (1.0f + p1);
            if (lane == 0) p.ROUTE[tok] = rt;
            const int e = lane == 0 ? rt.e0 : rt.e1; const int idx = (wv * RCH + kk) * 2 + lane;
            ent_e[idx] = e; ent_s[idx] = atomicAdd(&lcnt[e], 1); ent_v[idx] = tok * 2 + lane;
        }
    }
    if (VAR == 0) {
        __syncthreads();
        if (tidp < 16) lbase[tidp] = lcnt[tidp] > 0 ? atomicAdd(&p.CNT[tidp], lcnt[tidp]) : 0;
        __syncthreads();
#pragma unroll 1
        for (int i = tidp; i < 4 * RCH * 2; i += NTHR) { const int w_ = i / (RCH * 2), k_ = (i % (RCH * 2)) >> 1;
            if (k0 + k_ < kmax && tb + w_ + (k0 + k_) * nw < T_TOK) { const int e = ent_e[i]; p.LIST[e * LIST_CAP + lbase[e] + ent_s[i]] = ent_v[i]; } }
    }
    }
}

template <int DOWN> __device__ void phase_moe(const P& p, char* smem, int bid, int nblk, const Sched& sc) {
    bf16_t* As = (bf16_t*)smem; bf16_t* Bs = As + 128 * 64; bf16_t* Cs = (bf16_t*)smem;
    int* ents = (int*)(smem + 73728); float* cws = (float*)(ents + 128);
    const int tid = opaque_tid(), lane = tid & 63, wid = tid >> 6, wr = wid >> 1, wc = wid & 1;
    const int l31 = lane & 31, lh = lane >> 5;
    int cnt[16]; int total = 0;
#pragma unroll
    for (int e = 0; e < 16; ++e) { cnt[e] = p.CNT[e]; total += ((cnt[e] + 127) >> 7) * 8; }
    const XOrder xo(bid, nblk, sc);
    for (int rr = 0; ; ++rr) {
        int u; if (!xo.round(rr, total, u)) break; if (u < 0) continue;
        int e = 0, base = 0, ce = 0;
#pragma unroll
        for (int k = 0; k < 16; ++k) { const int n = ((cnt[k] + 127) >> 7) * 8; if (u >= base + n && k == e) { base += n; e = k + 1; } if (k == e) ce = cnt[k]; }
        const int loc = u - base; const int mt = loc >> 3, nt = loc & 7;
        const int nrows = min(128, ce - mt * 128);
        __syncthreads();
        if (tid < 128) { const int ent = p.LIST[e * LIST_CAP + mt * 128 + (tid < nrows ? tid : 0)]; ents[tid] = ent;
            if (DOWN) { const Route rt = p.ROUTE[ent >> 1]; cws[tid] = (ent & 1) ? rt.c1 : rt.c0; } }
        __syncthreads();
        const int KK = DOWN ? 512 : 1024;
        const bf16_t* Xb = DOWN ? p.HID : p.NBUF;
        int tu_ = tid; asm volatile("" : "+v"(tu_));
        const int g0 = gl_row(tu_, 0);
        const unsigned ol0 = (unsigned)(DOWN ? ents[g0] : ents[g0] >> 1) * (unsigned)KK + gl_col(tu_, g0), ol1 = (unsigned)(DOWN ? ents[g0 + 8] : ents[g0 + 8] >> 1) * (unsigned)KK + gl_col(tu_, g0 + 8);
        const unsigned ol2 = (unsigned)(DOWN ? ents[g0 + 16] : ents[g0 + 16] >> 1) * (unsigned)KK + gl_col(tu_, g0 + 16), ol3 = (unsigned)(DOWN ? ents[g0 + 24] : ents[g0 + 24] >> 1) * (unsigned)KK + gl_col(tu_, g0 + 24);
        const bf16_t* Wb = (DOWN ? p.WEO + (size_t)e * 1024 * 512 : p.WEI + (size_t)e * 1024 * 1024) + (size_t)nt * 128 * KK;
        const unsigned w0 = (unsigned)g0 * (unsigned)KK + gl_col(tu_, g0), w1 = (unsigned)(g0 + 8) * (unsigned)KK + gl_col(tu_, g0 + 8), w2 = (unsigned)(g0 + 16) * (unsigned)KK + gl_col(tu_, g0 + 16), w3 = (unsigned)(g0 + 24) * (unsigned)KK + gl_col(tu_, g0 + 24);
        f32x16 acc[2][2]; ZERO_ACC(acc);
        gemm_mainloop(Wb, w0, w1, w2, w3, Xb, ol0, ol1, ol2, ol3, KK, acc, As, Bs);
        if (DOWN) {
#pragma unroll
            for (int j = 0; j < 2; ++j) { const float c = cws[64 * wc + 32 * j + l31];
#pragma unroll
                for (int i = 0; i < 2; ++i)
#pragma unroll
                    for (int r = 0; r < 16; ++r) acc[i][j][r] *= c; }
        } else {
#pragma unroll
            for (int j = 0; j < 2; ++j)
#pragma unroll
                for (int r = 0; r < 16; ++r) { const float g = acc[0][j][r]; acc[0][j][r] = g * __builtin_amdgcn_rcpf(1.0f + __expf(-g)) * acc[1][j][r]; }
        }
        __syncthreads();
        if (DOWN) cimg_write(acc, Cs, wr, wc, l31, lh);
        else {
#pragma unroll
            for (int j = 0; j < 2; ++j)
#pragma unroll
                for (int g = 0; g < 4; ++g) { uint2 o; o.x = cvt_pk_bf16(acc[0][j][4 * g], acc[0][j][4 * g + 1]); o.y = cvt_pk_bf16(acc[0][j][4 * g + 2], acc[0][j][4 * g + 3]);
                    *(uint2*)(Cs + (64 * wc + 32 * j + l31) * CSTR + 32 * wr + 8 * g + 4 * lh) = o; }
        }
        __syncthreads();
        int te_ = tid; asm volatile("" : "+v"(te_));
        if (DOWN) {
#pragma unroll
            for (int k = 0; k < 8; ++k) { const int c = te_ + 256 * k; const int lrow = c >> 4, ch = c & 15;
                if (lrow < nrows) { const uint4 v = *(const uint4*)(Cs + lrow * CSTR + ch * 8); *(uint4*)(p.YMOE + (size_t)ents[lrow] * 1024 + nt * 128 + ch * 8) = v; } }
        } else {
#pragma unroll
            for (int k = 0; k < 4; ++k) { const int c = te_ + 256 * k; const int lrow = c >> 3, ch = c & 7;
                if (lrow < nrows) { const uint4 v = *(const uint4*)(Cs + lrow * CSTR + ch * 8); *(uint4*)(p.HID + (size_t)ents[lrow] * 512 + nt * 64 + ch * 8) = v; } }
        }
    }
}

template <int VAR = 0> __device__ void phase_final(const P& p, int bid, int nblk) {
    const int tidp = opaque_tid();
    const int lane = tidp & 63; const int gw = bid * 4 + (tidp >> 6), nw = nblk * 4;
    for (int tok = gw; tok < T_TOK; tok += nw) {
        float* hp = p.out + (size_t)tok * DM; const bf16_t* hb = p.HB + (size_t)tok * DM; const bf16_t* y0 = p.YMOE + (size_t)tok * 2 * DM; const bf16_t* y1 = y0 + DM;
        float4 v[4]; float ss = 0.f;
#pragma unroll
        for (int i = 0; i < 4; ++i) { const uint2 hu = *(const uint2*)(hb + i * 256 + lane * 4);
            v[i].x = __uint_as_float(hu.x << 16); v[i].y = __uint_as_float(hu.x & 0xffff0000u); v[i].z = __uint_as_float(hu.y << 16); v[i].w = __uint_as_float(hu.y & 0xffff0000u);
            const uint2 a = *(const uint2*)(y0 + i * 256 + lane * 4), b = *(const uint2*)(y1 + i * 256 + lane * 4);
            v[i].x += __uint_as_float(a.x << 16) + __uint_as_float(b.x << 16); v[i].y += __uint_as_float(a.x & 0xffff0000u) + __uint_as_float(b.x & 0xffff0000u);
            v[i].z += __uint_as_float(a.y << 16) + __uint_as_float(b.y << 16); v[i].w += __uint_as_float(a.y & 0xffff0000u) + __uint_as_float(b.y & 0xffff0000u);
            ss += v[i].x * v[i].x + v[i].y * v[i].y + v[i].z * v[i].z + v[i].w * v[i].w; }
        ss = wave_sum(ss);
        const float r = rsqrtf(ss * (1.0f / DM) + 1e-6f);
#pragma unroll
        for (int i = 0; i < 4; ++i) { const float4 gg = *(const float4*)(p.g_fin + i * 256 + lane * 4);
            float4 o; o.x = v[i].x * r * gg.x; o.y = v[i].y * r * gg.y; o.z = v[i].z * r * gg.z; o.w = v[i].w * r * gg.w;
            *(float4*)((VAR ? (float*)p.SGS + (size_t)4 * 1024 * 1024 + (size_t)(tok & 8191) * DM : hp) + i * 256 + lane * 4) = o; }
    }
}
__device__ __forceinline__ float fast_exp2(float x) { return __builtin_amdgcn_exp2f(x); }
typedef float f32x2v __attribute__((ext_vector_type(2)));
template <int KIND, int VAR = 0> __device__ void phase_attn(const P& p, char* smem, int bid, int nblk, const Sched& sc) {
    constexpr int NM = 1, NMAPS = KIND == 0 ? 2 : 1, DQK = KIND == 2 ? 128 : 64, DV = KIND == 1 ? 64 : 128;
    constexpr int KROW = DQK, QROW = NMAPS * DQK, KSTR = KROW + 8, VSTR = 72, NDT = DV / 32, NKS = DQK / 16;
    constexpr int KCH = 64 * KROW / 8 / NTHR, VCH = DV * 8 / NTHR;
    constexpr int NH = KIND == 1 ? 8 : 4;
    constexpr int NUNITS = NBATCH * NH * 64;
    constexpr bool DB = KIND != 2;
    bf16_t* Ks = (bf16_t*)smem; bf16_t* Vs = Ks + (DB ? 2 : 1) * 64 * KSTR;
    const int tid = opaque_tid(), lane = tid & 63, wid = tid >> 6, l31 = lane & 31, lh = lane >> 5;
    const float c = (KIND == 2 ? 0.08838834764831845f : 0.125f) * 1.4426950408889634f;
    float lam = 0.f;
    if (KIND == 0) { float d1 = 0.f, d2 = 0.f; for (int i = 0; i < 64; ++i) { d1 += p.lq1[i] * p.lk1[i]; d2 += p.lq2[i] * p.lk2[i]; } lam = expf(d1) - expf(d2) + 0.2f; }
    const bf16_t* Qb = KIND == 0 ? p.DQ : KIND == 1 ? p.SQ : p.MQ;
    const bf16_t* Kb = KIND == 0 ? p.DK : KIND == 1 ? p.SK : p.MK;
    const bf16_t* Vb = KIND == 0 ? p.DVT : KIND == 1 ? p.SVT : p.MVT;
    bf16_t* Yb = VAR != 0 ? (bf16_t*)p.SGS + (size_t)16 * 1024 * 1024 : KIND == 0 ? p.YD : KIND == 1 ? p.YS : p.YM;
    constexpr int VLEN = KIND == 2 ? 256 : S_LEN;
    const bool xaware = false;
    for (int rnd = 0; xaware ? (rnd < NBATCH * NH / 8) : (rnd * nblk < NUNITS); ++rnd) {
        int qt, bh;
        if (xaware) { bh = sc.x * (NBATCH * NH / 8) + rnd; qt = (rnd & 1) ? sc.j : 63 - sc.j; }
        else { const int rank = rnd * nblk + ((rnd & 1) ? nblk - 1 - bid : bid); if (rank >= NUNITS) continue;
               qt = KIND == 2 ? rank % 64 : 63 - rank / (NBATCH * NH); bh = KIND == 2 ? rank / 64 : rank % (NBATCH * NH); }
        const int b = bh / NH, h = bh % NH;
        const int q0 = qt * 128, qw = q0 + 32 * wid;
        const int nkt = KIND == 2 ? 4 : 2 * (qt + 1);
        unsigned o1pk[NDT][8];
#pragma unroll 1
        for (int map = 0; map < NMAPS; ++map) {
        bf16x8 qf[NM][NKS];
        const bf16_t* qp = Qb + ((size_t)(b * S_LEN + qw + l31)) * 512 + h * QROW + map * DQK + lh * 8;
        if (KIND != 2) {
#pragma unroll
            for (int m = 0; m < NM; ++m)
#pragma unroll
                for (int ks = 0; ks < NKS; ++ks) qf[m][ks] = *(const bf16x8*)(qp + m * DQK + ks * 16);
        }
        f32x16 o[NM][NDT];
#pragma unroll
        for (int m = 0; m < NM; ++m)
#pragma unroll
            for (int dt = 0; dt < NDT; ++dt)
#pragma unroll
                for (int r = 0; r < 16; ++r) o[m][dt][r] = 0.f;
        float mrow[NM], lrow[NM];
#pragma unroll
        for (int m = 0; m < NM; ++m) { mrow[m] = -INFINITY; lrow[m] = 0.f; }
        int tid_l = tid; asm volatile("" : "+v"(tid_l));
        const bf16_t* ksrc = Kb + ((size_t)(KIND == 2 ? b * 256 : b * S_LEN) + (tid_l >> (KROW == 128 ? 4 : 3))) * 512 + h * QROW + map * DQK + (tid_l & (KROW / 8 - 1)) * 8;
        constexpr int KROWS_PER_PASS = NTHR / (KROW / 8);
        const int krow_ = tid_l >> (KROW == 128 ? 4 : 3);
        bf16_t* kdst = Ks + ((krow_ & ~12) | ((krow_ & 4) << 1) | ((krow_ & 8) >> 1)) * KSTR + (tid_l & (KROW / 8 - 1)) * 8;
        const bf16_t* vsrc = Vb + ((size_t)(bh * DV + (tid_l >> 3))) * VLEN + (tid_l & 7) * 8;
        bf16_t* vdst = Vs + (tid_l >> 3) * VSTR + (tid_l & 7) * 8;
        uint4 rk0, rk1, rk2 = make_uint4(0,0,0,0), rk3 = make_uint4(0,0,0,0), rv0, rv1, rv2 = make_uint4(0,0,0,0), rv3 = make_uint4(0,0,0,0);
        { const bf16_t* s_ = ksrc + (size_t)(0) * 512; rk0 = *(const uint4*)(s_); rk1 = *(const uint4*)(s_ + (size_t)KROWS_PER_PASS * 512); if (KCH > 2) { rk2 = *(const uint4*)(s_ + (size_t)2 * KROWS_PER_PASS * 512); rk3 = *(const uint4*)(s_ + (size_t)3 * KROWS_PER_PASS * 512); } }
        { const bf16_t* s_ = vsrc + ((size_t)0); rv0 = *(const uint4*)(s_); rv1 = *(const uint4*)(s_ + (size_t)32 * VLEN); if (VCH > 2) { rv2 = *(const uint4*)(s_ + (size_t)64 * VLEN); rv3 = *(const uint4*)(s_ + (size_t)96 * VLEN); } }
        __syncthreads();
        { *(uint4*)(kdst) = rk0; *(uint4*)(kdst + KROWS_PER_PASS * KSTR) = rk1; if (KCH > 2) { *(uint4*)(kdst + 2 * KROWS_PER_PASS * KSTR) = rk2; *(uint4*)(kdst + 3 * KROWS_PER_PASS * KSTR) = rk3; } }
        { *(uint4*)(vdst) = rv0; *(uint4*)(vdst + 32 * VSTR) = rv1; if (VCH > 2) { *(uint4*)(vdst + 64 * VSTR) = rv2; *(uint4*)(vdst + 96 * VSTR) = rv3; } }
        __syncthreads();
        if (!DB && nkt > 1) { const bf16_t* s_ = ksrc + (size_t)(64) * 512; rk0 = *(const uint4*)(s_); rk1 = *(const uint4*)(s_ + (size_t)KROWS_PER_PASS * 512); if (KCH > 2) { rk2 = *(const uint4*)(s_ + (size_t)2 * KROWS_PER_PASS * 512); rk3 = *(const uint4*)(s_ + (size_t)3 * KROWS_PER_PASS * 512); } }
        uint2 mwn = make_uint2(0u, 0u);
        if (KIND == 1) mwn = *(const uint2*)(p.MASK + ((size_t)(b * S_LEN + qw + l31)) * 256);
        for (int kt = 0; kt < nkt; ++kt) {
            const bool active = KIND == 2 ? true : (kt * 64 <= qw + 31);
            const bf16_t* Kc = Ks + (DB ? (kt & 1) * 64 * KSTR : 0); const bf16_t* Vc = Vs + (DB ? (kt & 1) * DV * VSTR : 0);
            if (DB && kt + 1 < nkt && VAR != 6 && VAR != 7) {
                { const bf16_t* s_ = ksrc + (size_t)((kt + 1) * 64) * 512; rk0 = *(const uint4*)(s_); rk1 = *(const uint4*)(s_ + (size_t)KROWS_PER_PASS * 512); if (KCH > 2) { rk2 = *(const uint4*)(s_ + (size_t)2 * KROWS_PER_PASS * 512); rk3 = *(const uint4*)(s_ + (size_t)3 * KROWS_PER_PASS * 512); } }
                { const bf16_t* s_ = vsrc + ((size_t)(kt + 1) * 64); rv0 = *(const uint4*)(s_); rv1 = *(const uint4*)(s_ + (size_t)32 * VLEN); if (VCH > 2) { rv2 = *(const uint4*)(s_ + (size_t)64 * VLEN); rv3 = *(const uint4*)(s_ + (size_t)96 * VLEN); } }
            }
            __builtin_amdgcn_sched_barrier(0);
            unsigned pk[NM][2][2][4];
            if (active) {
                uint2 mw = mwn;
                if (KIND == 1) { mw.x >>= 8 * lh; mw.y >>= 8 * lh; if (kt + 1 < nkt) mwn = *(const uint2*)(p.MASK + ((size_t)(b * S_LEN + qw + l31)) * 256 + (kt + 1) * 2); }
#pragma unroll
                for (int m = 0; m < NM; ++m) {
                    f32x16 s[2];
#pragma unroll
                    for (int r = 0; r < 16; ++r) { s[0][r] = 0.f; s[1][r] = 0.f; }
#pragma unroll
                    for (int ks = 0; ks < NKS; ks += 2) {
                        const bf16x8 a00 = *(const bf16x8*)(Kc + l31 * KSTR + m * DQK + ks * 16 + lh * 8);
                        const bf16x8 a10 = *(const bf16x8*)(Kc + (32 + l31) * KSTR + m * DQK + ks * 16 + lh * 8);
                        const bf16x8 a01 = *(const bf16x8*)(Kc + l31 * KSTR + m * DQK + (ks + 1) * 16 + lh * 8);
                        const bf16x8 a11 = *(const bf16x8*)(Kc + (32 + l31) * KSTR + m * DQK + (ks + 1) * 16 + lh * 8);
                        const bf16x8 q0_ = KIND == 2 ? *(const bf16x8*)(qp + ks * 16) : qf[m][ks];
                        const bf16x8 q1_ = KIND == 2 ? *(const bf16x8*)(qp + (ks + 1) * 16) : qf[m][ks + 1];
                        __builtin_amdgcn_sched_barrier(0);
                        if (VAR != 5) {
                        s[0] = __builtin_amdgcn_mfma_f32_32x32x16_bf16(a00, q0_, s[0], 0, 0, 0);
                        s[1] = __builtin_amdgcn_mfma_f32_32x32x16_bf16(a10, q0_, s[1], 0, 0, 0);
                        s[0] = __builtin_amdgcn_mfma_f32_32x32x16_bf16(a01, q1_, s[0], 0, 0, 0);
                        s[1] = __builtin_amdgcn_mfma_f32_32x32x16_bf16(a11, q1_, s[1], 0, 0, 0);
                        } else { asm volatile("" :: "v"(a00), "v"(a10), "v"(a01), "v"(a11)); }
                    }
                    if (KIND == 0 && kt * 64 + 63 > qw) {
                        const int qi = qw + l31 - kt * 64 - 8 * lh;
#pragma unroll
                        for (int t = 0; t < 2; ++t)
#pragma unroll
                            for (int r = 0; r < 16; ++r) if (32 * t + (r & 7) + 16 * (r >> 3) > qi) s[t][r] = -INFINITY;
                    }
                    float mx = s[0][0];
#pragma unroll
                    for (int r = 1; r < 16; ++r) mx = fmaxf(mx, s[0][r]);
#pragma unroll
                    for (int r = 0; r < 16; ++r) mx = fmaxf(mx, s[1][r]);
                    mx = xhalf_max(mx);
                    const float mnew = fmaxf(mrow[m], mx * c);
                    const float corr = fast_exp2(mrow[m] - mnew);
                    mrow[m] = mnew;
                    f32x2v ps2 = {0.f, 0.f}; const f32x2v c2 = {c, c}, nm2 = {-mnew, -mnew};
#pragma unroll
                    for (int t = 0; t < 2; ++t)
#pragma unroll
                        for (int r = 0; r < 16; r += 2) {
                            const f32x2v sv = {s[t][r], s[t][r + 1]};
                            const f32x2v y = VAR == 3 ? sv : sv * c2 + nm2;
                            f32x2v pv = {(VAR == 1 || VAR == 3) ? y.x : fast_exp2(y.x), (VAR == 1 || VAR == 3) ? y.y : fast_exp2(y.y)};
                            if (KIND == 1) { int m0 = __builtin_amdgcn_sbfe((int)(t ? mw.y : mw.x), (r & 7) + 16 * (r >> 3), 1), m1 = __builtin_amdgcn_sbfe((int)(t ? mw.y : mw.x), ((r + 1) & 7) + 16 * ((r + 1) >> 3), 1);
                                             asm("" : "+v"(m0), "+v"(m1));
                                             pv.x = __uint_as_float(__float_as_uint(pv.x) & (unsigned)m0); pv.y = __uint_as_float(__float_as_uint(pv.y) & (unsigned)m1); }
                            ps2 += pv; s[t][r] = pv.x; s[t][r + 1] = pv.y;
                        }
                    const float psum = ps2.x + ps2.y;
                    lrow[m] = lrow[m] * corr + psum;
#pragma unroll
                    for (int t = 0; t < 2; ++t)
#pragma unroll
                        for (int s2 = 0; s2 < 2; ++s2)
#pragma unroll
                            for (int j = 0; j < 4; ++j) pk[m][t][s2][j] = cvt_pk_bf16(s[t][8 * s2 + 2 * j], s[t][8 * s2 + 2 * j + 1]);
                    if (__any(corr != 1.0f)) {
#pragma unroll
                        for (int dt = 0; dt < NDT; ++dt)
#pragma unroll
                            for (int r = 0; r < 16; ++r) o[m][dt][r] *= corr;
                    }
                }
            }
            if (!DB) {
            __syncthreads();
            if (kt + 1 < nkt) {
                { *(uint4*)(kdst) = rk0; *(uint4*)(kdst + KROWS_PER_PASS * KSTR) = rk1; if (KCH > 2) { *(uint4*)(kdst + 2 * KROWS_PER_PASS * KSTR) = rk2; *(uint4*)(kdst + 3 * KROWS_PER_PASS * KSTR) = rk3; } }
                { const bf16_t* s_ = vsrc + ((size_t)(kt + 1) * 64); rv0 = *(const uint4*)(s_); rv1 = *(const uint4*)(s_ + (size_t)32 * VLEN); if (VCH > 2) { rv2 = *(const uint4*)(s_ + (size_t)64 * VLEN); rv3 = *(const uint4*)(s_ + (size_t)96 * VLEN); } }
            }
            }
            if (active) {
                constexpr int GS = NDT == 4 ? 1 : 2;
#pragma unroll
                for (int ks2 = 0; ks2 < 4; ks2 += GS) {
                    bf16x8 va[GS][NDT];
#pragma unroll
                    for (int g = 0; g < GS; ++g)
#pragma unroll
                        for (int dt = 0; dt < NDT; ++dt) {
                            va[g][dt] = *(const bf16x8*)(Vc + (32 * dt + l31) * VSTR + 16 * (ks2 + g) + 8 * lh);
                        }
                    __builtin_amdgcn_sched_barrier(0);
#pragma unroll
                    for (int g = 0; g < GS; ++g)
#pragma unroll
                        for (int dt = 0; dt < NDT; ++dt)
#pragma unroll
                            for (int m = 0; m < NM; ++m) {
                                const int k2 = ks2 + g;
                                const uint4 pu = make_uint4(pk[m][k2 >> 1][k2 & 1][0], pk[m][k2 >> 1][k2 & 1][1], pk[m][k2 >> 1][k2 & 1][2], pk[m][k2 >> 1][k2 & 1][3]);
                                if (VAR != 2) o[m][dt] = __builtin_amdgcn_mfma_f32_32x32x16_bf16(va[g][dt], *(const bf16x8*)&pu, o[m][dt], 0, 0, 0); else { o[m][dt][0] += __uint_as_float(pu.x); asm volatile("" :: "v"(va[g][dt])); }
                            }
                }
            }
            if (DB) {
                if (kt + 1 < nkt && VAR != 6 && VAR != 7) {
                    bf16_t* kd = kdst + ((kt + 1) & 1) * 64 * KSTR; bf16_t* vd = vdst + ((kt + 1) & 1) * DV * VSTR;
                    { *(uint4*)(kd) = rk0; *(uint4*)(kd + KROWS_PER_PASS * KSTR) = rk1; if (KCH > 2) { *(uint4*)(kd + 2 * KROWS_PER_PASS * KSTR) = rk2; *(uint4*)(kd + 3 * KROWS_PER_PASS * KSTR) = rk3; } }
                    { *(uint4*)(vd) = rv0; *(uint4*)(vd + 32 * VSTR) = rv1; if (VCH > 2) { *(uint4*)(vd + 64 * VSTR) = rv2; *(uint4*)(vd + 96 * VSTR) = rv3; } }
                }
                if (VAR != 7) __syncthreads();
            } else {
            __syncthreads();
            if (kt + 1 < nkt) {
                { *(uint4*)(vdst) = rv0; *(uint4*)(vdst + 32 * VSTR) = rv1; if (VCH > 2) { *(uint4*)(vdst + 64 * VSTR) = rv2; *(uint4*)(vdst + 96 * VSTR) = rv3; } }
                if (kt + 2 < nkt) { const bf16_t* s_ = ksrc + (size_t)((kt + 2) * 64) * 512; rk0 = *(const uint4*)(s_); rk1 = *(const uint4*)(s_ + (size_t)KROWS_PER_PASS * 512); if (KCH > 2) { rk2 = *(const uint4*)(s_ + (size_t)2 * KROWS_PER_PASS * 512); rk3 = *(const uint4*)(s_ + (size_t)3 * KROWS_PER_PASS * 512); } }
            }
            }
        }
#pragma unroll
        for (int m = 0; m < NM; ++m) lrow[m] = xhalf_sum(lrow[m]);
        bf16_t* yp = Yb + ((size_t)(b * S_LEN + qw + l31)) * 512 + h * DV + 4 * lh;
        if (KIND == 0) {
            if (map == 0) {
                const float i1 = 1.0f / lrow[0];
#pragma unroll
                for (int dt = 0; dt < NDT; ++dt)
#pragma unroll
                    for (int j = 0; j < 8; ++j) o1pk[dt][j] = cvt_pk_bf16(o[0][dt][2 * j] * i1, o[0][dt][2 * j + 1] * i1);
            } else {
            const float i2 = lam / lrow[0];
            float ss = 0.f;
#pragma unroll
            for (int dt = 0; dt < NDT; ++dt)
#pragma unroll
                for (int r = 0; r < 16; ++r) { const float o1 = (r & 1) ? __uint_as_float(o1pk[dt][r >> 1] & 0xffff0000u) : __uint_as_float(o1pk[dt][r >> 1] << 16);
                    const float v = o1 - o[0][dt][r] * i2; o[0][dt][r] = v; ss += v * v; }
            ss = xhalf_sum(ss);
            const float rn = rsqrtf(ss * (1.0f / 128.0f) + 1e-6f) * 0.8f;
#pragma unroll
            for (int dt = 0; dt < NDT; ++dt)
#pragma unroll
                for (int g = 0; g < 4; ++g) { const int dv = 32 * dt + 8 * g + 4 * lh; const float4 gs = *(const float4*)(p.g_sub + dv);
                    uint2 w; w.x = cvt_pk_bf16(o[0][dt][4 * g] * rn * gs.x, o[0][dt][4 * g + 1] * rn * gs.y); w.y = cvt_pk_bf16(o[0][dt][4 * g + 2] * rn * gs.z, o[0][dt][4 * g + 3] * rn * gs.w);
                    *(uint2*)(yp + 32 * dt + 8 * g) = w; }
            }
        } else {
            const float i1 = 1.0f / lrow[0];
#pragma unroll
            for (int dt = 0; dt < NDT; ++dt)
#pragma unroll
                for (int g = 0; g < 4; ++g) {
                    uint2 w; w.x = cvt_pk_bf16(o[0][dt][4 * g] * i1, o[0][dt][4 * g + 1] * i1); w.y = cvt_pk_bf16(o[0][dt][4 * g + 2] * i1, o[0][dt][4 * g + 3] * i1);
                    *(uint2*)(yp + 32 * dt + 8 * g) = w; }
        }
        }
    }
}
template <int KIND> __device__ void phase_attn2(const P& p, char* smem, int bid, int nblk, const Sched& sc) {
    constexpr int NMAPS = KIND == 0 ? 2 : 1, DQK = 64, DV = KIND == 1 ? 64 : 128;
    constexpr int QROW = NMAPS * DQK, KSTR = 72, VSTR = 72, NDT = DV / 32, NKS = 4;
    constexpr int VCH = DV * 8 / NTHR;
    constexpr int NH = KIND == 1 ? 8 : 4;
    constexpr int NUNITS = NBATCH * NH * 64;
    bf16_t* Ks = (bf16_t*)smem; bf16_t* Vs = Ks + 2 * 64 * KSTR;
    const int tid = opaque_tid(), lane = tid & 63, wid = tid >> 6, l31 = lane & 31, lh = lane >> 5;
    const float c = 0.125f * 1.4426950408889634f;
    float lam = 0.f;
    if (KIND == 0) { float d1 = 0.f, d2 = 0.f; for (int i = 0; i < 64; ++i) { d1 += p.lq1[i] * p.lk1[i]; d2 += p.lq2[i] * p.lk2[i]; } lam = expf(d1) - expf(d2) + 0.2f; }
    const bf16_t* Qb = KIND == 0 ? p.DQ : p.SQ;
    const bf16_t* Kb = KIND == 0 ? p.DK : p.SK;
    const bf16_t* Vb = KIND == 0 ? p.DVT : p.SVT;
    bf16_t* Yb = KIND == 0 ? p.YD : p.YS;
    const bool xaware = false;
    for (int rnd = 0; xaware ? (rnd < NBATCH * NH / 8) : (rnd * nblk < NUNITS); ++rnd) {
        int qt, bh;
        if (xaware) { bh = sc.x * (NBATCH * NH / 8) + rnd; qt = (rnd & 1) ? sc.j : 63 - sc.j; }
        else { const int rank = rnd * nblk + ((rnd & 1) ? nblk - 1 - bid : bid); if (rank >= NUNITS) continue; qt = 63 - rank / (NBATCH * NH); bh = rank % (NBATCH * NH); }
        const int b = bh / NH, h = bh % NH;
        const int q0 = qt * 128, qw = q0 + 32 * wid;
        const int nkt = 2 * (qt + 1);
        const int last_act = min(nkt - 1, (qw + 31) >> 6);
#pragma unroll 1
        for (int map = 0; map < NMAPS; ++map) {
        bf16x8 qf[NKS];
        { const bf16_t* qp = Qb + ((size_t)(b * S_LEN + qw + l31)) * 512 + h * QROW + map * DQK + lh * 8;
#pragma unroll
          for (int ks = 0; ks < NKS; ++ks) qf[ks] = *(const bf16x8*)(qp + ks * 16); }
        f32x16 o[NDT];
#pragma unroll
        for (int dt = 0; dt < NDT; ++dt)
#pragma unroll
            for (int r = 0; r < 16; ++r) o[dt][r] = 0.f;
        float mrow = -INFINITY, lrow = 0.f;
        int tl_ = tid; asm volatile("" : "+v"(tl_));
        const bf16_t* ksrc = Kb + ((size_t)b * S_LEN + (tl_ >> 3)) * 512 + h * QROW + map * DQK + (tl_ & 7) * 8;
        bf16_t* kdst = Ks + (tl_ >> 3) * KSTR + (tl_ & 7) * 8;
        const bf16_t* vsrc = Vb + ((size_t)(bh * DV + (tl_ >> 3))) * S_LEN + (tl_ & 7) * 8;
        bf16_t* vdst = Vs + (tl_ >> 3) * VSTR + (tl_ & 7) * 8;
        uint4 rk0, rk1, rv0, rv1, rv2 = make_uint4(0, 0, 0, 0), rv3 = make_uint4(0, 0, 0, 0);
#define LDK(kt_) { const bf16_t* s_ = ksrc + (size_t)((kt_) * 64) * 512; rk0 = *(const uint4*)(s_); rk1 = *(const uint4*)(s_ + (size_t)32 * 512); }
#define LDV(kt_) { const bf16_t* s_ = vsrc + (size_t)(kt_) * 64; rv0 = *(const uint4*)(s_); rv1 = *(const uint4*)(s_ + (size_t)32 * S_LEN); if (VCH > 2) { rv2 = *(const uint4*)(s_ + (size_t)64 * S_LEN); rv3 = *(const uint4*)(s_ + (size_t)96 * S_LEN); } }
#define STK(buf_) { bf16_t* d_ = kdst + (buf_) * 64 * KSTR; *(uint4*)(d_) = rk0; *(uint4*)(d_ + 32 * KSTR) = rk1; }
#define STV(buf_) { bf16_t* d_ = vdst + (buf_) * DV * VSTR; *(uint4*)(d_) = rv0; *(uint4*)(d_ + 32 * VSTR) = rv1; if (VCH > 2) { *(uint4*)(d_ + 64 * VSTR) = rv2; *(uint4*)(d_ + 96 * VSTR) = rv3; } }
        LDK(0) LDV(0)
        __syncthreads();
        STK(0) STV(0)
        LDK(1)
        STK(1)
        __syncthreads();
        f32x16 s[2];
        auto qk = [&](int kt) {
            const bf16_t* Kc = Ks + (kt & 1) * 64 * KSTR;
#pragma unroll
            for (int r = 0; r < 16; ++r) { s[0][r] = 0.f; s[1][r] = 0.f; }
#pragma unroll
            for (int ks = 0; ks < NKS; ks += 2) {
                const bf16x8 a00 = *(const bf16x8*)(Kc + l31 * KSTR + ks * 16 + lh * 8), a10 = *(const bf16x8*)(Kc + (32 + l31) * KSTR + ks * 16 + lh * 8);
                const bf16x8 a01 = *(const bf16x8*)(Kc + l31 * KSTR + (ks + 1) * 16 + lh * 8), a11 = *(const bf16x8*)(Kc + (32 + l31) * KSTR + (ks + 1) * 16 + lh * 8);
                s[0] = __builtin_amdgcn_mfma_f32_32x32x16_bf16(a00, qf[ks], s[0], 0, 0, 0);
                s[1] = __builtin_amdgcn_mfma_f32_32x32x16_bf16(a10, qf[ks], s[1], 0, 0, 0);
                s[0] = __builtin_amdgcn_mfma_f32_32x32x16_bf16(a01, qf[ks + 1], s[0], 0, 0, 0);
                s[1] = __builtin_amdgcn_mfma_f32_32x32x16_bf16(a11, qf[ks + 1], s[1], 0, 0, 0);
            }
        };
        unsigned pkp[2][2][4], pkn[2][2][4];
        float corr = 1.0f;
        uint2 mw = make_uint2(0u, 0u);
        auto softmax = [&](int kt) {
            if (KIND == 0 && kt * 64 + 63 > qw) {
                const int qi = qw + l31 - kt * 64 - 4 * lh;
#pragma unroll
                for (int t = 0; t < 2; ++t)
#pragma unroll
                    for (int r = 0; r < 16; ++r) if (32 * t + (r & 3) + 8 * (r >> 2) > qi) s[t][r] = -INFINITY;
            }
            float mx = s[0][0];
#pragma unroll
            for (int r = 1; r < 16; ++r) mx = fmaxf(mx, s[0][r]);
#pragma unroll
            for (int r = 0; r < 16; ++r) mx = fmaxf(mx, s[1][r]);
            mx = xhalf_max(mx);
            const float mnew = fmaxf(mrow, mx * c);
            corr = fast_exp2(mrow - mnew);
            mrow = mnew;
            f32x2v ps2 = {0.f, 0.f}; const f32x2v c2 = {c, c}, nm2 = {-mnew, -mnew};
#pragma unroll
            for (int t = 0; t < 2; ++t)
#pragma unroll
                for (int r = 0; r < 16; r += 2) {
                    const f32x2v sv = {s[t][r], s[t][r + 1]};
                    const f32x2v y = sv * c2 + nm2;
                    f32x2v pv = {fast_exp2(y.x), fast_exp2(y.y)};
                    if (KIND == 1) { pv.x = __uint_as_float(__float_as_uint(pv.x) & (unsigned)__builtin_amdgcn_sbfe((int)(t ? mw.y : mw.x), (r & 3) + 8 * (r >> 2), 1));
                                     pv.y = __uint_as_float(__float_as_uint(pv.y) & (unsigned)__builtin_amdgcn_sbfe((int)(t ? mw.y : mw.x), ((r + 1) & 3) + 8 * ((r + 1) >> 2), 1)); }
                    ps2 += pv;
                    pkn[t][r >> 3][(r >> 1) & 3] = cvt_pk_bf16(pv.x, pv.y);
                }
            lrow = lrow * corr + (ps2.x + ps2.y);
        };
        auto pv_mma = [&](int kt) {
            const bf16_t* Vc = Vs + (kt % 3) * DV * VSTR;
            constexpr int GS = NDT == 4 ? 1 : 2;
#pragma unroll
            for (int ks2 = 0; ks2 < 4; ks2 += GS) {
                bf16x8 va[GS][NDT];
#pragma unroll
                for (int g = 0; g < GS; ++g)
#pragma unroll
                    for (int dt = 0; dt < NDT; ++dt) {
                        const bf16_t* vp = Vc + (32 * dt + l31) * VSTR + 16 * (ks2 + g) + 4 * lh;
                        const uint2 lo = *(const uint2*)vp, hi = *(const uint2*)(vp + 8);
                        const uint4 vv = make_uint4(lo.x, lo.y, hi.x, hi.y);
                        va[g][dt] = *(const bf16x8*)&vv;
                    }
#pragma unroll
                for (int g = 0; g < GS; ++g)
#pragma unroll
                    for (int dt = 0; dt < NDT; ++dt) {
                        const int k2 = ks2 + g;
                        const uint4 pu = make_uint4(pkp[k2 >> 1][k2 & 1][0], pkp[k2 >> 1][k2 & 1][1], pkp[k2 >> 1][k2 & 1][2], pkp[k2 >> 1][k2 & 1][3]);
                        o[dt] = __builtin_amdgcn_mfma_f32_32x32x16_bf16(va[g][dt], *(const bf16x8*)&pu, o[dt], 0, 0, 0);
                    }
            }
        };
        uint2 mwn = make_uint2(0u, 0u);
        if (KIND == 1) mwn = *(const uint2*)(p.MASK + ((size_t)(b * S_LEN + qw + l31)) * 256);
        qk(0);
        for (int kt = 0; kt <= nkt; ++kt) {
            if (kt + 2 < nkt) LDK(kt + 2)
            if (kt + 1 < nkt) LDV(kt + 1)
            const bool do_sm = kt <= last_act, do_pv = kt >= 1 && kt - 1 <= last_act;
            if (do_sm && KIND == 1) { mw = mwn; mw.x >>= 4 * lh; mw.y >>= 4 * lh; if (kt + 1 <= last_act) mwn = *(const uint2*)(p.MASK + ((size_t)(b * S_LEN + qw + l31)) * 256 + (kt + 1) * 2); }
            if (do_sm && do_pv) {
                softmax(kt); pv_mma(kt - 1);
            } else if (do_sm) softmax(kt);
            else if (do_pv) pv_mma(kt - 1);
            if (do_sm) {
                if (__any(corr != 1.0f)) {
#pragma unroll
                    for (int dt = 0; dt < NDT; ++dt)
#pragma unroll
                        for (int r = 0; r < 16; ++r) o[dt][r] *= corr;
                }
#pragma unroll
                for (int t = 0; t < 2; ++t)
#pragma unroll
                    for (int s2 = 0; s2 < 2; ++s2)
#pragma unroll
                        for (int j = 0; j < 4; ++j) pkp[t][s2][j] = pkn[t][s2][j];
            }
            if (kt + 1 <= last_act) qk(kt + 1);
            if (kt + 2 < nkt) STK(kt & 1)
            if (kt + 1 < nkt) STV((kt + 1) % 3)
            __syncthreads();
        }
#undef LDK
#undef LDV
#undef STK
#undef STV
        int te_ = tid; asm volatile("" : "+v"(te_));
        uint4* park = (uint4*)p.SGS + (size_t)bid * 2048 + te_;
        lrow = xhalf_sum(lrow);
        bf16_t* yp = Yb + ((size_t)(b * S_LEN + qw + l31)) * 512 + h * DV + 4 * lh;
        if (KIND == 0) {
            if (map == 0) {
                const float i1 = 1.0f / lrow;
#pragma unroll
                for (int dt = 0; dt < NDT; ++dt)
#pragma unroll
                    for (int h2 = 0; h2 < 2; ++h2)
                        park[(size_t)(dt * 2 + h2) * 256] = make_uint4(cvt_pk_bf16(o[dt][8 * h2] * i1, o[dt][8 * h2 + 1] * i1), cvt_pk_bf16(o[dt][8 * h2 + 2] * i1, o[dt][8 * h2 + 3] * i1),
                                                                      cvt_pk_bf16(o[dt][8 * h2 + 4] * i1, o[dt][8 * h2 + 5] * i1), cvt_pk_bf16(o[dt][8 * h2 + 6] * i1, o[dt][8 * h2 + 7] * i1));
                asm volatile("" ::: "memory");
            } else {
                const float i2 = lam / lrow;
                float ss = 0.f;
#pragma unroll
                for (int dt = 0; dt < NDT; ++dt)
#pragma unroll
                    for (int h2 = 0; h2 < 2; ++h2) { const uint4 w = park[(size_t)(dt * 2 + h2) * 256]; const unsigned ww[4] = {w.x, w.y, w.z, w.w};
#pragma unroll
                        for (int j = 0; j < 4; ++j) {
                            const float v0 = __uint_as_float(ww[j] << 16) - o[dt][8 * h2 + 2 * j] * i2, v1 = __uint_as_float(ww[j] & 0xffff0000u) - o[dt][8 * h2 + 2 * j + 1] * i2;
                            o[dt][8 * h2 + 2 * j] = v0; o[dt][8 * h2 + 2 * j + 1] = v1; ss += v0 * v0 + v1 * v1; } }
                ss = xhalf_sum(ss);
                const float rn = rsqrtf(ss * (1.0f / 128.0f) + 1e-6f) * 0.8f;
#pragma unroll
                for (int dt = 0; dt < NDT; ++dt)
#pragma unroll
                    for (int g = 0; g < 4; ++g) { const int dv = 32 * dt + 8 * g + 4 * lh; const float4 gs = *(const float4*)(p.g_sub + dv);
                        uint2 w; w.x = cvt_pk_bf16(o[dt][4 * g] * rn * gs.x, o[dt][4 * g + 1] * rn * gs.y); w.y = cvt_pk_bf16(o[dt][4 * g + 2] * rn * gs.z, o[dt][4 * g + 3] * rn * gs.w);
                        *(uint2*)(yp + 32 * dt + 8 * g) = w; }
            }
        } else {
            const float i1 = 1.0f / lrow;
#pragma unroll
            for (int dt = 0; dt < NDT; ++dt)
#pragma unroll
                for (int g = 0; g < 4; ++g) {
                    uint2 w; w.x = cvt_pk_bf16(o[dt][4 * g] * i1, o[dt][4 * g + 1] * i1); w.y = cvt_pk_bf16(o[dt][4 * g + 2] * i1, o[dt][4 * g + 3] * i1);
                    *(uint2*)(yp + 32 * dt + 8 * g) = w; }
        }
        }
    }
}
#define IDX_M 23
__device__ __forceinline__ float med3f(float a, float b, float c) { return __builtin_amdgcn_fmed3f(a, b, c); }
__device__ void phase_indexer(const P& p, char* smem, int bid, int nblk, const Sched& sc_) {
    bf16_t* Kb = (bf16_t*)smem;
    unsigned* mimg = (unsigned*)(smem + 18432);
    const int tid = opaque_tid(), lane = tid & 63, wid = tid >> 6, l31 = lane & 31, lh = lane >> 5;
    constexpr int NUNITS = NBATCH * 256;
    const bool xaware = false;
    for (int rnd = 0; xaware ? (rnd < 2) : (rnd * nblk < NUNITS); ++rnd) {
        int qu, b;
        if (xaware) { b = sc_.x >> 1; const int k = rnd == 0 ? 127 - sc_.j : sc_.j; qu = 2 * k + (sc_.x & 1); }
        else { const int rank = rnd * nblk + ((rnd & 1) ? nblk - 1 - bid : bid); if (rank >= NUNITS) continue; qu = 255 - (rank >> 2); b = rank & 3; }
        const int q0 = qu * 32;
        const size_t tok0 = (size_t)b * S_LEN + q0;
        if (q0 < 256) {
#pragma unroll 1
            for (int i = 0; i < 32; ++i) { const int q = q0 + i; const int w0 = tid * 32;
                p.MASK[(tok0 + i) * 256 + tid] = q >= w0 + 31 ? 0xffffffffu : (q < w0 ? 0u : ((2u << (q - w0)) - 1u)); }
            continue;
        }
        const int nkt = (q0 + 95) >> 6;
        const int qb = q0 + 8 * wid;
        bf16x8 aq[2][4]; float wq[2][2][8]; int qv[2][2];
#pragma unroll
        for (int rt = 0; rt < 2; ++rt) {
            const int qa = qb + 4 * rt + 2 * ((l31 >> 2) & 1) + (l31 >> 4), ha = 4 * ((l31 >> 3) & 1) + (l31 & 3);
            const bf16_t* ap = p.IQ + ((size_t)b * S_LEN + qa) * 512 + ha * 64 + lh * 8;
#pragma unroll
            for (int ks = 0; ks < 4; ++ks) aq[rt][ks] = *(const bf16x8*)(ap + ks * 16);
#pragma unroll
            for (int e = 0; e < 2; ++e) { const float* wp = p.IW + ((size_t)b * S_LEN + qb + 4 * rt + 2 * lh + e) * 8;
                const float4 w0 = *(const float4*)wp, w1 = *(const float4*)(wp + 4); const float sc = 0.125f * 0.35355339059327373f;
                wq[rt][e][0] = w0.x * sc; wq[rt][e][1] = w0.y * sc; wq[rt][e][2] = w0.z * sc; wq[rt][e][3] = w0.w * sc;
                wq[rt][e][4] = w1.x * sc; wq[rt][e][5] = w1.y * sc; wq[rt][e][6] = w1.z * sc; wq[rt][e][7] = w1.w * sc;
                qv[rt][e] = qb + 4 * rt + 2 * lh + e; }
        }
        const bf16_t* ksrc = p.IK + ((size_t)b * S_LEN + (tid >> 3)) * 64 + (tid & 7) * 8;
        bf16_t* kdst = Kb + (tid >> 3) * 72 + (tid & 7) * 8;
        auto tile_scores = [&](const bf16_t* kbuf, int t, float (&sc)[2][2]) {
            f32x16 acc[2];
#pragma unroll
            for (int r = 0; r < 16; ++r) { acc[0][r] = 0.f; acc[1][r] = 0.f; }
#pragma unroll
            for (int ks = 0; ks < 4; ++ks) {
                const bf16x8 kf = *(const bf16x8*)(kbuf + (32 * t + l31) * 72 + ks * 16 + lh * 8);
                acc[0] = __builtin_amdgcn_mfma_f32_32x32x16_bf16(aq[0][ks], kf, acc[0], 0, 0, 0);
                acc[1] = __builtin_amdgcn_mfma_f32_32x32x16_bf16(aq[1][ks], kf, acc[1], 0, 0, 0);
            }
#pragma unroll
            for (int rt = 0; rt < 2; ++rt)
#pragma unroll
                for (int e = 0; e < 2; ++e) { float s = 0.f;
#pragma unroll
                    for (int hd = 0; hd < 8; ++hd) s = __builtin_fmaf(wq[rt][e][hd], __int_as_float(max(__float_as_int(acc[rt][8 * e + hd]), 0)), s);
                    sc[rt][e] = s; }
        };
        float T[2][2]; int need[2][2];
        {
            float L[2][2][IDX_M];
#pragma unroll
            for (int rt = 0; rt < 2; ++rt)
#pragma unroll
                for (int e = 0; e < 2; ++e)
#pragma unroll
                    for (int i = 0; i < IDX_M; ++i) L[rt][e][i] = -INFINITY;
            __syncthreads();
            uint4 r0 = *(const uint4*)(ksrc), r1 = *(const uint4*)(ksrc + 32 * 64);
            *(uint4*)(kdst) = r0; *(uint4*)(kdst + 32 * 72) = r1;
            __syncthreads();
            for (int kt = 0; kt < nkt; ++kt) {
                const bf16_t* kbuf = Kb + (kt & 1) * 64 * 72;
                if (kt + 1 < nkt) { r0 = *(const uint4*)(ksrc + (size_t)(kt + 1) * 64 * 64); r1 = *(const uint4*)(ksrc + (size_t)(kt + 1) * 64 * 64 + 32 * 64); }
                __builtin_amdgcn_sched_barrier(0);
                const bool interior = kt * 64 + 63 <= qb;
#pragma unroll 1
                for (int t = 0; t < 2; ++t) {
                    float sc[2][2]; tile_scores(kbuf, t, sc);
                    const int key = kt * 64 + 32 * t + l31;
#pragma unroll
                    for (int rt = 0; rt < 2; ++rt)
#pragma unroll
                        for (int e = 0; e < 2; ++e) {
                            const float v = (interior || key <= qv[rt][e]) ? sc[rt][e] : -INFINITY;
#pragma unroll
                            for (int i = IDX_M - 1; i >= 1; --i) L[rt][e][i] = med3f(L[rt][e][i - 1], L[rt][e][i], v);
                            asm("v_max_f32 %0, %1, %2" : "=v"(L[rt][e][0]) : "v"(L[rt][e][0]), "v"(v));
                        }
                }
                if (kt + 1 < nkt) { bf16_t* d = kdst + ((kt + 1) & 1) * 64 * 72; *(uint4*)(d) = r0; *(uint4*)(d + 32 * 72) = r1; }
                __syncthreads();
            }
#pragma unroll
            for (int rt = 0; rt < 2; ++rt)
#pragma unroll
                for (int e = 0; e < 2; ++e) {
                    unsigned U[IDX_M];
#pragma unroll
                    for (int i = 0; i < IDX_M; ++i) { const unsigned bts = __float_as_uint(L[rt][e][i]); U[i] = bts ^ ((unsigned)((int)bts >> 31) | 0x80000000u); }
                    unsigned pre = 0u;
#pragma unroll 1
                    for (int bit = 31; bit >= 0; --bit) {
                        const unsigned cand = pre | (1u << bit);
                        int c0 = 0, c1 = 0;
#pragma unroll
                        for (int i = 0; i < IDX_M; ++i) { const unsigned long long m = __builtin_amdgcn_ballot_w64(U[i] >= cand); c0 += __popc((unsigned)m); c1 += __popc((unsigned)(m >> 32)); }
                        if ((lh ? c1 : c0) >= 256) pre = cand;
                    }
                    int g0 = 0, g1 = 0;
#pragma unroll
                    for (int i = 0; i < IDX_M; ++i) { const unsigned long long m = __builtin_amdgcn_ballot_w64(U[i] > pre); g0 += __popc((unsigned)m); g1 += __popc((unsigned)(m >> 32)); }
                    need[rt][e] = 256 - (lh ? g1 : g0);
                    T[rt][e] = __uint_as_float((pre & 0x80000000u) ? (pre ^ 0x80000000u) : ~pre);
                }
        }
        {
            int tcnt[2][2];
#pragma unroll
            for (int rt = 0; rt < 2; ++rt)
#pragma unroll
                for (int e = 0; e < 2; ++e) tcnt[rt][e] = 0;
            __syncthreads();
            uint4 r0 = *(const uint4*)(ksrc), r1 = *(const uint4*)(ksrc + 32 * 64);
#pragma unroll 1
            for (int i = tid; i < 32 * 256 / 4; i += NTHR) ((uint4*)mimg)[i] = make_uint4(0u, 0u, 0u, 0u);
            *(uint4*)(kdst) = r0; *(uint4*)(kdst + 32 * 72) = r1;
            __syncthreads();
            for (int kt = 0; kt < nkt; ++kt) {
                const bf16_t* kbuf = Kb + (kt & 1) * 64 * 72;
                if (kt + 1 < nkt) { r0 = *(const uint4*)(ksrc + (size_t)(kt + 1) * 64 * 64); r1 = *(const uint4*)(ksrc + (size_t)(kt + 1) * 64 * 64 + 32 * 64); }
                __builtin_amdgcn_sched_barrier(0);
                const bool interior = kt * 64 + 63 <= qb;
#pragma unroll 1
                for (int t = 0; t < 2; ++t) {
                    float sc[2][2]; tile_scores(kbuf, t, sc);
                    const int key = kt * 64 + 32 * t + l31;
#pragma unroll
                    for (int rt = 0; rt < 2; ++rt)
#pragma unroll
                        for (int e = 0; e < 2; ++e) {
                            const float sv = (interior || key <= qv[rt][e]) ? sc[rt][e] : -INFINITY;
                            unsigned long long bal = __builtin_amdgcn_ballot_w64(sv > T[rt][e]);
                            const unsigned long long tb = __builtin_amdgcn_ballot_w64(sv == T[rt][e]);
                            if (tb != 0ull) {
                                const unsigned half = (unsigned)(tb >> (32 * lh));
                                const int rk = tcnt[rt][e] + __popc(half & ((1u << l31) - 1u));
                                bal |= __builtin_amdgcn_ballot_w64(sv == T[rt][e] && rk < need[rt][e]);
                                tcnt[rt][e] += __popc(half);
                            }
                            if (l31 == 0) mimg[(8 * wid + 4 * rt + 2 * lh + e) * 256 + kt * 2 + t] = (unsigned)(bal >> (32 * lh));
                        }
                }
                if (kt + 1 < nkt) { bf16_t* d = kdst + ((kt + 1) & 1) * 64 * 72; *(uint4*)(d) = r0; *(uint4*)(d + 32 * 72) = r1; }
                __syncthreads();
            }
        }
#pragma unroll 1
        for (int i = tid; i < 32 * 64; i += NTHR) { const int row = i >> 6, c4 = i & 63; *(uint4*)(p.MASK + (tok0 + row) * 256 + c4 * 4) = ((const uint4*)mimg)[row * 64 + c4]; }
    }
}
#ifndef PROBE_REP
#define PROBE_REP -1
#endif
#define RUNPH(idx, call) { _Pragma("unroll 1") for (int rep_ = 0; rep_ < ((PROBE_REP == idx) ? 2 : 1); ++rep_) { call; if (rep_ == 0 && PROBE_REP == idx) xcd_barrier(bar); } }

__global__ void __launch_bounds__(NTHR, 2) k_forward(P p) {
    __shared__ __attribute__((aligned(16))) char smem[SMEM_BYTES];
    volatile LAS unsigned* xbw = (volatile LAS unsigned*)(smem + SMEM_BYTES - 16);
    if (threadIdx.x == 0) { xbw[0] = 0u; xbw[1] = 0u; xbw[2] = 0u; xbw[3] = 0u; }
    __syncthreads();
    XcdBarrier bar = xcd_barrier_post(p.bar, xbw);
    const int bid = blockIdx.x, nblk = gridDim.x;
    volatile LAS int* sw = (volatile LAS int*)(smem + SMEM_BYTES - 32);
    if (threadIdx.x == 0) { const int hx = (int)(xb_xcc_id() & 7u); sw[0] = hx; sw[1] = atomicAdd(&p.XC[hx * 64], 1); }
    RUNPH(0, phase_prologue(p, smem, bid, nblk))
    xcd_barrier(bar);
    Sched sc;
    {
        bool even = (nblk & 7) == 0;
#pragma unroll
        for (int i = 0; i < 8; ++i) even = even && (__hip_atomic_load(&p.XC[i * 64], __ATOMIC_RELAXED, __HIP_MEMORY_SCOPE_AGENT) == (nblk >> 3));
        sc.x = even ? sw[0] : (bid & 7); sc.j = even ? sw[1] : (bid >> 3);
        sc.x = __builtin_amdgcn_readfirstlane(sc.x); sc.j = __builtin_amdgcn_readfirstlane(sc.j);
    }
    RUNPH(1, phase_inproj<0>(p, smem, bid, nblk, sc))
    xcd_barrier(bar);
    RUNPH(2, phase_indexer(p, smem, bid, nblk, sc))
    xcd_split_arrive(bar);
    RUNPH(3, phase_attn<0>(p, smem, bid, nblk, sc))
    RUNPH(4, phase_attn<2>(p, smem, bid, nblk, sc))
    xcd_split_wait(bar);
    RUNPH(5, phase_attn<1>(p, smem, bid, nblk, sc))
    xcd_barrier(bar);
    RUNPH(6, phase_merge<1>(p, smem, bid, nblk, sc))
    xcd_barrier(bar);
    RUNPH(7, phase_outproj(p, smem, bid, nblk, sc))
    xcd_barrier(bar);
#if PROBE_REP == 10
    phase_route<1>(p, smem, bid, nblk);
    xcd_barrier(bar);
#endif
    phase_route<0>(p, smem, bid, nblk);
    xcd_barrier(bar);
    RUNPH(8, phase_moe<0>(p, smem, bid, nblk, sc))
    xcd_barrier(bar);
    RUNPH(9, phase_moe<1>(p, smem, bid, nblk, sc))
    xcd_barrier(bar);
#if PROBE_REP == 11
    phase_final<1>(p, bid, nblk);
    xcd_barrier(bar);
#endif
    phase_final<0>(p, bid, nblk);
}

#define MBYTES(x) ((size_t)(x) << 20)
extern "C" void kernel_launch(void* const* d_in, const int* in_sizes, int n_in, void* d_out, int out_size, void* d_ws, size_t ws_size, hipStream_t stream) {
    P p{};
    p.x = (const float*)d_in[0]; p.pos = (const int*)d_in[1]; p.mem = (const float*)d_in[2];
    p.g_mix = (const float*)d_in[3]; p.w_in = (const float*)d_in[4]; p.b_gate = (const float*)d_in[5];
    p.lq1 = (const float*)d_in[6]; p.lk1 = (const float*)d_in[7]; p.lq2 = (const float*)d_in[8]; p.lk2 = (const float*)d_in[9];
    p.g_sub = (const float*)d_in[10]; p.g_mem = (const float*)d_in[11]; p.w_mkv = (const float*)d_in[12];
    p.w_br0 = (const float*)d_in[13]; p.w_br1 = (const float*)d_in[14]; p.w_br2 = (const float*)d_in[15];
    p.w_out = (const float*)d_in[16]; p.g_ffn = (const float*)d_in[17];
    p.w_rg = (const float*)d_in[18]; p.b_rg = (const float*)d_in[19]; p.w_re = (const float*)d_in[20]; p.b_re = (const float*)d_in[21];
    p.w_ei = (const float*)d_in[22]; p.w_eo = (const float*)d_in[23]; p.g_fin = (const float*)d_in[24];
    char* ws = (char*)d_ws; p.out = (float*)d_out;
    p.bar = (unsigned*)ws; p.CNT = (int*)(ws + 65536); p.XC = (int*)(ws + 131072);
    p.NBUF = (bf16_t*)(ws + MBYTES(1));
    p.DQ = (bf16_t*)(ws + MBYTES(65)); p.DK = (bf16_t*)(ws + MBYTES(97)); p.MERGED = (bf16_t*)(ws + MBYTES(65));
    p.SQ = (bf16_t*)(ws + MBYTES(129)); p.SK = (bf16_t*)(ws + MBYTES(161)); p.HID = (bf16_t*)(ws + MBYTES(129));
    p.DVT = (bf16_t*)(ws + MBYTES(193)); p.SVT = (bf16_t*)(ws + MBYTES(225)); p.IQ = (bf16_t*)(ws + MBYTES(257)); p.MQ = (bf16_t*)(ws + MBYTES(289));
    p.YMOE = (bf16_t*)(ws + MBYTES(193));
    p.IK = (bf16_t*)(ws + MBYTES(321)); p.IW = (float*)(ws + MBYTES(325)); p.MASK = (unsigned*)(ws + MBYTES(326));
    p.MK = (bf16_t*)(ws + MBYTES(358)); p.MVT = (bf16_t*)(ws + MBYTES(359)); p.MEMN = (bf16_t*)(ws + MBYTES(360));
    p.ROPEC = (float*)(ws + MBYTES(362)); p.ROPES = (float*)(ws + MBYTES(363));
    p.ROUTE = (Route*)(ws + MBYTES(365)); p.LIST = (int*)(ws + MBYTES(366));
    p.WIN = (bf16_t*)(ws + MBYTES(368)); p.WMKV = (bf16_t*)(ws + MBYTES(383));
    p.WBR = (bf16_t*)(ws + MBYTES(385)); p.WOUT = (bf16_t*)(ws + MBYTES(388)); p.WEI = (bf16_t*)(ws + MBYTES(390)); p.WEO = (bf16_t*)(ws + MBYTES(422));
    p.SGS = (unsigned*)(ws + MBYTES(440));
    p.HB = (bf16_t*)(ws + MBYTES(440));
    p.YD = (bf16_t*)d_out; p.YS = p.YD + (size_t)T_TOK * 512; p.YM = p.YS + (size_t)T_TOK * 512;
    static int grid = 0;
    if (!grid) {
        int dev = 0, cus = 0, per_cu = 0;
        (void)hipGetDevice(&dev);
        (void)hipDeviceGetAttribute(&cus, hipDeviceAttributeMultiprocessorCount, dev);
        (void)hipOccupancyMaxActiveBlocksPerMultiprocessor(&per_cu, k_forward, NTHR, 0);
        if (cus <= 0) cus = 256;
        if (per_cu < 1) per_cu = 1;
        grid = cus * (per_cu < 2 ? per_cu : 2);
    }
    (void)hipMemsetAsync(p.bar, 0, 262144, stream);
    k_forward<<<grid, NTHR, 0, stream>>>(p);
}
```

```cpp
#include <hip/hip_runtime.h>
#include <stdint.h>
#include <type_traits>

typedef unsigned short bf16_t;

#define S_LEN 8192
#define NBATCH 4
#define T_TOK 32768
#define DM 1024
#define DPROJ 7240
#define LIST_CAP 32768

__device__ __forceinline__ float bf2f(bf16_t v) { return __uint_as_float(((unsigned)v) << 16); }
__device__ __forceinline__ bf16_t f2bf(float f) { unsigned u = __float_as_uint(f); u += 0x7fffu + ((u >> 16) & 1u); return (bf16_t)(u >> 16); }

__device__ __forceinline__ float xhalf_max(float x) {
    const auto r = __builtin_amdgcn_permlane32_swap(__float_as_uint(x), __float_as_uint(x), false, false);
    float m; asm("v_max_f32 %0, %1, %2" : "=v"(m) : "v"(r[0]), "v"(r[1])); return m;
}
__device__ __forceinline__ float xhalf_sum(float x) {
    const auto r = __builtin_amdgcn_permlane32_swap(__float_as_uint(x), __float_as_uint(x), false, false);
    return __uint_as_float(r[0]) + __uint_as_float(r[1]);
}
template <int CTRL> __device__ __forceinline__ float dpp_movf(float v) { return __int_as_float(__builtin_amdgcn_update_dpp(0, __float_as_int(v), CTRL, 0xF, 0xF, true)); }
template <int CTRL> __device__ __forceinline__ int dpp_movi(int v) { return __builtin_amdgcn_update_dpp(0, v, CTRL, 0xF, 0xF, true); }
__device__ __forceinline__ float wave_sum(float v) {
    v += dpp_movf<0xB1>(v); v += dpp_movf<0x4E>(v); v += dpp_movf<0x141>(v); v += dpp_movf<0x140>(v);
    { const auto r = __builtin_amdgcn_permlane16_swap(__float_as_uint(v), __float_as_uint(v), false, false); v = __uint_as_float(r[0]) + __uint_as_float(r[1]); }
    { const auto r = __builtin_amdgcn_permlane32_swap(__float_as_uint(v), __float_as_uint(v), false, false); v = __uint_as_float(r[0]) + __uint_as_float(r[1]); }
    return v;
}
__device__ __forceinline__ float wave_max(float v) {
    v = fmaxf(v, dpp_movf<0xB1>(v)); v = fmaxf(v, dpp_movf<0x4E>(v)); v = fmaxf(v, dpp_movf<0x141>(v)); v = fmaxf(v, dpp_movf<0x140>(v));
    { const auto r = __builtin_amdgcn_permlane16_swap(__float_as_uint(v), __float_as_uint(v), false, false); v = fmaxf(__uint_as_float(r[0]), __uint_as_float(r[1])); }
    { const auto r = __builtin_amdgcn_permlane32_swap(__float_as_uint(v), __float_as_uint(v), false, false); v = fmaxf(__uint_as_float(r[0]), __uint_as_float(r[1])); }
    return v;
}
__device__ __forceinline__ int wave_sum_i(int v) {
    v += dpp_movi<0xB1>(v); v += dpp_movi<0x4E>(v); v += dpp_movi<0x141>(v); v += dpp_movi<0x140>(v);
    { const auto r = __builtin_amdgcn_permlane16_swap((unsigned)v, (unsigned)v, false, false); v = (int)(r[0] + r[1]); }
    { const auto r = __builtin_amdgcn_permlane32_swap((unsigned)v, (unsigned)v, false, false); v = (int)(r[0] + r[1]); }
    return v;
}
__device__ __forceinline__ float block_sum(float v, float* red) {
    v = wave_sum(v);
    __syncthreads();
    if ((threadIdx.x & 63) == 0) red[threadIdx.x >> 6] = v;
    __syncthreads();
    return red[0] + red[1] + red[2] + red[3];
}
__device__ __forceinline__ int block_sum_i(int v, int* red) {
    v = wave_sum_i(v);
    __syncthreads();
    if ((threadIdx.x & 63) == 0) red[threadIdx.x >> 6] = v;
    __syncthreads();
    return red[0] + red[1] + red[2] + red[3];
}

struct Route { int e0, e1; float c0, c1; };
#define XB_TMO      128
#define XB_XCNT(j)  (256  + 64 * (j))
#define XB_XSUB(j)  (1280 + 64 * (j))
#define XB_XGEN(j)  (2304 + 64 * (j))
#define XB_TOP      3328
#define XB_TOPGEN   3392
#define XCD_BAR_WORDS 3456
#define XB_SPIN_CAP (1u << 18)
#define LAS __attribute__((address_space(3)))

__device__ __forceinline__ unsigned xb_ld(unsigned* p)              { return __hip_atomic_load(p, __ATOMIC_RELAXED, __HIP_MEMORY_SCOPE_AGENT); }
__device__ __forceinline__ unsigned xb_add(unsigned* p, unsigned v) { return __hip_atomic_fetch_add(p, v, __ATOMIC_RELAXED, __HIP_MEMORY_SCOPE_AGENT); }
__device__ __forceinline__ unsigned xb_xcc_id() { return (unsigned)__builtin_amdgcn_s_getreg((3 << 11) | 20) & 0xFu; }
#define XB_SPIN(cond, bar) do { unsigned _sp = 0; while (cond) { __builtin_amdgcn_s_sleep(1); \
    if ((++_sp & 255u) == 0u) { if (xb_ld(&(bar)[XB_TMO])) break; if (_sp > XB_SPIN_CAP) { atomicAdd(&(bar)[XB_TMO], 1u); break; } } } } while (0)

struct XcdBarrier {
    unsigned* bar; unsigned x;
    volatile LAS unsigned* st;
};

__device__ __forceinline__ XcdBarrier xcd_barrier_post(unsigned* bar, volatile LAS unsigned* st) {
    XcdBarrier b; b.bar = bar; b.x = xb_xcc_id(); b.st = st;
    if (threadIdx.x == 0) (void)xb_add(&bar[XB_XCNT(b.x)], 1u);
    return b;
}
__device__ __forceinline__ void xcd_barrier_complete(unsigned* bar, unsigned x, unsigned& nloc, unsigned& nx) {
    const unsigned G = gridDim.x * gridDim.y * gridDim.z;
    unsigned sum, cnt, mine, sp = 0u;
    for (;;) {
        sum = 0u; cnt = 0u; mine = 0u;
#pragma unroll
        for (unsigned j = 0; j < 16; ++j) { const unsigned c = xb_ld(&bar[XB_XCNT(j)]); sum += c; cnt += (c > 0u) ? 1u : 0u; mine = (j == x) ? c : mine; }
        if (sum == G) break;
        __builtin_amdgcn_s_sleep(1);
        if ((++sp & 255u) == 0u) { if (xb_ld(&bar[XB_TMO])) break; if (sp > XB_SPIN_CAP) { atomicAdd(&bar[XB_TMO], 1u); break; } }
    }
    nloc = mine > 0u ? mine : 1u; nx = cnt > 0u ? cnt : 1u;
}

__device__ __forceinline__ void xcd_barrier(const XcdBarrier& b) {
    asm volatile("s_waitcnt vmcnt(0)" ::: "memory");
    __syncthreads();
    if (threadIdx.x == 0) {
        unsigned* bar = b.bar;
        __builtin_amdgcn_s_waitcnt(0);
        unsigned nloc = b.st[0], nx = b.st[1];
        if (nloc == 0u) { xcd_barrier_complete(bar, b.x, nloc, nx); b.st[0] = nloc; b.st[1] = nx; }
        const unsigned old = xb_add(&bar[XB_XSUB(b.x)], 1u);
        const unsigned gen = old / nloc;
        if (old + 1u == (gen + 1u) * nloc) {
            __builtin_amdgcn_fence(__ATOMIC_RELEASE, "agent");
            asm volatile("s_waitcnt vmcnt(0)" ::: "memory");
            const unsigned og = xb_add(&bar[XB_TOP], 1u);
            const unsigned tg = og / nx;
            if (og + 1u == (tg + 1u) * nx) xb_add(&bar[XB_TOPGEN], 1u);
            else XB_SPIN(xb_ld(&bar[XB_TOPGEN]) == tg, bar);
            __builtin_amdgcn_fence(__ATOMIC_ACQUIRE, "agent");
            xb_add(&bar[XB_XGEN(b.x)], 1u);
            asm volatile("s_waitcnt vmcnt(0)" ::: "memory");
        } else {
            XB_SPIN(xb_ld(&bar[XB_XGEN(b.x)]) == gen, bar);
            __builtin_amdgcn_fence(__ATOMIC_ACQUIRE, "agent");
            asm volatile("s_waitcnt vmcnt(0)" ::: "memory");
        }
    }
    __syncthreads();
}


#define XB_SPLIT 4096
__device__ __forceinline__ void xcd_split_arrive(const XcdBarrier& b) {
    asm volatile("s_waitcnt vmcnt(0)" ::: "memory");
    __syncthreads();
    if (threadIdx.x == 0) {
        __builtin_amdgcn_s_waitcnt(0);
        __builtin_amdgcn_fence(__ATOMIC_RELEASE, "agent");
        asm volatile("s_waitcnt vmcnt(0)" ::: "memory");
        (void)xb_add(&b.bar[XB_SPLIT], 1u);
    }
}
__device__ __forceinline__ void xcd_split_wait(const XcdBarrier& b) {
    __syncthreads();
    if (threadIdx.x == 0) {
        const unsigned G = gridDim.x * gridDim.y * gridDim.z;
        XB_SPIN(xb_ld(&b.bar[XB_SPLIT]) < G, b.bar);
        __builtin_amdgcn_fence(__ATOMIC_ACQUIRE, "agent");
        asm volatile("s_waitcnt vmcnt(0)" ::: "memory");
    }
    __syncthreads();
}
typedef __attribute__((ext_vector_type(8))) __bf16 bf16x8;
typedef __attribute__((ext_vector_type(16))) float f32x16;
typedef __attribute__((ext_vector_type(4))) float f32x4;
#define NTHR 256
#define LDSK 72
#define SMEM_BYTES 81920

struct P {
    const float* x; const int* pos; const float* mem; const float* g_mix; const float* w_in; const float* b_gate;
    const float* lq1; const float* lk1; const float* lq2; const float* lk2; const float* g_sub; const float* g_mem; const float* w_mkv;
    const float* w_br0; const float* w_br1; const float* w_br2; const float* w_out; const float* g_ffn;
    const float* w_rg; const float* b_rg; const float* w_re; const float* b_re; const float* w_ei; const float* w_eo; const float* g_fin;
    float* out;
    unsigned* bar; int* CNT;
    bf16_t* NBUF; bf16_t* DQ; bf16_t* DK; bf16_t* DVT; bf16_t* SQ; bf16_t* SK; bf16_t* SVT; bf16_t* IQ; bf16_t* MQ; bf16_t* IK; float* IW; unsigned* MASK;
    bf16_t* MK; bf16_t* MVT; bf16_t* MEMN; float* ROPEC; float* ROPES;
    bf16_t* WIN; bf16_t* WBR; bf16_t* WOUT; bf16_t* WMKV; bf16_t* WEI; bf16_t* WEO;
    bf16_t* YD; bf16_t* YS; bf16_t* YM; bf16_t* MERGED; bf16_t* HID; bf16_t* YMOE; Route* ROUTE; int* LIST; unsigned* SGS; int* XC; bf16_t* HB;
};

__device__ __forceinline__ int opaque_tid() { int t = threadIdx.x; asm volatile("" : "+v"(t)); return t; }
typedef __bf16 bf16x2v_t __attribute__((ext_vector_type(2)));
typedef float f32x2c_t __attribute__((ext_vector_type(2)));
__device__ __forceinline__ unsigned cvt_pk_bf16_ord(float lo, float hi) { unsigned r; asm volatile("s_nop 0\n\tv_cvt_pk_bf16_f32 %0, %1, %2" : "=v"(r) : "v"(lo), "v"(hi)); return r; }
__device__ __forceinline__ unsigned cvt_pk_bf16(float lo, float hi) { const f32x2c_t v = {lo, hi}; const bf16x2v_t r = __builtin_convertvector(v, bf16x2v_t); return __builtin_bit_cast(unsigned, r); }

template <int MAP> __device__ __forceinline__ int colmap(int n) {
    if (MAP == 1) return n < 3584 ? n : n < 4096 ? n + 72 : n < 4168 ? n - 512 : n < 4224 ? -1 : n - 56;
    if (MAP == 2) { const int c = n >> 6, j = n & 63; return j < 32 ? 32 * c + j : 512 + 32 * c + (j - 32); }
    return n;
}
template <int MAP, int NTL> __device__ __forceinline__ void tconv_tile(const float* __restrict__ src, int ld, int K, bf16_t* __restrict__ dst, int tile, float* tl) {
    const int n0 = (tile % NTL) * 64, k0 = (tile / NTL) * 64;
    const int t = opaque_tid(); const int nn = (t & 15) * 4; const int c = colmap<MAP>(n0 + nn);
#pragma unroll
    for (int i = 0; i < 4; ++i) { const int kk = (t >> 4) + 16 * i;
        const float4 v = c >= 0 ? *(const float4*)(src + (size_t)(k0 + kk) * ld + c) : make_float4(0.f, 0.f, 0.f, 0.f);
        tl[kk * 65 + nn] = v.x; tl[kk * 65 + nn + 1] = v.y; tl[kk * 65 + nn + 2] = v.z; tl[kk * 65 + nn + 3] = v.w; }
    __syncthreads();
#pragma unroll
    for (int i = 0; i < 2; ++i) { const int cc = t + 256 * i; const int n2 = cc >> 3, kc = (cc & 7) * 8;
        uint4 o; o.x = cvt_pk_bf16(tl[(kc + 0) * 65 + n2], tl[(kc + 1) * 65 + n2]); o.y = cvt_pk_bf16(tl[(kc + 2) * 65 + n2], tl[(kc + 3) * 65 + n2]);
        o.z = cvt_pk_bf16(tl[(kc + 4) * 65 + n2], tl[(kc + 5) * 65 + n2]); o.w = cvt_pk_bf16(tl[(kc + 6) * 65 + n2], tl[(kc + 7) * 65 + n2]);
        *(uint4*)(dst + (size_t)(n0 + n2) * K + k0 + kc) = o; }
    __syncthreads();
}
#define TC_WIN 1824
#define TC_WBR (TC_WIN + 384)
#define TC_WOUT (TC_WBR + 256)
#define TC_WMKV (TC_WOUT + 256)
#define TC_WEI (TC_WMKV + 4096)
#define TC_WEO (TC_WEI + 2048)
__device__ void phase_prologue(const P& p, char* smem, int bid, int nblk) {
    float* tl = (float*)smem;
    const int tidp = opaque_tid();
    for (int g = bid; g < TC_WEO; g += nblk) {
        if (g < TC_WIN) tconv_tile<1, 114>(p.w_in, DPROJ, 1024, p.WIN, g, tl);
        else if (g < TC_WBR) { const int j = (g - TC_WIN) >> 7; const float* s = j == 0 ? p.w_br0 : j == 1 ? p.w_br1 : p.w_br2; tconv_tile<0, 16>(s, 1024, 512, p.WBR + (size_t)j * 1024 * 512, (g - TC_WIN) & 127, tl); }
        else if (g < TC_WOUT) tconv_tile<0, 16>(p.w_out, 1024, 1024, p.WOUT, g - TC_WBR, tl);
        else if (g < TC_WMKV) tconv_tile<0, 16>(p.w_mkv, 1024, 1024, p.WMKV, g - TC_WOUT, tl);
        else if (g < TC_WEI) { const int e = (g - TC_WMKV) >> 8; tconv_tile<2, 16>(p.w_ei + (size_t)e * 1024 * 1024, 1024, 1024, p.WEI + (size_t)e * 1024 * 1024, (g - TC_WMKV) & 255, tl); }
        else { const int e = (g - TC_WEI) >> 7; tconv_tile<0, 16>(p.w_eo + (size_t)e * 512 * 1024, 1024, 512, p.WEO + (size_t)e * 1024 * 512, (g - TC_WEI) & 127, tl); }
    }
    const int lane = tidp & 63; const int gw = bid * 4 + (tidp >> 6), nw = nblk * 4;
    for (int row = gw; row < T_TOK + 1024; row += nw) {
        const float* src; const float* g; bf16_t* dst;
        if (row < T_TOK) { src = p.x + (size_t)row * DM; g = p.g_mix; dst = p.NBUF + (size_t)row * DM; }
        else { src = p.mem + (size_t)(row - T_TOK) * DM; g = p.g_mem; dst = p.MEMN + (size_t)(row - T_TOK) * DM; }
        float4 v[4]; float ss = 0.f;
#pragma unroll
        for (int i = 0; i < 4; ++i) { v[i] = *(const float4*)(src + i * 256 + lane * 4); ss += v[i].x * v[i].x + v[i].y * v[i].y + v[i].z * v[i].z + v[i].w * v[i].w; }
        ss = wave_sum(ss);
        const float r = rsqrtf(ss * (1.0f / DM) + 1e-6f);
#pragma unroll
        for (int i = 0; i < 4; ++i) { const float4 gg = *(const float4*)(g + i * 256 + lane * 4);
            uint2 o; o.x = cvt_pk_bf16(v[i].x * r * gg.x, v[i].y * r * gg.y); o.y = cvt_pk_bf16(v[i].z * r * gg.z, v[i].w * r * gg.w);
            *(uint2*)(dst + i * 256 + lane * 4) = o; }
    }
    for (int i = bid * NTHR + tidp; i < T_TOK * 8; i += nblk * NTHR) {
        const float inv = powf(500000.0f, -(float)(i & 7) / 8.0f);
        const float ang = (float)p.pos[i >> 3] * inv;
        float sn, cs; sincosf(ang, &sn, &cs);
        p.ROPEC[i] = cs; p.ROPES[i] = sn;
    }
    if (bid == 0 && tidp < 16) p.CNT[tidp * 64] = 0;
}


struct Sched { int x, j; };
struct XOrder {
    int x, j, J, nblk, bid;
    __device__ __forceinline__ XOrder(int bid_, int nblk_, const Sched& s) : x(s.x), j(s.j), J(nblk_ >> 3), nblk(nblk_), bid(bid_) {}
    __device__ __forceinline__ bool round(int r, int N, int& u) const {
        if ((nblk & 7) != 0) { u = r * nblk + bid; if (r * nblk >= N) return false; if (u >= N) u = -1; return true; }
        const int c = r * 8 + x; if (r * 8 * J >= N) return false; u = c * J + j; if (u >= N) u = -1; return true;
    }
};
__device__ __forceinline__ void tile_mn(int u, int NT, int& mt, int& nt) { const int g = u / (8 * NT), rem = u - g * 8 * NT; nt = rem >> 3; mt = g * 8 + (rem & 7); }

__device__ __forceinline__ int gl_row(int tid, int q) { return (tid >> 6) * 32 + q * 8 + ((tid & 63) >> 3); }
__device__ __forceinline__ unsigned gl_col(int tid, int row) { return (unsigned)(((tid & 7) ^ ((row >> 1) & 7)) * 8); }
__device__ __forceinline__ void gemm_mainloop(const bf16_t* __restrict__ Rb, unsigned or0, unsigned or1, unsigned or2, unsigned or3,
                                              const bf16_t* __restrict__ Lb, unsigned ol0, unsigned ol1, unsigned ol2, unsigned ol3, int K, f32x16 (&acc)[2][2], bf16_t* As, bf16_t* Bs) {
    const int tid = opaque_tid(), lane = tid & 63, wid = tid >> 6, wr = wid >> 1, wc = wid & 1;
    const int nk = K >> 6;
    LAS unsigned* ldsA = (LAS unsigned*)(As + wid * 32 * 64);
    LAS unsigned* ldsB = (LAS unsigned*)(Bs + wid * 32 * 64);
    const int sw = (lane >> 1) & 7;
    const bf16_t* ard = As + (wr * 64 + (lane & 31)) * 64;
    const bf16_t* brd = Bs + (wc * 64 + (lane & 31)) * 64;
    const int lh = lane >> 5;
#define GLDS_TILE(stage_, ko_) { \
    __builtin_amdgcn_global_load_lds((const unsigned*)(Rb + or0 + (ko_)), (LAS unsigned*)((LAS char*)ldsA + (stage_) * 32768), 16, 0, 0); \
    __builtin_amdgcn_global_load_lds((const unsigned*)(Rb + or1 + (ko_)), (LAS unsigned*)((LAS char*)ldsA + (stage_) * 32768 + 1024), 16, 0, 0); \
    __builtin_amdgcn_global_load_lds((const unsigned*)(Rb + or2 + (ko_)), (LAS unsigned*)((LAS char*)ldsA + (stage_) * 32768 + 2048), 16, 0, 0); \
    __builtin_amdgcn_global_load_lds((const unsigned*)(Rb + or3 + (ko_)), (LAS unsigned*)((LAS char*)ldsA + (stage_) * 32768 + 3072), 16, 0, 0); \
    __builtin_amdgcn_global_load_lds((const unsigned*)(Lb + ol0 + (ko_)), (LAS unsigned*)((LAS char*)ldsB + (stage_) * 32768), 16, 0, 0); \
    __builtin_amdgcn_global_load_lds((const unsigned*)(Lb + ol1 + (ko_)), (LAS unsigned*)((LAS char*)ldsB + (stage_) * 32768 + 1024), 16, 0, 0); \
    __builtin_amdgcn_global_load_lds((const unsigned*)(Lb + ol2 + (ko_)), (LAS unsigned*)((LAS char*)ldsB + (stage_) * 32768 + 2048), 16, 0, 0); \
    __builtin_amdgcn_global_load_lds((const unsigned*)(Lb + ol3 + (ko_)), (LAS unsigned*)((LAS char*)ldsB + (stage_) * 32768 + 3072), 16, 0, 0); }
    __syncthreads();
    GLDS_TILE(0, 0u)
    __syncthreads();
    for (int kt = 0; kt < nk; ++kt) {
        const int cur = (kt & 1) * 16384;
        if (kt + 1 < nk) { if (kt & 1) GLDS_TILE(0, (unsigned)(kt + 1) * 64u) else GLDS_TILE(1, (unsigned)(kt + 1) * 64u) }
#pragma unroll
        for (int ks = 0; ks < 4; ++ks) {
            const int cc = ((2 * ks + lh) ^ sw) * 8;
            const bf16x8 fa0 = *(const bf16x8*)(ard + cur + cc), fa1 = *(const bf16x8*)(ard + cur + 32 * 64 + cc);
            const bf16x8 fb0 = *(const bf16x8*)(brd + cur + cc), fb1 = *(const bf16x8*)(brd + cur + 32 * 64 + cc);
            acc[0][0] = __builtin_amdgcn_mfma_f32_32x32x16_bf16(fa0, fb0, acc[0][0], 0, 0, 0);
            acc[0][1] = __builtin_amdgcn_mfma_f32_32x32x16_bf16(fa0, fb1, acc[0][1], 0, 0, 0);
            acc[1][0] = __builtin_amdgcn_mfma_f32_32x32x16_bf16(fa1, fb0, acc[1][0], 0, 0, 0);
            acc[1][1] = __builtin_amdgcn_mfma_f32_32x32x16_bf16(fa1, fb1, acc[1][1], 0, 0, 0);
        }
        __syncthreads();
    }
#undef GLDS_TILE
}
#define ZERO_ACC(acc) { _Pragma("unroll") for (int i_ = 0; i_ < 2; ++i_) _Pragma("unroll") for (int j_ = 0; j_ < 2; ++j_) _Pragma("unroll") for (int r_ = 0; r_ < 16; ++r_) acc[i_][j_][r_] = 0.f; }
#define CSTR 136
__device__ __forceinline__ void cimg_write(const f32x16 (&acc)[2][2], bf16_t* Cs, int wr, int wc, int l31, int lh) {
#pragma unroll
    for (int i = 0; i < 2; ++i)
#pragma unroll
        for (int j = 0; j < 2; ++j)
#pragma unroll
            for (int g = 0; g < 4; ++g) { uint2 o; o.x = cvt_pk_bf16(acc[i][j][4 * g], acc[i][j][4 * g + 1]); o.y = cvt_pk_bf16(acc[i][j][4 * g + 2], acc[i][j][4 * g + 3]);
                *(uint2*)(Cs + (64 * wc + 32 * j + l31) * CSTR + 64 * wr + 32 * i + 8 * g + 4 * lh) = o; }
}

template <int NOEPI> __device__ void phase_inproj(const P& p, char* smem, int bid, int nblk, const Sched& sc) {
    bf16_t* As = (bf16_t*)smem; bf16_t* Bs = As + 128 * 64; bf16_t* Cs = (bf16_t*)smem;
    const int tid = opaque_tid(), lane = tid & 63, wid = tid >> 6, wr = wid >> 1, wc = wid & 1;
    const int l31 = lane & 31, lh = lane >> 5;
    const int NT = 33, NMAIN = 256 * NT;
    const XOrder xo(bid, nblk, sc);
    const bool xaware = false;
    for (int rr = 0; ; ++rr) {
        bool main_t; int mt, nt;
        if (xaware) {
            if (rr < 16) { main_t = true; mt = ((sc.x >> 2) * 16 + rr) * 8 + (sc.j & 7); nt = (sc.x & 3) * 8 + (sc.j >> 3); }
            else if (rr == 16) { if (bid >= 320) break; main_t = bid < 256; mt = main_t ? bid : (bid - 256) >> 3; nt = main_t ? 32 : (bid - 256) & 7; }
            else break;
        } else {
            int t; if (!xo.round(rr, NMAIN + 64, t)) break; if (t < 0) continue;
            main_t = t < NMAIN;
            if (main_t) tile_mn(t, NT, mt, nt); else { mt = (t - NMAIN) >> 3; nt = (t - NMAIN) & 7; }
        }
        const bf16_t* X = main_t ? p.NBUF : p.MEMN; const bf16_t* W = main_t ? p.WIN : p.WMKV;
        const int grp = main_t ? (nt >> 2) : (nt < 4 ? 7 : 2);
        const bool transposed = grp == 2 || grp == 5;
        const int g0 = gl_row(tid, 0); const unsigned to = (unsigned)g0 * 1024u + gl_col(tid, g0);
        const unsigned t1 = (unsigned)(g0 + 8) * 1024u + gl_col(tid, g0 + 8), t2 = (unsigned)(g0 + 16) * 1024u + gl_col(tid, g0 + 16), t3 = (unsigned)(g0 + 24) * 1024u + gl_col(tid, g0 + 24);
        const bf16_t* Xt = X + (size_t)mt * 128 * 1024; const bf16_t* Wt = W + (size_t)nt * 128 * 1024;
        f32x16 acc[2][2]; ZERO_ACC(acc);
        gemm_mainloop(transposed ? Xt : Wt, to, t1, t2, t3, transposed ? Wt : Xt, to, t1, t2, t3, 1024, acc, As, Bs);
        if (NOEPI) { float s_ = 0.f; for (int i_ = 0; i_ < 2; ++i_) for (int j_ = 0; j_ < 2; ++j_) for (int r_ = 0; r_ < 16; ++r_) s_ += acc[i_][j_][r_]; if (s_ == 1.2345e30f) p.IW[0] = s_; continue; }
        const int tok0 = mt * 128;
        if (main_t && !transposed && grp != 7) {
            if (grp != 8 || wr == 0) {
#pragma unroll
                for (int j = 0; j < 2; ++j) { const int tok = tok0 + 64 * wc + 32 * j + l31;
                    const float4 c4 = *(const float4*)(p.ROPEC + (size_t)tok * 8 + 4 * lh), s4 = *(const float4*)(p.ROPES + (size_t)tok * 8 + 4 * lh);
                    const float cc[4] = {c4.x, c4.y, c4.z, c4.w}, ss[4] = {s4.x, s4.y, s4.z, s4.w};
#pragma unroll
                    for (int r = 0; r < 4; ++r) { const float x1 = acc[0][j][r], x2 = acc[0][j][r + 4]; acc[0][j][r] = x1 * cc[r] - x2 * ss[r]; acc[0][j][r + 4] = x2 * cc[r] + x1 * ss[r]; } }
            }
        }
        if (grp == 8 && wr == 1) {
#pragma unroll
            for (int j = 0; j < 2; ++j) { const int tok = tok0 + 64 * wc + 32 * j + l31; *(float4*)(p.IW + (size_t)tok * 8 + 4 * lh) = make_float4(acc[0][j][0], acc[0][j][1], acc[0][j][2], acc[0][j][3]); }
        }
        __syncthreads();
        cimg_write(acc, Cs, wr, wc, l31, lh);
        __syncthreads();
        bf16_t* dbase; size_t dstride; int nch = 16;
        if (!main_t) {
            if (nt < 4) { dbase = p.MK + (size_t)tok0 * 512 + nt * 128; dstride = 512; }
            else { dbase = p.MVT + ((size_t)((mt >> 1) * 4 + (nt - 4)) * 128) * 256 + (mt & 1) * 128; dstride = 256; }
        } else if (grp == 2) { dbase = p.DVT + ((size_t)((mt >> 6) * 4 + (nt - 8)) * 128) * S_LEN + (mt & 63) * 128; dstride = S_LEN; }
        else if (grp == 5) { dbase = p.SVT + ((size_t)((mt >> 6) * 8 + (nt - 20) * 2) * 64) * S_LEN + (mt & 63) * 128; dstride = S_LEN; }
        else if (grp == 8) { dbase = p.IK + (size_t)tok0 * 64; dstride = 64; nch = 8; }
        else { bf16_t* d = grp == 0 ? p.DQ : grp == 1 ? p.DK : grp == 3 ? p.SQ : grp == 4 ? p.SK : grp == 6 ? p.IQ : p.MQ; dbase = d + (size_t)tok0 * 512 + (nt & 3) * 128; dstride = 512; }
        int te_ = tid; asm volatile("" : "+v"(te_));
#pragma unroll
        for (int k = 0; k < 8; ++k) { const int c = te_ + 256 * k; const int lrow = c >> 4, ch = c & 15;
            if (ch < nch) { const uint4 v = *(const uint4*)(Cs + lrow * CSTR + ch * 8); *(uint4*)(dbase + (size_t)lrow * dstride + ch * 8) = v; } }
    }
}
template <int REPS = 1> __device__ void phase_merge(const P& p, char* smem, int bid, int nblk, const Sched& sc) {
    bf16_t* As = (bf16_t*)smem; bf16_t* Bs = As + 128 * 64; bf16_t* Cs = (bf16_t*)smem;
    const int tid = opaque_tid(), lane = tid & 63, wid = tid >> 6, wr = wid >> 1, wc = wid & 1;
    const int l31 = lane & 31, lh = lane >> 5;
    const XOrder xo(bid, nblk, sc);
    const bool xaware = false;
#pragma unroll 1
    for (int rep = 0; rep < REPS; ++rep)
    for (int rr = 0; ; ++rr) {
        int mt, nt;
        if (xaware) { if (rr >= 4) break; nt = sc.x; mt = rr * 64 + sc.j; }
        else { int t; if (!xo.round(rr, 256 * 8, t)) break; if (t < 0) continue; tile_mn(t, 8, mt, nt); }
        f32x16 mg[2][2]; ZERO_ACC(mg);
#pragma unroll 1
        for (int br = 0; br < 3; ++br) {
            int tl_ = tid; asm volatile("" : "+v"(tl_));
            unsigned sgr[8][4];
            {
                const int g0 = gl_row(tl_, 0);
                const unsigned to = (unsigned)g0 * 1024u + gl_col(tl_, g0), t1 = (unsigned)(g0 + 8) * 1024u + gl_col(tl_, g0 + 8), t2 = (unsigned)(g0 + 16) * 1024u + gl_col(tl_, g0 + 16), t3 = (unsigned)(g0 + 24) * 1024u + gl_col(tl_, g0 + 24);
                f32x16 acc[2][2]; ZERO_ACC(acc);
                gemm_mainloop(p.WIN + (size_t)(4224 + br * 1024 + nt * 128) * 1024, to, t1, t2, t3, p.NBUF + (size_t)mt * 128 * 1024, to, t1, t2, t3, 1024, acc, As, Bs);
#pragma unroll
                for (int i = 0; i < 2; ++i)
#pragma unroll
                    for (int g = 0; g < 4; ++g) { const float4 b4 = *(const float4*)(p.b_gate + br * 1024 + nt * 128 + 64 * wr + 32 * i + 8 * g + 4 * lh);
                        const float bb[4] = {b4.x, b4.y, b4.z, b4.w};
#pragma unroll
                        for (int j = 0; j < 2; ++j) { float s[4];
#pragma unroll
                            for (int r = 0; r < 4; ++r) s[r] = __builtin_amdgcn_rcpf(1.0f + __expf(-(acc[i][j][4 * g + r] + bb[r])));
                            acc[i][j][4 * g] = __uint_as_float(cvt_pk_bf16_ord(s[0], s[1])); acc[i][j][4 * g + 1] = __uint_as_float(cvt_pk_bf16_ord(s[2], s[3])); } }
#pragma unroll
                for (int i = 0; i < 2; ++i)
#pragma unroll
                    for (int j = 0; j < 2; ++j)
#pragma unroll
                        for (int h2 = 0; h2 < 2; ++h2) {
                            sgr[(i * 2 + j) * 2 + h2][0] = __float_as_uint(acc[i][j][8 * h2]); sgr[(i * 2 + j) * 2 + h2][1] = __float_as_uint(acc[i][j][8 * h2 + 1]);
                            sgr[(i * 2 + j) * 2 + h2][2] = __float_as_uint(acc[i][j][8 * h2 + 4]); sgr[(i * 2 + j) * 2 + h2][3] = __float_as_uint(acc[i][j][8 * h2 + 5]); }
                asm volatile("" ::: "memory");
            }
            {
                const bf16_t* Y = br == 0 ? p.YD : br == 1 ? p.YS : p.YM;
                int tl2_ = tid; asm volatile("" : "+v"(tl2_));
                const int g0 = gl_row(tl2_, 0);
                const unsigned to = (unsigned)g0 * 512u + gl_col(tl2_, g0), t1 = (unsigned)(g0 + 8) * 512u + gl_col(tl2_, g0 + 8), t2 = (unsigned)(g0 + 16) * 512u + gl_col(tl2_, g0 + 16), t3 = (unsigned)(g0 + 24) * 512u + gl_col(tl2_, g0 + 24);
                f32x16 acc[2][2]; ZERO_ACC(acc);
                gemm_mainloop(p.WBR + (size_t)br * 1024 * 512 + (size_t)nt * 128 * 512, to, t1, t2, t3, Y + (size_t)mt * 128 * 512, to, t1, t2, t3, 512, acc, As, Bs);
                asm volatile("" ::: "memory");
#pragma unroll
                for (int i = 0; i < 2; ++i)
#pragma unroll
                    for (int j = 0; j < 2; ++j)
#pragma unroll
                        for (int h2 = 0; h2 < 2; ++h2) { const unsigned ww[4] = {sgr[(i * 2 + j) * 2 + h2][0], sgr[(i * 2 + j) * 2 + h2][1], sgr[(i * 2 + j) * 2 + h2][2], sgr[(i * 2 + j) * 2 + h2][3]};
#pragma unroll
                            for (int q = 0; q < 2; ++q) {
                                const int g = 2 * h2 + q;
                                mg[i][j][4 * g] += __uint_as_float(ww[2 * q] << 16) * acc[i][j][4 * g];
                                mg[i][j][4 * g + 1] += __uint_as_float(ww[2 * q] & 0xffff0000u) * acc[i][j][4 * g + 1];
                                mg[i][j][4 * g + 2] += __uint_as_float(ww[2 * q + 1] << 16) * acc[i][j][4 * g + 2];
                                mg[i][j][4 * g + 3] += __uint_as_float(ww[2 * q + 1] & 0xffff0000u) * acc[i][j][4 * g + 3]; } }
            }
        }
        __syncthreads();
        cimg_write(mg, Cs, wr, wc, l31, lh);
        __syncthreads();
        bf16_t* dbase = p.MERGED + (size_t)mt * 128 * 1024 + nt * 128;
        int te_ = tid; asm volatile("" : "+v"(te_));
#pragma unroll
        for (int k = 0; k < 8; ++k) { const int c = te_ + 256 * k; const int lrow = c >> 4, ch = c & 15;
            const uint4 v = *(const uint4*)(Cs + lrow * CSTR + ch * 8); *(uint4*)(dbase + (size_t)lrow * 1024 + ch * 8) = v; }
    }
}

#define CFS 132
__device__ void phase_outproj(const P& p, char* smem, int bid, int nblk, const Sched& sc) {
    bf16_t* As = (bf16_t*)smem; bf16_t* Bs = As + 128 * 64;
    const int tid = opaque_tid(), lane = tid & 63, wid = tid >> 6, wr = wid >> 1, wc = wid & 1;
    const int l31 = lane & 31, lh = lane >> 5;
    const XOrder xo(bid, nblk, sc);
    for (int rr = 0; ; ++rr) {
        int t; if (!xo.round(rr, 256 * 8, t)) break; if (t < 0) continue;
        int mt, nt; tile_mn(t, 8, mt, nt);
        const int g0 = gl_row(tid, 0);
        const unsigned to = (unsigned)g0 * 1024u + gl_col(tid, g0), t1 = (unsigned)(g0 + 8) * 1024u + gl_col(tid, g0 + 8), t2 = (unsigned)(g0 + 16) * 1024u + gl_col(tid, g0 + 16), t3 = (unsigned)(g0 + 24) * 1024u + gl_col(tid, g0 + 24);
        f32x16 acc[2][2]; ZERO_ACC(acc);
        gemm_mainloop(p.WOUT + (size_t)nt * 128 * 1024, to, t1, t2, t3, p.MERGED + (size_t)mt * 128 * 1024, to, t1, t2, t3, 1024, acc, As, Bs);
        float* Cf = (float*)smem;
#pragma unroll
        for (int i = 0; i < 2; ++i)
#pragma unroll
            for (int j = 0; j < 2; ++j)
#pragma unroll
                for (int g = 0; g < 4; ++g)
                    *(float4*)(Cf + (64 * wc + 32 * j + l31) * CFS + 64 * wr + 32 * i + 8 * g + 4 * lh) = make_float4(acc[i][j][4 * g], acc[i][j][4 * g + 1], acc[i][j][4 * g + 2], acc[i][j][4 * g + 3]);
        __syncthreads();
        int to_ = tid; asm volatile("" : "+v"(to_));
#pragma unroll
        for (int k = 0; k < 8; ++k) { const int c = to_ + 256 * k; const int lrow = c >> 4, ch = c & 15;
            const float4 a0 = *(const float4*)(Cf + lrow * CFS + ch * 8), a1 = *(const float4*)(Cf + lrow * CFS + ch * 8 + 4);
            const size_t go = (size_t)(mt * 128 + lrow) * 1024 + nt * 128 + ch * 8;
            const float4 x0 = *(const float4*)(p.x + go), x1 = *(const float4*)(p.x + go + 4);
            uint4 o; o.x = cvt_pk_bf16(x0.x + a0.x, x0.y + a0.y); o.y = cvt_pk_bf16(x0.z + a0.z, x0.w + a0.w); o.z = cvt_pk_bf16(x1.x + a1.x, x1.y + a1.y); o.w = cvt_pk_bf16(x1.z + a1.z, x1.w + a1.w);
            *(uint4*)(p.HB + go) = o; }
    }
}

template <int VAR = 0> __device__ void phase_route(const P& p, char* smem, int bid, int nblk) {
    float4* wrg = (float4*)smem;
    const int tidp = opaque_tid();
    for (int i = tidp; i < 1024; i += NTHR) wrg[i] = *(const float4*)(p.w_rg + i * 4);
    constexpr int RCH = 64;
    int* lcnt = (int*)(smem + 16384); int* lbase = lcnt + 16; int* ent_e = lcnt + 32; int* ent_s = ent_e + 4 * RCH * 2; int* ent_v = ent_s + 4 * RCH * 2;
    const int lane = tidp & 63; const int wv = tidp >> 6; const int gw = bid * 4 + wv, nw = nblk * 4;
    const int tb = bid * 4;
    const int kmax = tb < T_TOK ? (T_TOK - tb + nw - 1) / nw : 0;
    for (int k0 = 0; k0 < kmax; k0 += RCH) {
    __syncthreads();
    if (tidp < 16) lcnt[tidp] = 0;
    __syncthreads();
    for (int kk = 0; kk < RCH && k0 + kk < kmax; ++kk) {
        const int tok = tb + wv + (k0 + kk) * nw;
        if (tok >= T_TOK) break;
        const bf16_t* src = p.HB + (size_t)tok * DM;
        float tv[16]; float ss = 0.f;
#pragma unroll
        for (int i = 0; i < 4; ++i) { const uint2 u = *(const uint2*)(src + i * 256 + lane * 4);
            float4 v; v.x = __uint_as_float(u.x << 16); v.y = __uint_as_float(u.x & 0xffff0000u); v.z = __uint_as_float(u.y << 16); v.w = __uint_as_float(u.y & 0xffff0000u);
            tv[4 * i] = v.x; tv[4 * i + 1] = v.y; tv[4 * i + 2] = v.z; tv[4 * i + 3] = v.w; ss += v.x * v.x + v.y * v.y + v.z * v.z + v.w * v.w; }
        ss = wave_sum(ss);
        const float r = rsqrtf(ss * (1.0f / DM) + 1e-6f);
        float g0 = 0.f, g1 = 0.f, g2 = 0.f, g3 = 0.f;
#pragma unroll
        for (int i = 0; i < 4; ++i) { const float4 gg = *(const float4*)(p.g_ffn + i * 256 + lane * 4);
            tv[4 * i] *= r * gg.x; tv[4 * i + 1] *= r * gg.y; tv[4 * i + 2] *= r * gg.z; tv[4 * i + 3] *= r * gg.w;
            uint2 o; o.x = cvt_pk_bf16(tv[4 * i], tv[4 * i + 1]); o.y = cvt_pk_bf16(tv[4 * i + 2], tv[4 * i + 3]);
            *(uint2*)((VAR ? (bf16_t*)p.SGS + (size_t)8 * 1024 * 1024 + (size_t)(tok & 16383) * DM : p.NBUF + (size_t)tok * DM) + i * 256 + lane * 4) = o;
#pragma unroll
            for (int j = 0; j < 4; ++j) { const float4 w = wrg[i * 256 + lane * 4 + j]; const float x = tv[4 * i + j]; g0 += x * w.x; g1 += x * w.y; g2 += x * w.z; g3 += x * w.w; } }
        g0 = wave_sum(g0) + p.b_rg[0]; g1 = wave_sum(g1) + p.b_rg[1]; g2 = wave_sum(g2) + p.b_rg[2]; g3 = wave_sum(g3) + p.b_rg[3];
        int grp = 0; float gm = g0;
        if (g1 > gm) { gm = g1; grp = 1; } if (g2 > gm) { gm = g2; grp = 2; } if (g3 > gm) { gm = g3; grp = 3; }
        const float pg = 1.0f / (expf(g0 - gm) + expf(g1 - gm) + expf(g2 - gm) + expf(g3 - gm));
        float e0 = 0.f, e1 = 0.f, e2 = 0.f, e3 = 0.f;
#pragma unroll
        for (int i = 0; i < 4; ++i)
#pragma unroll
            for (int j = 0; j < 4; ++j) { const float4 w = *(const float4*)(p.w_re + (size_t)(i * 256 + lane * 4 + j) * 16 + grp * 4); const float x = tv[4 * i + j]; e0 += x * w.x; e1 += x * w.y; e2 += x * w.z; e3 += x * w.w; }
        float el[4];
        el[0] = wave_sum(e0) + p.b_re[grp * 4]; el[1] = wave_sum(e1) + p.b_re[grp * 4 + 1]; el[2] = wave_sum(e2) + p.b_re[grp * 4 + 2]; el[3] = wave_sum(e3) + p.b_re[grp * 4 + 3];
        if (lane < 2 && VAR == 0) {
            int i0 = 0; float m0 = el[0];
            if (el[1] > m0) { m0 = el[1]; i0 = 1; } if (el[2] > m0) { m0 = el[2]; i0 = 2; } if (el[3] > m0) { m0 = el[3]; i0 = 3; }
            int i1 = -1; float m1 = -INFINITY;
            if (i0 != 0 && el[0] > m1) { m1 = el[0]; i1 = 0; } if (i0 != 1 && el[1] > m1) { m1 = el[1]; i1 = 1; }
            if (i0 != 2 && el[2] > m1) { m1 = el[2]; i1 = 2; } if (i0 != 3 && el[3] > m1) { m1 = el[3]; i1 = 3; }
            const float p1 = expf(m1 - m0);
            Route rt; rt.e0 = grp * 4 + i0; rt.e1 = grp * 4 + i1; rt.c0 = pg / (1.0f + p1); rt.c1 = pg * p1 / (1.0f + p1);
            if (lane == 0) p.ROUTE[tok] = rt;
            const int e = lane == 0 ? rt.e0 : rt.e1; const int idx = (wv * RCH + kk) * 2 + lane;
            ent_e[idx] = e; ent_s[idx] = atomicAdd(&lcnt[e], 1); ent_v[idx] = tok * 2 + lane;
        }
    }
    if (VAR == 0) {
        __syncthreads();
        if (tidp < 16) lbase[tidp] = lcnt[tidp] > 0 ? atomicAdd(&p.CNT[tidp * 64], lcnt[tidp]) : 0;
        __syncthreads();
#pragma unroll 1
        for (int i = tidp; i < 4 * RCH * 2; i += NTHR) { const int w_ = i / (RCH * 2), k_ = (i % (RCH * 2)) >> 1;
            if (k0 + k_ < kmax && tb + w_ + (k0 + k_) * nw < T_TOK) { const int e = ent_e[i]; p.LIST[e * LIST_CAP + lbase[e] + ent_s[i]] = ent_v[i]; } }
    }
    }
}

template <int DOWN> __device__ void phase_moe(const P& p, char* smem, int bid, int nblk, const Sched& sc) {
    bf16_t* As = (bf16_t*)smem; bf16_t* Bs = As + 128 * 64; bf16_t* Cs = (bf16_t*)smem;
    int* ents = (int*)(smem + 73728); float* cws = (float*)(ents + 128);
    const int tid = opaque_tid(), lane = tid & 63, wid = tid >> 6, wr = wid >> 1, wc = wid & 1;
    const int l31 = lane & 31, lh = lane >> 5;
    int cnt[16]; int total = 0;
#pragma unroll
    for (int e = 0; e < 16; ++e) { cnt[e] = p.CNT[e * 64]; total += ((cnt[e] + 127) >> 7) * 8; }
    const XOrder xo(bid, nblk, sc);
    for (int rr = 0; ; ++rr) {
        int u; if (!xo.round(rr, total, u)) break; if (u < 0) continue;
        int e = 0, base = 0, ce = 0;
#pragma unroll
        for (int k = 0; k < 16; ++k) { const int n = ((cnt[k] + 127) >> 7) * 8; if (u >= base + n && k == e) { base += n; e = k + 1; } if (k == e) ce = cnt[k]; }
        const int loc = u - base; const int mt = loc >> 3, nt = loc & 7;
        const int nrows = min(128, ce - mt * 128);
        __syncthreads();
        if (tid < 128) { const int ent = p.LIST[e * LIST_CAP + mt * 128 + (tid < nrows ? tid : 0)]; ents[tid] = ent;
            if (DOWN) { const Route rt = p.ROUTE[ent >> 1]; cws[tid] = (ent & 1) ? rt.c1 : rt.c0; } }
        __syncthreads();
        const int KK = DOWN ? 512 : 1024;
        const bf16_t* Xb = DOWN ? p.HID : p.NBUF;
        int tu_ = tid; asm volatile("" : "+v"(tu_));
        const int g0 = gl_row(tu_, 0);
        const unsigned ol0 = (unsigned)(DOWN ? ents[g0] : ents[g0] >> 1) * (unsigned)KK + gl_col(tu_, g0), ol1 = (unsigned)(DOWN ? ents[g0 + 8] : ents[g0 + 8] >> 1) * (unsigned)KK + gl_col(tu_, g0 + 8);
        const unsigned ol2 = (unsigned)(DOWN ? ents[g0 + 16] : ents[g0 + 16] >> 1) * (unsigned)KK + gl_col(tu_, g0 + 16), ol3 = (unsigned)(DOWN ? ents[g0 + 24] : ents[g0 + 24] >> 1) * (unsigned)KK + gl_col(tu_, g0 + 24);
        const bf16_t* Wb = (DOWN ? p.WEO + (size_t)e * 1024 * 512 : p.WEI + (size_t)e * 1024 * 1024) + (size_t)nt * 128 * KK;
        const unsigned w0 = (unsigned)g0 * (unsigned)KK + gl_col(tu_, g0), w1 = (unsigned)(g0 + 8) * (unsigned)KK + gl_col(tu_, g0 + 8), w2 = (unsigned)(g0 + 16) * (unsigned)KK + gl_col(tu_, g0 + 16), w3 = (unsigned)(g0 + 24) * (unsigned)KK + gl_col(tu_, g0 + 24);
        f32x16 acc[2][2]; ZERO_ACC(acc);
        gemm_mainloop(Wb, w0, w1, w2, w3, Xb, ol0, ol1, ol2, ol3, KK, acc, As, Bs);
        if (DOWN) {
#pragma unroll
            for (int j = 0; j < 2; ++j) { const float c = cws[64 * wc + 32 * j + l31];
#pragma unroll
                for (int i = 0; i < 2; ++i)
#pragma unroll
                    for (int r = 0; r < 16; ++r) acc[i][j][r] *= c; }
        } else {
#pragma unroll
            for (int j = 0; j < 2; ++j)
#pragma unroll
                for (int r = 0; r < 16; ++r) { const float g = acc[0][j][r]; acc[0][j][r] = g * __builtin_amdgcn_rcpf(1.0f + __expf(-g)) * acc[1][j][r]; }
        }
        __syncthreads();
        if (DOWN) cimg_write(acc, Cs, wr, wc, l31, lh);
        else {
#pragma unroll
            for (int j = 0; j < 2; ++j)
#pragma unroll
                for (int g = 0; g < 4; ++g) { uint2 o; o.x = cvt_pk_bf16(acc[0][j][4 * g], acc[0][j][4 * g + 1]); o.y = cvt_pk_bf16(acc[0][j][4 * g + 2], acc[0][j][4 * g + 3]);
                    *(uint2*)(Cs + (64 * wc + 32 * j + l31) * CSTR + 32 * wr + 8 * g + 4 * lh) = o; }
        }
        __syncthreads();
        int te_ = tid; asm volatile("" : "+v"(te_));
        if (DOWN) {
#pragma unroll
            for (int k = 0; k < 8; ++k) { const int c = te_ + 256 * k; const int lrow = c >> 4, ch = c & 15;
                if (lrow < nrows) { const uint4 v = *(const uint4*)(Cs + lrow * CSTR + ch * 8); *(uint4*)(p.YMOE + (size_t)ents[lrow] * 1024 + nt * 128 + ch * 8) = v; } }
        } else {
#pragma unroll
            for (int k = 0; k < 4; ++k) { const int c = te_ + 256 * k; const int lrow = c >> 3, ch = c & 7;
                if (lrow < nrows) { const uint4 v = *(const uint4*)(Cs + lrow * CSTR + ch * 8); *(uint4*)(p.HID + (size_t)ents[lrow] * 512 + nt * 64 + ch * 8) = v; } }
        }
    }
}

template <int VAR = 0> __device__ void phase_final(const P& p, int bid, int nblk) {
    const int tidp = opaque_tid();
    const int lane = tidp & 63; const int gw = bid * 4 + (tidp >> 6), nw = nblk * 4;
    for (int tok = gw; tok < T_TOK; tok += nw) {
        float* hp = p.out + (size_t)tok * DM; const bf16_t* hb = p.HB + (size_t)tok * DM; const bf16_t* y0 = p.YMOE + (size_t)tok * 2 * DM; const bf16_t* y1 = y0 + DM;
        float4 v[4]; float ss = 0.f;
#pragma unroll
        for (int i = 0; i < 4; ++i) { const uint2 hu = *(const uint2*)(hb + i * 256 + lane * 4);
            v[i].x = __uint_as_float(hu.x << 16); v[i].y = __uint_as_float(hu.x & 0xffff0000u); v[i].z = __uint_as_float(hu.y << 16); v[i].w = __uint_as_float(hu.y & 0xffff0000u);
            const uint2 a = *(const uint2*)(y0 + i * 256 + lane * 4), b = *(const uint2*)(y1 + i * 256 + lane * 4);
            v[i].x += __uint_as_float(a.x << 16) + __uint_as_float(b.x << 16); v[i].y += __uint_as_float(a.x & 0xffff0000u) + __uint_as_float(b.x & 0xffff0000u);
            v[i].z += __uint_as_float(a.y << 16) + __uint_as_float(b.y << 16); v[i].w += __uint_as_float(a.y & 0xffff0000u) + __uint_as_float(b.y & 0xffff0000u);
            ss += v[i].x * v[i].x + v[i].y * v[i].y + v[i].z * v[i].z + v[i].w * v[i].w; }
        ss = wave_sum(ss);
        const float r = rsqrtf(ss * (1.0f / DM) + 1e-6f);
#pragma unroll
        for (int i = 0; i < 4; ++i) { const float4 gg = *(const float4*)(p.g_fin + i * 256 + lane * 4);
            float4 o; o.x = v[i].x * r * gg.x; o.y = v[i].y * r * gg.y; o.z = v[i].z * r * gg.z; o.w = v[i].w * r * gg.w;
            *(float4*)((VAR ? (float*)p.SGS + (size_t)4 * 1024 * 1024 + (size_t)(tok & 8191) * DM : hp) + i * 256 + lane * 4) = o; }
    }
}
__device__ __forceinline__ float fast_exp2(float x) { return __builtin_amdgcn_exp2f(x); }
typedef float f32x2v __attribute__((ext_vector_type(2)));
template <int KIND, int VAR = 0> __device__ void phase_attn(const P& p, char* smem, int bid, int nblk, const Sched& sc) {
    constexpr int NM = 1, NMAPS = KIND == 0 ? 2 : 1, DQK = KIND == 2 ? 128 : 64, DV = KIND == 1 ? 64 : 128;
    constexpr int KROW = DQK, QROW = NMAPS * DQK, KSTR = KROW + 8, VSTR = 72, NDT = DV / 32, NKS = DQK / 16;
    constexpr int KCH = 64 * KROW / 8 / NTHR, VCH = DV * 8 / NTHR;
    constexpr int NH = KIND == 1 ? 8 : 4;
    constexpr int NUNITS = NBATCH * NH * 64;
    constexpr bool DB = KIND != 2;
    bf16_t* Ks = (bf16_t*)smem; bf16_t* Vs = Ks + (DB ? 2 : 1) * 64 * KSTR;
    const int tid = opaque_tid(), lane = tid & 63, wid = tid >> 6, l31 = lane & 31, lh = lane >> 5;
    const float c = (KIND == 2 ? 0.08838834764831845f : 0.125f) * 1.4426950408889634f;
    float lam = 0.f;
    if (KIND == 0) { float d1 = 0.f, d2 = 0.f; for (int i = 0; i < 64; ++i) { d1 += p.lq1[i] * p.lk1[i]; d2 += p.lq2[i] * p.lk2[i]; } lam = expf(d1) - expf(d2) + 0.2f; }
    const bf16_t* Qb = KIND == 0 ? p.DQ : KIND == 1 ? p.SQ : p.MQ;
    const bf16_t* Kb = KIND == 0 ? p.DK : KIND == 1 ? p.SK : p.MK;
    const bf16_t* Vb = KIND == 0 ? p.DVT : KIND == 1 ? p.SVT : p.MVT;
    bf16_t* Yb = VAR != 0 ? (bf16_t*)p.SGS + (size_t)16 * 1024 * 1024 : KIND == 0 ? p.YD : KIND == 1 ? p.YS : p.YM;
    constexpr int VLEN = KIND == 2 ? 256 : S_LEN;
    const bool xaware = false;
    for (int rnd = 0; xaware ? (rnd < NBATCH * NH / 8) : (rnd * nblk < NUNITS); ++rnd) {
        int qt, bh;
        if (xaware) { bh = sc.x * (NBATCH * NH / 8) + rnd; qt = (rnd & 1) ? sc.j : 63 - sc.j; }
        else { const int rank = rnd * nblk + ((rnd & 1) ? nblk - 1 - bid : bid); if (rank >= NUNITS) continue;
               qt = KIND == 2 ? rank % 64 : 63 - rank / (NBATCH * NH); bh = KIND == 2 ? rank / 64 : rank % (NBATCH * NH); }
        const int b = bh / NH, h = bh % NH;
        const int q0 = qt * 128, qw = q0 + 32 * wid;
        const int nkt = KIND == 2 ? 4 : 2 * (qt + 1);
        unsigned o1pk[NDT][8];
#pragma unroll 1
        for (int map = 0; map < NMAPS; ++map) {
        bf16x8 qf[NM][NKS];
        const bf16_t* qp = Qb + ((size_t)(b * S_LEN + qw + l31)) * 512 + h * QROW + map * DQK + lh * 8;
        if (KIND != 2) {
#pragma unroll
            for (int m = 0; m < NM; ++m)
#pragma unroll
                for (int ks = 0; ks < NKS; ++ks) qf[m][ks] = *(const bf16x8*)(qp + m * DQK + ks * 16);
        }
        f32x16 o[NM][NDT];
#pragma unroll
        for (int m = 0; m < NM; ++m)
#pragma unroll
            for (int dt = 0; dt < NDT; ++dt)
#pragma unroll
                for (int r = 0; r < 16; ++r) o[m][dt][r] = 0.f;
        float mrow[NM], lrow[NM];
#pragma unroll
        for (int m = 0; m < NM; ++m) { mrow[m] = -INFINITY; lrow[m] = 0.f; }
        int tid_l = tid; asm volatile("" : "+v"(tid_l));
        const bf16_t* ksrc = Kb + ((size_t)(KIND == 2 ? b * 256 : b * S_LEN) + (tid_l >> (KROW == 128 ? 4 : 3))) * 512 + h * QROW + map * DQK + (tid_l & (KROW / 8 - 1)) * 8;
        constexpr int KROWS_PER_PASS = NTHR / (KROW / 8);
        const int krow_ = tid_l >> (KROW == 128 ? 4 : 3);
        bf16_t* kdst = Ks + ((krow_ & ~12) | ((krow_ & 4) << 1) | ((krow_ & 8) >> 1)) * KSTR + (tid_l & (KROW / 8 - 1)) * 8;
        const bf16_t* vsrc = Vb + ((size_t)(bh * DV + (tid_l >> 3))) * VLEN + (tid_l & 7) * 8;
        bf16_t* vdst = Vs + (tid_l >> 3) * VSTR + (tid_l & 7) * 8;
        uint4 rk0, rk1, rk2 = make_uint4(0,0,0,0), rk3 = make_uint4(0,0,0,0), rv0, rv1, rv2 = make_uint4(0,0,0,0), rv3 = make_uint4(0,0,0,0);
        { const bf16_t* s_ = ksrc + (size_t)(0) * 512; rk0 = *(const uint4*)(s_); rk1 = *(const uint4*)(s_ + (size_t)KROWS_PER_PASS * 512); if (KCH > 2) { rk2 = *(const uint4*)(s_ + (size_t)2 * KROWS_PER_PASS * 512); rk3 = *(const uint4*)(s_ + (size_t)3 * KROWS_PER_PASS * 512); } }
        { const bf16_t* s_ = vsrc + ((size_t)0); rv0 = *(const uint4*)(s_); rv1 = *(const uint4*)(s_ + (size_t)32 * VLEN); if (VCH > 2) { rv2 = *(const uint4*)(s_ + (size_t)64 * VLEN); rv3 = *(const uint4*)(s_ + (size_t)96 * VLEN); } }
        __syncthreads();
        { *(uint4*)(kdst) = rk0; *(uint4*)(kdst + KROWS_PER_PASS * KSTR) = rk1; if (KCH > 2) { *(uint4*)(kdst + 2 * KROWS_PER_PASS * KSTR) = rk2; *(uint4*)(kdst + 3 * KROWS_PER_PASS * KSTR) = rk3; } }
        { *(uint4*)(vdst) = rv0; *(uint4*)(vdst + 32 * VSTR) = rv1; if (VCH > 2) { *(uint4*)(vdst + 64 * VSTR) = rv2; *(uint4*)(vdst + 96 * VSTR) = rv3; } }
        __syncthreads();
        if (!DB && nkt > 1) { const bf16_t* s_ = ksrc + (size_t)(64) * 512; rk0 = *(const uint4*)(s_); rk1 = *(const uint4*)(s_ + (size_t)KROWS_PER_PASS * 512); if (KCH > 2) { rk2 = *(const uint4*)(s_ + (size_t)2 * KROWS_PER_PASS * 512); rk3 = *(const uint4*)(s_ + (size_t)3 * KROWS_PER_PASS * 512); } }
        uint2 mwn = make_uint2(0u, 0u);
        if (KIND == 1) mwn = *(const uint2*)(p.MASK + ((size_t)(b * S_LEN + qw + l31)) * 256);
        for (int kt = 0; kt < nkt; ++kt) {
            const bool active = KIND == 2 ? true : (kt * 64 <= qw + 31);
            const bf16_t* Kc = Ks + (DB ? (kt & 1) * 64 * KSTR : 0); const bf16_t* Vc = Vs + (DB ? (kt & 1) * DV * VSTR : 0);
            if (DB && kt + 1 < nkt && VAR != 6 && VAR != 7) {
                { const bf16_t* s_ = ksrc + (size_t)((kt + 1) * 64) * 512; rk0 = *(const uint4*)(s_); rk1 = *(const uint4*)(s_ + (size_t)KROWS_PER_PASS * 512); if (KCH > 2) { rk2 = *(const uint4*)(s_ + (size_t)2 * KROWS_PER_PASS * 512); rk3 = *(const uint4*)(s_ + (size_t)3 * KROWS_PER_PASS * 512); } }
                { const bf16_t* s_ = vsrc + ((size_t)(kt + 1) * 64); rv0 = *(const uint4*)(s_); rv1 = *(const uint4*)(s_ + (size_t)32 * VLEN); if (VCH > 2) { rv2 = *(const uint4*)(s_ + (size_t)64 * VLEN); rv3 = *(const uint4*)(s_ + (size_t)96 * VLEN); } }
            }
            __builtin_amdgcn_sched_barrier(0);
            unsigned pk[NM][2][2][4];
            if (active) {
                uint2 mw = mwn;
                if (KIND == 1) { mw.x >>= 8 * lh; mw.y >>= 8 * lh; if (kt + 1 < nkt) mwn = *(const uint2*)(p.MASK + ((size_t)(b * S_LEN + qw + l31)) * 256 + (kt + 1) * 2); }
#pragma unroll
                for (int m = 0; m < NM; ++m) {
                    f32x16 s[2];
#pragma unroll
                    for (int r = 0; r < 16; ++r) { s[0][r] = 0.f; s[1][r] = 0.f; }
#pragma unroll
                    for (int ks = 0; ks < NKS; ks += 2) {
                        const bf16x8 a00 = *(const bf16x8*)(Kc + l31 * KSTR + m * DQK + ks * 16 + lh * 8);
                        const bf16x8 a10 = *(const bf16x8*)(Kc + (32 + l31) * KSTR + m * DQK + ks * 16 + lh * 8);
                        const bf16x8 a01 = *(const bf16x8*)(Kc + l31 * KSTR + m * DQK + (ks + 1) * 16 + lh * 8);
                        const bf16x8 a11 = *(const bf16x8*)(Kc + (32 + l31) * KSTR + m * DQK + (ks + 1) * 16 + lh * 8);
                        const bf16x8 q0_ = KIND == 2 ? *(const bf16x8*)(qp + ks * 16) : qf[m][ks];
                        const bf16x8 q1_ = KIND == 2 ? *(const bf16x8*)(qp + (ks + 1) * 16) : qf[m][ks + 1];
                        __builtin_amdgcn_sched_barrier(0);
                        if (VAR != 5) {
                        s[0] = __builtin_amdgcn_mfma_f32_32x32x16_bf16(a00, q0_, s[0], 0, 0, 0);
                        s[1] = __builtin_amdgcn_mfma_f32_32x32x16_bf16(a10, q0_, s[1], 0, 0, 0);
                        s[0] = __builtin_amdgcn_mfma_f32_32x32x16_bf16(a01, q1_, s[0], 0, 0, 0);
                        s[1] = __builtin_amdgcn_mfma_f32_32x32x16_bf16(a11, q1_, s[1], 0, 0, 0);
                        } else { asm volatile("" :: "v"(a00), "v"(a10), "v"(a01), "v"(a11)); }
                    }
                    if (KIND == 0 && kt * 64 + 63 > qw) {
                        const int qi = qw + l31 - kt * 64 - 8 * lh;
#pragma unroll
                        for (int t = 0; t < 2; ++t)
#pragma unroll
                            for (int r = 0; r < 16; ++r) if (32 * t + (r & 7) + 16 * (r >> 3) > qi) s[t][r] = -INFINITY;
                    }
                    float mx = s[0][0];
#pragma unroll
                    for (int r = 1; r < 16; ++r) mx = fmaxf(mx, s[0][r]);
#pragma unroll
                    for (int r = 0; r < 16; ++r) mx = fmaxf(mx, s[1][r]);
                    mx = xhalf_max(mx);
                    const float mnew = fmaxf(mrow[m], mx * c);
                    const float corr = fast_exp2(mrow[m] - mnew);
                    mrow[m] = mnew;
                    f32x2v ps2 = {0.f, 0.f}; const f32x2v c2 = {c, c}, nm2 = {-mnew, -mnew};
#pragma unroll
                    for (int t = 0; t < 2; ++t)
#pragma unroll
                        for (int r = 0; r < 16; r += 2) {
                            const f32x2v sv = {s[t][r], s[t][r + 1]};
                            const f32x2v y = VAR == 3 ? sv : sv * c2 + nm2;
                            f32x2v pv = {(VAR == 1 || VAR == 3) ? y.x : fast_exp2(y.x), (VAR == 1 || VAR == 3) ? y.y : fast_exp2(y.y)};
                            if (KIND == 1) { int m0 = __builtin_amdgcn_sbfe((int)(t ? mw.y : mw.x), (r & 7) + 16 * (r >> 3), 1), m1 = __builtin_amdgcn_sbfe((int)(t ? mw.y : mw.x), ((r + 1) & 7) + 16 * ((r + 1) >> 3), 1);
                                             asm("" : "+v"(m0), "+v"(m1));
                                             pv.x = __uint_as_float(__float_as_uint(pv.x) & (unsigned)m0); pv.y = __uint_as_float(__float_as_uint(pv.y) & (unsigned)m1); }
                            ps2 += pv; s[t][r] = pv.x; s[t][r + 1] = pv.y;
                        }
                    const float psum = ps2.x + ps2.y;
                    lrow[m] = lrow[m] * corr + psum;
#pragma unroll
                    for (int t = 0; t < 2; ++t)
#pragma unroll
                        for (int s2 = 0; s2 < 2; ++s2)
#pragma unroll
                            for (int j = 0; j < 4; ++j) pk[m][t][s2][j] = cvt_pk_bf16(s[t][8 * s2 + 2 * j], s[t][8 * s2 + 2 * j + 1]);
                    if (__any(corr != 1.0f)) {
#pragma unroll
                        for (int dt = 0; dt < NDT; ++dt)
#pragma unroll
                            for (int r = 0; r < 16; ++r) o[m][dt][r] *= corr;
                    }
                }
            }
            if (!DB) {
            __syncthreads();
            if (kt + 1 < nkt) {
                { *(uint4*)(kdst) = rk0; *(uint4*)(kdst + KROWS_PER_PASS * KSTR) = rk1; if (KCH > 2) { *(uint4*)(kdst + 2 * KROWS_PER_PASS * KSTR) = rk2; *(uint4*)(kdst + 3 * KROWS_PER_PASS * KSTR) = rk3; } }
                { const bf16_t* s_ = vsrc + ((size_t)(kt + 1) * 64); rv0 = *(const uint4*)(s_); rv1 = *(const uint4*)(s_ + (size_t)32 * VLEN); if (VCH > 2) { rv2 = *(const uint4*)(s_ + (size_t)64 * VLEN); rv3 = *(const uint4*)(s_ + (size_t)96 * VLEN); } }
            }
            }
            if (active) {
                constexpr int GS = NDT == 4 ? 1 : 2;
#pragma unroll
                for (int ks2 = 0; ks2 < 4; ks2 += GS) {
                    bf16x8 va[GS][NDT];
#pragma unroll
                    for (int g = 0; g < GS; ++g)
#pragma unroll
                        for (int dt = 0; dt < NDT; ++dt) {
                            va[g][dt] = *(const bf16x8*)(Vc + (32 * dt + l31) * VSTR + 16 * (ks2 + g) + 8 * lh);
                        }
                    __builtin_amdgcn_sched_barrier(0);
#pragma unroll
                    for (int g = 0; g < GS; ++g)
#pragma unroll
                        for (int dt = 0; dt < NDT; ++dt)
#pragma unroll
                            for (int m = 0; m < NM; ++m) {
                                const int k2 = ks2 + g;
                                const uint4 pu = make_uint4(pk[m][k2 >> 1][k2 & 1][0], pk[m][k2 >> 1][k2 & 1][1], pk[m][k2 >> 1][k2 & 1][2], pk[m][k2 >> 1][k2 & 1][3]);
                                if (VAR != 2) o[m][dt] = __builtin_amdgcn_mfma_f32_32x32x16_bf16(va[g][dt], *(const bf16x8*)&pu, o[m][dt], 0, 0, 0); else { o[m][dt][0] += __uint_as_float(pu.x); asm volatile("" :: "v"(va[g][dt])); }
                            }
                }
            }
            if (DB) {
                if (kt + 1 < nkt && VAR != 6 && VAR != 7) {
                    bf16_t* kd = kdst + ((kt + 1) & 1) * 64 * KSTR; bf16_t* vd = vdst + ((kt + 1) & 1) * DV * VSTR;
                    { *(uint4*)(kd) = rk0; *(uint4*)(kd + KROWS_PER_PASS * KSTR) = rk1; if (KCH > 2) { *(uint4*)(kd + 2 * KROWS_PER_PASS * KSTR) = rk2; *(uint4*)(kd + 3 * KROWS_PER_PASS * KSTR) = rk3; } }
                    { *(uint4*)(vd) = rv0; *(uint4*)(vd + 32 * VSTR) = rv1; if (VCH > 2) { *(uint4*)(vd + 64 * VSTR) = rv2; *(uint4*)(vd + 96 * VSTR) = rv3; } }
                }
                if (VAR != 7) __syncthreads();
            } else {
            __syncthreads();
            if (kt + 1 < nkt) {
                { *(uint4*)(vdst) = rv0; *(uint4*)(vdst + 32 * VSTR) = rv1; if (VCH > 2) { *(uint4*)(vdst + 64 * VSTR) = rv2; *(uint4*)(vdst + 96 * VSTR) = rv3; } }
                if (kt + 2 < nkt) { const bf16_t* s_ = ksrc + (size_t)((kt + 2) * 64) * 512; rk0 = *(const uint4*)(s_); rk1 = *(const uint4*)(s_ + (size_t)KROWS_PER_PASS * 512); if (KCH > 2) { rk2 = *(const uint4*)(s_ + (size_t)2 * KROWS_PER_PASS * 512); rk3 = *(const uint4*)(s_ + (size_t)3 * KROWS_PER_PASS * 512); } }
            }
            }
        }
#pragma unroll
        for (int m = 0; m < NM; ++m) lrow[m] = xhalf_sum(lrow[m]);
        bf16_t* yp = Yb + ((size_t)(b * S_LEN + qw + l31)) * 512 + h * DV + 4 * lh;
        if (KIND == 0) {
            if (map == 0) {
                const float i1 = 1.0f / lrow[0];
#pragma unroll
                for (int dt = 0; dt < NDT; ++dt)
#pragma unroll
                    for (int j = 0; j < 8; ++j) o1pk[dt][j] = cvt_pk_bf16(o[0][dt][2 * j] * i1, o[0][dt][2 * j + 1] * i1);
            } else {
            const float i2 = lam / lrow[0];
            float ss = 0.f;
#pragma unroll
            for (int dt = 0; dt < NDT; ++dt)
#pragma unroll
                for (int r = 0; r < 16; ++r) { const float o1 = (r & 1) ? __uint_as_float(o1pk[dt][r >> 1] & 0xffff0000u) : __uint_as_float(o1pk[dt][r >> 1] << 16);
                    const float v = o1 - o[0][dt][r] * i2; o[0][dt][r] = v; ss += v * v; }
            ss = xhalf_sum(ss);
            const float rn = rsqrtf(ss * (1.0f / 128.0f) + 1e-6f) * 0.8f;
#pragma unroll
            for (int dt = 0; dt < NDT; ++dt)
#pragma unroll
                for (int g = 0; g < 4; ++g) { const int dv = 32 * dt + 8 * g + 4 * lh; const float4 gs = *(const float4*)(p.g_sub + dv);
                    uint2 w; w.x = cvt_pk_bf16(o[0][dt][4 * g] * rn * gs.x, o[0][dt][4 * g + 1] * rn * gs.y); w.y = cvt_pk_bf16(o[0][dt][4 * g + 2] * rn * gs.z, o[0][dt][4 * g + 3] * rn * gs.w);
                    *(uint2*)(yp + 32 * dt + 8 * g) = w; }
            }
        } else {
            const float i1 = 1.0f / lrow[0];
#pragma unroll
            for (int dt = 0; dt < NDT; ++dt)
#pragma unroll
                for (int g = 0; g < 4; ++g) {
                    uint2 w; w.x = cvt_pk_bf16(o[0][dt][4 * g] * i1, o[0][dt][4 * g + 1] * i1); w.y = cvt_pk_bf16(o[0][dt][4 * g + 2] * i1, o[0][dt][4 * g + 3] * i1);
                    *(uint2*)(yp + 32 * dt + 8 * g) = w; }
        }
        }
    }
}
template <int KIND> __device__ void phase_attn2(const P& p, char* smem, int bid, int nblk, const Sched& sc) {
    constexpr int NMAPS = KIND == 0 ? 2 : 1, DQK = 64, DV = KIND == 1 ? 64 : 128;
    constexpr int QROW = NMAPS * DQK, KSTR = 72, VSTR = 72, NDT = DV / 32, NKS = 4;
    constexpr int VCH = DV * 8 / NTHR;
    constexpr int NH = KIND == 1 ? 8 : 4;
    constexpr int NUNITS = NBATCH * NH * 64;
    bf16_t* Ks = (bf16_t*)smem; bf16_t* Vs = Ks + 2 * 64 * KSTR;
    const int tid = opaque_tid(), lane = tid & 63, wid = tid >> 6, l31 = lane & 31, lh = lane >> 5;
    const float c = 0.125f * 1.4426950408889634f;
    float lam = 0.f;
    if (KIND == 0) { float d1 = 0.f, d2 = 0.f; for (int i = 0; i < 64; ++i) { d1 += p.lq1[i] * p.lk1[i]; d2 += p.lq2[i] * p.lk2[i]; } lam = expf(d1) - expf(d2) + 0.2f; }
    const bf16_t* Qb = KIND == 0 ? p.DQ : p.SQ;
    const bf16_t* Kb = KIND == 0 ? p.DK : p.SK;
    const bf16_t* Vb = KIND == 0 ? p.DVT : p.SVT;
    bf16_t* Yb = KIND == 0 ? p.YD : p.YS;
    const bool xaware = false;
    for (int rnd = 0; xaware ? (rnd < NBATCH * NH / 8) : (rnd * nblk < NUNITS); ++rnd) {
        int qt, bh;
        if (xaware) { bh = sc.x * (NBATCH * NH / 8) + rnd; qt = (rnd & 1) ? sc.j : 63 - sc.j; }
        else { const int rank = rnd * nblk + ((rnd & 1) ? nblk - 1 - bid : bid); if (rank >= NUNITS) continue; qt = 63 - rank / (NBATCH * NH); bh = rank % (NBATCH * NH); }
        const int b = bh / NH, h = bh % NH;
        const int q0 = qt * 128, qw = q0 + 32 * wid;
        const int nkt = 2 * (qt + 1);
        const int last_act = min(nkt - 1, (qw + 31) >> 6);
#pragma unroll 1
        for (int map = 0; map < NMAPS; ++map) {
        bf16x8 qf[NKS];
        { const bf16_t* qp = Qb + ((size_t)(b * S_LEN + qw + l31)) * 512 + h * QROW + map * DQK + lh * 8;
#pragma unroll
          for (int ks = 0; ks < NKS; ++ks) qf[ks] = *(const bf16x8*)(qp + ks * 16); }
        f32x16 o[NDT];
#pragma unroll
        for (int dt = 0; dt < NDT; ++dt)
#pragma unroll
            for (int r = 0; r < 16; ++r) o[dt][r] = 0.f;
        float mrow = -INFINITY, lrow = 0.f;
        int tl_ = tid; asm volatile("" : "+v"(tl_));
        const bf16_t* ksrc = Kb + ((size_t)b * S_LEN + (tl_ >> 3)) * 512 + h * QROW + map * DQK + (tl_ & 7) * 8;
        bf16_t* kdst = Ks + (tl_ >> 3) * KSTR + (tl_ & 7) * 8;
        const bf16_t* vsrc = Vb + ((size_t)(bh * DV + (tl_ >> 3))) * S_LEN + (tl_ & 7) * 8;
        bf16_t* vdst = Vs + (tl_ >> 3) * VSTR + (tl_ & 7) * 8;
        uint4 rk0, rk1, rv0, rv1, rv2 = make_uint4(0, 0, 0, 0), rv3 = make_uint4(0, 0, 0, 0);
#define LDK(kt_) { const bf16_t* s_ = ksrc + (size_t)((kt_) * 64) * 512; rk0 = *(const uint4*)(s_); rk1 = *(const uint4*)(s_ + (size_t)32 * 512); }
#define LDV(kt_) { const bf16_t* s_ = vsrc + (size_t)(kt_) * 64; rv0 = *(const uint4*)(s_); rv1 = *(const uint4*)(s_ + (size_t)32 * S_LEN); if (VCH > 2) { rv2 = *(const uint4*)(s_ + (size_t)64 * S_LEN); rv3 = *(const uint4*)(s_ + (size_t)96 * S_LEN); } }
#define STK(buf_) { bf16_t* d_ = kdst + (buf_) * 64 * KSTR; *(uint4*)(d_) = rk0; *(uint4*)(d_ + 32 * KSTR) = rk1; }
#define STV(buf_) { bf16_t* d_ = vdst + (buf_) * DV * VSTR; *(uint4*)(d_) = rv0; *(uint4*)(d_ + 32 * VSTR) = rv1; if (VCH > 2) { *(uint4*)(d_ + 64 * VSTR) = rv2; *(uint4*)(d_ + 96 * VSTR) = rv3; } }
        LDK(0) LDV(0)
        __syncthreads();
        STK(0) STV(0)
        LDK(1)
        STK(1)
        __syncthreads();
        f32x16 s[2];
        auto qk = [&](int kt) {
            const bf16_t* Kc = Ks + (kt & 1) * 64 * KSTR;
#pragma unroll
            for (int r = 0; r < 16; ++r) { s[0][r] = 0.f; s[1][r] = 0.f; }
#pragma unroll
            for (int ks = 0; ks < NKS; ks += 2) {
                const bf16x8 a00 = *(const bf16x8*)(Kc + l31 * KSTR + ks * 16 + lh * 8), a10 = *(const bf16x8*)(Kc + (32 + l31) * KSTR + ks * 16 + lh * 8);
                const bf16x8 a01 = *(const bf16x8*)(Kc + l31 * KSTR + (ks + 1) * 16 + lh * 8), a11 = *(const bf16x8*)(Kc + (32 + l31) * KSTR + (ks + 1) * 16 + lh * 8);
                s[0] = __builtin_amdgcn_mfma_f32_32x32x16_bf16(a00, qf[ks], s[0], 0, 0, 0);
                s[1] = __builtin_amdgcn_mfma_f32_32x32x16_bf16(a10, qf[ks], s[1], 0, 0, 0);
                s[0] = __builtin_amdgcn_mfma_f32_32x32x16_bf16(a01, qf[ks + 1], s[0], 0, 0, 0);
                s[1] = __builtin_amdgcn_mfma_f32_32x32x16_bf16(a11, qf[ks + 1], s[1], 0, 0, 0);
            }
        };
        unsigned pkp[2][2][4], pkn[2][2][4];
        float corr = 1.0f;
        uint2 mw = make_uint2(0u, 0u);
        auto softmax = [&](int kt) {
            if (KIND == 0 && kt * 64 + 63 > qw) {
                const int qi = qw + l31 - kt * 64 - 4 * lh;
#pragma unroll
                for (int t = 0; t < 2; ++t)
#pragma unroll
                    for (int r = 0; r < 16; ++r) if (32 * t + (r & 3) + 8 * (r >> 2) > qi) s[t][r] = -INFINITY;
            }
            float mx = s[0][0];
#pragma unroll
            for (int r = 1; r < 16; ++r) mx = fmaxf(mx, s[0][r]);
#pragma unroll
            for (int r = 0; r < 16; ++r) mx = fmaxf(mx, s[1][r]);
            mx = xhalf_max(mx);
            const float mnew = fmaxf(mrow, mx * c);
            corr = fast_exp2(mrow - mnew);
            mrow = mnew;
            f32x2v ps2 = {0.f, 0.f}; const f32x2v c2 = {c, c}, nm2 = {-mnew, -mnew};
#pragma unroll
            for (int t = 0; t < 2; ++t)
#pragma unroll
                for (int r = 0; r < 16; r += 2) {
                    const f32x2v sv = {s[t][r], s[t][r + 1]};
                    const f32x2v y = sv * c2 + nm2;
                    f32x2v pv = {fast_exp2(y.x), fast_exp2(y.y)};
                    if (KIND == 1) { pv.x = __uint_as_float(__float_as_uint(pv.x) & (unsigned)__builtin_amdgcn_sbfe((int)(t ? mw.y : mw.x), (r & 3) + 8 * (r >> 2), 1));
                                     pv.y = __uint_as_float(__float_as_uint(pv.y) & (unsigned)__builtin_amdgcn_sbfe((int)(t ? mw.y : mw.x), ((r + 1) & 3) + 8 * ((r + 1) >> 2), 1)); }
                    ps2 += pv;
                    pkn[t][r >> 3][(r >> 1) & 3] = cvt_pk_bf16(pv.x, pv.y);
                }
            lrow = lrow * corr + (ps2.x + ps2.y);
        };
        auto pv_mma = [&](int kt) {
            const bf16_t* Vc = Vs + (kt % 3) * DV * VSTR;
            constexpr int GS = NDT == 4 ? 1 : 2;
#pragma unroll
            for (int ks2 = 0; ks2 < 4; ks2 += GS) {
                bf16x8 va[GS][NDT];
#pragma unroll
                for (int g = 0; g < GS; ++g)
#pragma unroll
                    for (int dt = 0; dt < NDT; ++dt) {
                        const bf16_t* vp = Vc + (32 * dt + l31) * VSTR + 16 * (ks2 + g) + 4 * lh;
                        const uint2 lo = *(const uint2*)vp, hi = *(const uint2*)(vp + 8);
                        const uint4 vv = make_uint4(lo.x, lo.y, hi.x, hi.y);
                        va[g][dt] = *(const bf16x8*)&vv;
                    }
#pragma unroll
                for (int g = 0; g < GS; ++g)
#pragma unroll
                    for (int dt = 0; dt < NDT; ++dt) {
                        const int k2 = ks2 + g;
                        const uint4 pu = make_uint4(pkp[k2 >> 1][k2 & 1][0], pkp[k2 >> 1][k2 & 1][1], pkp[k2 >> 1][k2 & 1][2], pkp[k2 >> 1][k2 & 1][3]);
                        o[dt] = __builtin_amdgcn_mfma_f32_32x32x16_bf16(va[g][dt], *(const bf16x8*)&pu, o[dt], 0, 0, 0);
                    }
            }
        };
        uint2 mwn = make_uint2(0u, 0u);
        if (KIND == 1) mwn = *(const uint2*)(p.MASK + ((size_t)(b * S_LEN + qw + l31)) * 256);
        qk(0);
        for (int kt = 0; kt <= nkt; ++kt) {
            if (kt + 2 < nkt) LDK(kt + 2)
            if (kt + 1 < nkt) LDV(kt + 1)
            const bool do_sm = kt <= last_act, do_pv = kt >= 1 && kt - 1 <= last_act;
            if (do_sm && KIND == 1) { mw = mwn; mw.x >>= 4 * lh; mw.y >>= 4 * lh; if (kt + 1 <= last_act) mwn = *(const uint2*)(p.MASK + ((size_t)(b * S_LEN + qw + l31)) * 256 + (kt + 1) * 2); }
            if (do_sm && do_pv) {
                softmax(kt); pv_mma(kt - 1);
            } else if (do_sm) softmax(kt);
            else if (do_pv) pv_mma(kt - 1);
            if (do_sm) {
                if (__any(corr != 1.0f)) {
#pragma unroll
                    for (int dt = 0; dt < NDT; ++dt)
#pragma unroll
                        for (int r = 0; r < 16; ++r) o[dt][r] *= corr;
                }
#pragma unroll
                for (int t = 0; t < 2; ++t)
#pragma unroll
                    for (int s2 = 0; s2 < 2; ++s2)
#pragma unroll
                        for (int j = 0; j < 4; ++j) pkp[t][s2][j] = pkn[t][s2][j];
            }
            if (kt + 1 <= last_act) qk(kt + 1);
            if (kt + 2 < nkt) STK(kt & 1)
            if (kt + 1 < nkt) STV((kt + 1) % 3)
            __syncthreads();
        }
#undef LDK
#undef LDV
#undef STK
#undef STV
        int te_ = tid; asm volatile("" : "+v"(te_));
        uint4* park = (uint4*)p.SGS + (size_t)bid * 2048 + te_;
        lrow = xhalf_sum(lrow);
        bf16_t* yp = Yb + ((size_t)(b * S_LEN + qw + l31)) * 512 + h * DV + 4 * lh;
        if (KIND == 0) {
            if (map == 0) {
                const float i1 = 1.0f / lrow;
#pragma unroll
                for (int dt = 0; dt < NDT; ++dt)
#pragma unroll
                    for (int h2 = 0; h2 < 2; ++h2)
                        park[(size_t)(dt * 2 + h2) * 256] = make_uint4(cvt_pk_bf16(o[dt][8 * h2] * i1, o[dt][8 * h2 + 1] * i1), cvt_pk_bf16(o[dt][8 * h2 + 2] * i1, o[dt][8 * h2 + 3] * i1),
                                                                      cvt_pk_bf16(o[dt][8 * h2 + 4] * i1, o[dt][8 * h2 + 5] * i1), cvt_pk_bf16(o[dt][8 * h2 + 6] * i1, o[dt][8 * h2 + 7] * i1));
                asm volatile("" ::: "memory");
            } else {
                const float i2 = lam / lrow;
                float ss = 0.f;
#pragma unroll
                for (int dt = 0; dt < NDT; ++dt)
#pragma unroll
                    for (int h2 = 0; h2 < 2; ++h2) { const uint4 w = park[(size_t)(dt * 2 + h2) * 256]; const unsigned ww[4] = {w.x, w.y, w.z, w.w};
#pragma unroll
                        for (int j = 0; j < 4; ++j) {
                            const float v0 = __uint_as_float(ww[j] << 16) - o[dt][8 * h2 + 2 * j] * i2, v1 = __uint_as_float(ww[j] & 0xffff0000u) - o[dt][8 * h2 + 2 * j + 1] * i2;
                            o[dt][8 * h2 + 2 * j] = v0; o[dt][8 * h2 + 2 * j + 1] = v1; ss += v0 * v0 + v1 * v1; } }
                ss = xhalf_sum(ss);
                const float rn = rsqrtf(ss * (1.0f / 128.0f) + 1e-6f) * 0.8f;
#pragma unroll
                for (int dt = 0; dt < NDT; ++dt)
#pragma unroll
                    for (int g = 0; g < 4; ++g) { const int dv = 32 * dt + 8 * g + 4 * lh; const float4 gs = *(const float4*)(p.g_sub + dv);
                        uint2 w; w.x = cvt_pk_bf16(o[dt][4 * g] * rn * gs.x, o[dt][4 * g + 1] * rn * gs.y); w.y = cvt_pk_bf16(o[dt][4 * g + 2] * rn * gs.z, o[dt][4 * g + 3] * rn * gs.w);
                        *(uint2*)(yp + 32 * dt + 8 * g) = w; }
            }
        } else {
            const float i1 = 1.0f / lrow;
#pragma unroll
            for (int dt = 0; dt < NDT; ++dt)
#pragma unroll
                for (int g = 0; g < 4; ++g) {
                    uint2 w; w.x = cvt_pk_bf16(o[dt][4 * g] * i1, o[dt][4 * g + 1] * i1); w.y = cvt_pk_bf16(o[dt][4 * g + 2] * i1, o[dt][4 * g + 3] * i1);
                    *(uint2*)(yp + 32 * dt + 8 * g) = w; }
        }
        }
    }
}
#define IDX_M 23
__device__ __forceinline__ float med3f(float a, float b, float c) { return __builtin_amdgcn_fmed3f(a, b, c); }
__device__ void phase_indexer(const P& p, char* smem, int bid, int nblk, const Sched& sc_) {
    bf16_t* Kb = (bf16_t*)smem;
    unsigned* mimg = (unsigned*)(smem + 18432);
    const int tid = opaque_tid(), lane = tid & 63, wid = tid >> 6, l31 = lane & 31, lh = lane >> 5;
    constexpr int NUNITS = NBATCH * 256;
    const bool xaware = false;
    for (int rnd = 0; xaware ? (rnd < 2) : (rnd * nblk < NUNITS); ++rnd) {
        int qu, b;
        if (xaware) { b = sc_.x >> 1; const int k = rnd == 0 ? 127 - sc_.j : sc_.j; qu = 2 * k + (sc_.x & 1); }
        else { const int rank = rnd * nblk + ((rnd & 1) ? nblk - 1 - bid : bid); if (rank >= NUNITS) continue; qu = 255 - (rank >> 2); b = rank & 3; }
        const int q0 = qu * 32;
        const size_t tok0 = (size_t)b * S_LEN + q0;
        if (q0 < 256) {
#pragma unroll 1
            for (int i = 0; i < 32; ++i) { const int q = q0 + i; const int w0 = tid * 32;
                p.MASK[(tok0 + i) * 256 + tid] = q >= w0 + 31 ? 0xffffffffu : (q < w0 ? 0u : ((2u << (q - w0)) - 1u)); }
            continue;
        }
        const int nkt = (q0 + 95) >> 6;
        const int qb = q0 + 8 * wid;
        bf16x8 aq[2][4]; float wq[2][2][8]; int qv[2][2];
#pragma unroll
        for (int rt = 0; rt < 2; ++rt) {
            const int qa = qb + 4 * rt + 2 * ((l31 >> 2) & 1) + (l31 >> 4), ha = 4 * ((l31 >> 3) & 1) + (l31 & 3);
            const bf16_t* ap = p.IQ + ((size_t)b * S_LEN + qa) * 512 + ha * 64 + lh * 8;
#pragma unroll
            for (int ks = 0; ks < 4; ++ks) aq[rt][ks] = *(const bf16x8*)(ap + ks * 16);
#pragma unroll
            for (int e = 0; e < 2; ++e) { const float* wp = p.IW + ((size_t)b * S_LEN + qb + 4 * rt + 2 * lh + e) * 8;
                const float4 w0 = *(const float4*)wp, w1 = *(const float4*)(wp + 4); const float sc = 0.125f * 0.35355339059327373f;
                wq[rt][e][0] = w0.x * sc; wq[rt][e][1] = w0.y * sc; wq[rt][e][2] = w0.z * sc; wq[rt][e][3] = w0.w * sc;
                wq[rt][e][4] = w1.x * sc; wq[rt][e][5] = w1.y * sc; wq[rt][e][6] = w1.z * sc; wq[rt][e][7] = w1.w * sc;
                qv[rt][e] = qb + 4 * rt + 2 * lh + e; }
        }
        const bf16_t* ksrc = p.IK + ((size_t)b * S_LEN + (tid >> 3)) * 64 + (tid & 7) * 8;
        bf16_t* kdst = Kb + (tid >> 3) * 72 + (tid & 7) * 8;
        auto tile_scores = [&](const bf16_t* kbuf, int t, float (&sc)[2][2]) {
            f32x16 acc[2];
#pragma unroll
            for (int r = 0; r < 16; ++r) { acc[0][r] = 0.f; acc[1][r] = 0.f; }
#pragma unroll
            for (int ks = 0; ks < 4; ++ks) {
                const bf16x8 kf = *(const bf16x8*)(kbuf + (32 * t + l31) * 72 + ks * 16 + lh * 8);
                acc[0] = __builtin_amdgcn_mfma_f32_32x32x16_bf16(aq[0][ks], kf, acc[0], 0, 0, 0);
                acc[1] = __builtin_amdgcn_mfma_f32_32x32x16_bf16(aq[1][ks], kf, acc[1], 0, 0, 0);
            }
#pragma unroll
            for (int rt = 0; rt < 2; ++rt)
#pragma unroll
                for (int e = 0; e < 2; ++e) { float s = 0.f;
#pragma unroll
                    for (int hd = 0; hd < 8; ++hd) s = __builtin_fmaf(wq[rt][e][hd], __int_as_float(max(__float_as_int(acc[rt][8 * e + hd]), 0)), s);
                    sc[rt][e] = s; }
        };
        float T[2][2]; int need[2][2];
        {
            float L[2][2][IDX_M];
#pragma unroll
            for (int rt = 0; rt < 2; ++rt)
#pragma unroll
                for (int e = 0; e < 2; ++e)
#pragma unroll
                    for (int i = 0; i < IDX_M; ++i) L[rt][e][i] = -INFINITY;
            __syncthreads();
            uint4 r0 = *(const uint4*)(ksrc), r1 = *(const uint4*)(ksrc + 32 * 64);
            *(uint4*)(kdst) = r0; *(uint4*)(kdst + 32 * 72) = r1;
            __syncthreads();
            for (int kt = 0; kt < nkt; ++kt) {
                const bf16_t* kbuf = Kb + (kt & 1) * 64 * 72;
                if (kt + 1 < nkt) { r0 = *(const uint4*)(ksrc + (size_t)(kt + 1) * 64 * 64); r1 = *(const uint4*)(ksrc + (size_t)(kt + 1) * 64 * 64 + 32 * 64); }
                __builtin_amdgcn_sched_barrier(0);
                const bool interior = kt * 64 + 63 <= qb;
#pragma unroll 1
                for (int t = 0; t < 2; ++t) {
                    float sc[2][2]; tile_scores(kbuf, t, sc);
                    const int key = kt * 64 + 32 * t + l31;
#pragma unroll
                    for (int rt = 0; rt < 2; ++rt)
#pragma unroll
                        for (int e = 0; e < 2; ++e) {
                            const float v = (interior || key <= qv[rt][e]) ? sc[rt][e] : -INFINITY;
#pragma unroll
                            for (int i = IDX_M - 1; i >= 1; --i) L[rt][e][i] = med3f(L[rt][e][i - 1], L[rt][e][i], v);
                            asm("v_max_f32 %0, %1, %2" : "=v"(L[rt][e][0]) : "v"(L[rt][e][0]), "v"(v));
                        }
                }
                if (kt + 1 < nkt) { bf16_t* d = kdst + ((kt + 1) & 1) * 64 * 72; *(uint4*)(d) = r0; *(uint4*)(d + 32 * 72) = r1; }
                __syncthreads();
            }
#pragma unroll
            for (int rt = 0; rt < 2; ++rt)
#pragma unroll
                for (int e = 0; e < 2; ++e) {
                    unsigned U[IDX_M];
#pragma unroll
                    for (int i = 0; i < IDX_M; ++i) { const unsigned bts = __float_as_uint(L[rt][e][i]); U[i] = bts ^ ((unsigned)((int)bts >> 31) | 0x80000000u); }
                    unsigned pre = 0u;
#pragma unroll 1
                    for (int bit = 31; bit >= 0; --bit) {
                        const unsigned cand = pre | (1u << bit);
                        int c0 = 0, c1 = 0;
#pragma unroll
                        for (int i = 0; i < IDX_M; ++i) { const unsigned long long m = __builtin_amdgcn_ballot_w64(U[i] >= cand); c0 += __popc((unsigned)m); c1 += __popc((unsigned)(m >> 32)); }
                        if ((lh ? c1 : c0) >= 256) pre = cand;
                    }
                    int g0 = 0, g1 = 0;
#pragma unroll
                    for (int i = 0; i < IDX_M; ++i) { const unsigned long long m = __builtin_amdgcn_ballot_w64(U[i] > pre); g0 += __popc((unsigned)m); g1 += __popc((unsigned)(m >> 32)); }
                    need[rt][e] = 256 - (lh ? g1 : g0);
                    T[rt][e] = __uint_as_float((pre & 0x80000000u) ? (pre ^ 0x80000000u) : ~pre);
                }
        }
        {
            int tcnt[2][2];
#pragma unroll
            for (int rt = 0; rt < 2; ++rt)
#pragma unroll
                for (int e = 0; e < 2; ++e) tcnt[rt][e] = 0;
            __syncthreads();
            uint4 r0 = *(const uint4*)(ksrc), r1 = *(const uint4*)(ksrc + 32 * 64);
#pragma unroll 1
            for (int i = tid; i < 32 * 256 / 4; i += NTHR) ((uint4*)mimg)[i] = make_uint4(0u, 0u, 0u, 0u);
            *(uint4*)(kdst) = r0; *(uint4*)(kdst + 32 * 72) = r1;
            __syncthreads();
            for (int kt = 0; kt < nkt; ++kt) {
                const bf16_t* kbuf = Kb + (kt & 1) * 64 * 72;
                if (kt + 1 < nkt) { r0 = *(const uint4*)(ksrc + (size_t)(kt + 1) * 64 * 64); r1 = *(const uint4*)(ksrc + (size_t)(kt + 1) * 64 * 64 + 32 * 64); }
                __builtin_amdgcn_sched_barrier(0);
                const bool interior = kt * 64 + 63 <= qb;
#pragma unroll 1
                for (int t = 0; t < 2; ++t) {
                    float sc[2][2]; tile_scores(kbuf, t, sc);
                    const int key = kt * 64 + 32 * t + l31;
#pragma unroll
                    for (int rt = 0; rt < 2; ++rt)
#pragma unroll
                        for (int e = 0; e < 2; ++e) {
                            const float sv = (interior || key <= qv[rt][e]) ? sc[rt][e] : -INFINITY;
                            unsigned long long bal = __builtin_amdgcn_ballot_w64(sv > T[rt][e]);
                            const unsigned long long tb = __builtin_amdgcn_ballot_w64(sv == T[rt][e]);
                            if (tb != 0ull) {
                                const unsigned half = (unsigned)(tb >> (32 * lh));
                                const int rk = tcnt[rt][e] + __popc(half & ((1u << l31) - 1u));
                                bal |= __builtin_amdgcn_ballot_w64(sv == T[rt][e] && rk < need[rt][e]);
                                tcnt[rt][e] += __popc(half);
                            }
                            if (l31 == 0) mimg[(8 * wid + 4 * rt + 2 * lh + e) * 256 + kt * 2 + t] = (unsigned)(bal >> (32 * lh));
                        }
                }
                if (kt + 1 < nkt) { bf16_t* d = kdst + ((kt + 1) & 1) * 64 * 72; *(uint4*)(d) = r0; *(uint4*)(d + 32 * 72) = r1; }
                __syncthreads();
            }
        }
#pragma unroll 1
        for (int i = tid; i < 32 * 64; i += NTHR) { const int row = i >> 6, c4 = i & 63; *(uint4*)(p.MASK + (tok0 + row) * 256 + c4 * 4) = ((const uint4*)mimg)[row * 64 + c4]; }
    }
}
#ifndef PROBE_REP
#define PROBE_REP -1
#endif
#define RUNPH(idx, call) { _Pragma("unroll 1") for (int rep_ = 0; rep_ < ((PROBE_REP == idx) ? 2 : 1); ++rep_) { call; if (rep_ == 0 && PROBE_REP == idx) xcd_barrier(bar); } }

__global__ void __launch_bounds__(NTHR, 2) k_forward(P p) {
    __shared__ __attribute__((aligned(16))) char smem[SMEM_BYTES];
    volatile LAS unsigned* xbw = (volatile LAS unsigned*)(smem + SMEM_BYTES - 16);
    if (threadIdx.x == 0) { xbw[0] = 0u; xbw[1] = 0u; xbw[2] = 0u; xbw[3] = 0u; }
    __syncthreads();
    XcdBarrier bar = xcd_barrier_post(p.bar, xbw);
    const int bid = blockIdx.x, nblk = gridDim.x;
    volatile LAS int* sw = (volatile LAS int*)(smem + SMEM_BYTES - 32);
    if (threadIdx.x == 0) { const int hx = (int)(xb_xcc_id() & 7u); sw[0] = hx; sw[1] = atomicAdd(&p.XC[hx * 64], 1); }
    RUNPH(0, phase_prologue(p, smem, bid, nblk))
    xcd_barrier(bar);
    Sched sc;
    {
        bool even = (nblk & 7) == 0;
#pragma unroll
        for (int i = 0; i < 8; ++i) even = even && (__hip_atomic_load(&p.XC[i * 64], __ATOMIC_RELAXED, __HIP_MEMORY_SCOPE_AGENT) == (nblk >> 3));
        sc.x = even ? sw[0] : (bid & 7); sc.j = even ? sw[1] : (bid >> 3);
        sc.x = __builtin_amdgcn_readfirstlane(sc.x); sc.j = __builtin_amdgcn_readfirstlane(sc.j);
    }
    RUNPH(1, phase_inproj<0>(p, smem, bid, nblk, sc))
    xcd_barrier(bar);
    RUNPH(2, phase_indexer(p, smem, bid, nblk, sc))
    xcd_split_arrive(bar);
    RUNPH(3, phase_attn<0>(p, smem, bid, nblk, sc))
    RUNPH(4, phase_attn<2>(p, smem, bid, nblk, sc))
    xcd_split_wait(bar);
    RUNPH(5, phase_attn<1>(p, smem, bid, nblk, sc))
    xcd_barrier(bar);
    RUNPH(6, phase_merge<1>(p, smem, bid, nblk, sc))
    xcd_barrier(bar);
    RUNPH(7, phase_outproj(p, smem, bid, nblk, sc))
    xcd_barrier(bar);
#if PROBE_REP == 10
    phase_route<1>(p, smem, bid, nblk);
    xcd_barrier(bar);
#endif
    phase_route<0>(p, smem, bid, nblk);
    xcd_barrier(bar);
    RUNPH(8, phase_moe<0>(p, smem, bid, nblk, sc))
    xcd_barrier(bar);
    RUNPH(9, phase_moe<1>(p, smem, bid, nblk, sc))
    xcd_barrier(bar);
#if PROBE_REP == 11
    phase_final<1>(p, bid, nblk);
    xcd_barrier(bar);
#endif
    phase_final<0>(p, bid, nblk);
}

#define MBYTES(x) ((size_t)(x) << 20)
extern "C" void kernel_launch(void* const* d_in, const int* in_sizes, int n_in, void* d_out, int out_size, void* d_ws, size_t ws_size, hipStream_t stream) {
    P p{};
    p.x = (const float*)d_in[0]; p.pos = (const int*)d_in[1]; p.mem = (const float*)d_in[2];
    p.g_mix = (const float*)d_in[3]; p.w_in = (const float*)d_in[4]; p.b_gate = (const float*)d_in[5];
    p.lq1 = (const float*)d_in[6]; p.lk1 = (const float*)d_in[7]; p.lq2 = (const float*)d_in[8]; p.lk2 = (const float*)d_in[9];
    p.g_sub = (const float*)d_in[10]; p.g_mem = (const float*)d_in[11]; p.w_mkv = (const float*)d_in[12];
    p.w_br0 = (const float*)d_in[13]; p.w_br1 = (const float*)d_in[14]; p.w_br2 = (const float*)d_in[15];
    p.w_out = (const float*)d_in[16]; p.g_ffn = (const float*)d_in[17];
    p.w_rg = (const float*)d_in[18]; p.b_rg = (const float*)d_in[19]; p.w_re = (const float*)d_in[20]; p.b_re = (const float*)d_in[21];
    p.w_ei = (const float*)d_in[22]; p.w_eo = (const float*)d_in[23]; p.g_fin = (const float*)d_in[24];
    char* ws = (char*)d_ws; p.out = (float*)d_out;
    p.bar = (unsigned*)ws; p.CNT = (int*)(ws + 65536); p.XC = (int*)(ws + 131072);
    p.NBUF = (bf16_t*)(ws + MBYTES(1));
    p.DQ = (bf16_t*)(ws + MBYTES(65)); p.DK = (bf16_t*)(ws + MBYTES(97)); p.MERGED = (bf16_t*)(ws + MBYTES(65));
    p.SQ = (bf16_t*)(ws + MBYTES(129)); p.SK = (bf16_t*)(ws + MBYTES(161)); p.HID = (bf16_t*)(ws + MBYTES(129));
    p.DVT = (bf16_t*)(ws + MBYTES(193)); p.SVT = (bf16_t*)(ws + MBYTES(225)); p.IQ = (bf16_t*)(ws + MBYTES(257)); p.MQ = (bf16_t*)(ws + MBYTES(289));
    p.YMOE = (bf16_t*)(ws + MBYTES(193));
    p.IK = (bf16_t*)(ws + MBYTES(321)); p.IW = (float*)(ws + MBYTES(325)); p.MASK = (unsigned*)(ws + MBYTES(326));
    p.MK = (bf16_t*)(ws + MBYTES(358)); p.MVT = (bf16_t*)(ws + MBYTES(359)); p.MEMN = (bf16_t*)(ws + MBYTES(360));
    p.ROPEC = (float*)(ws + MBYTES(362)); p.ROPES = (float*)(ws + MBYTES(363));
    p.ROUTE = (Route*)(ws + MBYTES(365)); p.LIST = (int*)(ws + MBYTES(366));
    p.WIN = (bf16_t*)(ws + MBYTES(368)); p.WMKV = (bf16_t*)(ws + MBYTES(383));
    p.WBR = (bf16_t*)(ws + MBYTES(385)); p.WOUT = (bf16_t*)(ws + MBYTES(388)); p.WEI = (bf16_t*)(ws + MBYTES(390)); p.WEO = (bf16_t*)(ws + MBYTES(422));
    p.SGS = (unsigned*)(ws + MBYTES(440));
    p.HB = (bf16_t*)(ws + MBYTES(440));
    p.YD = (bf16_t*)d_out; p.YS = p.YD + (size_t)T_TOK * 512; p.YM = p.YS + (size_t)T_TOK * 512;
    static int grid = 0;
    if (!grid) {
        int dev = 0, cus = 0, per_cu = 0;
        (void)hipGetDevice(&dev);
        (void)hipDeviceGetAttribute(&cus, hipDeviceAttributeMultiprocessorCount, dev);
        (void)hipOccupancyMaxActiveBlocksPerMultiprocessor(&per_cu, k_forward, NTHR, 0);
        if (cus <= 0) cus = 256;
        if (per_cu < 1) per_cu = 1;
        grid = cus * (per_cu < 2 ? per_cu : 2);
    }
    (void)hipMemsetAsync(p.bar, 0, 262144, stream);
    k_forward<<<grid, NTHR, 0, stream>>>(p);
}
```

```cpp
#include <hip/hip_runtime.h>
#include <stdint.h>
#include <type_traits>

typedef unsigned short bf16_t;

#define S_LEN 8192
#define NBATCH 4
#define T_TOK 32768
#define DM 1024
#define DPROJ 7240
#define LIST_CAP 32768

__device__ __forceinline__ float bf2f(bf16_t v) { return __uint_as_float(((unsigned)v) << 16); }
__device__ __forceinline__ bf16_t f2bf(float f) { unsigned u = __float_as_uint(f); u += 0x7fffu + ((u >> 16) & 1u); return (bf16_t)(u >> 16); }

__device__ __forceinline__ float xhalf_max(float x) {
    const auto r = __builtin_amdgcn_permlane32_swap(__float_as_uint(x), __float_as_uint(x), false, false);
    float m; asm("v_max_f32 %0, %1, %2" : "=v"(m) : "v"(r[0]), "v"(r[1])); return m;
}
__device__ __forceinline__ float xhalf_sum(float x) {
    const auto r = __builtin_amdgcn_permlane32_swap(__float_as_uint(x), __float_as_uint(x), false, false);
    return __uint_as_float(r[0]) + __uint_as_float(r[1]);
}
template <int CTRL> __device__ __forceinline__ float dpp_movf(float v) { return __int_as_float(__builtin_amdgcn_update_dpp(0, __float_as_int(v), CTRL, 0xF, 0xF, true)); }
template <int CTRL> __device__ __forceinline__ int dpp_movi(int v) { return __builtin_amdgcn_update_dpp(0, v, CTRL, 0xF, 0xF, true); }
__device__ __forceinline__ float wave_sum(float v) {
    v += dpp_movf<0xB1>(v); v += dpp_movf<0x4E>(v); v += dpp_movf<0x141>(v); v += dpp_movf<0x140>(v);
    { const auto r = __builtin_amdgcn_permlane16_swap(__float_as_uint(v), __float_as_uint(v), false, false); v = __uint_as_float(r[0]) + __uint_as_float(r[1]); }
    { const auto r = __builtin_amdgcn_permlane32_swap(__float_as_uint(v), __float_as_uint(v), false, false); v = __uint_as_float(r[0]) + __uint_as_float(r[1]); }
    return v;
}
__device__ __forceinline__ float wave_max(float v) {
    v = fmaxf(v, dpp_movf<0xB1>(v)); v = fmaxf(v, dpp_movf<0x4E>(v)); v = fmaxf(v, dpp_movf<0x141>(v)); v = fmaxf(v, dpp_movf<0x140>(v));
    { const auto r = __builtin_amdgcn_permlane16_swap(__float_as_uint(v), __float_as_uint(v), false, false); v = fmaxf(__uint_as_float(r[0]), __uint_as_float(r[1])); }
    { const auto r = __builtin_amdgcn_permlane32_swap(__float_as_uint(v), __float_as_uint(v), false, false); v = fmaxf(__uint_as_float(r[0]), __uint_as_float(r[1])); }
    return v;
}
__device__ __forceinline__ int wave_sum_i(int v) {
    v += dpp_movi<0xB1>(v); v += dpp_movi<0x4E>(v); v += dpp_movi<0x141>(v); v += dpp_movi<0x140>(v);
    { const auto r = __builtin_amdgcn_permlane16_swap((unsigned)v, (unsigned)v, false, false); v = (int)(r[0] + r[1]); }
    { const auto r = __builtin_amdgcn_permlane32_swap((unsigned)v, (unsigned)v, false, false); v = (int)(r[0] + r[1]); }
    return v;
}
__device__ __forceinline__ float block_sum(float v, float* red) {
    v = wave_sum(v);
    __syncthreads();
    if ((threadIdx.x & 63) == 0) red[threadIdx.x >> 6] = v;
    __syncthreads();
    return red[0] + red[1] + red[2] + red[3];
}
__device__ __forceinline__ int block_sum_i(int v, int* red) {
    v = wave_sum_i(v);
    __syncthreads();
    if ((threadIdx.x & 63) == 0) red[threadIdx.x >> 6] = v;
    __syncthreads();
    return red[0] + red[1] + red[2] + red[3];
}

struct Route { int e0, e1; float c0, c1; };
#define XB_TMO      128
#define XB_XCNT(j)  (256  + 64 * (j))
#define XB_XSUB(j)  (1280 + 64 * (j))
#define XB_XGEN(j)  (2304 + 64 * (j))
#define XB_TOP      3328
#define XB_TOPGEN   3392
#define XCD_BAR_WORDS 3456
#define XB_SPIN_CAP (1u << 18)
#define LAS __attribute__((address_space(3)))

__device__ __forceinline__ unsigned xb_ld(unsigned* p)              { return __hip_atomic_load(p, __ATOMIC_RELAXED, __HIP_MEMORY_SCOPE_AGENT); }
__device__ __forceinline__ unsigned xb_add(unsigned* p, unsigned v) { return __hip_atomic_fetch_add(p, v, __ATOMIC_RELAXED, __HIP_MEMORY_SCOPE_AGENT); }
__device__ __forceinline__ unsigned xb_xcc_id() { return (unsigned)__builtin_amdgcn_s_getreg((3 << 11) | 20) & 0xFu; }
#define XB_SPIN(cond, bar) do { unsigned _sp = 0; while (cond) { __builtin_amdgcn_s_sleep(1); \
    if ((++_sp & 255u) == 0u) { if (xb_ld(&(bar)[XB_TMO])) break; if (_sp > XB_SPIN_CAP) { atomicAdd(&(bar)[XB_TMO], 1u); break; } } } } while (0)

struct XcdBarrier {
    unsigned* bar; unsigned x;
    volatile LAS unsigned* st;
};

__device__ __forceinline__ XcdBarrier xcd_barrier_post(unsigned* bar, volatile LAS unsigned* st) {
    XcdBarrier b; b.bar = bar; b.x = xb_xcc_id(); b.st = st;
    if (threadIdx.x == 0) (void)xb_add(&bar[XB_XCNT(b.x)], 1u);
    return b;
}
__device__ __forceinline__ void xcd_barrier_complete(unsigned* bar, unsigned x, unsigned& nloc, unsigned& nx) {
    const unsigned G = gridDim.x * gridDim.y * gridDim.z;
    unsigned sum, cnt, mine, sp = 0u;
    for (;;) {
        sum = 0u; cnt = 0u; mine = 0u;
#pragma unroll
        for (unsigned j = 0; j < 16; ++j) { const unsigned c = xb_ld(&bar[XB_XCNT(j)]); sum += c; cnt += (c > 0u) ? 1u : 0u; mine = (j == x) ? c : mine; }
        if (sum == G) break;
        __builtin_amdgcn_s_sleep(1);
        if ((++sp & 255u) == 0u) { if (xb_ld(&bar[XB_TMO])) break; if (sp > XB_SPIN_CAP) { atomicAdd(&bar[XB_TMO], 1u); break; } }
    }
    nloc = mine > 0u ? mine : 1u; nx = cnt > 0u ? cnt : 1u;
}

__device__ __forceinline__ void xcd_barrier(const XcdBarrier& b) {
    asm volatile("s_waitcnt vmcnt(0)" ::: "memory");
    __syncthreads();
    if (threadIdx.x == 0) {
        unsigned* bar = b.bar;
        __builtin_amdgcn_s_waitcnt(0);
        unsigned nloc = b.st[0], nx = b.st[1];
        if (nloc == 0u) { xcd_barrier_complete(bar, b.x, nloc, nx); b.st[0] = nloc; b.st[1] = nx; }
        const unsigned old = xb_add(&bar[XB_XSUB(b.x)], 1u);
        const unsigned gen = old / nloc;
        if (old + 1u == (gen + 1u) * nloc) {
            __builtin_amdgcn_fence(__ATOMIC_RELEASE, "agent");
            asm volatile("s_waitcnt vmcnt(0)" ::: "memory");
            const unsigned og = xb_add(&bar[XB_TOP], 1u);
            const unsigned tg = og / nx;
            if (og + 1u == (tg + 1u) * nx) xb_add(&bar[XB_TOPGEN], 1u);
            else XB_SPIN(xb_ld(&bar[XB_TOPGEN]) == tg, bar);
            __builtin_amdgcn_fence(__ATOMIC_ACQUIRE, "agent");
            xb_add(&bar[XB_XGEN(b.x)], 1u);
            asm volatile("s_waitcnt vmcnt(0)" ::: "memory");
        } else {
            XB_SPIN(xb_ld(&bar[XB_XGEN(b.x)]) == gen, bar);
            __builtin_amdgcn_fence(__ATOMIC_ACQUIRE, "agent");
            asm volatile("s_waitcnt vmcnt(0)" ::: "memory");
        }
    }
    __syncthreads();
}


#define XB_SPLIT 4096
__device__ __forceinline__ void xcd_split_arrive(const XcdBarrier& b) {
    asm volatile("s_waitcnt vmcnt(0)" ::: "memory");
    __syncthreads();
    if (threadIdx.x == 0) {
        __builtin_amdgcn_s_waitcnt(0);
        __builtin_amdgcn_fence(__ATOMIC_RELEASE, "agent");
        asm volatile("s_waitcnt vmcnt(0)" ::: "memory");
        (void)xb_add(&b.bar[XB_SPLIT], 1u);
    }
}
__device__ __forceinline__ void xcd_split_wait(const XcdBarrier& b) {
    __syncthreads();
    if (threadIdx.x == 0) {
        const unsigned G = gridDim.x * gridDim.y * gridDim.z;
        XB_SPIN(xb_ld(&b.bar[XB_SPLIT]) < G, b.bar);
        __builtin_amdgcn_fence(__ATOMIC_ACQUIRE, "agent");
        asm volatile("s_waitcnt vmcnt(0)" ::: "memory");
    }
    __syncthreads();
}
typedef __attribute__((ext_vector_type(8))) __bf16 bf16x8;
typedef __attribute__((ext_vector_type(16))) float f32x16;
typedef __attribute__((ext_vector_type(4))) float f32x4;
#define NTHR 256
#define LDSK 72
#define SMEM_BYTES 81920

struct P {
    const float* x; const int* pos; const float* mem; const float* g_mix; const float* w_in; const float* b_gate;
    const float* lq1; const float* lk1; const float* lq2; const float* lk2; const float* g_sub; const float* g_mem; const float* w_mkv;
    const float* w_br0; const float* w_br1; const float* w_br2; const float* w_out; const float* g_ffn;
    const float* w_rg; const float* b_rg; const float* w_re; const float* b_re; const float* w_ei; const float* w_eo; const float* g_fin;
    float* out;
    unsigned* bar; int* CNT;
    bf16_t* NBUF; bf16_t* DQ; bf16_t* DK; bf16_t* DVT; bf16_t* SQ; bf16_t* SK; bf16_t* SVT; bf16_t* IQ; bf16_t* MQ; bf16_t* IK; float* IW; unsigned* MASK;
    bf16_t* MK; bf16_t* MVT; bf16_t* MEMN; float* ROPEC; float* ROPES;
    bf16_t* WIN; bf16_t* WBR; bf16_t* WOUT; bf16_t* WMKV; bf16_t* WEI; bf16_t* WEO;
    bf16_t* YD; bf16_t* YS; bf16_t* YM; bf16_t* MERGED; bf16_t* HID; bf16_t* YMOE; Route* ROUTE; int* LIST; unsigned* SGS; int* XC; bf16_t* HB;
};

__device__ __forceinline__ int opaque_tid() { int t = threadIdx.x; asm volatile("" : "+v"(t)); return t; }
typedef __bf16 bf16x2v_t __attribute__((ext_vector_type(2)));
typedef float f32x2c_t __attribute__((ext_vector_type(2)));
__device__ __forceinline__ unsigned cvt_pk_bf16_ord(float lo, float hi) { unsigned r; asm volatile("s_nop 0\n\tv_cvt_pk_bf16_f32 %0, %1, %2" : "=v"(r) : "v"(lo), "v"(hi)); return r; }
__device__ __forceinline__ unsigned cvt_pk_bf16(float lo, float hi) { const f32x2c_t v = {lo, hi}; const bf16x2v_t r = __builtin_convertvector(v, bf16x2v_t); return __builtin_bit_cast(unsigned, r); }

template <int MAP> __device__ __forceinline__ int colmap(int n) {
    if (MAP == 1) return n < 3584 ? n : n < 4096 ? n + 72 : n < 4168 ? n - 512 : n < 4224 ? -1 : n - 56;
    if (MAP == 2) { const int c = n >> 6, j = n & 63; return j < 32 ? 32 * c + j : 512 + 32 * c + (j - 32); }
    return n;
}
template <int MAP, int NTL> __device__ __forceinline__ void tconv_tile(const float* __restrict__ src, int ld, int K, bf16_t* __restrict__ dst, int tile, float* tl) {
    const int n0 = (tile % NTL) * 64, k0 = (tile / NTL) * 64;
    const int t = opaque_tid(); const int nn = (t & 15) * 4; const int c = colmap<MAP>(n0 + nn);
#pragma unroll
    for (int i = 0; i < 4; ++i) { const int kk = (t >> 4) + 16 * i;
        const float4 v = c >= 0 ? *(const float4*)(src + (size_t)(k0 + kk) * ld + c) : make_float4(0.f, 0.f, 0.f, 0.f);
        tl[kk * 65 + nn] = v.x; tl[kk * 65 + nn + 1] = v.y; tl[kk * 65 + nn + 2] = v.z; tl[kk * 65 + nn + 3] = v.w; }
    __syncthreads();
#pragma unroll
    for (int i = 0; i < 2; ++i) { const int cc = t + 256 * i; const int n2 = cc >> 3, kc = (cc & 7) * 8;
        uint4 o; o.x = cvt_pk_bf16(tl[(kc + 0) * 65 + n2], tl[(kc + 1) * 65 + n2]); o.y = cvt_pk_bf16(tl[(kc + 2) * 65 + n2], tl[(kc + 3) * 65 + n2]);
        o.z = cvt_pk_bf16(tl[(kc + 4) * 65 + n2], tl[(kc + 5) * 65 + n2]); o.w = cvt_pk_bf16(tl[(kc + 6) * 65 + n2], tl[(kc + 7) * 65 + n2]);
        *(uint4*)(dst + (size_t)(n0 + n2) * K + k0 + kc) = o; }
    __syncthreads();
}
#define TC_WIN 1824
#define TC_WBR (TC_WIN + 384)
#define TC_WOUT (TC_WBR + 256)
#define TC_WMKV (TC_WOUT + 256)
#define TC_WEI (TC_WMKV + 4096)
#define TC_WEO (TC_WEI + 2048)
__device__ void phase_prologue(const P& p, char* smem, int bid, int nblk) {
    float* tl = (float*)smem;
    const int tidp = opaque_tid();
    for (int g = bid; g < TC_WEO; g += nblk) {
        if (g < TC_WIN) tconv_tile<1, 114>(p.w_in, DPROJ, 1024, p.WIN, g, tl);
        else if (g < TC_WBR) { const int j = (g - TC_WIN) >> 7; const float* s = j == 0 ? p.w_br0 : j == 1 ? p.w_br1 : p.w_br2; tconv_tile<0, 16>(s, 1024, 512, p.WBR + (size_t)j * 1024 * 512, (g - TC_WIN) & 127, tl); }
        else if (g < TC_WOUT) tconv_tile<0, 16>(p.w_out, 1024, 1024, p.WOUT, g - TC_WBR, tl);
        else if (g < TC_WMKV) tconv_tile<0, 16>(p.w_mkv, 1024, 1024, p.WMKV, g - TC_WOUT, tl);
        else if (g < TC_WEI) { const int e = (g - TC_WMKV) >> 8; tconv_tile<2, 16>(p.w_ei + (size_t)e * 1024 * 1024, 1024, 1024, p.WEI + (size_t)e * 1024 * 1024, (g - TC_WMKV) & 255, tl); }
        else { const int e = (g - TC_WEI) >> 7; tconv_tile<0, 16>(p.w_eo + (size_t)e * 512 * 1024, 1024, 512, p.WEO + (size_t)e * 1024 * 512, (g - TC_WEI) & 127, tl); }
    }
    const int lane = tidp & 63; const int gw = bid * 4 + (tidp >> 6), nw = nblk * 4;
    for (int row = gw; row < T_TOK + 1024; row += nw) {
        const float* src; const float* g; bf16_t* dst;
        if (row < T_TOK) { src = p.x + (size_t)row * DM; g = p.g_mix; dst = p.NBUF + (size_t)row * DM; }
        else { src = p.mem + (size_t)(row - T_TOK) * DM; g = p.g_mem; dst = p.MEMN + (size_t)(row - T_TOK) * DM; }
        float4 v[4]; float ss = 0.f;
#pragma unroll
        for (int i = 0; i < 4; ++i) { v[i] = *(const float4*)(src + i * 256 + lane * 4); ss += v[i].x * v[i].x + v[i].y * v[i].y + v[i].z * v[i].z + v[i].w * v[i].w; }
        ss = wave_sum(ss);
        const float r = rsqrtf(ss * (1.0f / DM) + 1e-6f);
#pragma unroll
        for (int i = 0; i < 4; ++i) { const float4 gg = *(const float4*)(g + i * 256 + lane * 4);
            uint2 o; o.x = cvt_pk_bf16(v[i].x * r * gg.x, v[i].y * r * gg.y); o.y = cvt_pk_bf16(v[i].z * r * gg.z, v[i].w * r * gg.w);
            *(uint2*)(dst + i * 256 + lane * 4) = o; }
    }
    for (int i = bid * NTHR + tidp; i < T_TOK * 8; i += nblk * NTHR) {
        const float inv = powf(500000.0f, -(float)(i & 7) / 8.0f);
        const float ang = (float)p.pos[i >> 3] * inv;
        float sn, cs; sincosf(ang, &sn, &cs);
        p.ROPEC[i] = cs; p.ROPES[i] = sn;
    }
    if (bid == 0 && tidp < 16) p.CNT[tidp * 64] = 0;
}


struct Sched { int x, j; };
struct XOrder {
    int x, j, J, nblk, bid;
    __device__ __forceinline__ XOrder(int bid_, int nblk_, const Sched& s) : x(s.x), j(s.j), J(nblk_ >> 3), nblk(nblk_), bid(bid_) {}
    __device__ __forceinline__ bool round(int r, int N, int& u) const {
        if ((nblk & 7) != 0) { u = r * nblk + bid; if (r * nblk >= N) return false; if (u >= N) u = -1; return true; }
        const int c = r * 8 + x; if (r * 8 * J >= N) return false; u = c * J + j; if (u >= N) u = -1; return true;
    }
};
__device__ __forceinline__ void tile_mn(int u, int NT, int& mt, int& nt) { const int g = u / (8 * NT), rem = u - g * 8 * NT; nt = rem >> 3; mt = g * 8 + (rem & 7); }

__device__ __forceinline__ int gl_row(int tid, int q) { return (tid >> 6) * 32 + q * 8 + ((tid & 63) >> 3); }
__device__ __forceinline__ unsigned gl_col(int tid, int row) { return (unsigned)(((tid & 7) ^ ((row >> 1) & 7)) * 8); }
__device__ __forceinline__ void gemm_mainloop(const bf16_t* __restrict__ Rb, unsigned or0, unsigned or1, unsigned or2, unsigned or3,
                                              const bf16_t* __restrict__ Lb, unsigned ol0, unsigned ol1, unsigned ol2, unsigned ol3, int K, f32x16 (&acc)[2][2], bf16_t* As, bf16_t* Bs) {
    const int tid = opaque_tid(), lane = tid & 63, wid = tid >> 6, wr = wid >> 1, wc = wid & 1;
    const int nk = K >> 6;
    LAS unsigned* ldsA = (LAS unsigned*)(As + wid * 32 * 64);
    LAS unsigned* ldsB = (LAS unsigned*)(Bs + wid * 32 * 64);
    const int sw = (lane >> 1) & 7;
    const bf16_t* ard = As + (wr * 64 + (lane & 31)) * 64;
    const bf16_t* brd = Bs + (wc * 64 + (lane & 31)) * 64;
    const int lh = lane >> 5;
#define GLDS_TILE(stage_, ko_) { \
    __builtin_amdgcn_global_load_lds((const unsigned*)(Rb + or0 + (ko_)), (LAS unsigned*)((LAS char*)ldsA + (stage_) * 32768), 16, 0, 0); \
    __builtin_amdgcn_global_load_lds((const unsigned*)(Rb + or1 + (ko_)), (LAS unsigned*)((LAS char*)ldsA + (stage_) * 32768 + 1024), 16, 0, 0); \
    __builtin_amdgcn_global_load_lds((const unsigned*)(Rb + or2 + (ko_)), (LAS unsigned*)((LAS char*)ldsA + (stage_) * 32768 + 2048), 16, 0, 0); \
    __builtin_amdgcn_global_load_lds((const unsigned*)(Rb + or3 + (ko_)), (LAS unsigned*)((LAS char*)ldsA + (stage_) * 32768 + 3072), 16, 0, 0); \
    __builtin_amdgcn_global_load_lds((const unsigned*)(Lb + ol0 + (ko_)), (LAS unsigned*)((LAS char*)ldsB + (stage_) * 32768), 16, 0, 0); \
    __builtin_amdgcn_global_load_lds((const unsigned*)(Lb + ol1 + (ko_)), (LAS unsigned*)((LAS char*)ldsB + (stage_) * 32768 + 1024), 16, 0, 0); \
    __builtin_amdgcn_global_load_lds((const unsigned*)(Lb + ol2 + (ko_)), (LAS unsigned*)((LAS char*)ldsB + (stage_) * 32768 + 2048), 16, 0, 0); \
    __builtin_amdgcn_global_load_lds((const unsigned*)(Lb + ol3 + (ko_)), (LAS unsigned*)((LAS char*)ldsB + (stage_) * 32768 + 3072), 16, 0, 0); }
    __syncthreads();
    GLDS_TILE(0, 0u)
    __syncthreads();
    for (int kt = 0; kt < nk; ++kt) {
        const int cur = (kt & 1) * 16384;
        if (kt + 1 < nk) { if (kt & 1) GLDS_TILE(0, (unsigned)(kt + 1) * 64u) else GLDS_TILE(1, (unsigned)(kt + 1) * 64u) }
#pragma unroll
        for (int ks = 0; ks < 4; ++ks) {
            const int cc = ((2 * ks + lh) ^ sw) * 8;
            const bf16x8 fa0 = *(const bf16x8*)(ard + cur + cc), fa1 = *(const bf16x8*)(ard + cur + 32 * 64 + cc);
            const bf16x8 fb0 = *(const bf16x8*)(brd + cur + cc), fb1 = *(const bf16x8*)(brd + cur + 32 * 64 + cc);
            acc[0][0] = __builtin_amdgcn_mfma_f32_32x32x16_bf16(fa0, fb0, acc[0][0], 0, 0, 0);
            acc[0][1] = __builtin_amdgcn_mfma_f32_32x32x16_bf16(fa0, fb1, acc[0][1], 0, 0, 0);
            acc[1][0] = __builtin_amdgcn_mfma_f32_32x32x16_bf16(fa1, fb0, acc[1][0], 0, 0, 0);
            acc[1][1] = __builtin_amdgcn_mfma_f32_32x32x16_bf16(fa1, fb1, acc[1][1], 0, 0, 0);
        }
        __syncthreads();
    }
#undef GLDS_TILE
}
#define ZERO_ACC(acc) { _Pragma("unroll") for (int i_ = 0; i_ < 2; ++i_) _Pragma("unroll") for (int j_ = 0; j_ < 2; ++j_) _Pragma("unroll") for (int r_ = 0; r_ < 16; ++r_) acc[i_][j_][r_] = 0.f; }
#define CSTR 136
__device__ __forceinline__ void cimg_write(const f32x16 (&acc)[2][2], bf16_t* Cs, int wr, int wc, int l31, int lh) {
#pragma unroll
    for (int i = 0; i < 2; ++i)
#pragma unroll
        for (int j = 0; j < 2; ++j)
#pragma unroll
            for (int g = 0; g < 4; ++g) { uint2 o; o.x = cvt_pk_bf16(acc[i][j][4 * g], acc[i][j][4 * g + 1]); o.y = cvt_pk_bf16(acc[i][j][4 * g + 2], acc[i][j][4 * g + 3]);
                *(uint2*)(Cs + (64 * wc + 32 * j + l31) * CSTR + 64 * wr + 32 * i + 8 * g + 4 * lh) = o; }
}

template <int NOEPI> __device__ void phase_inproj(const P& p, char* smem, int bid, int nblk, const Sched& sc) {
    bf16_t* As = (bf16_t*)smem; bf16_t* Bs = As + 128 * 64; bf16_t* Cs = (bf16_t*)smem;
    const int tid = opaque_tid(), lane = tid & 63, wid = tid >> 6, wr = wid >> 1, wc = wid & 1;
    const int l31 = lane & 31, lh = lane >> 5;
    const int NT = 33, NMAIN = 256 * NT;
    const XOrder xo(bid, nblk, sc);
    const bool xaware = false;
    for (int rr = 0; ; ++rr) {
        bool main_t; int mt, nt;
        if (xaware) {
            if (rr < 16) { main_t = true; mt = ((sc.x >> 2) * 16 + rr) * 8 + (sc.j & 7); nt = (sc.x & 3) * 8 + (sc.j >> 3); }
            else if (rr == 16) { if (bid >= 320) break; main_t = bid < 256; mt = main_t ? bid : (bid - 256) >> 3; nt = main_t ? 32 : (bid - 256) & 7; }
            else break;
        } else {
            int t; if (!xo.round(rr, NMAIN + 64, t)) break; if (t < 0) continue;
            main_t = t < NMAIN;
            if (main_t) tile_mn(t, NT, mt, nt); else { mt = (t - NMAIN) >> 3; nt = (t - NMAIN) & 7; }
        }
        const bf16_t* X = main_t ? p.NBUF : p.MEMN; const bf16_t* W = main_t ? p.WIN : p.WMKV;
        const int grp = main_t ? (nt >> 2) : (nt < 4 ? 7 : 2);
        const bool transposed = grp == 2 || grp == 5;
        const int g0 = gl_row(tid, 0); const unsigned to = (unsigned)g0 * 1024u + gl_col(tid, g0);
        const unsigned t1 = (unsigned)(g0 + 8) * 1024u + gl_col(tid, g0 + 8), t2 = (unsigned)(g0 + 16) * 1024u + gl_col(tid, g0 + 16), t3 = (unsigned)(g0 + 24) * 1024u + gl_col(tid, g0 + 24);
        const bf16_t* Xt = X + (size_t)mt * 128 * 1024; const bf16_t* Wt = W + (size_t)nt * 128 * 1024;
        f32x16 acc[2][2]; ZERO_ACC(acc);
        gemm_mainloop(transposed ? Xt : Wt, to, t1, t2, t3, transposed ? Wt : Xt, to, t1, t2, t3, 1024, acc, As, Bs);
        if (NOEPI) { float s_ = 0.f; for (int i_ = 0; i_ < 2; ++i_) for (int j_ = 0; j_ < 2; ++j_) for (int r_ = 0; r_ < 16; ++r_) s_ += acc[i_][j_][r_]; if (s_ == 1.2345e30f) p.IW[0] = s_; continue; }
        const int tok0 = mt * 128;
        if (main_t && !transposed && grp != 7) {
            if (grp != 8 || wr == 0) {
#pragma unroll
                for (int j = 0; j < 2; ++j) { const int tok = tok0 + 64 * wc + 32 * j + l31;
                    const float4 c4 = *(const float4*)(p.ROPEC + (size_t)tok * 8 + 4 * lh), s4 = *(const float4*)(p.ROPES + (size_t)tok * 8 + 4 * lh);
                    const float cc[4] = {c4.x, c4.y, c4.z, c4.w}, ss[4] = {s4.x, s4.y, s4.z, s4.w};
#pragma unroll
                    for (int r = 0; r < 4; ++r) { const float x1 = acc[0][j][r], x2 = acc[0][j][r + 4]; acc[0][j][r] = x1 * cc[r] - x2 * ss[r]; acc[0][j][r + 4] = x2 * cc[r] + x1 * ss[r]; } }
            }
        }
        if (grp == 8 && wr == 1) {
#pragma unroll
            for (int j = 0; j < 2; ++j) { const int tok = tok0 + 64 * wc + 32 * j + l31; *(float4*)(p.IW + (size_t)tok * 8 + 4 * lh) = make_float4(acc[0][j][0], acc[0][j][1], acc[0][j][2], acc[0][j][3]); }
        }
        __syncthreads();
        cimg_write(acc, Cs, wr, wc, l31, lh);
        __syncthreads();
        bf16_t* dbase; size_t dstride; int nch = 16;
        if (!main_t) {
            if (nt < 4) { dbase = p.MK + (size_t)tok0 * 512 + nt * 128; dstride = 512; }
            else { dbase = p.MVT + ((size_t)((mt >> 1) * 4 + (nt - 4)) * 128) * 256 + (mt & 1) * 128; dstride = 256; }
        } else if (grp == 2) { dbase = p.DVT + ((size_t)((mt >> 6) * 4 + (nt - 8)) * 128) * S_LEN + (mt & 63) * 128; dstride = S_LEN; }
        else if (grp == 5) { dbase = p.SVT + ((size_t)((mt >> 6) * 8 + (nt - 20) * 2) * 64) * S_LEN + (mt & 63) * 128; dstride = S_LEN; }
        else if (grp == 8) { dbase = p.IK + (size_t)tok0 * 64; dstride = 64; nch = 8; }
        else { bf16_t* d = grp == 0 ? p.DQ : grp == 1 ? p.DK : grp == 3 ? p.SQ : grp == 4 ? p.SK : grp == 6 ? p.IQ : p.MQ; dbase = d + (size_t)tok0 * 512 + (nt & 3) * 128; dstride = 512; }
        int te_ = tid; asm volatile("" : "+v"(te_));
#pragma unroll
        for (int k = 0; k < 8; ++k) { const int c = te_ + 256 * k; const int lrow = c >> 4, ch = c & 15;
            if (ch < nch) { const uint4 v = *(const uint4*)(Cs + lrow * CSTR + ch * 8); *(uint4*)(dbase + (size_t)lrow * dstride + ch * 8) = v; } }
    }
}
template <int REPS = 1> __device__ void phase_merge(const P& p, char* smem, int bid, int nblk, const Sched& sc) {
    bf16_t* As = (bf16_t*)smem; bf16_t* Bs = As + 128 * 64; bf16_t* Cs = (bf16_t*)smem;
    const int tid = opaque_tid(), lane = tid & 63, wid = tid >> 6, wr = wid >> 1, wc = wid & 1;
    const int l31 = lane & 31, lh = lane >> 5;
    const XOrder xo(bid, nblk, sc);
    const bool xaware = false;
#pragma unroll 1
    for (int rep = 0; rep < REPS; ++rep)
    for (int rr = 0; ; ++rr) {
        int mt, nt;
        if (xaware) { if (rr >= 4) break; nt = sc.x; mt = rr * 64 + sc.j; }
        else { int t; if (!xo.round(rr, 256 * 8, t)) break; if (t < 0) continue; tile_mn(t, 8, mt, nt); }
        f32x16 mg[2][2]; ZERO_ACC(mg);
#pragma unroll 1
        for (int br = 0; br < 3; ++br) {
            int tl_ = tid; asm volatile("" : "+v"(tl_));
            unsigned sgr[8][4];
            {
                const int g0 = gl_row(tl_, 0);
                const unsigned to = (unsigned)g0 * 1024u + gl_col(tl_, g0), t1 = (unsigned)(g0 + 8) * 1024u + gl_col(tl_, g0 + 8), t2 = (unsigned)(g0 + 16) * 1024u + gl_col(tl_, g0 + 16), t3 = (unsigned)(g0 + 24) * 1024u + gl_col(tl_, g0 + 24);
                f32x16 acc[2][2]; ZERO_ACC(acc);
                gemm_mainloop(p.WIN + (size_t)(4224 + br * 1024 + nt * 128) * 1024, to, t1, t2, t3, p.NBUF + (size_t)mt * 128 * 1024, to, t1, t2, t3, 1024, acc, As, Bs);
#pragma unroll
                for (int i = 0; i < 2; ++i)
#pragma unroll
                    for (int g = 0; g < 4; ++g) { const float4 b4 = *(const float4*)(p.b_gate + br * 1024 + nt * 128 + 64 * wr + 32 * i + 8 * g + 4 * lh);
                        const float bb[4] = {b4.x, b4.y, b4.z, b4.w};
#pragma unroll
                        for (int j = 0; j < 2; ++j) { float s[4];
#pragma unroll
                            for (int r = 0; r < 4; ++r) s[r] = __builtin_amdgcn_rcpf(1.0f + __expf(-(acc[i][j][4 * g + r] + bb[r])));
                            acc[i][j][4 * g] = __uint_as_float(cvt_pk_bf16_ord(s[0], s[1])); acc[i][j][4 * g + 1] = __uint_as_float(cvt_pk_bf16_ord(s[2], s[3])); } }
#pragma unroll
                for (int i = 0; i < 2; ++i)
#pragma unroll
                    for (int j = 0; j < 2; ++j)
#pragma unroll
                        for (int h2 = 0; h2 < 2; ++h2) {
                            sgr[(i * 2 + j) * 2 + h2][0] = __float_as_uint(acc[i][j][8 * h2]); sgr[(i * 2 + j) * 2 + h2][1] = __float_as_uint(acc[i][j][8 * h2 + 1]);
                            sgr[(i * 2 + j) * 2 + h2][2] = __float_as_uint(acc[i][j][8 * h2 + 4]); sgr[(i * 2 + j) * 2 + h2][3] = __float_as_uint(acc[i][j][8 * h2 + 5]); }
                asm volatile("" ::: "memory");
            }
            {
                const bf16_t* Y = br == 0 ? p.YD : br == 1 ? p.YS : p.YM;
                int tl2_ = tid; asm volatile("" : "+v"(tl2_));
                const int g0 = gl_row(tl2_, 0);
                const unsigned to = (unsigned)g0 * 512u + gl_col(tl2_, g0), t1 = (unsigned)(g0 + 8) * 512u + gl_col(tl2_, g0 + 8), t2 = (unsigned)(g0 + 16) * 512u + gl_col(tl2_, g0 + 16), t3 = (unsigned)(g0 + 24) * 512u + gl_col(tl2_, g0 + 24);
                f32x16 acc[2][2]; ZERO_ACC(acc);
                gemm_mainloop(p.WBR + (size_t)br * 1024 * 512 + (size_t)nt * 128 * 512, to, t1, t2, t3, Y + (size_t)mt * 128 * 512, to, t1, t2, t3, 512, acc, As, Bs);
                asm volatile("" ::: "memory");
#pragma unroll
                for (int i = 0; i < 2; ++i)
#pragma unroll
                    for (int j = 0; j < 2; ++j)
#pragma unroll
                        for (int h2 = 0; h2 < 2; ++h2) { const unsigned ww[4] = {sgr[(i * 2 + j) * 2 + h2][0], sgr[(i * 2 + j) * 2 + h2][1], sgr[(i * 2 + j) * 2 + h2][2], sgr[(i * 2 + j) * 2 + h2][3]};
#pragma unroll
                            for (int q = 0; q < 2; ++q) {
                                const int g = 2 * h2 + q;
                                mg[i][j][4 * g] += __uint_as_float(ww[2 * q] << 16) * acc[i][j][4 * g];
                                mg[i][j][4 * g + 1] += __uint_as_float(ww[2 * q] & 0xffff0000u) * acc[i][j][4 * g + 1];
                                mg[i][j][4 * g + 2] += __uint_as_float(ww[2 * q + 1] << 16) * acc[i][j][4 * g + 2];
                                mg[i][j][4 * g + 3] += __uint_as_float(ww[2 * q + 1] & 0xffff0000u) * acc[i][j][4 * g + 3]; } }
            }
        }
        __syncthreads();
        cimg_write(mg, Cs, wr, wc, l31, lh);
        __syncthreads();
        bf16_t* dbase = p.MERGED + (size_t)mt * 128 * 1024 + nt * 128;
        int te_ = tid; asm volatile("" : "+v"(te_));
#pragma unroll
        for (int k = 0; k < 8; ++k) { const int c = te_ + 256 * k; const int lrow = c >> 4, ch = c & 15;
            const uint4 v = *(const uint4*)(Cs + lrow * CSTR + ch * 8); *(uint4*)(dbase + (size_t)lrow * 1024 + ch * 8) = v; }
    }
}

#define CFS 132
__device__ void phase_outproj(const P& p, char* smem, int bid, int nblk, const Sched& sc) {
    bf16_t* As = (bf16_t*)smem; bf16_t* Bs = As + 128 * 64;
    const int tid = opaque_tid(), lane = tid & 63, wid = tid >> 6, wr = wid >> 1, wc = wid & 1;
    const int l31 = lane & 31, lh = lane >> 5;
    const XOrder xo(bid, nblk, sc);
    for (int rr = 0; ; ++rr) {
        int t; if (!xo.round(rr, 256 * 8, t)) break; if (t < 0) continue;
        int mt, nt; tile_mn(t, 8, mt, nt);
        const int g0 = gl_row(tid, 0);
        const unsigned to = (unsigned)g0 * 1024u + gl_col(tid, g0), t1 = (unsigned)(g0 + 8) * 1024u + gl_col(tid, g0 + 8), t2 = (unsigned)(g0 + 16) * 1024u + gl_col(tid, g0 + 16), t3 = (unsigned)(g0 + 24) * 1024u + gl_col(tid, g0 + 24);
        f32x16 acc[2][2]; ZERO_ACC(acc);
        gemm_mainloop(p.WOUT + (size_t)nt * 128 * 1024, to, t1, t2, t3, p.MERGED + (size_t)mt * 128 * 1024, to, t1, t2, t3, 1024, acc, As, Bs);
        float* Cf = (float*)smem;
#pragma unroll
        for (int i = 0; i < 2; ++i)
#pragma unroll
            for (int j = 0; j < 2; ++j)
#pragma unroll
                for (int g = 0; g < 4; ++g)
                    *(float4*)(Cf + (64 * wc + 32 * j + l31) * CFS + 64 * wr + 32 * i + 8 * g + 4 * lh) = make_float4(acc[i][j][4 * g], acc[i][j][4 * g + 1], acc[i][j][4 * g + 2], acc[i][j][4 * g + 3]);
        __syncthreads();
        int to_ = tid; asm volatile("" : "+v"(to_));
#pragma unroll
        for (int k = 0; k < 8; ++k) { const int c = to_ + 256 * k; const int lrow = c >> 4, ch = c & 15;
            const float4 a0 = *(const float4*)(Cf + lrow * CFS + ch * 8), a1 = *(const float4*)(Cf + lrow * CFS + ch * 8 + 4);
            const size_t go = (size_t)(mt * 128 + lrow) * 1024 + nt * 128 + ch * 8;
            const float4 x0 = *(const float4*)(p.x + go), x1 = *(const float4*)(p.x + go + 4);
            uint4 o; o.x = cvt_pk_bf16(x0.x + a0.x, x0.y + a0.y); o.y = cvt_pk_bf16(x0.z + a0.z, x0.w + a0.w); o.z = cvt_pk_bf16(x1.x + a1.x, x1.y + a1.y); o.w = cvt_pk_bf16(x1.z + a1.z, x1.w + a1.w);
            *(uint4*)(p.HB + go) = o; }
    }
}

template <int VAR = 0> __device__ void phase_route(const P& p, char* smem, int bid, int nblk) {
    float4* wre = (float4*)smem;
    const int tidp = opaque_tid();
    for (int idx = tidp; idx < 4096; idx += NTHR) { const int row = idx >> 2, g = idx & 3;
        wre[g * 1024 + (row >> 8) * 256 + (row & 3) * 64 + ((row & 255) >> 2)] = *(const float4*)(p.w_re + (size_t)row * 16 + g * 4); }
    constexpr int RCH = 64;
    int* lcnt = (int*)(smem + 65536); int* lbase = lcnt + 16; float* bre = (float*)(lcnt + 32); int* ent_e = lcnt + 48; int* ent_s = ent_e + 4 * RCH * 2; int* ent_v = ent_s + 4 * RCH * 2;
    if (tidp < 16) bre[tidp] = p.b_re[tidp];
    const int lane = tidp & 63; const int wv = tidp >> 6; const int nw = nblk * 4;
    float4 wg[16], gg[4];
#pragma unroll
    for (int i = 0; i < 4; ++i) { gg[i] = *(const float4*)(p.g_ffn + i * 256 + lane * 4);
#pragma unroll
        for (int j = 0; j < 4; ++j) wg[4 * i + j] = *(const float4*)(p.w_rg + (size_t)(i * 256 + lane * 4 + j) * 4); }
    const float brg0 = p.b_rg[0], brg1 = p.b_rg[1], brg2 = p.b_rg[2], brg3 = p.b_rg[3];
    const int tb = bid * 4;
    const int kmax = tb < T_TOK ? (T_TOK - tb + nw - 1) / nw : 0;
    uint2 nx[4];
    { const int t0 = tb + wv; const bf16_t* s0 = p.HB + (size_t)(t0 < T_TOK ? t0 : 0) * DM;
#pragma unroll
      for (int i = 0; i < 4; ++i) nx[i] = *(const uint2*)(s0 + i * 256 + lane * 4); }
    for (int k0 = 0; k0 < kmax; k0 += RCH) {
    __syncthreads();
    if (tidp < 16) lcnt[tidp] = 0;
    __syncthreads();
    for (int kk = 0; kk < RCH && k0 + kk < kmax; ++kk) {
        const int tok = tb + wv + (k0 + kk) * nw;
        if (tok >= T_TOK) break;
        float tv[16]; float ss = 0.f;
#pragma unroll
        for (int i = 0; i < 4; ++i) { const uint2 u = nx[i];
            float4 v; v.x = __uint_as_float(u.x << 16); v.y = __uint_as_float(u.x & 0xffff0000u); v.z = __uint_as_float(u.y << 16); v.w = __uint_as_float(u.y & 0xffff0000u);
            tv[4 * i] = v.x; tv[4 * i + 1] = v.y; tv[4 * i + 2] = v.z; tv[4 * i + 3] = v.w; ss += v.x * v.x + v.y * v.y + v.z * v.z + v.w * v.w; }
        { const int tn = tok + nw; const bf16_t* sn = p.HB + (size_t)(tn < T_TOK ? tn : tok) * DM;
#pragma unroll
          for (int i = 0; i < 4; ++i) nx[i] = *(const uint2*)(sn + i * 256 + lane * 4); }
        ss = wave_sum(ss);
        const float r = rsqrtf(ss * (1.0f / DM) + 1e-6f);
        float g0 = 0.f, g1 = 0.f, g2 = 0.f, g3 = 0.f;
#pragma unroll
        for (int i = 0; i < 4; ++i) {
            tv[4 * i] *= r * gg[i].x; tv[4 * i + 1] *= r * gg[i].y; tv[4 * i + 2] *= r * gg[i].z; tv[4 * i + 3] *= r * gg[i].w;
            uint2 o; o.x = cvt_pk_bf16(tv[4 * i], tv[4 * i + 1]); o.y = cvt_pk_bf16(tv[4 * i + 2], tv[4 * i + 3]);
            *(uint2*)((VAR ? (bf16_t*)p.SGS + (size_t)8 * 1024 * 1024 + (size_t)(tok & 16383) * DM : p.NBUF + (size_t)tok * DM) + i * 256 + lane * 4) = o;
#pragma unroll
            for (int j = 0; j < 4; ++j) { const float4 w = wg[4 * i + j]; const float x = tv[4 * i + j]; g0 += x * w.x; g1 += x * w.y; g2 += x * w.z; g3 += x * w.w; } }
        g0 = wave_sum(g0) + brg0; g1 = wave_sum(g1) + brg1; g2 = wave_sum(g2) + brg2; g3 = wave_sum(g3) + brg3;
        int grp = 0; float gm = g0;
        if (g1 > gm) { gm = g1; grp = 1; } if (g2 > gm) { gm = g2; grp = 2; } if (g3 > gm) { gm = g3; grp = 3; }
        const float pg = 1.0f / (expf(g0 - gm) + expf(g1 - gm) + expf(g2 - gm) + expf(g3 - gm));
        float e0 = 0.f, e1 = 0.f, e2 = 0.f, e3 = 0.f;
        const float4* wgp = wre + grp * 1024 + lane;
#pragma unroll
        for (int i = 0; i < 4; ++i)
#pragma unroll
            for (int j = 0; j < 4; ++j) { const float4 w = wgp[i * 256 + j * 64]; const float x = tv[4 * i + j]; e0 += x * w.x; e1 += x * w.y; e2 += x * w.z; e3 += x * w.w; }
        float el[4];
        el[0] = wave_sum(e0) + bre[grp * 4]; el[1] = wave_sum(e1) + bre[grp * 4 + 1]; el[2] = wave_sum(e2) + bre[grp * 4 + 2]; el[3] = wave_sum(e3) + bre[grp * 4 + 3];
        if (lane < 2 && VAR == 0) {
            int i0 = 0; float m0 = el[0];
            if (el[1] > m0) { m0 = el[1]; i0 = 1; } if (el[2] > m0) { m0 = el[2]; i0 = 2; } if (el[3] > m0) { m0 = el[3]; i0 = 3; }
            int i1 = -1; float m1 = -INFINITY;
            if (i0 != 0 && el[0] > m1) { m1 = el[0]; i1 = 0; } if (i0 != 1 && el[1] > m1) { m1 = el[1]; i1 = 1; }
            if (i0 != 2 && el[2] > m1) { m1 = el[2]; i1 = 2; } if (i0 != 3 && el[3] > m1) { m1 = el[3]; i1 = 3; }
            const float p1 = expf(m1 - m0);
            Route rt; rt.e0 = grp * 4 + i0; rt.e1 = grp * 4 + i1; rt.c0 = pg / (1.0f + p1); rt.c1 = pg * p1 / (1.0f + p1);
            if (lane == 0) p.ROUTE[tok] = rt;
            const int e = lane == 0 ? rt.e0 : rt.e1; const int idx = (wv * RCH + kk) * 2 + lane;
            ent_e[idx] = e; ent_s[idx] = atomicAdd(&lcnt[e], 1); ent_v[idx] = tok * 2 + lane;
        }
    }
    if (VAR == 0) {
        __syncthreads();
        if (tidp < 16) lbase[tidp] = lcnt[tidp] > 0 ? atomicAdd(&p.CNT[tidp * 64], lcnt[tidp]) : 0;
        __syncthreads();
#pragma unroll 1
        for (int i = tidp; i < 4 * RCH * 2; i += NTHR) { const int w_ = i / (RCH * 2), k_ = (i % (RCH * 2)) >> 1;
            if (k0 + k_ < kmax && tb + w_ + (k0 + k_) * nw < T_TOK) { const int e = ent_e[i]; p.LIST[e * LIST_CAP + lbase[e] + ent_s[i]] = ent_v[i]; } }
    }
    }
}

template <int DOWN> __device__ void phase_moe(const P& p, char* smem, int bid, int nblk, const Sched& sc) {
    bf16_t* As = (bf16_t*)smem; bf16_t* Bs = As + 128 * 64; bf16_t* Cs = (bf16_t*)smem;
    int* ents = (int*)(smem + 73728); float* cws = (float*)(ents + 128);
    const int tid = opaque_tid(), lane = tid & 63, wid = tid >> 6, wr = wid >> 1, wc = wid & 1;
    const int l31 = lane & 31, lh = lane >> 5;
    int cnt[16]; int total = 0;
#pragma unroll
    for (int e = 0; e < 16; ++e) { cnt[e] = p.CNT[e * 64]; total += ((cnt[e] + 127) >> 7) * 8; }
    const XOrder xo(bid, nblk, sc);
    for (int rr = 0; ; ++rr) {
        int u; if (!xo.round(rr, total, u)) break; if (u < 0) continue;
        int e = 0, base = 0, ce = 0;
#pragma unroll
        for (int k = 0; k < 16; ++k) { const int n = ((cnt[k] + 127) >> 7) * 8; if (u >= base + n && k == e) { base += n; e = k + 1; } if (k == e) ce = cnt[k]; }
        const int loc = u - base; const int mt = loc >> 3, nt = loc & 7;
        const int nrows = min(128, ce - mt * 128);
        __syncthreads();
        if (tid < 128) { const int ent = p.LIST[e * LIST_CAP + mt * 128 + (tid < nrows ? tid : 0)]; ents[tid] = ent;
            if (DOWN) { const Route rt = p.ROUTE[ent >> 1]; cws[tid] = (ent & 1) ? rt.c1 : rt.c0; } }
        __syncthreads();
        const int KK = DOWN ? 512 : 1024;
        const bf16_t* Xb = DOWN ? p.HID : p.NBUF;
        int tu_ = tid; asm volatile("" : "+v"(tu_));
        const int g0 = gl_row(tu_, 0);
        const unsigned ol0 = (unsigned)(DOWN ? ents[g0] : ents[g0] >> 1) * (unsigned)KK + gl_col(tu_, g0), ol1 = (unsigned)(DOWN ? ents[g0 + 8] : ents[g0 + 8] >> 1) * (unsigned)KK + gl_col(tu_, g0 + 8);
        const unsigned ol2 = (unsigned)(DOWN ? ents[g0 + 16] : ents[g0 + 16] >> 1) * (unsigned)KK + gl_col(tu_, g0 + 16), ol3 = (unsigned)(DOWN ? ents[g0 + 24] : ents[g0 + 24] >> 1) * (unsigned)KK + gl_col(tu_, g0 + 24);
        const bf16_t* Wb = (DOWN ? p.WEO + (size_t)e * 1024 * 512 : p.WEI + (size_t)e * 1024 * 1024) + (size_t)nt * 128 * KK;
        const unsigned w0 = (unsigned)g0 * (unsigned)KK + gl_col(tu_, g0), w1 = (unsigned)(g0 + 8) * (unsigned)KK + gl_col(tu_, g0 + 8), w2 = (unsigned)(g0 + 16) * (unsigned)KK + gl_col(tu_, g0 + 16), w3 = (unsigned)(g0 + 24) * (unsigned)KK + gl_col(tu_, g0 + 24);
        f32x16 acc[2][2]; ZERO_ACC(acc);
        gemm_mainloop(Wb, w0, w1, w2, w3, Xb, ol0, ol1, ol2, ol3, KK, acc, As, Bs);
        if (DOWN) {
#pragma unroll
            for (int j = 0; j < 2; ++j) { const float c = cws[64 * wc + 32 * j + l31];
#pragma unroll
                for (int i = 0; i < 2; ++i)
#pragma unroll
                    for (int r = 0; r < 16; ++r) acc[i][j][r] *= c; }
        } else {
#pragma unroll
            for (int j = 0; j < 2; ++j)
#pragma unroll
                for (int r = 0; r < 16; ++r) { const float g = acc[0][j][r]; acc[0][j][r] = g * __builtin_amdgcn_rcpf(1.0f + __expf(-g)) * acc[1][j][r]; }
        }
        __syncthreads();
        if (DOWN) cimg_write(acc, Cs, wr, wc, l31, lh);
        else {
#pragma unroll
            for (int j = 0; j < 2; ++j)
#pragma unroll
                for (int g = 0; g < 4; ++g) { uint2 o; o.x = cvt_pk_bf16(acc[0][j][4 * g], acc[0][j][4 * g + 1]); o.y = cvt_pk_bf16(acc[0][j][4 * g + 2], acc[0][j][4 * g + 3]);
                    *(uint2*)(Cs + (64 * wc + 32 * j + l31) * CSTR + 32 * wr + 8 * g + 4 * lh) = o; }
        }
        __syncthreads();
        int te_ = tid; asm volatile("" : "+v"(te_));
        if (DOWN) {
#pragma unroll
            for (int k = 0; k < 8; ++k) { const int c = te_ + 256 * k; const int lrow = c >> 4, ch = c & 15;
                if (lrow < nrows) { const uint4 v = *(const uint4*)(Cs + lrow * CSTR + ch * 8); *(uint4*)(p.YMOE + (size_t)ents[lrow] * 1024 + nt * 128 + ch * 8) = v; } }
        } else {
#pragma unroll
            for (int k = 0; k < 4; ++k) { const int c = te_ + 256 * k; const int lrow = c >> 3, ch = c & 7;
                if (lrow < nrows) { const uint4 v = *(const uint4*)(Cs + lrow * CSTR + ch * 8); *(uint4*)(p.HID + (size_t)ents[lrow] * 512 + nt * 64 + ch * 8) = v; } }
        }
    }
}

template <int VAR = 0> __device__ void phase_final(const P& p, int bid, int nblk) {
    const int tidp = opaque_tid();
    const int lane = tidp & 63; const int gw = bid * 4 + (tidp >> 6), nw = nblk * 4;
    for (int tok = gw; tok < T_TOK; tok += nw) {
        float* hp = p.out + (size_t)tok * DM; const bf16_t* hb = p.HB + (size_t)tok * DM; const bf16_t* y0 = p.YMOE + (size_t)tok * 2 * DM; const bf16_t* y1 = y0 + DM;
        float4 v[4]; float ss = 0.f;
#pragma unroll
        for (int i = 0; i < 4; ++i) { const uint2 hu = *(const uint2*)(hb + i * 256 + lane * 4);
            v[i].x = __uint_as_float(hu.x << 16); v[i].y = __uint_as_float(hu.x & 0xffff0000u); v[i].z = __uint_as_float(hu.y << 16); v[i].w = __uint_as_float(hu.y & 0xffff0000u);
            const uint2 a = *(const uint2*)(y0 + i * 256 + lane * 4), b = *(const uint2*)(y1 + i * 256 + lane * 4);
            v[i].x += __uint_as_float(a.x << 16) + __uint_as_float(b.x << 16); v[i].y += __uint_as_float(a.x & 0xffff0000u) + __uint_as_float(b.x & 0xffff0000u);
            v[i].z += __uint_as_float(a.y << 16) + __uint_as_float(b.y << 16); v[i].w += __uint_as_float(a.y & 0xffff0000u) + __uint_as_float(b.y & 0xffff0000u);
            ss += v[i].x * v[i].x + v[i].y * v[i].y + v[i].z * v[i].z + v[i].w * v[i].w; }
        ss = wave_sum(ss);
        const float r = rsqrtf(ss * (1.0f / DM) + 1e-6f);
#pragma unroll
        for (int i = 0; i < 4; ++i) { const float4 gg = *(const float4*)(p.g_fin + i * 256 + lane * 4);
            float4 o; o.x = v[i].x * r * gg.x; o.y = v[i].y * r * gg.y; o.z = v[i].z * r * gg.z; o.w = v[i].w * r * gg.w;
            *(float4*)((VAR ? (float*)p.SGS + (size_t)4 * 1024 * 1024 + (size_t)(tok & 8191) * DM : hp) + i * 256 + lane * 4) = o; }
    }
}
__device__ __forceinline__ float fast_exp2(float x) { return __builtin_amdgcn_exp2f(x); }
typedef float f32x2v __attribute__((ext_vector_type(2)));
template <int KIND, int VAR = 0> __device__ void phase_attn(const P& p, char* smem, int bid, int nblk, const Sched& sc) {
    constexpr int NM = 1, NMAPS = KIND == 0 ? 2 : 1, DQK = KIND == 2 ? 128 : 64, DV = KIND == 1 ? 64 : 128;
    constexpr int KROW = DQK, QROW = NMAPS * DQK, KSTR = KROW + 8, VSTR = 72, NDT = DV / 32, NKS = DQK / 16;
    constexpr int KCH = 64 * KROW / 8 / NTHR, VCH = DV * 8 / NTHR;
    constexpr int NH = KIND == 1 ? 8 : 4;
    constexpr int NUNITS = NBATCH * NH * 64;
    constexpr bool DB = KIND != 2;
    bf16_t* Ks = (bf16_t*)smem; bf16_t* Vs = Ks + (DB ? 2 : 1) * 64 * KSTR;
    const int tid = opaque_tid(), lane = tid & 63, wid = tid >> 6, l31 = lane & 31, lh = lane >> 5;
    const float c = (KIND == 2 ? 0.08838834764831845f : 0.125f) * 1.4426950408889634f;
    float lam = 0.f;
    if (KIND == 0) { float d1 = 0.f, d2 = 0.f; for (int i = 0; i < 64; ++i) { d1 += p.lq1[i] * p.lk1[i]; d2 += p.lq2[i] * p.lk2[i]; } lam = expf(d1) - expf(d2) + 0.2f; }
    const bf16_t* Qb = KIND == 0 ? p.DQ : KIND == 1 ? p.SQ : p.MQ;
    const bf16_t* Kb = KIND == 0 ? p.DK : KIND == 1 ? p.SK : p.MK;
    const bf16_t* Vb = KIND == 0 ? p.DVT : KIND == 1 ? p.SVT : p.MVT;
    bf16_t* Yb = VAR != 0 ? (bf16_t*)p.SGS + (size_t)16 * 1024 * 1024 : KIND == 0 ? p.YD : KIND == 1 ? p.YS : p.YM;
    constexpr int VLEN = KIND == 2 ? 256 : S_LEN;
    const bool xaware = false;
    for (int rnd = 0; xaware ? (rnd < NBATCH * NH / 8) : (rnd * nblk < NUNITS); ++rnd) {
        int qt, bh;
        if (xaware) { bh = sc.x * (NBATCH * NH / 8) + rnd; qt = (rnd & 1) ? sc.j : 63 - sc.j; }
        else { const int rank = rnd * nblk + ((rnd & 1) ? nblk - 1 - bid : bid); if (rank >= NUNITS) continue;
               qt = KIND == 2 ? rank % 64 : 63 - rank / (NBATCH * NH); bh = KIND == 2 ? rank / 64 : rank % (NBATCH * NH); }
        const int b = bh / NH, h = bh % NH;
        const int q0 = qt * 128, qw = q0 + 32 * wid;
        const int nkt = KIND == 2 ? 4 : 2 * (qt + 1);
        unsigned o1pk[NDT][8];
#pragma unroll 1
        for (int map = 0; map < NMAPS; ++map) {
        bf16x8 qf[NM][NKS];
        const bf16_t* qp = Qb + ((size_t)(b * S_LEN + qw + l31)) * 512 + h * QROW + map * DQK + lh * 8;
        if (KIND != 2) {
#pragma unroll
            for (int m = 0; m < NM; ++m)
#pragma unroll
                for (int ks = 0; ks < NKS; ++ks) qf[m][ks] = *(const bf16x8*)(qp + m * DQK + ks * 16);
        }
        f32x16 o[NM][NDT];
#pragma unroll
        for (int m = 0; m < NM; ++m)
#pragma unroll
            for (int dt = 0; dt < NDT; ++dt)
#pragma unroll
                for (int r = 0; r < 16; ++r) o[m][dt][r] = 0.f;
        float mrow[NM], lrow[NM];
#pragma unroll
        for (int m = 0; m < NM; ++m) { mrow[m] = -INFINITY; lrow[m] = 0.f; }
        int tid_l = tid; asm volatile("" : "+v"(tid_l));
        const bf16_t* ksrc = Kb + ((size_t)(KIND == 2 ? b * 256 : b * S_LEN) + (tid_l >> (KROW == 128 ? 4 : 3))) * 512 + h * QROW + map * DQK + (tid_l & (KROW / 8 - 1)) * 8;
        constexpr int KROWS_PER_PASS = NTHR / (KROW / 8);
        const int krow_ = tid_l >> (KROW == 128 ? 4 : 3);
        bf16_t* kdst = Ks + ((krow_ & ~12) | ((krow_ & 4) << 1) | ((krow_ & 8) >> 1)) * KSTR + (tid_l & (KROW / 8 - 1)) * 8;
        const bf16_t* vsrc = Vb + ((size_t)(bh * DV + (tid_l >> 3))) * VLEN + (tid_l & 7) * 8;
        bf16_t* vdst = Vs + (tid_l >> 3) * VSTR + (tid_l & 7) * 8;
        uint4 rk0, rk1, rk2 = make_uint4(0,0,0,0), rk3 = make_uint4(0,0,0,0), rv0, rv1, rv2 = make_uint4(0,0,0,0), rv3 = make_uint4(0,0,0,0);
        { const bf16_t* s_ = ksrc + (size_t)(0) * 512; rk0 = *(const uint4*)(s_); rk1 = *(const uint4*)(s_ + (size_t)KROWS_PER_PASS * 512); if (KCH > 2) { rk2 = *(const uint4*)(s_ + (size_t)2 * KROWS_PER_PASS * 512); rk3 = *(const uint4*)(s_ + (size_t)3 * KROWS_PER_PASS * 512); } }
        { const bf16_t* s_ = vsrc + ((size_t)0); rv0 = *(const uint4*)(s_); rv1 = *(const uint4*)(s_ + (size_t)32 * VLEN); if (VCH > 2) { rv2 = *(const uint4*)(s_ + (size_t)64 * VLEN); rv3 = *(const uint4*)(s_ + (size_t)96 * VLEN); } }
        __syncthreads();
        { *(uint4*)(kdst) = rk0; *(uint4*)(kdst + KROWS_PER_PASS * KSTR) = rk1; if (KCH > 2) { *(uint4*)(kdst + 2 * KROWS_PER_PASS * KSTR) = rk2; *(uint4*)(kdst + 3 * KROWS_PER_PASS * KSTR) = rk3; } }
        { *(uint4*)(vdst) = rv0; *(uint4*)(vdst + 32 * VSTR) = rv1; if (VCH > 2) { *(uint4*)(vdst + 64 * VSTR) = rv2; *(uint4*)(vdst + 96 * VSTR) = rv3; } }
        __syncthreads();
        if (!DB && nkt > 1) { const bf16_t* s_ = ksrc + (size_t)(64) * 512; rk0 = *(const uint4*)(s_); rk1 = *(const uint4*)(s_ + (size_t)KROWS_PER_PASS * 512); if (KCH > 2) { rk2 = *(const uint4*)(s_ + (size_t)2 * KROWS_PER_PASS * 512); rk3 = *(const uint4*)(s_ + (size_t)3 * KROWS_PER_PASS * 512); } }
        uint2 mwn = make_uint2(0u, 0u);
        if (KIND == 1) mwn = *(const uint2*)(p.MASK + ((size_t)(b * S_LEN + qw + l31)) * 256);
        for (int kt = 0; kt < nkt; ++kt) {
            const bool active = KIND == 2 ? true : (kt * 64 <= qw + 31);
            const bf16_t* Kc = Ks + (DB ? (kt & 1) * 64 * KSTR : 0); const bf16_t* Vc = Vs + (DB ? (kt & 1) * DV * VSTR : 0);
            if (DB && kt + 1 < nkt && VAR != 6 && VAR != 7) {
                { const bf16_t* s_ = ksrc + (size_t)((kt + 1) * 64) * 512; rk0 = *(const uint4*)(s_); rk1 = *(const uint4*)(s_ + (size_t)KROWS_PER_PASS * 512); if (KCH > 2) { rk2 = *(const uint4*)(s_ + (size_t)2 * KROWS_PER_PASS * 512); rk3 = *(const uint4*)(s_ + (size_t)3 * KROWS_PER_PASS * 512); } }
                { const bf16_t* s_ = vsrc + ((size_t)(kt + 1) * 64); rv0 = *(const uint4*)(s_); rv1 = *(const uint4*)(s_ + (size_t)32 * VLEN); if (VCH > 2) { rv2 = *(const uint4*)(s_ + (size_t)64 * VLEN); rv3 = *(const uint4*)(s_ + (size_t)96 * VLEN); } }
            }
            __builtin_amdgcn_sched_barrier(0);
            unsigned pk[NM][2][2][4];
            if (active) {
                uint2 mw = mwn;
                if (KIND == 1) { mw.x >>= 8 * lh; mw.y >>= 8 * lh; if (kt + 1 < nkt) mwn = *(const uint2*)(p.MASK + ((size_t)(b * S_LEN + qw + l31)) * 256 + (kt + 1) * 2); }
#pragma unroll
                for (int m = 0; m < NM; ++m) {
                    f32x16 s[2];
#pragma unroll
                    for (int r = 0; r < 16; ++r) { s[0][r] = 0.f; s[1][r] = 0.f; }
#pragma unroll
                    for (int ks = 0; ks < NKS; ks += 2) {
                        const bf16x8 a00 = *(const bf16x8*)(Kc + l31 * KSTR + m * DQK + ks * 16 + lh * 8);
                        const bf16x8 a10 = *(const bf16x8*)(Kc + (32 + l31) * KSTR + m * DQK + ks * 16 + lh * 8);
                        const bf16x8 a01 = *(const bf16x8*)(Kc + l31 * KSTR + m * DQK + (ks + 1) * 16 + lh * 8);
                        const bf16x8 a11 = *(const bf16x8*)(Kc + (32 + l31) * KSTR + m * DQK + (ks + 1) * 16 + lh * 8);
                        const bf16x8 q0_ = KIND == 2 ? *(const bf16x8*)(qp + ks * 16) : qf[m][ks];
                        const bf16x8 q1_ = KIND == 2 ? *(const bf16x8*)(qp + (ks + 1) * 16) : qf[m][ks + 1];
                        __builtin_amdgcn_sched_barrier(0);
                        if (VAR != 5) {
                        s[0] = __builtin_amdgcn_mfma_f32_32x32x16_bf16(a00, q0_, s[0], 0, 0, 0);
                        s[1] = __builtin_amdgcn_mfma_f32_32x32x16_bf16(a10, q0_, s[1], 0, 0, 0);
                        s[0] = __builtin_amdgcn_mfma_f32_32x32x16_bf16(a01, q1_, s[0], 0, 0, 0);
                        s[1] = __builtin_amdgcn_mfma_f32_32x32x16_bf16(a11, q1_, s[1], 0, 0, 0);
                        } else { asm volatile("" :: "v"(a00), "v"(a10), "v"(a01), "v"(a11)); }
                    }
                    if (KIND == 0 && kt * 64 + 63 > qw) {
                        const int qi = qw + l31 - kt * 64 - 8 * lh;
#pragma unroll
                        for (int t = 0; t < 2; ++t)
#pragma unroll
                            for (int r = 0; r < 16; ++r) if (32 * t + (r & 7) + 16 * (r >> 3) > qi) s[t][r] = -INFINITY;
                    }
                    float mx = s[0][0];
#pragma unroll
                    for (int r = 1; r < 16; ++r) mx = fmaxf(mx, s[0][r]);
#pragma unroll
                    for (int r = 0; r < 16; ++r) mx = fmaxf(mx, s[1][r]);
                    mx = xhalf_max(mx);
                    const float mnew = fmaxf(mrow[m], mx * c);
                    const float corr = fast_exp2(mrow[m] - mnew);
                    mrow[m] = mnew;
                    f32x2v ps2 = {0.f, 0.f}; const f32x2v c2 = {c, c}, nm2 = {-mnew, -mnew};
#pragma unroll
                    for (int t = 0; t < 2; ++t)
#pragma unroll
                        for (int r = 0; r < 16; r += 2) {
                            const f32x2v sv = {s[t][r], s[t][r + 1]};
                            const f32x2v y = VAR == 3 ? sv : sv * c2 + nm2;
                            f32x2v pv = {(VAR == 1 || VAR == 3) ? y.x : fast_exp2(y.x), (VAR == 1 || VAR == 3) ? y.y : fast_exp2(y.y)};
                            if (KIND == 1) { int m0 = __builtin_amdgcn_sbfe((int)(t ? mw.y : mw.x), (r & 7) + 16 * (r >> 3), 1), m1 = __builtin_amdgcn_sbfe((int)(t ? mw.y : mw.x), ((r + 1) & 7) + 16 * ((r + 1) >> 3), 1);
                                             asm("" : "+v"(m0), "+v"(m1));
                                             pv.x = __uint_as_float(__float_as_uint(pv.x) & (unsigned)m0); pv.y = __uint_as_float(__float_as_uint(pv.y) & (unsigned)m1); }
                            ps2 += pv; s[t][r] = pv.x; s[t][r + 1] = pv.y;
                        }
                    const float psum = ps2.x + ps2.y;
                    lrow[m] = lrow[m] * corr + psum;
#pragma unroll
                    for (int t = 0; t < 2; ++t)
#pragma unroll
                        for (int s2 = 0; s2 < 2; ++s2)
#pragma unroll
                            for (int j = 0; j < 4; ++j) pk[m][t][s2][j] = cvt_pk_bf16(s[t][8 * s2 + 2 * j], s[t][8 * s2 + 2 * j + 1]);
                    if (__any(corr != 1.0f)) {
#pragma unroll
                        for (int dt = 0; dt < NDT; ++dt)
#pragma unroll
                            for (int r = 0; r < 16; ++r) o[m][dt][r] *= corr;
                    }
                }
            }
            if (!DB) {
            __syncthreads();
            if (kt + 1 < nkt) {
                { *(uint4*)(kdst) = rk0; *(uint4*)(kdst + KROWS_PER_PASS * KSTR) = rk1; if (KCH > 2) { *(uint4*)(kdst + 2 * KROWS_PER_PASS * KSTR) = rk2; *(uint4*)(kdst + 3 * KROWS_PER_PASS * KSTR) = rk3; } }
                { const bf16_t* s_ = vsrc + ((size_t)(kt + 1) * 64); rv0 = *(const uint4*)(s_); rv1 = *(const uint4*)(s_ + (size_t)32 * VLEN); if (VCH > 2) { rv2 = *(const uint4*)(s_ + (size_t)64 * VLEN); rv3 = *(const uint4*)(s_ + (size_t)96 * VLEN); } }
            }
            }
            if (active) {
                constexpr int GS = NDT == 4 ? 1 : 2;
#pragma unroll
                for (int ks2 = 0; ks2 < 4; ks2 += GS) {
                    bf16x8 va[GS][NDT];
#pragma unroll
                    for (int g = 0; g < GS; ++g)
#pragma unroll
                        for (int dt = 0; dt < NDT; ++dt) {
                            va[g][dt] = *(const bf16x8*)(Vc + (32 * dt + l31) * VSTR + 16 * (ks2 + g) + 8 * lh);
                        }
                    __builtin_amdgcn_sched_barrier(0);
#pragma unroll
                    for (int g = 0; g < GS; ++g)
#pragma unroll
                        for (int dt = 0; dt < NDT; ++dt)
#pragma unroll
                            for (int m = 0; m < NM; ++m) {
                                const int k2 = ks2 + g;
                                const uint4 pu = make_uint4(pk[m][k2 >> 1][k2 & 1][0], pk[m][k2 >> 1][k2 & 1][1], pk[m][k2 >> 1][k2 & 1][2], pk[m][k2 >> 1][k2 & 1][3]);
                                if (VAR != 2) o[m][dt] = __builtin_amdgcn_mfma_f32_32x32x16_bf16(va[g][dt], *(const bf16x8*)&pu, o[m][dt], 0, 0, 0); else { o[m][dt][0] += __uint_as_float(pu.x); asm volatile("" :: "v"(va[g][dt])); }
                            }
                }
            }
            if (DB) {
                if (kt + 1 < nkt && VAR != 6 && VAR != 7) {
                    bf16_t* kd = kdst + ((kt + 1) & 1) * 64 * KSTR; bf16_t* vd = vdst + ((kt + 1) & 1) * DV * VSTR;
                    { *(uint4*)(kd) = rk0; *(uint4*)(kd + KROWS_PER_PASS * KSTR) = rk1; if (KCH > 2) { *(uint4*)(kd + 2 * KROWS_PER_PASS * KSTR) = rk2; *(uint4*)(kd + 3 * KROWS_PER_PASS * KSTR) = rk3; } }
                    { *(uint4*)(vd) = rv0; *(uint4*)(vd + 32 * VSTR) = rv1; if (VCH > 2) { *(uint4*)(vd + 64 * VSTR) = rv2; *(uint4*)(vd + 96 * VSTR) = rv3; } }
                }
                if (VAR != 7) __syncthreads();
            } else {
            __syncthreads();
            if (kt + 1 < nkt) {
                { *(uint4*)(vdst) = rv0; *(uint4*)(vdst + 32 * VSTR) = rv1; if (VCH > 2) { *(uint4*)(vdst + 64 * VSTR) = rv2; *(uint4*)(vdst + 96 * VSTR) = rv3; } }
                if (kt + 2 < nkt) { const bf16_t* s_ = ksrc + (size_t)((kt + 2) * 64) * 512; rk0 = *(const uint4*)(s_); rk1 = *(const uint4*)(s_ + (size_t)KROWS_PER_PASS * 512); if (KCH > 2) { rk2 = *(const uint4*)(s_ + (size_t)2 * KROWS_PER_PASS * 512); rk3 = *(const uint4*)(s_ + (size_t)3 * KROWS_PER_PASS * 512); } }
            }
            }
        }
#pragma unroll
        for (int m = 0; m < NM; ++m) lrow[m] = xhalf_sum(lrow[m]);
        bf16_t* yp = Yb + ((size_t)(b * S_LEN + qw + l31)) * 512 + h * DV + 4 * lh;
        if (KIND == 0) {
            if (map == 0) {
                const float i1 = 1.0f / lrow[0];
#pragma unroll
                for (int dt = 0; dt < NDT; ++dt)
#pragma unroll
                    for (int j = 0; j < 8; ++j) o1pk[dt][j] = cvt_pk_bf16(o[0][dt][2 * j] * i1, o[0][dt][2 * j + 1] * i1);
            } else {
            const float i2 = lam / lrow[0];
            float ss = 0.f;
#pragma unroll
            for (int dt = 0; dt < NDT; ++dt)
#pragma unroll
                for (int r = 0; r < 16; ++r) { const float o1 = (r & 1) ? __uint_as_float(o1pk[dt][r >> 1] & 0xffff0000u) : __uint_as_float(o1pk[dt][r >> 1] << 16);
                    const float v = o1 - o[0][dt][r] * i2; o[0][dt][r] = v; ss += v * v; }
            ss = xhalf_sum(ss);
            const float rn = rsqrtf(ss * (1.0f / 128.0f) + 1e-6f) * 0.8f;
#pragma unroll
            for (int dt = 0; dt < NDT; ++dt)
#pragma unroll
                for (int g = 0; g < 4; ++g) { const int dv = 32 * dt + 8 * g + 4 * lh; const float4 gs = *(const float4*)(p.g_sub + dv);
                    uint2 w; w.x = cvt_pk_bf16(o[0][dt][4 * g] * rn * gs.x, o[0][dt][4 * g + 1] * rn * gs.y); w.y = cvt_pk_bf16(o[0][dt][4 * g + 2] * rn * gs.z, o[0][dt][4 * g + 3] * rn * gs.w);
                    *(uint2*)(yp + 32 * dt + 8 * g) = w; }
            }
        } else {
            const float i1 = 1.0f / lrow[0];
#pragma unroll
            for (int dt = 0; dt < NDT; ++dt)
#pragma unroll
                for (int g = 0; g < 4; ++g) {
                    uint2 w; w.x = cvt_pk_bf16(o[0][dt][4 * g] * i1, o[0][dt][4 * g + 1] * i1); w.y = cvt_pk_bf16(o[0][dt][4 * g + 2] * i1, o[0][dt][4 * g + 3] * i1);
                    *(uint2*)(yp + 32 * dt + 8 * g) = w; }
        }
        }
    }
}
template <int KIND> __device__ void phase_attn2(const P& p, char* smem, int bid, int nblk, const Sched& sc) {
    constexpr int NMAPS = KIND == 0 ? 2 : 1, DQK = 64, DV = KIND == 1 ? 64 : 128;
    constexpr int QROW = NMAPS * DQK, KSTR = 72, VSTR = 72, NDT = DV / 32, NKS = 4;
    constexpr int VCH = DV * 8 / NTHR;
    constexpr int NH = KIND == 1 ? 8 : 4;
    constexpr int NUNITS = NBATCH * NH * 64;
    bf16_t* Ks = (bf16_t*)smem; bf16_t* Vs = Ks + 2 * 64 * KSTR;
    const int tid = opaque_tid(), lane = tid & 63, wid = tid >> 6, l31 = lane & 31, lh = lane >> 5;
    const float c = 0.125f * 1.4426950408889634f;
    float lam = 0.f;
    if (KIND == 0) { float d1 = 0.f, d2 = 0.f; for (int i = 0; i < 64; ++i) { d1 += p.lq1[i] * p.lk1[i]; d2 += p.lq2[i] * p.lk2[i]; } lam = expf(d1) - expf(d2) + 0.2f; }
    const bf16_t* Qb = KIND == 0 ? p.DQ : p.SQ;
    const bf16_t* Kb = KIND == 0 ? p.DK : p.SK;
    const bf16_t* Vb = KIND == 0 ? p.DVT : p.SVT;
    bf16_t* Yb = KIND == 0 ? p.YD : p.YS;
    const bool xaware = false;
    for (int rnd = 0; xaware ? (rnd < NBATCH * NH / 8) : (rnd * nblk < NUNITS); ++rnd) {
        int qt, bh;
        if (xaware) { bh = sc.x * (NBATCH * NH / 8) + rnd; qt = (rnd & 1) ? sc.j : 63 - sc.j; }
        else { const int rank = rnd * nblk + ((rnd & 1) ? nblk - 1 - bid : bid); if (rank >= NUNITS) continue; qt = 63 - rank / (NBATCH * NH); bh = rank % (NBATCH * NH); }
        const int b = bh / NH, h = bh % NH;
        const int q0 = qt * 128, qw = q0 + 32 * wid;
        const int nkt = 2 * (qt + 1);
        const int last_act = min(nkt - 1, (qw + 31) >> 6);
#pragma unroll 1
        for (int map = 0; map < NMAPS; ++map) {
        bf16x8 qf[NKS];
        { const bf16_t* qp = Qb + ((size_t)(b * S_LEN + qw + l31)) * 512 + h * QROW + map * DQK + lh * 8;
#pragma unroll
          for (int ks = 0; ks < NKS; ++ks) qf[ks] = *(const bf16x8*)(qp + ks * 16); }
        f32x16 o[NDT];
#pragma unroll
        for (int dt = 0; dt < NDT; ++dt)
#pragma unroll
            for (int r = 0; r < 16; ++r) o[dt][r] = 0.f;
        float mrow = -INFINITY, lrow = 0.f;
        int tl_ = tid; asm volatile("" : "+v"(tl_));
        const bf16_t* ksrc = Kb + ((size_t)b * S_LEN + (tl_ >> 3)) * 512 + h * QROW + map * DQK + (tl_ & 7) * 8;
        bf16_t* kdst = Ks + (tl_ >> 3) * KSTR + (tl_ & 7) * 8;
        const bf16_t* vsrc = Vb + ((size_t)(bh * DV + (tl_ >> 3))) * S_LEN + (tl_ & 7) * 8;
        bf16_t* vdst = Vs + (tl_ >> 3) * VSTR + (tl_ & 7) * 8;
        uint4 rk0, rk1, rv0, rv1, rv2 = make_uint4(0, 0, 0, 0), rv3 = make_uint4(0, 0, 0, 0);
#define LDK(kt_) { const bf16_t* s_ = ksrc + (size_t)((kt_) * 64) * 512; rk0 = *(const uint4*)(s_); rk1 = *(const uint4*)(s_ + (size_t)32 * 512); }
#define LDV(kt_) { const bf16_t* s_ = vsrc + (size_t)(kt_) * 64; rv0 = *(const uint4*)(s_); rv1 = *(const uint4*)(s_ + (size_t)32 * S_LEN); if (VCH > 2) { rv2 = *(const uint4*)(s_ + (size_t)64 * S_LEN); rv3 = *(const uint4*)(s_ + (size_t)96 * S_LEN); } }
#define STK(buf_) { bf16_t* d_ = kdst + (buf_) * 64 * KSTR; *(uint4*)(d_) = rk0; *(uint4*)(d_ + 32 * KSTR) = rk1; }
#define STV(buf_) { bf16_t* d_ = vdst + (buf_) * DV * VSTR; *(uint4*)(d_) = rv0; *(uint4*)(d_ + 32 * VSTR) = rv1; if (VCH > 2) { *(uint4*)(d_ + 64 * VSTR) = rv2; *(uint4*)(d_ + 96 * VSTR) = rv3; } }
        LDK(0) LDV(0)
        __syncthreads();
        STK(0) STV(0)
        LDK(1)
        STK(1)
        __syncthreads();
        f32x16 s[2];
        auto qk = [&](int kt) {
            const bf16_t* Kc = Ks + (kt & 1) * 64 * KSTR;
#pragma unroll
            for (int r = 0; r < 16; ++r) { s[0][r] = 0.f; s[1][r] = 0.f; }
#pragma unroll
            for (int ks = 0; ks < NKS; ks += 2) {
                const bf16x8 a00 = *(const bf16x8*)(Kc + l31 * KSTR + ks * 16 + lh * 8), a10 = *(const bf16x8*)(Kc + (32 + l31) * KSTR + ks * 16 + lh * 8);
                const bf16x8 a01 = *(const bf16x8*)(Kc + l31 * KSTR + (ks + 1) * 16 + lh * 8), a11 = *(const bf16x8*)(Kc + (32 + l31) * KSTR + (ks + 1) * 16 + lh * 8);
                s[0] = __builtin_amdgcn_mfma_f32_32x32x16_bf16(a00, qf[ks], s[0], 0, 0, 0);
                s[1] = __builtin_amdgcn_mfma_f32_32x32x16_bf16(a10, qf[ks], s[1], 0, 0, 0);
                s[0] = __builtin_amdgcn_mfma_f32_32x32x16_bf16(a01, qf[ks + 1], s[0], 0, 0, 0);
                s[1] = __builtin_amdgcn_mfma_f32_32x32x16_bf16(a11, qf[ks + 1], s[1], 0, 0, 0);
            }
        };
        unsigned pkp[2][2][4], pkn[2][2][4];
        float corr = 1.0f;
        uint2 mw = make_uint2(0u, 0u);
        auto softmax = [&](int kt) {
            if (KIND == 0 && kt * 64 + 63 > qw) {
                const int qi = qw + l31 - kt * 64 - 4 * lh;
#pragma unroll
                for (int t = 0; t < 2; ++t)
#pragma unroll
                    for (int r = 0; r < 16; ++r) if (32 * t + (r & 3) + 8 * (r >> 2) > qi) s[t][r] = -INFINITY;
            }
            float mx = s[0][0];
#pragma unroll
            for (int r = 1; r < 16; ++r) mx = fmaxf(mx, s[0][r]);
#pragma unroll
            for (int r = 0; r < 16; ++r) mx = fmaxf(mx, s[1][r]);
            mx = xhalf_max(mx);
            const float mnew = fmaxf(mrow, mx * c);
            corr = fast_exp2(mrow - mnew);
            mrow = mnew;
            f32x2v ps2 = {0.f, 0.f}; const f32x2v c2 = {c, c}, nm2 = {-mnew, -mnew};
#pragma unroll
            for (int t = 0; t < 2; ++t)
#pragma unroll
                for (int r = 0; r < 16; r += 2) {
                    const f32x2v sv = {s[t][r], s[t][r + 1]};
                    const f32x2v y = sv * c2 + nm2;
                    f32x2v pv = {fast_exp2(y.x), fast_exp2(y.y)};
                    if (KIND == 1) { pv.x = __uint_as_float(__float_as_uint(pv.x) & (unsigned)__builtin_amdgcn_sbfe((int)(t ? mw.y : mw.x), (r & 3) + 8 * (r >> 2), 1));
                                     pv.y = __uint_as_float(__float_as_uint(pv.y) & (unsigned)__builtin_amdgcn_sbfe((int)(t ? mw.y : mw.x), ((r + 1) & 3) + 8 * ((r + 1) >> 2), 1)); }
                    ps2 += pv;
                    pkn[t][r >> 3][(r >> 1) & 3] = cvt_pk_bf16(pv.x, pv.y);
                }
            lrow = lrow * corr + (ps2.x + ps2.y);
        };
        auto pv_mma = [&](int kt) {
            const bf16_t* Vc = Vs + (kt % 3) * DV * VSTR;
            constexpr int GS = NDT == 4 ? 1 : 2;
#pragma unroll
            for (int ks2 = 0; ks2 < 4; ks2 += GS) {
                bf16x8 va[GS][NDT];
#pragma unroll
                for (int g = 0; g < GS; ++g)
#pragma unroll
                    for (int dt = 0; dt < NDT; ++dt) {
                        const bf16_t* vp = Vc + (32 * dt + l31) * VSTR + 16 * (ks2 + g) + 4 * lh;
                        const uint2 lo = *(const uint2*)vp, hi = *(const uint2*)(vp + 8);
                        const uint4 vv = make_uint4(lo.x, lo.y, hi.x, hi.y);
                        va[g][dt] = *(const bf16x8*)&vv;
                    }
#pragma unroll
                for (int g = 0; g < GS; ++g)
#pragma unroll
                    for (int dt = 0; dt < NDT; ++dt) {
                        const int k2 = ks2 + g;
                        const uint4 pu = make_uint4(pkp[k2 >> 1][k2 & 1][0], pkp[k2 >> 1][k2 & 1][1], pkp[k2 >> 1][k2 & 1][2], pkp[k2 >> 1][k2 & 1][3]);
                        o[dt] = __builtin_amdgcn_mfma_f32_32x32x16_bf16(va[g][dt], *(const bf16x8*)&pu, o[dt], 0, 0, 0);
                    }
            }
        };
        uint2 mwn = make_uint2(0u, 0u);
        if (KIND == 1) mwn = *(const uint2*)(p.MASK + ((size_t)(b * S_LEN + qw + l31)) * 256);
        qk(0);
        for (int kt = 0; kt <= nkt; ++kt) {
            if (kt + 2 < nkt) LDK(kt + 2)
            if (kt + 1 < nkt) LDV(kt + 1)
            const bool do_sm = kt <= last_act, do_pv = kt >= 1 && kt - 1 <= last_act;
            if (do_sm && KIND == 1) { mw = mwn; mw.x >>= 4 * lh; mw.y >>= 4 * lh; if (kt + 1 <= last_act) mwn = *(const uint2*)(p.MASK + ((size_t)(b * S_LEN + qw + l31)) * 256 + (kt + 1) * 2); }
            if (do_sm && do_pv) {
                softmax(kt); pv_mma(kt - 1);
            } else if (do_sm) softmax(kt);
            else if (do_pv) pv_mma(kt - 1);
            if (do_sm) {
                if (__any(corr != 1.0f)) {
#pragma unroll
                    for (int dt = 0; dt < NDT; ++dt)
#pragma unroll
                        for (int r = 0; r < 16; ++r) o[dt][r] *= corr;
                }
#pragma unroll
                for (int t = 0; t < 2; ++t)
#pragma unroll
                    for (int s2 = 0; s2 < 2; ++s2)
#pragma unroll
                        for (int j = 0; j < 4; ++j) pkp[t][s2][j] = pkn[t][s2][j];
            }
            if (kt + 1 <= last_act) qk(kt + 1);
            if (kt + 2 < nkt) STK(kt & 1)
            if (kt + 1 < nkt) STV((kt + 1) % 3)
            __syncthreads();
        }
#undef LDK
#undef LDV
#undef STK
#undef STV
        int te_ = tid; asm volatile("" : "+v"(te_));
        uint4* park = (uint4*)p.SGS + (size_t)bid * 2048 + te_;
        lrow = xhalf_sum(lrow);
        bf16_t* yp = Yb + ((size_t)(b * S_LEN + qw + l31)) * 512 + h * DV + 4 * lh;
        if (KIND == 0) {
            if (map == 0) {
                const float i1 = 1.0f / lrow;
#pragma unroll
                for (int dt = 0; dt < NDT; ++dt)
#pragma unroll
                    for (int h2 = 0; h2 < 2; ++h2)
                        park[(size_t)(dt * 2 + h2) * 256] = make_uint4(cvt_pk_bf16(o[dt][8 * h2] * i1, o[dt][8 * h2 + 1] * i1), cvt_pk_bf16(o[dt][8 * h2 + 2] * i1, o[dt][8 * h2 + 3] * i1),
                                                                      cvt_pk_bf16(o[dt][8 * h2 + 4] * i1, o[dt][8 * h2 + 5] * i1), cvt_pk_bf16(o[dt][8 * h2 + 6] * i1, o[dt][8 * h2 + 7] * i1));
                asm volatile("" ::: "memory");
            } else {
                const float i2 = lam / lrow;
                float ss = 0.f;
#pragma unroll
                for (int dt = 0; dt < NDT; ++dt)
#pragma unroll
                    for (int h2 = 0; h2 < 2; ++h2) { const uint4 w = park[(size_t)(dt * 2 + h2) * 256]; const unsigned ww[4] = {w.x, w.y, w.z, w.w};
#pragma unroll
                        for (int j = 0; j < 4; ++j) {
                            const float v0 = __uint_as_float(ww[j] << 16) - o[dt][8 * h2 + 2 * j] * i2, v1 = __uint_as_float(ww[j] & 0xffff0000u) - o[dt][8 * h2 + 2 * j + 1] * i2;
                            o[dt][8 * h2 + 2 * j] = v0; o[dt][8 * h2 + 2 * j + 1] = v1; ss += v0 * v0 + v1 * v1; } }
                ss = xhalf_sum(ss);
                const float rn = rsqrtf(ss * (1.0f / 128.0f) + 1e-6f) * 0.8f;
#pragma unroll
                for (int dt = 0; dt < NDT; ++dt)
#pragma unroll
                    for (int g = 0; g < 4; ++g) { const int dv = 32 * dt + 8 * g + 4 * lh; const float4 gs = *(const float4*)(p.g_sub + dv);
                        uint2 w; w.x = cvt_pk_bf16(o[dt][4 * g] * rn * gs.x, o[dt][4 * g + 1] * rn * gs.y); w.y = cvt_pk_bf16(o[dt][4 * g + 2] * rn * gs.z, o[dt][4 * g + 3] * rn * gs.w);
                        *(uint2*)(yp + 32 * dt + 8 * g) = w; }
            }
        } else {
            const float i1 = 1.0f / lrow;
#pragma unroll
            for (int dt = 0; dt < NDT; ++dt)
#pragma unroll
                for (int g = 0; g < 4; ++g) {
                    uint2 w; w.x = cvt_pk_bf16(o[dt][4 * g] * i1, o[dt][4 * g + 1] * i1); w.y = cvt_pk_bf16(o[dt][4 * g + 2] * i1, o[dt][4 * g + 3] * i1);
                    *(uint2*)(yp + 32 * dt + 8 * g) = w; }
        }
        }
    }
}
#define IDX_M 23
__device__ __forceinline__ float med3f(float a, float b, float c) { return __builtin_amdgcn_fmed3f(a, b, c); }
__device__ void phase_indexer(const P& p, char* smem, int bid, int nblk, const Sched& sc_) {
    bf16_t* Kb = (bf16_t*)smem;
    unsigned* mimg = (unsigned*)(smem + 18432);
    const int tid = opaque_tid(), lane = tid & 63, wid = tid >> 6, l31 = lane & 31, lh = lane >> 5;
    constexpr int NUNITS = NBATCH * 256;
    const bool xaware = false;
    for (int rnd = 0; xaware ? (rnd < 2) : (rnd * nblk < NUNITS); ++rnd) {
        int qu, b;
        if (xaware) { b = sc_.x >> 1; const int k = rnd == 0 ? 127 - sc_.j : sc_.j; qu = 2 * k + (sc_.x & 1); }
        else { const int rank = rnd * nblk + ((rnd & 1) ? nblk - 1 - bid : bid); if (rank >= NUNITS) continue; qu = 255 - (rank >> 2); b = rank & 3; }
        const int q0 = qu * 32;
        const size_t tok0 = (size_t)b * S_LEN + q0;
        if (q0 < 256) {
#pragma unroll 1
            for (int i = 0; i < 32; ++i) { const int q = q0 + i; const int w0 = tid * 32;
                p.MASK[(tok0 + i) * 256 + tid] = q >= w0 + 31 ? 0xffffffffu : (q < w0 ? 0u : ((2u << (q - w0)) - 1u)); }
            continue;
        }
        const int nkt = (q0 + 95) >> 6;
        const int qb = q0 + 8 * wid;
        bf16x8 aq[2][4]; float wq[2][2][8]; int qv[2][2];
#pragma unroll
        for (int rt = 0; rt < 2; ++rt) {
            const int qa = qb + 4 * rt + 2 * ((l31 >> 2) & 1) + (l31 >> 4), ha = 4 * ((l31 >> 3) & 1) + (l31 & 3);
            const bf16_t* ap = p.IQ + ((size_t)b * S_LEN + qa) * 512 + ha * 64 + lh * 8;
#pragma unroll
            for (int ks = 0; ks < 4; ++ks) aq[rt][ks] = *(const bf16x8*)(ap + ks * 16);
#pragma unroll
            for (int e = 0; e < 2; ++e) { const float* wp = p.IW + ((size_t)b * S_LEN + qb + 4 * rt + 2 * lh + e) * 8;
                const float4 w0 = *(const float4*)wp, w1 = *(const float4*)(wp + 4); const float sc = 0.125f * 0.35355339059327373f;
                wq[rt][e][0] = w0.x * sc; wq[rt][e][1] = w0.y * sc; wq[rt][e][2] = w0.z * sc; wq[rt][e][3] = w0.w * sc;
                wq[rt][e][4] = w1.x * sc; wq[rt][e][5] = w1.y * sc; wq[rt][e][6] = w1.z * sc; wq[rt][e][7] = w1.w * sc;
                qv[rt][e] = qb + 4 * rt + 2 * lh + e; }
        }
        const bf16_t* ksrc = p.IK + ((size_t)b * S_LEN + (tid >> 3)) * 64 + (tid & 7) * 8;
        bf16_t* kdst = Kb + (tid >> 3) * 72 + (tid & 7) * 8;
        auto tile_scores = [&](const bf16_t* kbuf, int t, float (&sc)[2][2]) {
            f32x16 acc[2];
#pragma unroll
            for (int r = 0; r < 16; ++r) { acc[0][r] = 0.f; acc[1][r] = 0.f; }
#pragma unroll
            for (int ks = 0; ks < 4; ++ks) {
                const bf16x8 kf = *(const bf16x8*)(kbuf + (32 * t + l31) * 72 + ks * 16 + lh * 8);
                acc[0] = __builtin_amdgcn_mfma_f32_32x32x16_bf16(aq[0][ks], kf, acc[0], 0, 0, 0);
                acc[1] = __builtin_amdgcn_mfma_f32_32x32x16_bf16(aq[1][ks], kf, acc[1], 0, 0, 0);
            }
#pragma unroll
            for (int rt = 0; rt < 2; ++rt)
#pragma unroll
                for (int e = 0; e < 2; ++e) { float s = 0.f;
#pragma unroll
                    for (int hd = 0; hd < 8; ++hd) s = __builtin_fmaf(wq[rt][e][hd], __int_as_float(max(__float_as_int(acc[rt][8 * e + hd]), 0)), s);
                    sc[rt][e] = s; }
        };
        float T[2][2]; int need[2][2];
        {
            float L[2][2][IDX_M];
#pragma unroll
            for (int rt = 0; rt < 2; ++rt)
#pragma unroll
                for (int e = 0; e < 2; ++e)
#pragma unroll
                    for (int i = 0; i < IDX_M; ++i) L[rt][e][i] = -INFINITY;
            __syncthreads();
            uint4 r0 = *(const uint4*)(ksrc), r1 = *(const uint4*)(ksrc + 32 * 64);
            *(uint4*)(kdst) = r0; *(uint4*)(kdst + 32 * 72) = r1;
            __syncthreads();
            for (int kt = 0; kt < nkt; ++kt) {
                const bf16_t* kbuf = Kb + (kt & 1) * 64 * 72;
                if (kt + 1 < nkt) { r0 = *(const uint4*)(ksrc + (size_t)(kt + 1) * 64 * 64); r1 = *(const uint4*)(ksrc + (size_t)(kt + 1) * 64 * 64 + 32 * 64); }
                __builtin_amdgcn_sched_barrier(0);
                const bool interior = kt * 64 + 63 <= qb;
#pragma unroll 1
                for (int t = 0; t < 2; ++t) {
                    float sc[2][2]; tile_scores(kbuf, t, sc);
                    const int key = kt * 64 + 32 * t + l31;
#pragma unroll
                    for (int rt = 0; rt < 2; ++rt)
#pragma unroll
                        for (int e = 0; e < 2; ++e) {
                            const float v = (interior || key <= qv[rt][e]) ? sc[rt][e] : -INFINITY;
#pragma unroll
                            for (int i = IDX_M - 1; i >= 1; --i) L[rt][e][i] = med3f(L[rt][e][i - 1], L[rt][e][i], v);
                            asm("v_max_f32 %0, %1, %2" : "=v"(L[rt][e][0]) : "v"(L[rt][e][0]), "v"(v));
                        }
                }
                if (kt + 1 < nkt) { bf16_t* d = kdst + ((kt + 1) & 1) * 64 * 72; *(uint4*)(d) = r0; *(uint4*)(d + 32 * 72) = r1; }
                __syncthreads();
            }
#pragma unroll
            for (int rt = 0; rt < 2; ++rt)
#pragma unroll
                for (int e = 0; e < 2; ++e) {
                    unsigned U[IDX_M];
#pragma unroll
                    for (int i = 0; i < IDX_M; ++i) { const unsigned bts = __float_as_uint(L[rt][e][i]); U[i] = bts ^ ((unsigned)((int)bts >> 31) | 0x80000000u); }
                    unsigned pre = 0u;
#pragma unroll 1
                    for (int bit = 31; bit >= 0; --bit) {
                        const unsigned cand = pre | (1u << bit);
                        int c0 = 0, c1 = 0;
#pragma unroll
                        for (int i = 0; i < IDX_M; ++i) { const unsigned long long m = __builtin_amdgcn_ballot_w64(U[i] >= cand); c0 += __popc((unsigned)m); c1 += __popc((unsigned)(m >> 32)); }
                        if ((lh ? c1 : c0) >= 256) pre = cand;
                    }
                    int g0 = 0, g1 = 0;
#pragma unroll
                    for (int i = 0; i < IDX_M; ++i) { const unsigned long long m = __builtin_amdgcn_ballot_w64(U[i] > pre); g0 += __popc((unsigned)m); g1 += __popc((unsigned)(m >> 32)); }
                    need[rt][e] = 256 - (lh ? g1 : g0);
                    T[rt][e] = __uint_as_float((pre & 0x80000000u) ? (pre ^ 0x80000000u) : ~pre);
                }
        }
        {
            int tcnt[2][2];
#pragma unroll
            for (int rt = 0; rt < 2; ++rt)
#pragma unroll
                for (int e = 0; e < 2; ++e) tcnt[rt][e] = 0;
            __syncthreads();
            uint4 r0 = *(const uint4*)(ksrc), r1 = *(const uint4*)(ksrc + 32 * 64);
#pragma unroll 1
            for (int i = tid; i < 32 * 256 / 4; i += NTHR) ((uint4*)mimg)[i] = make_uint4(0u, 0u, 0u, 0u);
            *(uint4*)(kdst) = r0; *(uint4*)(kdst + 32 * 72) = r1;
            __syncthreads();
            for (int kt = 0; kt < nkt; ++kt) {
                const bf16_t* kbuf = Kb + (kt & 1) * 64 * 72;
                if (kt + 1 < nkt) { r0 = *(const uint4*)(ksrc + (size_t)(kt + 1) * 64 * 64); r1 = *(const uint4*)(ksrc + (size_t)(kt + 1) * 64 * 64 + 32 * 64); }
                __builtin_amdgcn_sched_barrier(0);
                const bool interior = kt * 64 + 63 <= qb;
#pragma unroll 1
                for (int t = 0; t < 2; ++t) {
                    float sc[2][2]; tile_scores(kbuf, t, sc);
                    const int key = kt * 64 + 32 * t + l31;
#pragma unroll
                    for (int rt = 0; rt < 2; ++rt)
#pragma unroll
                        for (int e = 0; e < 2; ++e) {
                            const float sv = (interior || key <= qv[rt][e]) ? sc[rt][e] : -INFINITY;
                            unsigned long long bal = __builtin_amdgcn_ballot_w64(sv > T[rt][e]);
                            const unsigned long long tb = __builtin_amdgcn_ballot_w64(sv == T[rt][e]);
                            if (tb != 0ull) {
                                const unsigned half = (unsigned)(tb >> (32 * lh));
                                const int rk = tcnt[rt][e] + __popc(half & ((1u << l31) - 1u));
                                bal |= __builtin_amdgcn_ballot_w64(sv == T[rt][e] && rk < need[rt][e]);
                                tcnt[rt][e] += __popc(half);
                            }
                            if (l31 == 0) mimg[(8 * wid + 4 * rt + 2 * lh + e) * 256 + kt * 2 + t] = (unsigned)(bal >> (32 * lh));
                        }
                }
                if (kt + 1 < nkt) { bf16_t* d = kdst + ((kt + 1) & 1) * 64 * 72; *(uint4*)(d) = r0; *(uint4*)(d + 32 * 72) = r1; }
                __syncthreads();
            }
        }
#pragma unroll 1
        for (int i = tid; i < 32 * 64; i += NTHR) { const int row = i >> 6, c4 = i & 63; *(uint4*)(p.MASK + (tok0 + row) * 256 + c4 * 4) = ((const uint4*)mimg)[row * 64 + c4]; }
    }
}
#ifndef PROBE_REP
#define PROBE_REP -1
#endif
#define RUNPH(idx, call) { _Pragma("unroll 1") for (int rep_ = 0; rep_ < ((PROBE_REP == idx) ? 2 : 1); ++rep_) { call; if (rep_ == 0 && PROBE_REP == idx) xcd_barrier(bar); } }

__global__ void __launch_bounds__(NTHR, 2) k_forward(P p) {
    __shared__ __attribute__((aligned(16))) char smem[SMEM_BYTES];
    volatile LAS unsigned* xbw = (volatile LAS unsigned*)(smem + SMEM_BYTES - 16);
    if (threadIdx.x == 0) { xbw[0] = 0u; xbw[1] = 0u; xbw[2] = 0u; xbw[3] = 0u; }
    __syncthreads();
    XcdBarrier bar = xcd_barrier_post(p.bar, xbw);
    const int bid = blockIdx.x, nblk = gridDim.x;
    volatile LAS int* sw = (volatile LAS int*)(smem + SMEM_BYTES - 32);
    if (threadIdx.x == 0) { const int hx = (int)(xb_xcc_id() & 7u); sw[0] = hx; sw[1] = atomicAdd(&p.XC[hx * 64], 1); }
    RUNPH(0, phase_prologue(p, smem, bid, nblk))
    xcd_barrier(bar);
    Sched sc;
    {
        bool even = (nblk & 7) == 0;
#pragma unroll
        for (int i = 0; i < 8; ++i) even = even && (__hip_atomic_load(&p.XC[i * 64], __ATOMIC_RELAXED, __HIP_MEMORY_SCOPE_AGENT) == (nblk >> 3));
        sc.x = even ? sw[0] : (bid & 7); sc.j = even ? sw[1] : (bid >> 3);
        sc.x = __builtin_amdgcn_readfirstlane(sc.x); sc.j = __builtin_amdgcn_readfirstlane(sc.j);
    }
    RUNPH(1, phase_inproj<0>(p, smem, bid, nblk, sc))
    xcd_barrier(bar);
    RUNPH(2, phase_indexer(p, smem, bid, nblk, sc))
    xcd_split_arrive(bar);
    RUNPH(3, phase_attn<0>(p, smem, bid, nblk, sc))
    RUNPH(4, phase_attn<2>(p, smem, bid, nblk, sc))
    xcd_split_wait(bar);
    RUNPH(5, phase_attn<1>(p, smem, bid, nblk, sc))
    xcd_barrier(bar);
    RUNPH(6, phase_merge<1>(p, smem, bid, nblk, sc))
    xcd_barrier(bar);
    RUNPH(7, phase_outproj(p, smem, bid, nblk, sc))
    xcd_barrier(bar);
#if PROBE_REP == 10
    phase_route<1>(p, smem, bid, nblk);
    xcd_barrier(bar);
#endif
    phase_route<0>(p, smem, bid, nblk);
    xcd_barrier(bar);
    RUNPH(8, phase_moe<0>(p, smem, bid, nblk, sc))
    xcd_barrier(bar);
    RUNPH(9, phase_moe<1>(p, smem, bid, nblk, sc))
    xcd_barrier(bar);
#if PROBE_REP == 11
    phase_final<1>(p, bid, nblk);
    xcd_barrier(bar);
#endif
    phase_final<0>(p, bid, nblk);
}

#define MBYTES(x) ((size_t)(x) << 20)
extern "C" void kernel_launch(void* const* d_in, const int* in_sizes, int n_in, void* d_out, int out_size, void* d_ws, size_t ws_size, hipStream_t stream) {
    P p{};
    p.x = (const float*)d_in[0]; p.pos = (const int*)d_in[1]; p.mem = (const float*)d_in[2];
    p.g_mix = (const float*)d_in[3]; p.w_in = (const float*)d_in[4]; p.b_gate = (const float*)d_in[5];
    p.lq1 = (const float*)d_in[6]; p.lk1 = (const float*)d_in[7]; p.lq2 = (const float*)d_in[8]; p.lk2 = (const float*)d_in[9];
    p.g_sub = (const float*)d_in[10]; p.g_mem = (const float*)d_in[11]; p.w_mkv = (const float*)d_in[12];
    p.w_br0 = (const float*)d_in[13]; p.w_br1 = (const float*)d_in[14]; p.w_br2 = (const float*)d_in[15];
    p.w_out = (const float*)d_in[16]; p.g_ffn = (const float*)d_in[17];
    p.w_rg = (const float*)d_in[18]; p.b_rg = (const float*)d_in[19]; p.w_re = (const float*)d_in[20]; p.b_re = (const float*)d_in[21];
    p.w_ei = (const float*)d_in[22]; p.w_eo = (const float*)d_in[23]; p.g_fin = (const float*)d_in[24];
    char* ws = (char*)d_ws; p.out = (float*)d_out;
    p.bar = (unsigned*)ws; p.CNT = (int*)(ws + 65536); p.XC = (int*)(ws + 131072);
    p.NBUF = (bf16_t*)(ws + MBYTES(1));
    p.DQ = (bf16_t*)(ws + MBYTES(65)); p.DK = (bf16_t*)(ws + MBYTES(97)); p.MERGED = (bf16_t*)(ws + MBYTES(65));
    p.SQ = (bf16_t*)(ws + MBYTES(129)); p.SK = (bf16_t*)(ws + MBYTES(161)); p.HID = (bf16_t*)(ws + MBYTES(129));
    p.DVT = (bf16_t*)(ws + MBYTES(193)); p.SVT = (bf16_t*)(ws + MBYTES(225)); p.IQ = (bf16_t*)(ws + MBYTES(257)); p.MQ = (bf16_t*)(ws + MBYTES(289));
    p.YMOE = (bf16_t*)(ws + MBYTES(193));
    p.IK = (bf16_t*)(ws + MBYTES(321)); p.IW = (float*)(ws + MBYTES(325)); p.MASK = (unsigned*)(ws + MBYTES(326));
    p.MK = (bf16_t*)(ws + MBYTES(358)); p.MVT = (bf16_t*)(ws + MBYTES(359)); p.MEMN = (bf16_t*)(ws + MBYTES(360));
    p.ROPEC = (float*)(ws + MBYTES(362)); p.ROPES = (float*)(ws + MBYTES(363));
    p.ROUTE = (Route*)(ws + MBYTES(365)); p.LIST = (int*)(ws + MBYTES(366));
    p.WIN = (bf16_t*)(ws + MBYTES(368)); p.WMKV = (bf16_t*)(ws + MBYTES(383));
    p.WBR = (bf16_t*)(ws + MBYTES(385)); p.WOUT = (bf16_t*)(ws + MBYTES(388)); p.WEI = (bf16_t*)(ws + MBYTES(390)); p.WEO = (bf16_t*)(ws + MBYTES(422));
    p.SGS = (unsigned*)(ws + MBYTES(440));
    p.HB = (bf16_t*)(ws + MBYTES(440));
    p.YD = (bf16_t*)d_out; p.YS = p.YD + (size_t)T_TOK * 512; p.YM = p.YS + (size_t)T_TOK * 512;
    static int grid = 0;
    if (!grid) {
        int dev = 0, cus = 0, per_cu = 0;
        (void)hipGetDevice(&dev);
        (void)hipDeviceGetAttribute(&cus, hipDeviceAttributeMultiprocessorCount, dev);
        (void)hipOccupancyMaxActiveBlocksPerMultiprocessor(&per_cu, k_forward, NTHR, 0);
        if (cus <= 0) cus = 256;
        if (per_cu < 1) per_cu = 1;
        grid = cus * (per_cu < 2 ? per_cu : 2);
    }
    (void)hipMemsetAsync(p.bar, 0, 262144, stream);
    k_forward<<<grid, NTHR, 0, stream>>>(p);
}
```

```cpp
#include <hip/hip_runtime.h>
#include <stdint.h>
#include <type_traits>

typedef unsigned short bf16_t;

#define S_LEN 8192
#define NBATCH 4
#define T_TOK 32768
#define DM 1024
#define DPROJ 7240
#define LIST_CAP 32768

__device__ __forceinline__ float bf2f(bf16_t v) { return __uint_as_float(((unsigned)v) << 16); }
__device__ __forceinline__ bf16_t f2bf(float f) { unsigned u = __float_as_uint(f); u += 0x7fffu + ((u >> 16) & 1u); return (bf16_t)(u >> 16); }

__device__ __forceinline__ float xhalf_max(float x) {
    const auto r = __builtin_amdgcn_permlane32_swap(__float_as_uint(x), __float_as_uint(x), false, false);
    float m; asm("v_max_f32 %0, %1, %2" : "=v"(m) : "v"(r[0]), "v"(r[1])); return m;
}
__device__ __forceinline__ float xhalf_sum(float x) {
    const auto r = __builtin_amdgcn_permlane32_swap(__float_as_uint(x), __float_as_uint(x), false, false);
    return __uint_as_float(r[0]) + __uint_as_float(r[1]);
}
template <int CTRL> __device__ __forceinline__ float dpp_movf(float v) { return __int_as_float(__builtin_amdgcn_update_dpp(0, __float_as_int(v), CTRL, 0xF, 0xF, true)); }
template <int CTRL> __device__ __forceinline__ int dpp_movi(int v) { return __builtin_amdgcn_update_dpp(0, v, CTRL, 0xF, 0xF, true); }
__device__ __forceinline__ float wave_sum(float v) {
    v += dpp_movf<0xB1>(v); v += dpp_movf<0x4E>(v); v += dpp_movf<0x141>(v); v += dpp_movf<0x140>(v);
    { const auto r = __builtin_amdgcn_permlane16_swap(__float_as_uint(v), __float_as_uint(v), false, false); v = __uint_as_float(r[0]) + __uint_as_float(r[1]); }
    { const auto r = __builtin_amdgcn_permlane32_swap(__float_as_uint(v), __float_as_uint(v), false, false); v = __uint_as_float(r[0]) + __uint_as_float(r[1]); }
    return v;
}
__device__ __forceinline__ float wave_max(float v) {
    v = fmaxf(v, dpp_movf<0xB1>(v)); v = fmaxf(v, dpp_movf<0x4E>(v)); v = fmaxf(v, dpp_movf<0x141>(v)); v = fmaxf(v, dpp_movf<0x140>(v));
    { const auto r = __builtin_amdgcn_permlane16_swap(__float_as_uint(v), __float_as_uint(v), false, false); v = fmaxf(__uint_as_float(r[0]), __uint_as_float(r[1])); }
    { const auto r = __builtin_amdgcn_permlane32_swap(__float_as_uint(v), __float_as_uint(v), false, false); v = fmaxf(__uint_as_float(r[0]), __uint_as_float(r[1])); }
    return v;
}
__device__ __forceinline__ int wave_sum_i(int v) {
    v += dpp_movi<0xB1>(v); v += dpp_movi<0x4E>(v); v += dpp_movi<0x141>(v); v += dpp_movi<0x140>(v);
    { const auto r = __builtin_amdgcn_permlane16_swap((unsigned)v, (unsigned)v, false, false); v = (int)(r[0] + r[1]); }
    { const auto r = __builtin_amdgcn_permlane32_swap((unsigned)v, (unsigned)v, false, false); v = (int)(r[0] + r[1]); }
    return v;
}
__device__ __forceinline__ float block_sum(float v, float* red) {
    v = wave_sum(v);
    __syncthreads();
    if ((threadIdx.x & 63) == 0) red[threadIdx.x >> 6] = v;
    __syncthreads();
    return red[0] + red[1] + red[2] + red[3];
}
__device__ __forceinline__ int block_sum_i(int v, int* red) {
    v = wave_sum_i(v);
    __syncthreads();
    if ((threadIdx.x & 63) == 0) red[threadIdx.x >> 6] = v;
    __syncthreads();
    return red[0] + red[1] + red[2] + red[3];
}

struct Route { int e0, e1; float c0, c1; };
#define XB_TMO      128
#define XB_XCNT(j)  (256  + 64 * (j))
#define XB_XSUB(j)  (1280 + 64 * (j))
#define XB_XGEN(j)  (2304 + 64 * (j))
#define XB_TOP      3328
#define XB_TOPGEN   3392
#define XCD_BAR_WORDS 3456
#define XB_SPIN_CAP (1u << 18)
#define LAS __attribute__((address_space(3)))

__device__ __forceinline__ unsigned xb_ld(unsigned* p)              { return __hip_atomic_load(p, __ATOMIC_RELAXED, __HIP_MEMORY_SCOPE_AGENT); }
__device__ __forceinline__ unsigned xb_add(unsigned* p, unsigned v) { return __hip_atomic_fetch_add(p, v, __ATOMIC_RELAXED, __HIP_MEMORY_SCOPE_AGENT); }
__device__ __forceinline__ unsigned xb_xcc_id() { return (unsigned)__builtin_amdgcn_s_getreg((3 << 11) | 20) & 0xFu; }
#define XB_SPIN(cond, bar) do { unsigned _sp = 0; while (cond) { __builtin_amdgcn_s_sleep(1); \
    if ((++_sp & 255u) == 0u) { if (xb_ld(&(bar)[XB_TMO])) break; if (_sp > XB_SPIN_CAP) { atomicAdd(&(bar)[XB_TMO], 1u); break; } } } } while (0)

struct XcdBarrier {
    unsigned* bar; unsigned x;
    volatile LAS unsigned* st;
};

__device__ __forceinline__ XcdBarrier xcd_barrier_post(unsigned* bar, volatile LAS unsigned* st) {
    XcdBarrier b; b.bar = bar; b.x = xb_xcc_id(); b.st = st;
    if (threadIdx.x == 0) (void)xb_add(&bar[XB_XCNT(b.x)], 1u);
    return b;
}
__device__ __forceinline__ void xcd_barrier_complete(unsigned* bar, unsigned x, unsigned& nloc, unsigned& nx) {
    const unsigned G = gridDim.x * gridDim.y * gridDim.z;
    unsigned sum, cnt, mine, sp = 0u;
    for (;;) {
        sum = 0u; cnt = 0u; mine = 0u;
#pragma unroll
        for (unsigned j = 0; j < 16; ++j) { const unsigned c = xb_ld(&bar[XB_XCNT(j)]); sum += c; cnt += (c > 0u) ? 1u : 0u; mine = (j == x) ? c : mine; }
        if (sum == G) break;
        __builtin_amdgcn_s_sleep(1);
        if ((++sp & 255u) == 0u) { if (xb_ld(&bar[XB_TMO])) break; if (sp > XB_SPIN_CAP) { atomicAdd(&bar[XB_TMO], 1u); break; } }
    }
    nloc = mine > 0u ? mine : 1u; nx = cnt > 0u ? cnt : 1u;
}

__device__ __forceinline__ void xcd_barrier(const XcdBarrier& b) {
    asm volatile("s_waitcnt vmcnt(0)" ::: "memory");
    __syncthreads();
    if (threadIdx.x == 0) {
        unsigned* bar = b.bar;
        __builtin_amdgcn_s_waitcnt(0);
        unsigned nloc = b.st[0], nx = b.st[1];
        if (nloc == 0u) { xcd_barrier_complete(bar, b.x, nloc, nx); b.st[0] = nloc; b.st[1] = nx; }
        const unsigned old = xb_add(&bar[XB_XSUB(b.x)], 1u);
        const unsigned gen = old / nloc;
        if (old + 1u == (gen + 1u) * nloc) {
            __builtin_amdgcn_fence(__ATOMIC_RELEASE, "agent");
            asm volatile("s_waitcnt vmcnt(0)" ::: "memory");
            const unsigned og = xb_add(&bar[XB_TOP], 1u);
            const unsigned tg = og / nx;
            if (og + 1u == (tg + 1u) * nx) xb_add(&bar[XB_TOPGEN], 1u);
            else XB_SPIN(xb_ld(&bar[XB_TOPGEN]) == tg, bar);
            __builtin_amdgcn_fence(__ATOMIC_ACQUIRE, "agent");
            xb_add(&bar[XB_XGEN(b.x)], 1u);
            asm volatile("s_waitcnt vmcnt(0)" ::: "memory");
        } else {
            XB_SPIN(xb_ld(&bar[XB_XGEN(b.x)]) == gen, bar);
            __builtin_amdgcn_fence(__ATOMIC_ACQUIRE, "agent");
            asm volatile("s_waitcnt vmcnt(0)" ::: "memory");
        }
    }
    __syncthreads();
}


#define XB_SPLIT 4096
__device__ __forceinline__ void xcd_split_arrive(const XcdBarrier& b) {
    asm volatile("s_waitcnt vmcnt(0)" ::: "memory");
    __syncthreads();
    if (threadIdx.x == 0) {
        __builtin_amdgcn_s_waitcnt(0);
        __builtin_amdgcn_fence(__ATOMIC_RELEASE, "agent");
        asm volatile("s_waitcnt vmcnt(0)" ::: "memory");
        (void)xb_add(&b.bar[XB_SPLIT], 1u);
    }
}
__device__ __forceinline__ void xcd_split_wait(const XcdBarrier& b) {
    __syncthreads();
    if (threadIdx.x == 0) {
        const unsigned G = gridDim.x * gridDim.y * gridDim.z;
        XB_SPIN(xb_ld(&b.bar[XB_SPLIT]) < G, b.bar);
        __builtin_amdgcn_fence(__ATOMIC_ACQUIRE, "agent");
        asm volatile("s_waitcnt vmcnt(0)" ::: "memory");
    }
    __syncthreads();
}
typedef __attribute__((ext_vector_type(8))) __bf16 bf16x8;
typedef __attribute__((ext_vector_type(16))) float f32x16;
typedef __attribute__((ext_vector_type(4))) float f32x4;
#define NTHR 256
#define LDSK 72
#define SMEM_BYTES 81920

struct P {
    const float* x; const int* pos; const float* mem; const float* g_mix; const float* w_in; const float* b_gate;
    const float* lq1; const float* lk1; const float* lq2; const float* lk2; const float* g_sub; const float* g_mem; const float* w_mkv;
    const float* w_br0; const float* w_br1; const float* w_br2; const float* w_out; const float* g_ffn;
    const float* w_rg; const float* b_rg; const float* w_re; const float* b_re; const float* w_ei; const float* w_eo; const float* g_fin;
    float* out;
    unsigned* bar; int* CNT;
    bf16_t* NBUF; bf16_t* DQ; bf16_t* DK; bf16_t* DVT; bf16_t* SQ; bf16_t* SK; bf16_t* SVT; bf16_t* IQ; bf16_t* MQ; bf16_t* IK; float* IW; unsigned* MASK;
    bf16_t* MK; bf16_t* MVT; bf16_t* MEMN; float* ROPEC; float* ROPES;
    bf16_t* WIN; bf16_t* WBR; bf16_t* WOUT; bf16_t* WMKV; bf16_t* WEI; bf16_t* WEO;
    bf16_t* YD; bf16_t* YS; bf16_t* YM; bf16_t* MERGED; bf16_t* HID; bf16_t* YMOE; Route* ROUTE; int* LIST; unsigned* SGS; int* XC; bf16_t* HB;
};

__device__ __forceinline__ int opaque_tid() { int t = threadIdx.x; asm volatile("" : "+v"(t)); return t; }
typedef __bf16 bf16x2v_t __attribute__((ext_vector_type(2)));
typedef float f32x2c_t __attribute__((ext_vector_type(2)));
__device__ __forceinline__ unsigned cvt_pk_bf16_ord(float lo, float hi) { unsigned r; asm volatile("s_nop 0\n\tv_cvt_pk_bf16_f32 %0, %1, %2" : "=v"(r) : "v"(lo), "v"(hi)); return r; }
__device__ __forceinline__ unsigned cvt_pk_bf16(float lo, float hi) { const f32x2c_t v = {lo, hi}; const bf16x2v_t r = __builtin_convertvector(v, bf16x2v_t); return __builtin_bit_cast(unsigned, r); }

template <int MAP> __device__ __forceinline__ int colmap(int n) {
    if (MAP == 1) return n < 3584 ? n : n < 4096 ? n + 72 : n < 4168 ? n - 512 : n < 4224 ? -1 : n - 56;
    if (MAP == 2) { const int c = n >> 6, j = n & 63; return j < 32 ? 32 * c + j : 512 + 32 * c + (j - 32); }
    return n;
}
template <int MAP, int NTL> __device__ __forceinline__ void tconv_tile(const float* __restrict__ src, int ld, int K, bf16_t* __restrict__ dst, int tile, float* tl) {
    const int n0 = (tile % NTL) * 64, k0 = (tile / NTL) * 64;
    const int t = opaque_tid(); const int nn = (t & 15) * 4; const int c = colmap<MAP>(n0 + nn);
#pragma unroll
    for (int i = 0; i < 4; ++i) { const int kk = (t >> 4) + 16 * i;
        const float4 v = c >= 0 ? *(const float4*)(src + (size_t)(k0 + kk) * ld + c) : make_float4(0.f, 0.f, 0.f, 0.f);
        tl[kk * 65 + nn] = v.x; tl[kk * 65 + nn + 1] = v.y; tl[kk * 65 + nn + 2] = v.z; tl[kk * 65 + nn + 3] = v.w; }
    __syncthreads();
#pragma unroll
    for (int i = 0; i < 2; ++i) { const int cc = t + 256 * i; const int n2 = cc >> 3, kc = (cc & 7) * 8;
        uint4 o; o.x = cvt_pk_bf16(tl[(kc + 0) * 65 + n2], tl[(kc + 1) * 65 + n2]); o.y = cvt_pk_bf16(tl[(kc + 2) * 65 + n2], tl[(kc + 3) * 65 + n2]);
        o.z = cvt_pk_bf16(tl[(kc + 4) * 65 + n2], tl[(kc + 5) * 65 + n2]); o.w = cvt_pk_bf16(tl[(kc + 6) * 65 + n2], tl[(kc + 7) * 65 + n2]);
        *(uint4*)(dst + (size_t)(n0 + n2) * K + k0 + kc) = o; }
    __syncthreads();
}
#define TC_WIN 1824
#define TC_WBR (TC_WIN + 384)
#define TC_WOUT (TC_WBR + 256)
#define TC_WMKV (TC_WOUT + 256)
#define TC_WEI (TC_WMKV + 4096)
#define TC_WEO (TC_WEI + 2048)
__device__ void phase_prologue(const P& p, char* smem, int bid, int nblk) {
    float* tl = (float*)smem;
    const int tidp = opaque_tid();
    for (int g = bid; g < TC_WEO; g += nblk) {
        if (g < TC_WIN) tconv_tile<1, 114>(p.w_in, DPROJ, 1024, p.WIN, g, tl);
        else if (g < TC_WBR) { const int j = (g - TC_WIN) >> 7; const float* s = j == 0 ? p.w_br0 : j == 1 ? p.w_br1 : p.w_br2; tconv_tile<0, 16>(s, 1024, 512, p.WBR + (size_t)j * 1024 * 512, (g - TC_WIN) & 127, tl); }
        else if (g < TC_WOUT) tconv_tile<0, 16>(p.w_out, 1024, 1024, p.WOUT, g - TC_WBR, tl);
        else if (g < TC_WMKV) tconv_tile<0, 16>(p.w_mkv, 1024, 1024, p.WMKV, g - TC_WOUT, tl);
        else if (g < TC_WEI) { const int e = (g - TC_WMKV) >> 8; tconv_tile<2, 16>(p.w_ei + (size_t)e * 1024 * 1024, 1024, 1024, p.WEI + (size_t)e * 1024 * 1024, (g - TC_WMKV) & 255, tl); }
        else { const int e = (g - TC_WEI) >> 7; tconv_tile<0, 16>(p.w_eo + (size_t)e * 512 * 1024, 1024, 512, p.WEO + (size_t)e * 1024 * 512, (g - TC_WEI) & 127, tl); }
    }
    const int lane = tidp & 63; const int gw = bid * 4 + (tidp >> 6), nw = nblk * 4;
    for (int row = gw; row < T_TOK + 1024; row += nw) {
        const float* src; const float* g; bf16_t* dst;
        if (row < T_TOK) { src = p.x + (size_t)row * DM; g = p.g_mix; dst = p.NBUF + (size_t)row * DM; }
        else { src = p.mem + (size_t)(row - T_TOK) * DM; g = p.g_mem; dst = p.MEMN + (size_t)(row - T_TOK) * DM; }
        float4 v[4]; float ss = 0.f;
#pragma unroll
        for (int i = 0; i < 4; ++i) { v[i] = *(const float4*)(src + i * 256 + lane * 4); ss += v[i].x * v[i].x + v[i].y * v[i].y + v[i].z * v[i].z + v[i].w * v[i].w; }
        ss = wave_sum(ss);
        const float r = rsqrtf(ss * (1.0f / DM) + 1e-6f);
#pragma unroll
        for (int i = 0; i < 4; ++i) { const float4 gg = *(const float4*)(g + i * 256 + lane * 4);
            uint2 o; o.x = cvt_pk_bf16(v[i].x * r * gg.x, v[i].y * r * gg.y); o.y = cvt_pk_bf16(v[i].z * r * gg.z, v[i].w * r * gg.w);
            *(uint2*)(dst + i * 256 + lane * 4) = o; }
    }
    for (int i = bid * NTHR + tidp; i < T_TOK * 8; i += nblk * NTHR) {
        const float inv = powf(500000.0f, -(float)(i & 7) / 8.0f);
        const float ang = (float)p.pos[i >> 3] * inv;
        float sn, cs; sincosf(ang, &sn, &cs);
        p.ROPEC[i] = cs; p.ROPES[i] = sn;
    }
    if (bid == 0 && tidp < 16) p.CNT[tidp * 64] = 0;
}


struct Sched { int x, j; };
struct XOrder {
    int x, j, J, nblk, bid;
    __device__ __forceinline__ XOrder(int bid_, int nblk_, const Sched& s) : x(s.x), j(s.j), J(nblk_ >> 3), nblk(nblk_), bid(bid_) {}
    __device__ __forceinline__ bool round(int r, int N, int& u) const {
        if ((nblk & 7) != 0) { u = r * nblk + bid; if (r * nblk >= N) return false; if (u >= N) u = -1; return true; }
        const int c = r * 8 + x; if (r * 8 * J >= N) return false; u = c * J + j; if (u >= N) u = -1; return true;
    }
};
__device__ __forceinline__ void tile_mn(int u, int NT, int& mt, int& nt) { const int g = u / (8 * NT), rem = u - g * 8 * NT; nt = rem >> 3; mt = g * 8 + (rem & 7); }

__device__ __forceinline__ int gl_row(int tid, int q) { return (tid >> 6) * 32 + q * 8 + ((tid & 63) >> 3); }
__device__ __forceinline__ unsigned gl_col(int tid, int row) { return (unsigned)(((tid & 7) ^ ((row >> 1) & 7)) * 8); }
__device__ __forceinline__ void gemm_mainloop(const bf16_t* __restrict__ Rb, unsigned or0, unsigned or1, unsigned or2, unsigned or3,
                                              const bf16_t* __restrict__ Lb, unsigned ol0, unsigned ol1, unsigned ol2, unsigned ol3, int K, f32x16 (&acc)[2][2], bf16_t* As, bf16_t* Bs) {
    const int tid = opaque_tid(), lane = tid & 63, wid = tid >> 6, wr = wid >> 1, wc = wid & 1;
    const int nk = K >> 6;
    LAS unsigned* ldsA = (LAS unsigned*)(As + wid * 32 * 64);
    LAS unsigned* ldsB = (LAS unsigned*)(Bs + wid * 32 * 64);
    const int sw = (lane >> 1) & 7;
    const bf16_t* ard = As + (wr * 64 + (lane & 31)) * 64;
    const bf16_t* brd = Bs + (wc * 64 + (lane & 31)) * 64;
    const int lh = lane >> 5;
#define GLDS_TILE(stage_, ko_) { \
    __builtin_amdgcn_global_load_lds((const unsigned*)(Rb + or0 + (ko_)), (LAS unsigned*)((LAS char*)ldsA + (stage_) * 32768), 16, 0, 0); \
    __builtin_amdgcn_global_load_lds((const unsigned*)(Rb + or1 + (ko_)), (LAS unsigned*)((LAS char*)ldsA + (stage_) * 32768 + 1024), 16, 0, 0); \
    __builtin_amdgcn_global_load_lds((const unsigned*)(Rb + or2 + (ko_)), (LAS unsigned*)((LAS char*)ldsA + (stage_) * 32768 + 2048), 16, 0, 0); \
    __builtin_amdgcn_global_load_lds((const unsigned*)(Rb + or3 + (ko_)), (LAS unsigned*)((LAS char*)ldsA + (stage_) * 32768 + 3072), 16, 0, 0); \
    __builtin_amdgcn_global_load_lds((const unsigned*)(Lb + ol0 + (ko_)), (LAS unsigned*)((LAS char*)ldsB + (stage_) * 32768), 16, 0, 0); \
    __builtin_amdgcn_global_load_lds((const unsigned*)(Lb + ol1 + (ko_)), (LAS unsigned*)((LAS char*)ldsB + (stage_) * 32768 + 1024), 16, 0, 0); \
    __builtin_amdgcn_global_load_lds((const unsigned*)(Lb + ol2 + (ko_)), (LAS unsigned*)((LAS char*)ldsB + (stage_) * 32768 + 2048), 16, 0, 0); \
    __builtin_amdgcn_global_load_lds((const unsigned*)(Lb + ol3 + (ko_)), (LAS unsigned*)((LAS char*)ldsB + (stage_) * 32768 + 3072), 16, 0, 0); }
    __syncthreads();
    GLDS_TILE(0, 0u)
    __syncthreads();
    for (int kt = 0; kt < nk; ++kt) {
        const int cur = (kt & 1) * 16384;
        if (kt + 1 < nk) { if (kt & 1) GLDS_TILE(0, (unsigned)(kt + 1) * 64u) else GLDS_TILE(1, (unsigned)(kt + 1) * 64u) }
#pragma unroll
        for (int ks = 0; ks < 4; ++ks) {
            const int cc = ((2 * ks + lh) ^ sw) * 8;
            const bf16x8 fa0 = *(const bf16x8*)(ard + cur + cc), fa1 = *(const bf16x8*)(ard + cur + 32 * 64 + cc);
            const bf16x8 fb0 = *(const bf16x8*)(brd + cur + cc), fb1 = *(const bf16x8*)(brd + cur + 32 * 64 + cc);
            acc[0][0] = __builtin_amdgcn_mfma_f32_32x32x16_bf16(fa0, fb0, acc[0][0], 0, 0, 0);
            acc[0][1] = __builtin_amdgcn_mfma_f32_32x32x16_bf16(fa0, fb1, acc[0][1], 0, 0, 0);
            acc[1][0] = __builtin_amdgcn_mfma_f32_32x32x16_bf16(fa1, fb0, acc[1][0], 0, 0, 0);
            acc[1][1] = __builtin_amdgcn_mfma_f32_32x32x16_bf16(fa1, fb1, acc[1][1], 0, 0, 0);
        }
        __syncthreads();
    }
#undef GLDS_TILE
}
#define ZERO_ACC(acc) { _Pragma("unroll") for (int i_ = 0; i_ < 2; ++i_) _Pragma("unroll") for (int j_ = 0; j_ < 2; ++j_) _Pragma("unroll") for (int r_ = 0; r_ < 16; ++r_) acc[i_][j_][r_] = 0.f; }
#define CSTR 136
__device__ __forceinline__ void cimg_write(const f32x16 (&acc)[2][2], bf16_t* Cs, int wr, int wc, int l31, int lh) {
#pragma unroll
    for (int i = 0; i < 2; ++i)
#pragma unroll
        for (int j = 0; j < 2; ++j)
#pragma unroll
            for (int g = 0; g < 4; ++g) { uint2 o; o.x = cvt_pk_bf16(acc[i][j][4 * g], acc[i][j][4 * g + 1]); o.y = cvt_pk_bf16(acc[i][j][4 * g + 2], acc[i][j][4 * g + 3]);
                *(uint2*)(Cs + (64 * wc + 32 * j + l31) * CSTR + 64 * wr + 32 * i + 8 * g + 4 * lh) = o; }
}

template <int NOEPI> __device__ void phase_inproj(const P& p, char* smem, int bid, int nblk, const Sched& sc) {
    bf16_t* As = (bf16_t*)smem; bf16_t* Bs = As + 128 * 64; bf16_t* Cs = (bf16_t*)smem;
    const int tid = opaque_tid(), lane = tid & 63, wid = tid >> 6, wr = wid >> 1, wc = wid & 1;
    const int l31 = lane & 31, lh = lane >> 5;
    const int NT = 33, NMAIN = 256 * NT;
    const XOrder xo(bid, nblk, sc);
    const bool xaware = false;
    for (int rr = 0; ; ++rr) {
        bool main_t; int mt, nt;
        if (xaware) {
            if (rr < 16) { main_t = true; mt = ((sc.x >> 2) * 16 + rr) * 8 + (sc.j & 7); nt = (sc.x & 3) * 8 + (sc.j >> 3); }
            else if (rr == 16) { if (bid >= 320) break; main_t = bid < 256; mt = main_t ? bid : (bid - 256) >> 3; nt = main_t ? 32 : (bid - 256) & 7; }
            else break;
        } else {
            int t; if (!xo.round(rr, NMAIN + 64, t)) break; if (t < 0) continue;
            main_t = t < NMAIN;
            if (main_t) tile_mn(t, NT, mt, nt); else { mt = (t - NMAIN) >> 3; nt = (t - NMAIN) & 7; }
        }
        const bf16_t* X = main_t ? p.NBUF : p.MEMN; const bf16_t* W = main_t ? p.WIN : p.WMKV;
        const int grp = main_t ? (nt >> 2) : (nt < 4 ? 7 : 2);
        const bool transposed = grp == 2 || grp == 5;
        const int g0 = gl_row(tid, 0); const unsigned to = (unsigned)g0 * 1024u + gl_col(tid, g0);
        const unsigned t1 = (unsigned)(g0 + 8) * 1024u + gl_col(tid, g0 + 8), t2 = (unsigned)(g0 + 16) * 1024u + gl_col(tid, g0 + 16), t3 = (unsigned)(g0 + 24) * 1024u + gl_col(tid, g0 + 24);
        const bf16_t* Xt = X + (size_t)mt * 128 * 1024; const bf16_t* Wt = W + (size_t)nt * 128 * 1024;
        f32x16 acc[2][2]; ZERO_ACC(acc);
        gemm_mainloop(transposed ? Xt : Wt, to, t1, t2, t3, transposed ? Wt : Xt, to, t1, t2, t3, 1024, acc, As, Bs);
        if (NOEPI) { float s_ = 0.f; for (int i_ = 0; i_ < 2; ++i_) for (int j_ = 0; j_ < 2; ++j_) for (int r_ = 0; r_ < 16; ++r_) s_ += acc[i_][j_][r_]; if (s_ == 1.2345e30f) p.IW[0] = s_; continue; }
        const int tok0 = mt * 128;
        if (main_t && !transposed && grp != 7) {
            if (grp != 8 || wr == 0) {
#pragma unroll
                for (int j = 0; j < 2; ++j) { const int tok = tok0 + 64 * wc + 32 * j + l31;
                    const float4 c4 = *(const float4*)(p.ROPEC + (size_t)tok * 8 + 4 * lh), s4 = *(const float4*)(p.ROPES + (size_t)tok * 8 + 4 * lh);
                    const float cc[4] = {c4.x, c4.y, c4.z, c4.w}, ss[4] = {s4.x, s4.y, s4.z, s4.w};
#pragma unroll
                    for (int r = 0; r < 4; ++r) { const float x1 = acc[0][j][r], x2 = acc[0][j][r + 4]; acc[0][j][r] = x1 * cc[r] - x2 * ss[r]; acc[0][j][r + 4] = x2 * cc[r] + x1 * ss[r]; } }
            }
        }
        if (grp == 8 && wr == 1) {
#pragma unroll
            for (int j = 0; j < 2; ++j) { const int tok = tok0 + 64 * wc + 32 * j + l31; *(float4*)(p.IW + (size_t)tok * 8 + 4 * lh) = make_float4(acc[0][j][0], acc[0][j][1], acc[0][j][2], acc[0][j][3]); }
        }
        __syncthreads();
        cimg_write(acc, Cs, wr, wc, l31, lh);
        __syncthreads();
        bf16_t* dbase; size_t dstride; int nch = 16;
        if (!main_t) {
            if (nt < 4) { dbase = p.MK + (size_t)tok0 * 512 + nt * 128; dstride = 512; }
            else { dbase = p.MVT + ((size_t)((mt >> 1) * 4 + (nt - 4)) * 128) * 256 + (mt & 1) * 128; dstride = 256; }
        } else if (grp == 2) { dbase = p.DVT + ((size_t)((mt >> 6) * 4 + (nt - 8)) * 128) * S_LEN + (mt & 63) * 128; dstride = S_LEN; }
        else if (grp == 5) { dbase = p.SVT + ((size_t)((mt >> 6) * 8 + (nt - 20) * 2) * 64) * S_LEN + (mt & 63) * 128; dstride = S_LEN; }
        else if (grp == 8) { dbase = p.IK + (size_t)tok0 * 64; dstride = 64; nch = 8; }
        else { bf16_t* d = grp == 0 ? p.DQ : grp == 1 ? p.DK : grp == 3 ? p.SQ : grp == 4 ? p.SK : grp == 6 ? p.IQ : p.MQ; dbase = d + (size_t)tok0 * 512 + (nt & 3) * 128; dstride = 512; }
        int te_ = tid; asm volatile("" : "+v"(te_));
#pragma unroll
        for (int k = 0; k < 8; ++k) { const int c = te_ + 256 * k; const int lrow = c >> 4, ch = c & 15;
            if (ch < nch) { const uint4 v = *(const uint4*)(Cs + lrow * CSTR + ch * 8); *(uint4*)(dbase + (size_t)lrow * dstride + ch * 8) = v; } }
    }
}
template <int REPS = 1> __device__ void phase_merge(const P& p, char* smem, int bid, int nblk, const Sched& sc) {
    bf16_t* As = (bf16_t*)smem; bf16_t* Bs = As + 128 * 64; bf16_t* Cs = (bf16_t*)smem;
    const int tid = opaque_tid(), lane = tid & 63, wid = tid >> 6, wr = wid >> 1, wc = wid & 1;
    const int l31 = lane & 31, lh = lane >> 5;
    const XOrder xo(bid, nblk, sc);
    const bool xaware = false;
#pragma unroll 1
    for (int rep = 0; rep < REPS; ++rep)
    for (int rr = 0; ; ++rr) {
        int mt, nt;
        if (xaware) { if (rr >= 4) break; nt = sc.x; mt = rr * 64 + sc.j; }
        else { int t; if (!xo.round(rr, 256 * 8, t)) break; if (t < 0) continue; tile_mn(t, 8, mt, nt); }
        f32x16 mg[2][2]; ZERO_ACC(mg);
#pragma unroll 1
        for (int br = 0; br < 3; ++br) {
            int tl_ = tid; asm volatile("" : "+v"(tl_));
            unsigned sgr[8][4];
            {
                const int g0 = gl_row(tl_, 0);
                const unsigned to = (unsigned)g0 * 1024u + gl_col(tl_, g0), t1 = (unsigned)(g0 + 8) * 1024u + gl_col(tl_, g0 + 8), t2 = (unsigned)(g0 + 16) * 1024u + gl_col(tl_, g0 + 16), t3 = (unsigned)(g0 + 24) * 1024u + gl_col(tl_, g0 + 24);
                f32x16 acc[2][2]; ZERO_ACC(acc);
                gemm_mainloop(p.WIN + (size_t)(4224 + br * 1024 + nt * 128) * 1024, to, t1, t2, t3, p.NBUF + (size_t)mt * 128 * 1024, to, t1, t2, t3, 1024, acc, As, Bs);
#pragma unroll
                for (int i = 0; i < 2; ++i)
#pragma unroll
                    for (int g = 0; g < 4; ++g) { const float4 b4 = *(const float4*)(p.b_gate + br * 1024 + nt * 128 + 64 * wr + 32 * i + 8 * g + 4 * lh);
                        const float bb[4] = {b4.x, b4.y, b4.z, b4.w};
#pragma unroll
                        for (int j = 0; j < 2; ++j) { float s[4];
#pragma unroll
                            for (int r = 0; r < 4; ++r) s[r] = __builtin_amdgcn_rcpf(1.0f + __expf(-(acc[i][j][4 * g + r] + bb[r])));
                            acc[i][j][4 * g] = __uint_as_float(cvt_pk_bf16_ord(s[0], s[1])); acc[i][j][4 * g + 1] = __uint_as_float(cvt_pk_bf16_ord(s[2], s[3])); } }
#pragma unroll
                for (int i = 0; i < 2; ++i)
#pragma unroll
                    for (int j = 0; j < 2; ++j)
#pragma unroll
                        for (int h2 = 0; h2 < 2; ++h2) {
                            sgr[(i * 2 + j) * 2 + h2][0] = __float_as_uint(acc[i][j][8 * h2]); sgr[(i * 2 + j) * 2 + h2][1] = __float_as_uint(acc[i][j][8 * h2 + 1]);
                            sgr[(i * 2 + j) * 2 + h2][2] = __float_as_uint(acc[i][j][8 * h2 + 4]); sgr[(i * 2 + j) * 2 + h2][3] = __float_as_uint(acc[i][j][8 * h2 + 5]); }
                asm volatile("" ::: "memory");
            }
            {
                const bf16_t* Y = br == 0 ? p.YD : br == 1 ? p.YS : p.YM;
                int tl2_ = tid; asm volatile("" : "+v"(tl2_));
                const int g0 = gl_row(tl2_, 0);
                const unsigned to = (unsigned)g0 * 512u + gl_col(tl2_, g0), t1 = (unsigned)(g0 + 8) * 512u + gl_col(tl2_, g0 + 8), t2 = (unsigned)(g0 + 16) * 512u + gl_col(tl2_, g0 + 16), t3 = (unsigned)(g0 + 24) * 512u + gl_col(tl2_, g0 + 24);
                f32x16 acc[2][2]; ZERO_ACC(acc);
                gemm_mainloop(p.WBR + (size_t)br * 1024 * 512 + (size_t)nt * 128 * 512, to, t1, t2, t3, Y + (size_t)mt * 128 * 512, to, t1, t2, t3, 512, acc, As, Bs);
                asm volatile("" ::: "memory");
#pragma unroll
                for (int i = 0; i < 2; ++i)
#pragma unroll
                    for (int j = 0; j < 2; ++j)
#pragma unroll
                        for (int h2 = 0; h2 < 2; ++h2) { const unsigned ww[4] = {sgr[(i * 2 + j) * 2 + h2][0], sgr[(i * 2 + j) * 2 + h2][1], sgr[(i * 2 + j) * 2 + h2][2], sgr[(i * 2 + j) * 2 + h2][3]};
#pragma unroll
                            for (int q = 0; q < 2; ++q) {
                                const int g = 2 * h2 + q;
                                mg[i][j][4 * g] += __uint_as_float(ww[2 * q] << 16) * acc[i][j][4 * g];
                                mg[i][j][4 * g + 1] += __uint_as_float(ww[2 * q] & 0xffff0000u) * acc[i][j][4 * g + 1];
                                mg[i][j][4 * g + 2] += __uint_as_float(ww[2 * q + 1] << 16) * acc[i][j][4 * g + 2];
                                mg[i][j][4 * g + 3] += __uint_as_float(ww[2 * q + 1] & 0xffff0000u) * acc[i][j][4 * g + 3]; } }
            }
        }
        __syncthreads();
        cimg_write(mg, Cs, wr, wc, l31, lh);
        __syncthreads();
        bf16_t* dbase = p.MERGED + (size_t)mt * 128 * 1024 + nt * 128;
        int te_ = tid; asm volatile("" : "+v"(te_));
#pragma unroll
        for (int k = 0; k < 8; ++k) { const int c = te_ + 256 * k; const int lrow = c >> 4, ch = c & 15;
            const uint4 v = *(const uint4*)(Cs + lrow * CSTR + ch * 8); *(uint4*)(dbase + (size_t)lrow * 1024 + ch * 8) = v; }
    }
}

#define CFS 132
__device__ void phase_outproj(const P& p, char* smem, int bid, int nblk, const Sched& sc) {
    bf16_t* As = (bf16_t*)smem; bf16_t* Bs = As + 128 * 64;
    const int tid = opaque_tid(), lane = tid & 63, wid = tid >> 6, wr = wid >> 1, wc = wid & 1;
    const int l31 = lane & 31, lh = lane >> 5;
    const XOrder xo(bid, nblk, sc);
    for (int rr = 0; ; ++rr) {
        int t; if (!xo.round(rr, 256 * 8, t)) break; if (t < 0) continue;
        int mt, nt; tile_mn(t, 8, mt, nt);
        const int g0 = gl_row(tid, 0);
        const unsigned to = (unsigned)g0 * 1024u + gl_col(tid, g0), t1 = (unsigned)(g0 + 8) * 1024u + gl_col(tid, g0 + 8), t2 = (unsigned)(g0 + 16) * 1024u + gl_col(tid, g0 + 16), t3 = (unsigned)(g0 + 24) * 1024u + gl_col(tid, g0 + 24);
        f32x16 acc[2][2]; ZERO_ACC(acc);
        gemm_mainloop(p.WOUT + (size_t)nt * 128 * 1024, to, t1, t2, t3, p.MERGED + (size_t)mt * 128 * 1024, to, t1, t2, t3, 1024, acc, As, Bs);
        float* Cf = (float*)smem;
#pragma unroll
        for (int i = 0; i < 2; ++i)
#pragma unroll
            for (int j = 0; j < 2; ++j)
#pragma unroll
                for (int g = 0; g < 4; ++g)
                    *(float4*)(Cf + (64 * wc + 32 * j + l31) * CFS + 64 * wr + 32 * i + 8 * g + 4 * lh) = make_float4(acc[i][j][4 * g], acc[i][j][4 * g + 1], acc[i][j][4 * g + 2], acc[i][j][4 * g + 3]);
        __syncthreads();
        int to_ = tid; asm volatile("" : "+v"(to_));
#pragma unroll
        for (int k = 0; k < 8; ++k) { const int c = to_ + 256 * k; const int lrow = c >> 4, ch = c & 15;
            const float4 a0 = *(const float4*)(Cf + lrow * CFS + ch * 8), a1 = *(const float4*)(Cf + lrow * CFS + ch * 8 + 4);
            const size_t go = (size_t)(mt * 128 + lrow) * 1024 + nt * 128 + ch * 8;
            const float4 x0 = *(const float4*)(p.x + go), x1 = *(const float4*)(p.x + go + 4);
            uint4 o; o.x = cvt_pk_bf16(x0.x + a0.x, x0.y + a0.y); o.y = cvt_pk_bf16(x0.z + a0.z, x0.w + a0.w); o.z = cvt_pk_bf16(x1.x + a1.x, x1.y + a1.y); o.w = cvt_pk_bf16(x1.z + a1.z, x1.w + a1.w);
            *(uint4*)(p.HB + go) = o; }
    }
}

template <int VAR = 0> __device__ void phase_route(const P& p, char* smem, int bid, int nblk) {
    float4* wre = (float4*)smem;
    const int tidp = opaque_tid();
    for (int idx = tidp; idx < 4096; idx += NTHR) { const int row = idx >> 2, g = idx & 3;
        wre[g * 1024 + (row >> 8) * 256 + (row & 3) * 64 + ((row & 255) >> 2)] = *(const float4*)(p.w_re + (size_t)row * 16 + g * 4); }
    constexpr int RCH = 64;
    int* lcnt = (int*)(smem + 65536); int* lbase = lcnt + 16; float* bre = (float*)(lcnt + 32); int* ent_e = lcnt + 48; int* ent_s = ent_e + 4 * RCH * 2; int* ent_v = ent_s + 4 * RCH * 2;
    if (tidp < 16) bre[tidp] = p.b_re[tidp];
    const int lane = tidp & 63; const int wv = tidp >> 6; const int nw = nblk * 4;
    float4 wg[16], gg[4];
#pragma unroll
    for (int i = 0; i < 4; ++i) { gg[i] = *(const float4*)(p.g_ffn + i * 256 + lane * 4);
#pragma unroll
        for (int j = 0; j < 4; ++j) wg[4 * i + j] = *(const float4*)(p.w_rg + (size_t)(i * 256 + lane * 4 + j) * 4); }
    const float brg0 = p.b_rg[0], brg1 = p.b_rg[1], brg2 = p.b_rg[2], brg3 = p.b_rg[3];
    const int tb = bid * 4;
    const int kmax = tb < T_TOK ? (T_TOK - tb + nw - 1) / nw : 0;
    uint2 nx[4];
    { const int t0 = tb + wv; const bf16_t* s0 = p.HB + (size_t)(t0 < T_TOK ? t0 : 0) * DM;
#pragma unroll
      for (int i = 0; i < 4; ++i) nx[i] = *(const uint2*)(s0 + i * 256 + lane * 4); }
    for (int k0 = 0; k0 < kmax; k0 += RCH) {
    __syncthreads();
    if (tidp < 16) lcnt[tidp] = 0;
    __syncthreads();
    for (int kk = 0; kk < RCH && k0 + kk < kmax; ++kk) {
        const int tok = tb + wv + (k0 + kk) * nw;
        if (tok >= T_TOK) break;
        float tv[16]; float ss = 0.f;
#pragma unroll
        for (int i = 0; i < 4; ++i) { const uint2 u = nx[i];
            float4 v; v.x = __uint_as_float(u.x << 16); v.y = __uint_as_float(u.x & 0xffff0000u); v.z = __uint_as_float(u.y << 16); v.w = __uint_as_float(u.y & 0xffff0000u);
            tv[4 * i] = v.x; tv[4 * i + 1] = v.y; tv[4 * i + 2] = v.z; tv[4 * i + 3] = v.w; ss += v.x * v.x + v.y * v.y + v.z * v.z + v.w * v.w; }
        { const int tn = tok + nw; const bf16_t* sn = p.HB + (size_t)(tn < T_TOK ? tn : tok) * DM;
#pragma unroll
          for (int i = 0; i < 4; ++i) nx[i] = *(const uint2*)(sn + i * 256 + lane * 4); }
        ss = wave_sum(ss);
        const float r = rsqrtf(ss * (1.0f / DM) + 1e-6f);
        float g0 = 0.f, g1 = 0.f, g2 = 0.f, g3 = 0.f;
#pragma unroll
        for (int i = 0; i < 4; ++i) {
            tv[4 * i] *= r * gg[i].x; tv[4 * i + 1] *= r * gg[i].y; tv[4 * i + 2] *= r * gg[i].z; tv[4 * i + 3] *= r * gg[i].w;
            uint2 o; o.x = cvt_pk_bf16(tv[4 * i], tv[4 * i + 1]); o.y = cvt_pk_bf16(tv[4 * i + 2], tv[4 * i + 3]);
            *(uint2*)((VAR ? (bf16_t*)p.SGS + (size_t)8 * 1024 * 1024 + (size_t)(tok & 16383) * DM : p.NBUF + (size_t)tok * DM) + i * 256 + lane * 4) = o;
#pragma unroll
            for (int j = 0; j < 4; ++j) { const float4 w = wg[4 * i + j]; const float x = tv[4 * i + j]; g0 += x * w.x; g1 += x * w.y; g2 += x * w.z; g3 += x * w.w; } }
        g0 = wave_sum(g0) + brg0; g1 = wave_sum(g1) + brg1; g2 = wave_sum(g2) + brg2; g3 = wave_sum(g3) + brg3;
        int grp = 0; float gm = g0;
        if (g1 > gm) { gm = g1; grp = 1; } if (g2 > gm) { gm = g2; grp = 2; } if (g3 > gm) { gm = g3; grp = 3; }
        const float pg = 1.0f / (expf(g0 - gm) + expf(g1 - gm) + expf(g2 - gm) + expf(g3 - gm));
        float e0 = 0.f, e1 = 0.f, e2 = 0.f, e3 = 0.f;
        const float4* wgp = wre + grp * 1024 + lane;
#pragma unroll
        for (int i = 0; i < 4; ++i)
#pragma unroll
            for (int j = 0; j < 4; ++j) { const float4 w = wgp[i * 256 + j * 64]; const float x = tv[4 * i + j]; e0 += x * w.x; e1 += x * w.y; e2 += x * w.z; e3 += x * w.w; }
        float el[4];
        el[0] = wave_sum(e0) + bre[grp * 4]; el[1] = wave_sum(e1) + bre[grp * 4 + 1]; el[2] = wave_sum(e2) + bre[grp * 4 + 2]; el[3] = wave_sum(e3) + bre[grp * 4 + 3];
        if (lane < 2 && VAR == 0) {
            int i0 = 0; float m0 = el[0];
            if (el[1] > m0) { m0 = el[1]; i0 = 1; } if (el[2] > m0) { m0 = el[2]; i0 = 2; } if (el[3] > m0) { m0 = el[3]; i0 = 3; }
            int i1 = -1; float m1 = -INFINITY;
            if (i0 != 0 && el[0] > m1) { m1 = el[0]; i1 = 0; } if (i0 != 1 && el[1] > m1) { m1 = el[1]; i1 = 1; }
            if (i0 != 2 && el[2] > m1) { m1 = el[2]; i1 = 2; } if (i0 != 3 && el[3] > m1) { m1 = el[3]; i1 = 3; }
            const float p1 = expf(m1 - m0);
            Route rt; rt.e0 = grp * 4 + i0; rt.e1 = grp * 4 + i1; rt.c0 = pg / (1.0f + p1); rt.c1 = pg * p1 / (1.0f + p1);
            if (lane == 0) p.ROUTE[tok] = rt;
            const int e = lane == 0 ? rt.e0 : rt.e1; const int idx = (wv * RCH + kk) * 2 + lane;
            ent_e[idx] = e; ent_s[idx] = atomicAdd(&lcnt[e], 1); ent_v[idx] = tok * 2 + lane;
        }
    }
    if (VAR == 0) {
        __syncthreads();
        if (tidp < 16) lbase[tidp] = lcnt[tidp] > 0 ? atomicAdd(&p.CNT[tidp * 64], lcnt[tidp]) : 0;
        __syncthreads();
#pragma unroll 1
        for (int i = tidp; i < 4 * RCH * 2; i += NTHR) { const int w_ = i / (RCH * 2), k_ = (i % (RCH * 2)) >> 1;
            if (k0 + k_ < kmax && tb + w_ + (k0 + k_) * nw < T_TOK) { const int e = ent_e[i]; p.LIST[e * LIST_CAP + lbase[e] + ent_s[i]] = ent_v[i]; } }
    }
    }
}

template <int DOWN> __device__ void phase_moe(const P& p, char* smem, int bid, int nblk, const Sched& sc) {
    bf16_t* As = (bf16_t*)smem; bf16_t* Bs = As + 128 * 64; bf16_t* Cs = (bf16_t*)smem;
    int* ents = (int*)(smem + 73728); float* cws = (float*)(ents + 128);
    const int tid = opaque_tid(), lane = tid & 63, wid = tid >> 6, wr = wid >> 1, wc = wid & 1;
    const int l31 = lane & 31, lh = lane >> 5;
    int cnt[16]; int total = 0;
#pragma unroll
    for (int e = 0; e < 16; ++e) { cnt[e] = p.CNT[e * 64]; total += ((cnt[e] + 127) >> 7) * 8; }
    const XOrder xo(bid, nblk, sc);
    for (int rr = 0; ; ++rr) {
        int u; if (!xo.round(rr, total, u)) break; if (u < 0) continue;
        int e = 0, base = 0, ce = 0;
#pragma unroll
        for (int k = 0; k < 16; ++k) { const int n = ((cnt[k] + 127) >> 7) * 8; if (u >= base + n && k == e) { base += n; e = k + 1; } if (k == e) ce = cnt[k]; }
        const int loc = u - base; const int mt = loc >> 3, nt = loc & 7;
        const int nrows = min(128, ce - mt * 128);
        __syncthreads();
        if (tid < 128) { const int ent = p.LIST[e * LIST_CAP + mt * 128 + (tid < nrows ? tid : 0)]; ents[tid] = ent;
            if (DOWN) { const Route rt = p.ROUTE[ent >> 1]; cws[tid] = (ent & 1) ? rt.c1 : rt.c0; } }
        __syncthreads();
        const int KK = DOWN ? 512 : 1024;
        const bf16_t* Xb = DOWN ? p.HID : p.NBUF;
        int tu_ = tid; asm volatile("" : "+v"(tu_));
        const int g0 = gl_row(tu_, 0);
        const unsigned ol0 = (unsigned)(DOWN ? ents[g0] : ents[g0] >> 1) * (unsigned)KK + gl_col(tu_, g0), ol1 = (unsigned)(DOWN ? ents[g0 + 8] : ents[g0 + 8] >> 1) * (unsigned)KK + gl_col(tu_, g0 + 8);
        const unsigned ol2 = (unsigned)(DOWN ? ents[g0 + 16] : ents[g0 + 16] >> 1) * (unsigned)KK + gl_col(tu_, g0 + 16), ol3 = (unsigned)(DOWN ? ents[g0 + 24] : ents[g0 + 24] >> 1) * (unsigned)KK + gl_col(tu_, g0 + 24);
        const bf16_t* Wb = (DOWN ? p.WEO + (size_t)e * 1024 * 512 : p.WEI + (size_t)e * 1024 * 1024) + (size_t)nt * 128 * KK;
        const unsigned w0 = (unsigned)g0 * (unsigned)KK + gl_col(tu_, g0), w1 = (unsigned)(g0 + 8) * (unsigned)KK + gl_col(tu_, g0 + 8), w2 = (unsigned)(g0 + 16) * (unsigned)KK + gl_col(tu_, g0 + 16), w3 = (unsigned)(g0 + 24) * (unsigned)KK + gl_col(tu_, g0 + 24);
        f32x16 acc[2][2]; ZERO_ACC(acc);
        gemm_mainloop(Wb, w0, w1, w2, w3, Xb, ol0, ol1, ol2, ol3, KK, acc, As, Bs);
        if (DOWN) {
#pragma unroll
            for (int j = 0; j < 2; ++j) { const float c = cws[64 * wc + 32 * j + l31];
#pragma unroll
                for (int i = 0; i < 2; ++i)
#pragma unroll
                    for (int r = 0; r < 16; ++r) acc[i][j][r] *= c; }
        } else {
#pragma unroll
            for (int j = 0; j < 2; ++j)
#pragma unroll
                for (int r = 0; r < 16; ++r) { const float g = acc[0][j][r]; acc[0][j][r] = g * __builtin_amdgcn_rcpf(1.0f + __expf(-g)) * acc[1][j][r]; }
        }
        __syncthreads();
        if (DOWN) cimg_write(acc, Cs, wr, wc, l31, lh);
        else {
#pragma unroll
            for (int j = 0; j < 2; ++j)
#pragma unroll
                for (int g = 0; g < 4; ++g) { uint2 o; o.x = cvt_pk_bf16(acc[0][j][4 * g], acc[0][j][4 * g + 1]); o.y = cvt_pk_bf16(acc[0][j][4 * g + 2], acc[0][j][4 * g + 3]);
                    *(uint2*)(Cs + (64 * wc + 32 * j + l31) * CSTR + 32 * wr + 8 * g + 4 * lh) = o; }
        }
        __syncthreads();
        int te_ = tid; asm volatile("" : "+v"(te_));
        if (DOWN) {
#pragma unroll
            for (int k = 0; k < 8; ++k) { const int c = te_ + 256 * k; const int lrow = c >> 4, ch = c & 15;
                if (lrow < nrows) { const uint4 v = *(const uint4*)(Cs + lrow * CSTR + ch * 8); *(uint4*)(p.YMOE + (size_t)ents[lrow] * 1024 + nt * 128 + ch * 8) = v; } }
        } else {
#pragma unroll
            for (int k = 0; k < 4; ++k) { const int c = te_ + 256 * k; const int lrow = c >> 3, ch = c & 7;
                if (lrow < nrows) { const uint4 v = *(const uint4*)(Cs + lrow * CSTR + ch * 8); *(uint4*)(p.HID + (size_t)ents[lrow] * 512 + nt * 64 + ch * 8) = v; } }
        }
    }
}

template <int VAR = 0> __device__ void phase_final(const P& p, int bid, int nblk) {
    const int tidp = opaque_tid();
    const int lane = tidp & 63; const int gw = bid * 4 + (tidp >> 6), nw = nblk * 4;
    for (int tok = gw; tok < T_TOK; tok += nw) {
        float* hp = p.out + (size_t)tok * DM; const bf16_t* hb = p.HB + (size_t)tok * DM; const bf16_t* y0 = p.YMOE + (size_t)tok * 2 * DM; const bf16_t* y1 = y0 + DM;
        float4 v[4]; float ss = 0.f;
#pragma unroll
        for (int i = 0; i < 4; ++i) { const uint2 hu = *(const uint2*)(hb + i * 256 + lane * 4);
            v[i].x = __uint_as_float(hu.x << 16); v[i].y = __uint_as_float(hu.x & 0xffff0000u); v[i].z = __uint_as_float(hu.y << 16); v[i].w = __uint_as_float(hu.y & 0xffff0000u);
            const uint2 a = *(const uint2*)(y0 + i * 256 + lane * 4), b = *(const uint2*)(y1 + i * 256 + lane * 4);
            v[i].x += __uint_as_float(a.x << 16) + __uint_as_float(b.x << 16); v[i].y += __uint_as_float(a.x & 0xffff0000u) + __uint_as_float(b.x & 0xffff0000u);
            v[i].z += __uint_as_float(a.y << 16) + __uint_as_float(b.y << 16); v[i].w += __uint_as_float(a.y & 0xffff0000u) + __uint_as_float(b.y & 0xffff0000u);
            ss += v[i].x * v[i].x + v[i].y * v[i].y + v[i].z * v[i].z + v[i].w * v[i].w; }
        ss = wave_sum(ss);
        const float r = rsqrtf(ss * (1.0f / DM) + 1e-6f);
#pragma unroll
        for (int i = 0; i < 4; ++i) { const float4 gg = *(const float4*)(p.g_fin + i * 256 + lane * 4);
            float4 o; o.x = v[i].x * r * gg.x; o.y = v[i].y * r * gg.y; o.z = v[i].z * r * gg.z; o.w = v[i].w * r * gg.w;
            *(float4*)((VAR ? (float*)p.SGS + (size_t)4 * 1024 * 1024 + (size_t)(tok & 8191) * DM : hp) + i * 256 + lane * 4) = o; }
    }
}
__device__ __forceinline__ float fast_exp2(float x) { return __builtin_amdgcn_exp2f(x); }
typedef float f32x2v __attribute__((ext_vector_type(2)));
template <int KIND, int VAR = 0> __device__ void phase_attn(const P& p, char* smem, int bid, int nblk, const Sched& sc) {
    constexpr int NM = 1, NMAPS = KIND == 0 ? 2 : 1, DQK = KIND == 2 ? 128 : 64, DV = KIND == 1 ? 64 : 128;
    constexpr int KROW = DQK, QROW = NMAPS * DQK, KSTR = KROW + 8, VSTR = 72, NDT = DV / 32, NKS = DQK / 16;
    constexpr int KCH = 64 * KROW / 8 / NTHR, VCH = DV * 8 / NTHR;
    constexpr int NH = KIND == 1 ? 8 : 4;
    constexpr int NUNITS = NBATCH * NH * 64;
    constexpr bool DB = KIND != 2;
    constexpr bool PF2 = KIND == 1;
    bf16_t* Ks = (bf16_t*)smem; bf16_t* Vs = Ks + (DB ? 2 : 1) * 64 * KSTR;
    const int tid = opaque_tid(), lane = tid & 63, wid = tid >> 6, l31 = lane & 31, lh = lane >> 5;
    const float c = (KIND == 2 ? 0.08838834764831845f : 0.125f) * 1.4426950408889634f;
    float lam = 0.f;
    if (KIND == 0) { float d1 = 0.f, d2 = 0.f; for (int i = 0; i < 64; ++i) { d1 += p.lq1[i] * p.lk1[i]; d2 += p.lq2[i] * p.lk2[i]; } lam = expf(d1) - expf(d2) + 0.2f; }
    const bf16_t* Qb = KIND == 0 ? p.DQ : KIND == 1 ? p.SQ : p.MQ;
    const bf16_t* Kb = KIND == 0 ? p.DK : KIND == 1 ? p.SK : p.MK;
    const bf16_t* Vb = KIND == 0 ? p.DVT : KIND == 1 ? p.SVT : p.MVT;
    bf16_t* Yb = VAR != 0 ? (bf16_t*)p.SGS + (size_t)16 * 1024 * 1024 : KIND == 0 ? p.YD : KIND == 1 ? p.YS : p.YM;
    constexpr int VLEN = KIND == 2 ? 256 : S_LEN;
    const bool xaware = false;
    for (int rnd = 0; xaware ? (rnd < NBATCH * NH / 8) : (rnd * nblk < NUNITS); ++rnd) {
        int qt, bh;
        if (xaware) { bh = sc.x * (NBATCH * NH / 8) + rnd; qt = (rnd & 1) ? sc.j : 63 - sc.j; }
        else { const int rank = rnd * nblk + ((rnd & 1) ? nblk - 1 - bid : bid); if (rank >= NUNITS) continue;
               qt = KIND == 2 ? rank % 64 : 63 - rank / (NBATCH * NH); bh = KIND == 2 ? rank / 64 : rank % (NBATCH * NH); }
        const int b = bh / NH, h = bh % NH;
        const int q0 = qt * 128, qw = q0 + 32 * wid;
        const int nkt = KIND == 2 ? 4 : 2 * (qt + 1);
        unsigned o1pk[NDT][8];
#pragma unroll 1
        for (int map = 0; map < NMAPS; ++map) {
        bf16x8 qf[NM][NKS];
        const bf16_t* qp = Qb + ((size_t)(b * S_LEN + qw + l31)) * 512 + h * QROW + map * DQK + lh * 8;
        if (KIND != 2) {
#pragma unroll
            for (int m = 0; m < NM; ++m)
#pragma unroll
                for (int ks = 0; ks < NKS; ++ks) qf[m][ks] = *(const bf16x8*)(qp + m * DQK + ks * 16);
        }
        f32x16 o[NM][NDT];
#pragma unroll
        for (int m = 0; m < NM; ++m)
#pragma unroll
            for (int dt = 0; dt < NDT; ++dt)
#pragma unroll
                for (int r = 0; r < 16; ++r) o[m][dt][r] = 0.f;
        float mrow[NM], lrow[NM];
#pragma unroll
        for (int m = 0; m < NM; ++m) { mrow[m] = -INFINITY; lrow[m] = 0.f; }
        int tid_l = tid; asm volatile("" : "+v"(tid_l));
        const bf16_t* ksrc = Kb + ((size_t)(KIND == 2 ? b * 256 : b * S_LEN) + (tid_l >> (KROW == 128 ? 4 : 3))) * 512 + h * QROW + map * DQK + (tid_l & (KROW / 8 - 1)) * 8;
        constexpr int KROWS_PER_PASS = NTHR / (KROW / 8);
        const int krow_ = tid_l >> (KROW == 128 ? 4 : 3);
        bf16_t* kdst = Ks + ((krow_ & ~12) | ((krow_ & 4) << 1) | ((krow_ & 8) >> 1)) * KSTR + (tid_l & (KROW / 8 - 1)) * 8;
        const bf16_t* vsrc = Vb + ((size_t)(bh * DV + (tid_l >> 3))) * VLEN + (tid_l & 7) * 8;
        bf16_t* vdst = Vs + (tid_l >> 3) * VSTR + (tid_l & 7) * 8;
        uint4 rk0, rk1, rk2 = make_uint4(0,0,0,0), rk3 = make_uint4(0,0,0,0), rv0, rv1, rv2 = make_uint4(0,0,0,0), rv3 = make_uint4(0,0,0,0);
        uint4 rk0b = make_uint4(0,0,0,0), rk1b = make_uint4(0,0,0,0), rv0b = make_uint4(0,0,0,0), rv1b = make_uint4(0,0,0,0);
        { const bf16_t* s_ = ksrc + (size_t)(0) * 512; rk0 = *(const uint4*)(s_); rk1 = *(const uint4*)(s_ + (size_t)KROWS_PER_PASS * 512); if (KCH > 2) { rk2 = *(const uint4*)(s_ + (size_t)2 * KROWS_PER_PASS * 512); rk3 = *(const uint4*)(s_ + (size_t)3 * KROWS_PER_PASS * 512); } }
        { const bf16_t* s_ = vsrc + ((size_t)0); rv0 = *(const uint4*)(s_); rv1 = *(const uint4*)(s_ + (size_t)32 * VLEN); if (VCH > 2) { rv2 = *(const uint4*)(s_ + (size_t)64 * VLEN); rv3 = *(const uint4*)(s_ + (size_t)96 * VLEN); } }
        __syncthreads();
        { *(uint4*)(kdst) = rk0; *(uint4*)(kdst + KROWS_PER_PASS * KSTR) = rk1; if (KCH > 2) { *(uint4*)(kdst + 2 * KROWS_PER_PASS * KSTR) = rk2; *(uint4*)(kdst + 3 * KROWS_PER_PASS * KSTR) = rk3; } }
        { *(uint4*)(vdst) = rv0; *(uint4*)(vdst + 32 * VSTR) = rv1; if (VCH > 2) { *(uint4*)(vdst + 64 * VSTR) = rv2; *(uint4*)(vdst + 96 * VSTR) = rv3; } }
        __syncthreads();
        if (PF2) { const int t1 = nkt > 1 ? 1 : 0;
                   { const bf16_t* s_ = ksrc + (size_t)(t1 * 64) * 512; rk0 = *(const uint4*)(s_); rk1 = *(const uint4*)(s_ + (size_t)KROWS_PER_PASS * 512); }
                   { const bf16_t* s_ = vsrc + (size_t)(t1 * 64); rv0 = *(const uint4*)(s_); rv1 = *(const uint4*)(s_ + (size_t)32 * VLEN); } }
        if (!DB && nkt > 1) { const bf16_t* s_ = ksrc + (size_t)(64) * 512; rk0 = *(const uint4*)(s_); rk1 = *(const uint4*)(s_ + (size_t)KROWS_PER_PASS * 512); if (KCH > 2) { rk2 = *(const uint4*)(s_ + (size_t)2 * KROWS_PER_PASS * 512); rk3 = *(const uint4*)(s_ + (size_t)3 * KROWS_PER_PASS * 512); } }
        uint2 mwn = make_uint2(0u, 0u);
        if (KIND == 1) mwn = *(const uint2*)(p.MASK + ((size_t)(b * S_LEN + qw + l31)) * 256);
        for (int kt = 0; kt < nkt; ++kt) {
            const bool active = KIND == 2 ? true : (kt * 64 <= qw + 31);
            const bf16_t* Kc = Ks + (DB ? (kt & 1) * 64 * KSTR : 0); const bf16_t* Vc = Vs + (DB ? (kt & 1) * DV * VSTR : 0);
            if (PF2) {
                const int t2 = kt + 2 < nkt ? kt + 2 : nkt - 1;
                { const bf16_t* s_ = ksrc + (size_t)(t2 * 64) * 512; rk0b = *(const uint4*)(s_); rk1b = *(const uint4*)(s_ + (size_t)KROWS_PER_PASS * 512); }
                { const bf16_t* s_ = vsrc + ((size_t)t2 * 64); rv0b = *(const uint4*)(s_); rv1b = *(const uint4*)(s_ + (size_t)32 * VLEN); }
            } else
            if (DB && kt + 1 < nkt && VAR != 6 && VAR != 7) {
                { const bf16_t* s_ = ksrc + (size_t)((kt + 1) * 64) * 512; rk0 = *(const uint4*)(s_); rk1 = *(const uint4*)(s_ + (size_t)KROWS_PER_PASS * 512); if (KCH > 2) { rk2 = *(const uint4*)(s_ + (size_t)2 * KROWS_PER_PASS * 512); rk3 = *(const uint4*)(s_ + (size_t)3 * KROWS_PER_PASS * 512); } }
                { const bf16_t* s_ = vsrc + ((size_t)(kt + 1) * 64); rv0 = *(const uint4*)(s_); rv1 = *(const uint4*)(s_ + (size_t)32 * VLEN); if (VCH > 2) { rv2 = *(const uint4*)(s_ + (size_t)64 * VLEN); rv3 = *(const uint4*)(s_ + (size_t)96 * VLEN); } }
            }
            __builtin_amdgcn_sched_barrier(0);
            unsigned pk[NM][2][2][4];
            if (active) {
                uint2 mw = mwn;
                if (KIND == 1) { mw.x >>= 8 * lh; mw.y >>= 8 * lh; mwn = *(const uint2*)(p.MASK + ((size_t)(b * S_LEN + qw + l31)) * 256 + (kt + 1 < nkt ? kt + 1 : kt) * 2); }
#pragma unroll
                for (int m = 0; m < NM; ++m) {
                    f32x16 s[2];
#pragma unroll
                    for (int r = 0; r < 16; ++r) { s[0][r] = 0.f; s[1][r] = 0.f; }
#pragma unroll
                    for (int ks = 0; ks < NKS; ks += 2) {
                        const bf16x8 a00 = *(const bf16x8*)(Kc + l31 * KSTR + m * DQK + ks * 16 + lh * 8);
                        const bf16x8 a10 = *(const bf16x8*)(Kc + (32 + l31) * KSTR + m * DQK + ks * 16 + lh * 8);
                        const bf16x8 a01 = *(const bf16x8*)(Kc + l31 * KSTR + m * DQK + (ks + 1) * 16 + lh * 8);
                        const bf16x8 a11 = *(const bf16x8*)(Kc + (32 + l31) * KSTR + m * DQK + (ks + 1) * 16 + lh * 8);
                        const bf16x8 q0_ = KIND == 2 ? *(const bf16x8*)(qp + ks * 16) : qf[m][ks];
                        const bf16x8 q1_ = KIND == 2 ? *(const bf16x8*)(qp + (ks + 1) * 16) : qf[m][ks + 1];
                        __builtin_amdgcn_sched_barrier(0);
                        if (VAR != 5) {
                        s[0] = __builtin_amdgcn_mfma_f32_32x32x16_bf16(a00, q0_, s[0], 0, 0, 0);
                        s[1] = __builtin_amdgcn_mfma_f32_32x32x16_bf16(a10, q0_, s[1], 0, 0, 0);
                        s[0] = __builtin_amdgcn_mfma_f32_32x32x16_bf16(a01, q1_, s[0], 0, 0, 0);
                        s[1] = __builtin_amdgcn_mfma_f32_32x32x16_bf16(a11, q1_, s[1], 0, 0, 0);
                        } else { asm volatile("" :: "v"(a00), "v"(a10), "v"(a01), "v"(a11)); }
                    }
                    if (KIND == 0 && kt * 64 + 63 > qw) {
                        const int qi = qw + l31 - kt * 64 - 8 * lh;
#pragma unroll
                        for (int t = 0; t < 2; ++t)
#pragma unroll
                            for (int r = 0; r < 16; ++r) if (32 * t + (r & 7) + 16 * (r >> 3) > qi) s[t][r] = -INFINITY;
                    }
                    float mx = s[0][0];
#pragma unroll
                    for (int r = 1; r < 16; ++r) mx = fmaxf(mx, s[0][r]);
#pragma unroll
                    for (int r = 0; r < 16; ++r) mx = fmaxf(mx, s[1][r]);
                    mx = xhalf_max(mx);
                    const float mnew = fmaxf(mrow[m], mx * c);
                    const float corr = fast_exp2(mrow[m] - mnew);
                    mrow[m] = mnew;
                    f32x2v ps2 = {0.f, 0.f}; const f32x2v c2 = {c, c}, nm2 = {-mnew, -mnew};
#pragma unroll
                    for (int t = 0; t < 2; ++t)
#pragma unroll
                        for (int r = 0; r < 16; r += 2) {
                            const f32x2v sv = {s[t][r], s[t][r + 1]};
                            const f32x2v y = VAR == 3 ? sv : sv * c2 + nm2;
                            f32x2v pv = {(VAR == 1 || VAR == 3) ? y.x : fast_exp2(y.x), (VAR == 1 || VAR == 3) ? y.y : fast_exp2(y.y)};
                            if (KIND == 1) { int m0 = __builtin_amdgcn_sbfe((int)(t ? mw.y : mw.x), (r & 7) + 16 * (r >> 3), 1), m1 = __builtin_amdgcn_sbfe((int)(t ? mw.y : mw.x), ((r + 1) & 7) + 16 * ((r + 1) >> 3), 1);
                                             asm("" : "+v"(m0), "+v"(m1));
                                             pv.x = __uint_as_float(__float_as_uint(pv.x) & (unsigned)m0); pv.y = __uint_as_float(__float_as_uint(pv.y) & (unsigned)m1); }
                            ps2 += pv; s[t][r] = pv.x; s[t][r + 1] = pv.y;
                        }
                    const float psum = ps2.x + ps2.y;
                    lrow[m] = lrow[m] * corr + psum;
#pragma unroll
                    for (int t = 0; t < 2; ++t)
#pragma unroll
                        for (int s2 = 0; s2 < 2; ++s2)
#pragma unroll
                            for (int j = 0; j < 4; ++j) pk[m][t][s2][j] = cvt_pk_bf16(s[t][8 * s2 + 2 * j], s[t][8 * s2 + 2 * j + 1]);
                    if (__any(corr != 1.0f)) {
#pragma unroll
                        for (int dt = 0; dt < NDT; ++dt)
#pragma unroll
                            for (int r = 0; r < 16; ++r) o[m][dt][r] *= corr;
                    }
                }
            }
            if (!DB) {
            __syncthreads();
            if (kt + 1 < nkt) {
                { *(uint4*)(kdst) = rk0; *(uint4*)(kdst + KROWS_PER_PASS * KSTR) = rk1; if (KCH > 2) { *(uint4*)(kdst + 2 * KROWS_PER_PASS * KSTR) = rk2; *(uint4*)(kdst + 3 * KROWS_PER_PASS * KSTR) = rk3; } }
                { const bf16_t* s_ = vsrc + ((size_t)(kt + 1) * 64); rv0 = *(const uint4*)(s_); rv1 = *(const uint4*)(s_ + (size_t)32 * VLEN); if (VCH > 2) { rv2 = *(const uint4*)(s_ + (size_t)64 * VLEN); rv3 = *(const uint4*)(s_ + (size_t)96 * VLEN); } }
            }
            }
            if (active) {
                constexpr int GS = NDT == 4 ? 1 : 2;
#pragma unroll
                for (int ks2 = 0; ks2 < 4; ks2 += GS) {
                    bf16x8 va[GS][NDT];
#pragma unroll
                    for (int g = 0; g < GS; ++g)
#pragma unroll
                        for (int dt = 0; dt < NDT; ++dt) {
                            va[g][dt] = *(const bf16x8*)(Vc + (32 * dt + l31) * VSTR + 16 * (ks2 + g) + 8 * lh);
                        }
                    __builtin_amdgcn_sched_barrier(0);
#pragma unroll
                    for (int g = 0; g < GS; ++g)
#pragma unroll
                        for (int dt = 0; dt < NDT; ++dt)
#pragma unroll
                            for (int m = 0; m < NM; ++m) {
                                const int k2 = ks2 + g;
                                const uint4 pu = make_uint4(pk[m][k2 >> 1][k2 & 1][0], pk[m][k2 >> 1][k2 & 1][1], pk[m][k2 >> 1][k2 & 1][2], pk[m][k2 >> 1][k2 & 1][3]);
                                if (VAR != 2) o[m][dt] = __builtin_amdgcn_mfma_f32_32x32x16_bf16(va[g][dt], *(const bf16x8*)&pu, o[m][dt], 0, 0, 0); else { o[m][dt][0] += __uint_as_float(pu.x); asm volatile("" :: "v"(va[g][dt])); }
                            }
                }
            }
            if (DB) {
                if (kt + 1 < nkt && VAR != 6 && VAR != 7) {
                    bf16_t* kd = kdst + ((kt + 1) & 1) * 64 * KSTR; bf16_t* vd = vdst + ((kt + 1) & 1) * DV * VSTR;
                    { *(uint4*)(kd) = rk0; *(uint4*)(kd + KROWS_PER_PASS * KSTR) = rk1; if (KCH > 2) { *(uint4*)(kd + 2 * KROWS_PER_PASS * KSTR) = rk2; *(uint4*)(kd + 3 * KROWS_PER_PASS * KSTR) = rk3; } }
                    { *(uint4*)(vd) = rv0; *(uint4*)(vd + 32 * VSTR) = rv1; if (VCH > 2) { *(uint4*)(vd + 64 * VSTR) = rv2; *(uint4*)(vd + 96 * VSTR) = rv3; } }
                }
                if (VAR != 7) __syncthreads();
                if (PF2) { rk0 = rk0b; rk1 = rk1b; rv0 = rv0b; rv1 = rv1b; }
            } else {
            __syncthreads();
            if (kt + 1 < nkt) {
                { *(uint4*)(vdst) = rv0; *(uint4*)(vdst + 32 * VSTR) = rv1; if (VCH > 2) { *(uint4*)(vdst + 64 * VSTR) = rv2; *(uint4*)(vdst + 96 * VSTR) = rv3; } }
                if (kt + 2 < nkt) { const bf16_t* s_ = ksrc + (size_t)((kt + 2) * 64) * 512; rk0 = *(const uint4*)(s_); rk1 = *(const uint4*)(s_ + (size_t)KROWS_PER_PASS * 512); if (KCH > 2) { rk2 = *(const uint4*)(s_ + (size_t)2 * KROWS_PER_PASS * 512); rk3 = *(const uint4*)(s_ + (size_t)3 * KROWS_PER_PASS * 512); } }
            }
            }
        }
#pragma unroll
        for (int m = 0; m < NM; ++m) lrow[m] = xhalf_sum(lrow[m]);
        bf16_t* yp = Yb + ((size_t)(b * S_LEN + qw + l31)) * 512 + h * DV + 4 * lh;
        if (KIND == 0) {
            if (map == 0) {
                const float i1 = 1.0f / lrow[0];
#pragma unroll
                for (int dt = 0; dt < NDT; ++dt)
#pragma unroll
                    for (int j = 0; j < 8; ++j) o1pk[dt][j] = cvt_pk_bf16(o[0][dt][2 * j] * i1, o[0][dt][2 * j + 1] * i1);
            } else {
            const float i2 = lam / lrow[0];
            float ss = 0.f;
#pragma unroll
            for (int dt = 0; dt < NDT; ++dt)
#pragma unroll
                for (int r = 0; r < 16; ++r) { const float o1 = (r & 1) ? __uint_as_float(o1pk[dt][r >> 1] & 0xffff0000u) : __uint_as_float(o1pk[dt][r >> 1] << 16);
                    const float v = o1 - o[0][dt][r] * i2; o[0][dt][r] = v; ss += v * v; }
            ss = xhalf_sum(ss);
            const float rn = rsqrtf(ss * (1.0f / 128.0f) + 1e-6f) * 0.8f;
#pragma unroll
            for (int dt = 0; dt < NDT; ++dt)
#pragma unroll
                for (int g = 0; g < 4; ++g) { const int dv = 32 * dt + 8 * g + 4 * lh; const float4 gs = *(const float4*)(p.g_sub + dv);
                    uint2 w; w.x = cvt_pk_bf16(o[0][dt][4 * g] * rn * gs.x, o[0][dt][4 * g + 1] * rn * gs.y); w.y = cvt_pk_bf16(o[0][dt][4 * g + 2] * rn * gs.z, o[0][dt][4 * g + 3] * rn * gs.w);
                    *(uint2*)(yp + 32 * dt + 8 * g) = w; }
            }
        } else {
            const float i1 = 1.0f / lrow[0];
#pragma unroll
            for (int dt = 0; dt < NDT; ++dt)
#pragma unroll
                for (int g = 0; g < 4; ++g) {
                    uint2 w; w.x = cvt_pk_bf16(o[0][dt][4 * g] * i1, o[0][dt][4 * g + 1] * i1); w.y = cvt_pk_bf16(o[0][dt][4 * g + 2] * i1, o[0][dt][4 * g + 3] * i1);
                    *(uint2*)(yp + 32 * dt + 8 * g) = w; }
        }
        }
    }
}
template <int KIND> __device__ void phase_attn2(const P& p, char* smem, int bid, int nblk, const Sched& sc) {
    constexpr int NMAPS = KIND == 0 ? 2 : 1, DQK = 64, DV = KIND == 1 ? 64 : 128;
    constexpr int QROW = NMAPS * DQK, KSTR = 72, VSTR = 72, NDT = DV / 32, NKS = 4;
    constexpr int VCH = DV * 8 / NTHR;
    constexpr int NH = KIND == 1 ? 8 : 4;
    constexpr int NUNITS = NBATCH * NH * 64;
    bf16_t* Ks = (bf16_t*)smem; bf16_t* Vs = Ks + 2 * 64 * KSTR;
    const int tid = opaque_tid(), lane = tid & 63, wid = tid >> 6, l31 = lane & 31, lh = lane >> 5;
    const float c = 0.125f * 1.4426950408889634f;
    float lam = 0.f;
    if (KIND == 0) { float d1 = 0.f, d2 = 0.f; for (int i = 0; i < 64; ++i) { d1 += p.lq1[i] * p.lk1[i]; d2 += p.lq2[i] * p.lk2[i]; } lam = expf(d1) - expf(d2) + 0.2f; }
    const bf16_t* Qb = KIND == 0 ? p.DQ : p.SQ;
    const bf16_t* Kb = KIND == 0 ? p.DK : p.SK;
    const bf16_t* Vb = KIND == 0 ? p.DVT : p.SVT;
    bf16_t* Yb = KIND == 0 ? p.YD : p.YS;
    const bool xaware = false;
    for (int rnd = 0; xaware ? (rnd < NBATCH * NH / 8) : (rnd * nblk < NUNITS); ++rnd) {
        int qt, bh;
        if (xaware) { bh = sc.x * (NBATCH * NH / 8) + rnd; qt = (rnd & 1) ? sc.j : 63 - sc.j; }
        else { const int rank = rnd * nblk + ((rnd & 1) ? nblk - 1 - bid : bid); if (rank >= NUNITS) continue; qt = 63 - rank / (NBATCH * NH); bh = rank % (NBATCH * NH); }
        const int b = bh / NH, h = bh % NH;
        const int q0 = qt * 128, qw = q0 + 32 * wid;
        const int nkt = 2 * (qt + 1);
        const int last_act = min(nkt - 1, (qw + 31) >> 6);
#pragma unroll 1
        for (int map = 0; map < NMAPS; ++map) {
        bf16x8 qf[NKS];
        { const bf16_t* qp = Qb + ((size_t)(b * S_LEN + qw + l31)) * 512 + h * QROW + map * DQK + lh * 8;
#pragma unroll
          for (int ks = 0; ks < NKS; ++ks) qf[ks] = *(const bf16x8*)(qp + ks * 16); }
        f32x16 o[NDT];
#pragma unroll
        for (int dt = 0; dt < NDT; ++dt)
#pragma unroll
            for (int r = 0; r < 16; ++r) o[dt][r] = 0.f;
        float mrow = -INFINITY, lrow = 0.f;
        int tl_ = tid; asm volatile("" : "+v"(tl_));
        const bf16_t* ksrc = Kb + ((size_t)b * S_LEN + (tl_ >> 3)) * 512 + h * QROW + map * DQK + (tl_ & 7) * 8;
        bf16_t* kdst = Ks + (tl_ >> 3) * KSTR + (tl_ & 7) * 8;
        const bf16_t* vsrc = Vb + ((size_t)(bh * DV + (tl_ >> 3))) * S_LEN + (tl_ & 7) * 8;
        bf16_t* vdst = Vs + (tl_ >> 3) * VSTR + (tl_ & 7) * 8;
        uint4 rk0, rk1, rv0, rv1, rv2 = make_uint4(0, 0, 0, 0), rv3 = make_uint4(0, 0, 0, 0);
#define LDK(kt_) { const bf16_t* s_ = ksrc + (size_t)((kt_) * 64) * 512; rk0 = *(const uint4*)(s_); rk1 = *(const uint4*)(s_ + (size_t)32 * 512); }
#define LDV(kt_) { const bf16_t* s_ = vsrc + (size_t)(kt_) * 64; rv0 = *(const uint4*)(s_); rv1 = *(const uint4*)(s_ + (size_t)32 * S_LEN); if (VCH > 2) { rv2 = *(const uint4*)(s_ + (size_t)64 * S_LEN); rv3 = *(const uint4*)(s_ + (size_t)96 * S_LEN); } }
#define STK(buf_) { bf16_t* d_ = kdst + (buf_) * 64 * KSTR; *(uint4*)(d_) = rk0; *(uint4*)(d_ + 32 * KSTR) = rk1; }
#define STV(buf_) { bf16_t* d_ = vdst + (buf_) * DV * VSTR; *(uint4*)(d_) = rv0; *(uint4*)(d_ + 32 * VSTR) = rv1; if (VCH > 2) { *(uint4*)(d_ + 64 * VSTR) = rv2; *(uint4*)(d_ + 96 * VSTR) = rv3; } }
        LDK(0) LDV(0)
        __syncthreads();
        STK(0) STV(0)
        LDK(1)
        STK(1)
        __syncthreads();
        f32x16 s[2];
        auto qk = [&](int kt) {
            const bf16_t* Kc = Ks + (kt & 1) * 64 * KSTR;
#pragma unroll
            for (int r = 0; r < 16; ++r) { s[0][r] = 0.f; s[1][r] = 0.f; }
#pragma unroll
            for (int ks = 0; ks < NKS; ks += 2) {
                const bf16x8 a00 = *(const bf16x8*)(Kc + l31 * KSTR + ks * 16 + lh * 8), a10 = *(const bf16x8*)(Kc + (32 + l31) * KSTR + ks * 16 + lh * 8);
                const bf16x8 a01 = *(const bf16x8*)(Kc + l31 * KSTR + (ks + 1) * 16 + lh * 8), a11 = *(const bf16x8*)(Kc + (32 + l31) * KSTR + (ks + 1) * 16 + lh * 8);
                s[0] = __builtin_amdgcn_mfma_f32_32x32x16_bf16(a00, qf[ks], s[0], 0, 0, 0);
                s[1] = __builtin_amdgcn_mfma_f32_32x32x16_bf16(a10, qf[ks], s[1], 0, 0, 0);
                s[0] = __builtin_amdgcn_mfma_f32_32x32x16_bf16(a01, qf[ks + 1], s[0], 0, 0, 0);
                s[1] = __builtin_amdgcn_mfma_f32_32x32x16_bf16(a11, qf[ks + 1], s[1], 0, 0, 0);
            }
        };
        unsigned pkp[2][2][4], pkn[2][2][4];
        float corr = 1.0f;
        uint2 mw = make_uint2(0u, 0u);
        auto softmax = [&](int kt) {
            if (KIND == 0 && kt * 64 + 63 > qw) {
                const int qi = qw + l31 - kt * 64 - 4 * lh;
#pragma unroll
                for (int t = 0; t < 2; ++t)
#pragma unroll
                    for (int r = 0; r < 16; ++r) if (32 * t + (r & 3) + 8 * (r >> 2) > qi) s[t][r] = -INFINITY;
            }
            float mx = s[0][0];
#pragma unroll
            for (int r = 1; r < 16; ++r) mx = fmaxf(mx, s[0][r]);
#pragma unroll
            for (int r = 0; r < 16; ++r) mx = fmaxf(mx, s[1][r]);
            mx = xhalf_max(mx);
            const float mnew = fmaxf(mrow, mx * c);
            corr = fast_exp2(mrow - mnew);
            mrow = mnew;
            f32x2v ps2 = {0.f, 0.f}; const f32x2v c2 = {c, c}, nm2 = {-mnew, -mnew};
#pragma unroll
            for (int t = 0; t < 2; ++t)
#pragma unroll
                for (int r = 0; r < 16; r += 2) {
                    const f32x2v sv = {s[t][r], s[t][r + 1]};
                    const f32x2v y = sv * c2 + nm2;
                    f32x2v pv = {fast_exp2(y.x), fast_exp2(y.y)};
                    if (KIND == 1) { pv.x = __uint_as_float(__float_as_uint(pv.x) & (unsigned)__builtin_amdgcn_sbfe((int)(t ? mw.y : mw.x), (r & 3) + 8 * (r >> 2), 1));
                                     pv.y = __uint_as_float(__float_as_uint(pv.y) & (unsigned)__builtin_amdgcn_sbfe((int)(t ? mw.y : mw.x), ((r + 1) & 3) + 8 * ((r + 1) >> 2), 1)); }
                    ps2 += pv;
                    pkn[t][r >> 3][(r >> 1) & 3] = cvt_pk_bf16(pv.x, pv.y);
                }
            lrow = lrow * corr + (ps2.x + ps2.y);
        };
        auto pv_mma = [&](int kt) {
            const bf16_t* Vc = Vs + (kt % 3) * DV * VSTR;
            constexpr int GS = NDT == 4 ? 1 : 2;
#pragma unroll
            for (int ks2 = 0; ks2 < 4; ks2 += GS) {
                bf16x8 va[GS][NDT];
#pragma unroll
                for (int g = 0; g < GS; ++g)
#pragma unroll
                    for (int dt = 0; dt < NDT; ++dt) {
                        const bf16_t* vp = Vc + (32 * dt + l31) * VSTR + 16 * (ks2 + g) + 4 * lh;
                        const uint2 lo = *(const uint2*)vp, hi = *(const uint2*)(vp + 8);
                        const uint4 vv = make_uint4(lo.x, lo.y, hi.x, hi.y);
                        va[g][dt] = *(const bf16x8*)&vv;
                    }
#pragma unroll
                for (int g = 0; g < GS; ++g)
#pragma unroll
                    for (int dt = 0; dt < NDT; ++dt) {
                        const int k2 = ks2 + g;
                        const uint4 pu = make_uint4(pkp[k2 >> 1][k2 & 1][0], pkp[k2 >> 1][k2 & 1][1], pkp[k2 >> 1][k2 & 1][2], pkp[k2 >> 1][k2 & 1][3]);
                        o[dt] = __builtin_amdgcn_mfma_f32_32x32x16_bf16(va[g][dt], *(const bf16x8*)&pu, o[dt], 0, 0, 0);
                    }
            }
        };
        uint2 mwn = make_uint2(0u, 0u);
        if (KIND == 1) mwn = *(const uint2*)(p.MASK + ((size_t)(b * S_LEN + qw + l31)) * 256);
        qk(0);
        for (int kt = 0; kt <= nkt; ++kt) {
            if (kt + 2 < nkt) LDK(kt + 2)
            if (kt + 1 < nkt) LDV(kt + 1)
            const bool do_sm = kt <= last_act, do_pv = kt >= 1 && kt - 1 <= last_act;
            if (do_sm && KIND == 1) { mw = mwn; mw.x >>= 4 * lh; mw.y >>= 4 * lh; if (kt + 1 <= last_act) mwn = *(const uint2*)(p.MASK + ((size_t)(b * S_LEN + qw + l31)) * 256 + (kt + 1) * 2); }
            if (do_sm && do_pv) {
                softmax(kt); pv_mma(kt - 1);
            } else if (do_sm) softmax(kt);
            else if (do_pv) pv_mma(kt - 1);
            if (do_sm) {
                if (__any(corr != 1.0f)) {
#pragma unroll
                    for (int dt = 0; dt < NDT; ++dt)
#pragma unroll
                        for (int r = 0; r < 16; ++r) o[dt][r] *= corr;
                }
#pragma unroll
                for (int t = 0; t < 2; ++t)
#pragma unroll
                    for (int s2 = 0; s2 < 2; ++s2)
#pragma unroll
                        for (int j = 0; j < 4; ++j) pkp[t][s2][j] = pkn[t][s2][j];
            }
            if (kt + 1 <= last_act) qk(kt + 1);
            if (kt + 2 < nkt) STK(kt & 1)
            if (kt + 1 < nkt) STV((kt + 1) % 3)
            __syncthreads();
        }
#undef LDK
#undef LDV
#undef STK
#undef STV
        int te_ = tid; asm volatile("" : "+v"(te_));
        uint4* park = (uint4*)p.SGS + (size_t)bid * 2048 + te_;
        lrow = xhalf_sum(lrow);
        bf16_t* yp = Yb + ((size_t)(b * S_LEN + qw + l31)) * 512 + h * DV + 4 * lh;
        if (KIND == 0) {
            if (map == 0) {
                const float i1 = 1.0f / lrow;
#pragma unroll
                for (int dt = 0; dt < NDT; ++dt)
#pragma unroll
                    for (int h2 = 0; h2 < 2; ++h2)
                        park[(size_t)(dt * 2 + h2) * 256] = make_uint4(cvt_pk_bf16(o[dt][8 * h2] * i1, o[dt][8 * h2 + 1] * i1), cvt_pk_bf16(o[dt][8 * h2 + 2] * i1, o[dt][8 * h2 + 3] * i1),
                                                                      cvt_pk_bf16(o[dt][8 * h2 + 4] * i1, o[dt][8 * h2 + 5] * i1), cvt_pk_bf16(o[dt][8 * h2 + 6] * i1, o[dt][8 * h2 + 7] * i1));
                asm volatile("" ::: "memory");
            } else {
                const float i2 = lam / lrow;
                float ss = 0.f;
#pragma unroll
                for (int dt = 0; dt < NDT; ++dt)
#pragma unroll
                    for (int h2 = 0; h2 < 2; ++h2) { const uint4 w = park[(size_t)(dt * 2 + h2) * 256]; const unsigned ww[4] = {w.x, w.y, w.z, w.w};
#pragma unroll
                        for (int j = 0; j < 4; ++j) {
                            const float v0 = __uint_as_float(ww[j] << 16) - o[dt][8 * h2 + 2 * j] * i2, v1 = __uint_as_float(ww[j] & 0xffff0000u) - o[dt][8 * h2 + 2 * j + 1] * i2;
                            o[dt][8 * h2 + 2 * j] = v0; o[dt][8 * h2 + 2 * j + 1] = v1; ss += v0 * v0 + v1 * v1; } }
                ss = xhalf_sum(ss);
                const float rn = rsqrtf(ss * (1.0f / 128.0f) + 1e-6f) * 0.8f;
#pragma unroll
                for (int dt = 0; dt < NDT; ++dt)
#pragma unroll
                    for (int g = 0; g < 4; ++g) { const int dv = 32 * dt + 8 * g + 4 * lh; const float4 gs = *(const float4*)(p.g_sub + dv);
                        uint2 w; w.x = cvt_pk_bf16(o[dt][4 * g] * rn * gs.x, o[dt][4 * g + 1] * rn * gs.y); w.y = cvt_pk_bf16(o[dt][4 * g + 2] * rn * gs.z, o[dt][4 * g + 3] * rn * gs.w);
                        *(uint2*)(yp + 32 * dt + 8 * g) = w; }
            }
        } else {
            const float i1 = 1.0f / lrow;
#pragma unroll
            for (int dt = 0; dt < NDT; ++dt)
#pragma unroll
                for (int g = 0; g < 4; ++g) {
                    uint2 w; w.x = cvt_pk_bf16(o[dt][4 * g] * i1, o[dt][4 * g + 1] * i1); w.y = cvt_pk_bf16(o[dt][4 * g + 2] * i1, o[dt][4 * g + 3] * i1);
                    *(uint2*)(yp + 32 * dt + 8 * g) = w; }
        }
        }
    }
}
#define IDX_M 23
__device__ __forceinline__ float med3f(float a, float b, float c) { return __builtin_amdgcn_fmed3f(a, b, c); }
__device__ void phase_indexer(const P& p, char* smem, int bid, int nblk, const Sched& sc_) {
    bf16_t* Kb = (bf16_t*)smem;
    unsigned* mimg = (unsigned*)(smem + 18432);
    const int tid = opaque_tid(), lane = tid & 63, wid = tid >> 6, l31 = lane & 31, lh = lane >> 5;
    constexpr int NUNITS = NBATCH * 256;
    const bool xaware = false;
    for (int rnd = 0; xaware ? (rnd < 2) : (rnd * nblk < NUNITS); ++rnd) {
        int qu, b;
        if (xaware) { b = sc_.x >> 1; const int k = rnd == 0 ? 127 - sc_.j : sc_.j; qu = 2 * k + (sc_.x & 1); }
        else { const int rank = rnd * nblk + ((rnd & 1) ? nblk - 1 - bid : bid); if (rank >= NUNITS) continue; qu = 255 - (rank >> 2); b = rank & 3; }
        const int q0 = qu * 32;
        const size_t tok0 = (size_t)b * S_LEN + q0;
        if (q0 < 256) {
#pragma unroll 1
            for (int i = 0; i < 32; ++i) { const int q = q0 + i; const int w0 = tid * 32;
                p.MASK[(tok0 + i) * 256 + tid] = q >= w0 + 31 ? 0xffffffffu : (q < w0 ? 0u : ((2u << (q - w0)) - 1u)); }
            continue;
        }
        const int nkt = (q0 + 95) >> 6;
        const int qb = q0 + 8 * wid;
        bf16x8 aq[2][4]; float wq[2][2][8]; int qv[2][2];
#pragma unroll
        for (int rt = 0; rt < 2; ++rt) {
            const int qa = qb + 4 * rt + 2 * ((l31 >> 2) & 1) + (l31 >> 4), ha = 4 * ((l31 >> 3) & 1) + (l31 & 3);
            const bf16_t* ap = p.IQ + ((size_t)b * S_LEN + qa) * 512 + ha * 64 + lh * 8;
#pragma unroll
            for (int ks = 0; ks < 4; ++ks) aq[rt][ks] = *(const bf16x8*)(ap + ks * 16);
#pragma unroll
            for (int e = 0; e < 2; ++e) { const float* wp = p.IW + ((size_t)b * S_LEN + qb + 4 * rt + 2 * lh + e) * 8;
                const float4 w0 = *(const float4*)wp, w1 = *(const float4*)(wp + 4); const float sc = 0.125f * 0.35355339059327373f;
                wq[rt][e][0] = w0.x * sc; wq[rt][e][1] = w0.y * sc; wq[rt][e][2] = w0.z * sc; wq[rt][e][3] = w0.w * sc;
                wq[rt][e][4] = w1.x * sc; wq[rt][e][5] = w1.y * sc; wq[rt][e][6] = w1.z * sc; wq[rt][e][7] = w1.w * sc;
                qv[rt][e] = qb + 4 * rt + 2 * lh + e; }
        }
        const bf16_t* ksrc = p.IK + ((size_t)b * S_LEN + (tid >> 3)) * 64 + (tid & 7) * 8;
        bf16_t* kdst = Kb + (tid >> 3) * 72 + (tid & 7) * 8;
        auto tile_scores = [&](const bf16_t* kbuf, int t, float (&sc)[2][2]) {
            f32x16 acc[2];
#pragma unroll
            for (int r = 0; r < 16; ++r) { acc[0][r] = 0.f; acc[1][r] = 0.f; }
#pragma unroll
            for (int ks = 0; ks < 4; ++ks) {
                const bf16x8 kf = *(const bf16x8*)(kbuf + (32 * t + l31) * 72 + ks * 16 + lh * 8);
                acc[0] = __builtin_amdgcn_mfma_f32_32x32x16_bf16(aq[0][ks], kf, acc[0], 0, 0, 0);
                acc[1] = __builtin_amdgcn_mfma_f32_32x32x16_bf16(aq[1][ks], kf, acc[1], 0, 0, 0);
            }
#pragma unroll
            for (int rt = 0; rt < 2; ++rt)
#pragma unroll
                for (int e = 0; e < 2; ++e) { float s = 0.f;
#pragma unroll
                    for (int hd = 0; hd < 8; ++hd) s = __builtin_fmaf(wq[rt][e][hd], __int_as_float(max(__float_as_int(acc[rt][8 * e + hd]), 0)), s);
                    sc[rt][e] = s; }
        };
        float T[2][2]; int need[2][2];
        {
            float L[2][2][IDX_M];
#pragma unroll
            for (int rt = 0; rt < 2; ++rt)
#pragma unroll
                for (int e = 0; e < 2; ++e)
#pragma unroll
                    for (int i = 0; i < IDX_M; ++i) L[rt][e][i] = -INFINITY;
            __syncthreads();
            uint4 r0 = *(const uint4*)(ksrc), r1 = *(const uint4*)(ksrc + 32 * 64);
            *(uint4*)(kdst) = r0; *(uint4*)(kdst + 32 * 72) = r1;
            __syncthreads();
            for (int kt = 0; kt < nkt; ++kt) {
                const bf16_t* kbuf = Kb + (kt & 1) * 64 * 72;
                if (kt + 1 < nkt) { r0 = *(const uint4*)(ksrc + (size_t)(kt + 1) * 64 * 64); r1 = *(const uint4*)(ksrc + (size_t)(kt + 1) * 64 * 64 + 32 * 64); }
                __builtin_amdgcn_sched_barrier(0);
                const bool interior = kt * 64 + 63 <= qb;
#pragma unroll 1
                for (int t = 0; t < 2; ++t) {
                    float sc[2][2]; tile_scores(kbuf, t, sc);
                    const int key = kt * 64 + 32 * t + l31;
#pragma unroll
                    for (int rt = 0; rt < 2; ++rt)
#pragma unroll
                        for (int e = 0; e < 2; ++e) {
                            const float v = (interior || key <= qv[rt][e]) ? sc[rt][e] : -INFINITY;
#pragma unroll
                            for (int i = IDX_M - 1; i >= 1; --i) L[rt][e][i] = med3f(L[rt][e][i - 1], L[rt][e][i], v);
                            asm("v_max_f32 %0, %1, %2" : "=v"(L[rt][e][0]) : "v"(L[rt][e][0]), "v"(v));
                        }
                }
                if (kt + 1 < nkt) { bf16_t* d = kdst + ((kt + 1) & 1) * 64 * 72; *(uint4*)(d) = r0; *(uint4*)(d + 32 * 72) = r1; }
                __syncthreads();
            }
#pragma unroll
            for (int rt = 0; rt < 2; ++rt)
#pragma unroll
                for (int e = 0; e < 2; ++e) {
                    unsigned U[IDX_M];
#pragma unroll
                    for (int i = 0; i < IDX_M; ++i) { const unsigned bts = __float_as_uint(L[rt][e][i]); U[i] = bts ^ ((unsigned)((int)bts >> 31) | 0x80000000u); }
                    unsigned pre = 0u;
#pragma unroll 1
                    for (int bit = 31; bit >= 0; --bit) {
                        const unsigned cand = pre | (1u << bit);
                        int c0 = 0, c1 = 0;
#pragma unroll
                        for (int i = 0; i < IDX_M; ++i) { const unsigned long long m = __builtin_amdgcn_ballot_w64(U[i] >= cand); c0 += __popc((unsigned)m); c1 += __popc((unsigned)(m >> 32)); }
                        if ((lh ? c1 : c0) >= 256) pre = cand;
                    }
                    int g0 = 0, g1 = 0;
#pragma unroll
                    for (int i = 0; i < IDX_M; ++i) { const unsigned long long m = __builtin_amdgcn_ballot_w64(U[i] > pre); g0 += __popc((unsigned)m); g1 += __popc((unsigned)(m >> 32)); }
                    need[rt][e] = 256 - (lh ? g1 : g0);
                    T[rt][e] = __uint_as_float((pre & 0x80000000u) ? (pre ^ 0x80000000u) : ~pre);
                }
        }
        {
            int tcnt[2][2];
#pragma unroll
            for (int rt = 0; rt < 2; ++rt)
#pragma unroll
                for (int e = 0; e < 2; ++e) tcnt[rt][e] = 0;
            __syncthreads();
            uint4 r0 = *(const uint4*)(ksrc), r1 = *(const uint4*)(ksrc + 32 * 64);
#pragma unroll 1
            for (int i = tid; i < 32 * 256 / 4; i += NTHR) ((uint4*)mimg)[i] = make_uint4(0u, 0u, 0u, 0u);
            *(uint4*)(kdst) = r0; *(uint4*)(kdst + 32 * 72) = r1;
            __syncthreads();
            for (int kt = 0; kt < nkt; ++kt) {
                const bf16_t* kbuf = Kb + (kt & 1) * 64 * 72;
                if (kt + 1 < nkt) { r0 = *(const uint4*)(ksrc + (size_t)(kt + 1) * 64 * 64); r1 = *(const uint4*)(ksrc + (size_t)(kt + 1) * 64 * 64 + 32 * 64); }
                __builtin_amdgcn_sched_barrier(0);
                const bool interior = kt * 64 + 63 <= qb;
#pragma unroll 1
                for (int t = 0; t < 2; ++t) {
                    float sc[2][2]; tile_scores(kbuf, t, sc);
                    const int key = kt * 64 + 32 * t + l31;
#pragma unroll
                    for (int rt = 0; rt < 2; ++rt)
#pragma unroll
                        for (int e = 0; e < 2; ++e) {
                            const float sv = (interior || key <= qv[rt][e]) ? sc[rt][e] : -INFINITY;
                            unsigned long long bal = __builtin_amdgcn_ballot_w64(sv > T[rt][e]);
                            const unsigned long long tb = __builtin_amdgcn_ballot_w64(sv == T[rt][e]);
                            if (tb != 0ull) {
                                const unsigned half = (unsigned)(tb >> (32 * lh));
                                const int rk = tcnt[rt][e] + __popc(half & ((1u << l31) - 1u));
                                bal |= __builtin_amdgcn_ballot_w64(sv == T[rt][e] && rk < need[rt][e]);
                                tcnt[rt][e] += __popc(half);
                            }
                            if (l31 == 0) mimg[(8 * wid + 4 * rt + 2 * lh + e) * 256 + kt * 2 + t] = (unsigned)(bal >> (32 * lh));
                        }
                }
                if (kt + 1 < nkt) { bf16_t* d = kdst + ((kt + 1) & 1) * 64 * 72; *(uint4*)(d) = r0; *(uint4*)(d + 32 * 72) = r1; }
                __syncthreads();
            }
        }
#pragma unroll 1
        for (int i = tid; i < 32 * 64; i += NTHR) { const int row = i >> 6, c4 = i & 63; *(uint4*)(p.MASK + (tok0 + row) * 256 + c4 * 4) = ((const uint4*)mimg)[row * 64 + c4]; }
    }
}
#ifndef PROBE_REP
#define PROBE_REP -1
#endif
#define RUNPH(idx, call) { _Pragma("unroll 1") for (int rep_ = 0; rep_ < ((PROBE_REP == idx) ? 2 : 1); ++rep_) { call; if (rep_ == 0 && PROBE_REP == idx) xcd_barrier(bar); } }

__global__ void __launch_bounds__(NTHR, 2) k_forward(P p) {
    __shared__ __attribute__((aligned(16))) char smem[SMEM_BYTES];
    volatile LAS unsigned* xbw = (volatile LAS unsigned*)(smem + SMEM_BYTES - 16);
    if (threadIdx.x == 0) { xbw[0] = 0u; xbw[1] = 0u; xbw[2] = 0u; xbw[3] = 0u; }
    __syncthreads();
    XcdBarrier bar = xcd_barrier_post(p.bar, xbw);
    const int bid = blockIdx.x, nblk = gridDim.x;
    volatile LAS int* sw = (volatile LAS int*)(smem + SMEM_BYTES - 32);
    if (threadIdx.x == 0) { const int hx = (int)(xb_xcc_id() & 7u); sw[0] = hx; sw[1] = atomicAdd(&p.XC[hx * 64], 1); }
    RUNPH(0, phase_prologue(p, smem, bid, nblk))
    xcd_barrier(bar);
    Sched sc;
    {
        bool even = (nblk & 7) == 0;
#pragma unroll
        for (int i = 0; i < 8; ++i) even = even && (__hip_atomic_load(&p.XC[i * 64], __ATOMIC_RELAXED, __HIP_MEMORY_SCOPE_AGENT) == (nblk >> 3));
        sc.x = even ? sw[0] : (bid & 7); sc.j = even ? sw[1] : (bid >> 3);
        sc.x = __builtin_amdgcn_readfirstlane(sc.x); sc.j = __builtin_amdgcn_readfirstlane(sc.j);
    }
    RUNPH(1, phase_inproj<0>(p, smem, bid, nblk, sc))
    xcd_barrier(bar);
    RUNPH(2, phase_indexer(p, smem, bid, nblk, sc))
    xcd_split_arrive(bar);
    RUNPH(3, phase_attn<0>(p, smem, bid, nblk, sc))
    RUNPH(4, phase_attn<2>(p, smem, bid, nblk, sc))
    xcd_split_wait(bar);
    RUNPH(5, phase_attn<1>(p, smem, bid, nblk, sc))
    xcd_barrier(bar);
    RUNPH(6, phase_merge<1>(p, smem, bid, nblk, sc))
    xcd_barrier(bar);
    RUNPH(7, phase_outproj(p, smem, bid, nblk, sc))
    xcd_barrier(bar);
#if PROBE_REP == 10
    phase_route<1>(p, smem, bid, nblk);
    xcd_barrier(bar);
#endif
    phase_route<0>(p, smem, bid, nblk);
    xcd_barrier(bar);
    RUNPH(8, phase_moe<0>(p, smem, bid, nblk, sc))
    xcd_barrier(bar);
    RUNPH(9, phase_moe<1>(p, smem, bid, nblk, sc))
    xcd_barrier(bar);
#if PROBE_REP == 11
    phase_final<1>(p, bid, nblk);
    xcd_barrier(bar);
#endif
    phase_final<0>(p, bid, nblk);
}

#define MBYTES(x) ((size_t)(x) << 20)
extern "C" void kernel_launch(void* const* d_in, const int* in_sizes, int n_in, void* d_out, int out_size, void* d_ws, size_t ws_size, hipStream_t stream) {
    P p{};
    p.x = (const float*)d_in[0]; p.pos = (const int*)d_in[1]; p.mem = (const float*)d_in[2];
    p.g_mix = (const float*)d_in[3]; p.w_in = (const float*)d_in[4]; p.b_gate = (const float*)d_in[5];
    p.lq1 = (const float*)d_in[6]; p.lk1 = (const float*)d_in[7]; p.lq2 = (const float*)d_in[8]; p.lk2 = (const float*)d_in[9];
    p.g_sub = (const float*)d_in[10]; p.g_mem = (const float*)d_in[11]; p.w_mkv = (const float*)d_in[12];
    p.w_br0 = (const float*)d_in[13]; p.w_br1 = (const float*)d_in[14]; p.w_br2 = (const float*)d_in[15];
    p.w_out = (const float*)d_in[16]; p.g_ffn = (const float*)d_in[17];
    p.w_rg = (const float*)d_in[18]; p.b_rg = (const float*)d_in[19]; p.w_re = (const float*)d_in[20]; p.b_re = (const float*)d_in[21];
    p.w_ei = (const float*)d_in[22]; p.w_eo = (const float*)d_in[23]; p.g_fin = (const float*)d_in[24];
    char* ws = (char*)d_ws; p.out = (float*)d_out;
    p.bar = (unsigned*)ws; p.CNT = (int*)(ws + 65536); p.XC = (int*)(ws + 131072);
    p.NBUF = (bf16_t*)(ws + MBYTES(1));
    p.DQ = (bf16_t*)(ws + MBYTES(65)); p.DK = (bf16_t*)(ws + MBYTES(97)); p.MERGED = (bf16_t*)(ws + MBYTES(65));
    p.SQ = (bf16_t*)(ws + MBYTES(129)); p.SK = (bf16_t*)(ws + MBYTES(161)); p.HID = (bf16_t*)(ws + MBYTES(129));
    p.DVT = (bf16_t*)(ws + MBYTES(193)); p.SVT = (bf16_t*)(ws + MBYTES(225)); p.IQ = (bf16_t*)(ws + MBYTES(257)); p.MQ = (bf16_t*)(ws + MBYTES(289));
    p.YMOE = (bf16_t*)(ws + MBYTES(193));
    p.IK = (bf16_t*)(ws + MBYTES(321)); p.IW = (float*)(ws + MBYTES(325)); p.MASK = (unsigned*)(ws + MBYTES(326));
    p.MK = (bf16_t*)(ws + MBYTES(358)); p.MVT = (bf16_t*)(ws + MBYTES(359)); p.MEMN = (bf16_t*)(ws + MBYTES(360));
    p.ROPEC = (float*)(ws + MBYTES(362)); p.ROPES = (float*)(ws + MBYTES(363));
    p.ROUTE = (Route*)(ws + MBYTES(365)); p.LIST = (int*)(ws + MBYTES(366));
    p.WIN = (bf16_t*)(ws + MBYTES(368)); p.WMKV = (bf16_t*)(ws + MBYTES(383));
    p.WBR = (bf16_t*)(ws + MBYTES(385)); p.WOUT = (bf16_t*)(ws + MBYTES(388)); p.WEI = (bf16_t*)(ws + MBYTES(390)); p.WEO = (bf16_t*)(ws + MBYTES(422));
    p.SGS = (unsigned*)(ws + MBYTES(440));
    p.HB = (bf16_t*)(ws + MBYTES(440));
    p.YD = (bf16_t*)d_out; p.YS = p.YD + (size_t)T_TOK * 512; p.YM = p.YS + (size_t)T_TOK * 512;
    static int grid = 0;
    if (!grid) {
        int dev = 0, cus = 0, per_cu = 0;
        (void)hipGetDevice(&dev);
        (void)hipDeviceGetAttribute(&cus, hipDeviceAttributeMultiprocessorCount, dev);
        (void)hipOccupancyMaxActiveBlocksPerMultiprocessor(&per_cu, k_forward, NTHR, 0);
        if (cus <= 0) cus = 256;
        if (per_cu < 1) per_cu = 1;
        grid = cus * (per_cu < 2 ? per_cu : 2);
    }
    (void)hipMemsetAsync(p.bar, 0, 262144, stream);
    k_forward<<<grid, NTHR, 0, stream>>>(p);
}
```

```cpp
#include <hip/hip_runtime.h>
#include <stdint.h>
#include <type_traits>

typedef unsigned short bf16_t;

#define S_LEN 8192
#define NBATCH 4
#define T_TOK 32768
#define DM 1024
#define DPROJ 7240
#define LIST_CAP 32768

__device__ __forceinline__ float bf2f(bf16_t v) { return __uint_as_float(((unsigned)v) << 16); }
__device__ __forceinline__ bf16_t f2bf(float f) { unsigned u = __float_as_uint(f); u += 0x7fffu + ((u >> 16) & 1u); return (bf16_t)(u >> 16); }

__device__ __forceinline__ float xhalf_max(float x) {
    const auto r = __builtin_amdgcn_permlane32_swap(__float_as_uint(x), __float_as_uint(x), false, false);
    float m; asm("v_max_f32 %0, %1, %2" : "=v"(m) : "v"(r[0]), "v"(r[1])); return m;
}
__device__ __forceinline__ float xhalf_sum(float x) {
    const auto r = __builtin_amdgcn_permlane32_swap(__float_as_uint(x), __float_as_uint(x), false, false);
    return __uint_as_float(r[0]) + __uint_as_float(r[1]);
}
template <int CTRL> __device__ __forceinline__ float dpp_movf(float v) { return __int_as_float(__builtin_amdgcn_update_dpp(0, __float_as_int(v), CTRL, 0xF, 0xF, true)); }
template <int CTRL> __device__ __forceinline__ int dpp_movi(int v) { return __builtin_amdgcn_update_dpp(0, v, CTRL, 0xF, 0xF, true); }
__device__ __forceinline__ float wave_sum(float v) {
    v += dpp_movf<0xB1>(v); v += dpp_movf<0x4E>(v); v += dpp_movf<0x141>(v); v += dpp_movf<0x140>(v);
    { const auto r = __builtin_amdgcn_permlane16_swap(__float_as_uint(v), __float_as_uint(v), false, false); v = __uint_as_float(r[0]) + __uint_as_float(r[1]); }
    { const auto r = __builtin_amdgcn_permlane32_swap(__float_as_uint(v), __float_as_uint(v), false, false); v = __uint_as_float(r[0]) + __uint_as_float(r[1]); }
    return v;
}
__device__ __forceinline__ float wave_max(float v) {
    v = fmaxf(v, dpp_movf<0xB1>(v)); v = fmaxf(v, dpp_movf<0x4E>(v)); v = fmaxf(v, dpp_movf<0x141>(v)); v = fmaxf(v, dpp_movf<0x140>(v));
    { const auto r = __builtin_amdgcn_permlane16_swap(__float_as_uint(v), __float_as_uint(v), false, false); v = fmaxf(__uint_as_float(r[0]), __uint_as_float(r[1])); }
    { const auto r = __builtin_amdgcn_permlane32_swap(__float_as_uint(v), __float_as_uint(v), false, false); v = fmaxf(__uint_as_float(r[0]), __uint_as_float(r[1])); }
    return v;
}
__device__ __forceinline__ int wave_sum_i(int v) {
    v += dpp_movi<0xB1>(v); v += dpp_movi<0x4E>(v); v += dpp_movi<0x141>(v); v += dpp_movi<0x140>(v);
    { const auto r = __builtin_amdgcn_permlane16_swap((unsigned)v, (unsigned)v, false, false); v = (int)(r[0] + r[1]); }
    { const auto r = __builtin_amdgcn_permlane32_swap((unsigned)v, (unsigned)v, false, false); v = (int)(r[0] + r[1]); }
    return v;
}
__device__ __forceinline__ float block_sum(float v, float* red) {
    v = wave_sum(v);
    __syncthreads();
    if ((threadIdx.x & 63) == 0) red[threadIdx.x >> 6] = v;
    __syncthreads();
    return red[0] + red[1] + red[2] + red[3];
}
__device__ __forceinline__ int block_sum_i(int v, int* red) {
    v = wave_sum_i(v);
    __syncthreads();
    if ((threadIdx.x & 63) == 0) red[threadIdx.x >> 6] = v;
    __syncthreads();
    return red[0] + red[1] + red[2] + red[3];
}

struct Route { int e0, e1; float c0, c1; };
#define XB_TMO      128
#define XB_XCNT(j)  (256  + 64 * (j))
#define XB_XSUB(j)  (1280 + 64 * (j))
#define XB_XGEN(j)  (2304 + 64 * (j))
#define XB_TOP      3328
#define XB_TOPGEN   3392
#define XCD_BAR_WORDS 3456
#define XB_SPIN_CAP (1u << 18)
#define LAS __attribute__((address_space(3)))

__device__ __forceinline__ unsigned xb_ld(unsigned* p)              { return __hip_atomic_load(p, __ATOMIC_RELAXED, __HIP_MEMORY_SCOPE_AGENT); }
__device__ __forceinline__ unsigned xb_add(unsigned* p, unsigned v) { return __hip_atomic_fetch_add(p, v, __ATOMIC_RELAXED, __HIP_MEMORY_SCOPE_AGENT); }
__device__ __forceinline__ unsigned xb_xcc_id() { return (unsigned)__builtin_amdgcn_s_getreg((3 << 11) | 20) & 0xFu; }
#define XB_SPIN(cond, bar) do { unsigned _sp = 0; while (cond) { __builtin_amdgcn_s_sleep(1); \
    if ((++_sp & 255u) == 0u) { if (xb_ld(&(bar)[XB_TMO])) break; if (_sp > XB_SPIN_CAP) { atomicAdd(&(bar)[XB_TMO], 1u); break; } } } } while (0)

struct XcdBarrier {
    unsigned* bar; unsigned x;
    volatile LAS unsigned* st;
};

__device__ __forceinline__ XcdBarrier xcd_barrier_post(unsigned* bar, volatile LAS unsigned* st) {
    XcdBarrier b; b.bar = bar; b.x = xb_xcc_id(); b.st = st;
    if (threadIdx.x == 0) (void)xb_add(&bar[XB_XCNT(b.x)], 1u);
    return b;
}
__device__ __forceinline__ void xcd_barrier_complete(unsigned* bar, unsigned x, unsigned& nloc, unsigned& nx) {
    const unsigned G = gridDim.x * gridDim.y * gridDim.z;
    unsigned sum, cnt, mine, sp = 0u;
    for (;;) {
        sum = 0u; cnt = 0u; mine = 0u;
#pragma unroll
        for (unsigned j = 0; j < 16; ++j) { const unsigned c = xb_ld(&bar[XB_XCNT(j)]); sum += c; cnt += (c > 0u) ? 1u : 0u; mine = (j == x) ? c : mine; }
        if (sum == G) break;
        __builtin_amdgcn_s_sleep(1);
        if ((++sp & 255u) == 0u) { if (xb_ld(&bar[XB_TMO])) break; if (sp > XB_SPIN_CAP) { atomicAdd(&bar[XB_TMO], 1u); break; } }
    }
    nloc = mine > 0u ? mine : 1u; nx = cnt > 0u ? cnt : 1u;
}

__device__ __forceinline__ void xcd_barrier(const XcdBarrier& b) {
    asm volatile("s_waitcnt vmcnt(0)" ::: "memory");
    __syncthreads();
    if (threadIdx.x == 0) {
        unsigned* bar = b.bar;
        __builtin_amdgcn_s_waitcnt(0);
        unsigned nloc = b.st[0], nx = b.st[1];
        if (nloc == 0u) { xcd_barrier_complete(bar, b.x, nloc, nx); b.st[0] = nloc; b.st[1] = nx; }
        const unsigned old = xb_add(&bar[XB_XSUB(b.x)], 1u);
        const unsigned gen = old / nloc;
        if (old + 1u == (gen + 1u) * nloc) {
            __builtin_amdgcn_fence(__ATOMIC_RELEASE, "agent");
            asm volatile("s_waitcnt vmcnt(0)" ::: "memory");
            const unsigned og = xb_add(&bar[XB_TOP], 1u);
            const unsigned tg = og / nx;
            if (og + 1u == (tg + 1u) * nx) xb_add(&bar[XB_TOPGEN], 1u);
            else XB_SPIN(xb_ld(&bar[XB_TOPGEN]) == tg, bar);
            __builtin_amdgcn_fence(__ATOMIC_ACQUIRE, "agent");
            xb_add(&bar[XB_XGEN(b.x)], 1u);
            asm volatile("s_waitcnt vmcnt(0)" ::: "memory");
        } else {
            XB_SPIN(xb_ld(&bar[XB_XGEN(b.x)]) == gen, bar);
            __builtin_amdgcn_fence(__ATOMIC_ACQUIRE, "agent");
            asm volatile("s_waitcnt vmcnt(0)" ::: "memory");
        }
    }
    __syncthreads();
}


#define XB_SPLIT 4096
__device__ __forceinline__ void xcd_split_arrive(const XcdBarrier& b) {
    asm volatile("s_waitcnt vmcnt(0)" ::: "memory");
    __syncthreads();
    if (threadIdx.x == 0) {
        __builtin_amdgcn_s_waitcnt(0);
        __builtin_amdgcn_fence(__ATOMIC_RELEASE, "agent");
        asm volatile("s_waitcnt vmcnt(0)" ::: "memory");
        (void)xb_add(&b.bar[XB_SPLIT], 1u);
    }
}
__device__ __forceinline__ void xcd_split_wait(const XcdBarrier& b) {
    __syncthreads();
    if (threadIdx.x == 0) {
        const unsigned G = gridDim.x * gridDim.y * gridDim.z;
        XB_SPIN(xb_ld(&b.bar[XB_SPLIT]) < G, b.bar);
        __builtin_amdgcn_fence(__ATOMIC_ACQUIRE, "agent");
        asm volatile("s_waitcnt vmcnt(0)" ::: "memory");
    }
    __syncthreads();
}
typedef __attribute__((ext_vector_type(8))) __bf16 bf16x8;
typedef __attribute__((ext_vector_type(16))) float f32x16;
typedef __attribute__((ext_vector_type(4))) float f32x4;
#define NTHR 256
#define LDSK 72
#define SMEM_BYTES 81920

struct P {
    const float* x; const int* pos; const float* mem; const float* g_mix; const float* w_in; const float* b_gate;
    const float* lq1; const float* lk1; const float* lq2; const float* lk2; const float* g_sub; const float* g_mem; const float* w_mkv;
    const float* w_br0; const float* w_br1; const float* w_br2; const float* w_out; const float* g_ffn;
    const float* w_rg; const float* b_rg; const float* w_re; const float* b_re; const float* w_ei; const float* w_eo; const float* g_fin;
    float* out;
    unsigned* bar; int* CNT;
    bf16_t* NBUF; bf16_t* DQ; bf16_t* DK; bf16_t* DVT; bf16_t* SQ; bf16_t* SK; bf16_t* SVT; bf16_t* IQ; bf16_t* MQ; bf16_t* IK; float* IW; unsigned* MASK;
    bf16_t* MK; bf16_t* MVT; bf16_t* MEMN; float* ROPEC; float* ROPES;
    bf16_t* WIN; bf16_t* WBR; bf16_t* WOUT; bf16_t* WMKV; bf16_t* WEI; bf16_t* WEO;
    bf16_t* YD; bf16_t* YS; bf16_t* YM; bf16_t* MERGED; bf16_t* HID; bf16_t* YMOE; Route* ROUTE; int* LIST; unsigned* SGS; int* XC; bf16_t* HB;
};

__device__ __forceinline__ int opaque_tid() { int t = threadIdx.x; asm volatile("" : "+v"(t)); return t; }
typedef __bf16 bf16x2v_t __attribute__((ext_vector_type(2)));
typedef float f32x2c_t __attribute__((ext_vector_type(2)));
__device__ __forceinline__ unsigned cvt_pk_bf16_ord(float lo, float hi) { unsigned r; asm volatile("s_nop 0\n\tv_cvt_pk_bf16_f32 %0, %1, %2" : "=v"(r) : "v"(lo), "v"(hi)); return r; }
__device__ __forceinline__ unsigned cvt_pk_bf16(float lo, float hi) { const f32x2c_t v = {lo, hi}; const bf16x2v_t r = __builtin_convertvector(v, bf16x2v_t); return __builtin_bit_cast(unsigned, r); }

template <int MAP> __device__ __forceinline__ int colmap(int n) {
    if (MAP == 1) return n < 3584 ? n : n < 4096 ? n + 72 : n < 4168 ? n - 512 : n < 4224 ? -1 : n - 56;
    if (MAP == 2) { const int c = n >> 6, j = n & 63; return j < 32 ? 32 * c + j : 512 + 32 * c + (j - 32); }
    return n;
}
template <int MAP, int NTL> __device__ __forceinline__ void tconv_tile(const float* __restrict__ src, int ld, int K, bf16_t* __restrict__ dst, int tile, float* tl) {
    const int n0 = (tile % NTL) * 64, k0 = (tile / NTL) * 64;
    const int t = opaque_tid(); const int nn = (t & 15) * 4; const int c = colmap<MAP>(n0 + nn);
#pragma unroll
    for (int i = 0; i < 4; ++i) { const int kk = (t >> 4) + 16 * i;
        const float4 v = c >= 0 ? *(const float4*)(src + (size_t)(k0 + kk) * ld + c) : make_float4(0.f, 0.f, 0.f, 0.f);
        tl[kk * 65 + nn] = v.x; tl[kk * 65 + nn + 1] = v.y; tl[kk * 65 + nn + 2] = v.z; tl[kk * 65 + nn + 3] = v.w; }
    __syncthreads();
#pragma unroll
    for (int i = 0; i < 2; ++i) { const int cc = t + 256 * i; const int n2 = cc >> 3, kc = (cc & 7) * 8;
        uint4 o; o.x = cvt_pk_bf16(tl[(kc + 0) * 65 + n2], tl[(kc + 1) * 65 + n2]); o.y = cvt_pk_bf16(tl[(kc + 2) * 65 + n2], tl[(kc + 3) * 65 + n2]);
        o.z = cvt_pk_bf16(tl[(kc + 4) * 65 + n2], tl[(kc + 5) * 65 + n2]); o.w = cvt_pk_bf16(tl[(kc + 6) * 65 + n2], tl[(kc + 7) * 65 + n2]);
        *(uint4*)(dst + (size_t)(n0 + n2) * K + k0 + kc) = o; }
    __syncthreads();
}
#define TC_WIN 1824
#define TC_WBR (TC_WIN + 384)
#define TC_WOUT (TC_WBR + 256)
#define TC_WMKV (TC_WOUT + 256)
#define TC_WEI (TC_WMKV + 4096)
#define TC_WEO (TC_WEI + 2048)
__device__ void phase_prologue(const P& p, char* smem, int bid, int nblk) {
    float* tl = (float*)smem;
    const int tidp = opaque_tid();
    for (int g = bid; g < TC_WEO; g += nblk) {
        if (g < TC_WIN) tconv_tile<1, 114>(p.w_in, DPROJ, 1024, p.WIN, g, tl);
        else if (g < TC_WBR) { const int j = (g - TC_WIN) >> 7; const float* s = j == 0 ? p.w_br0 : j == 1 ? p.w_br1 : p.w_br2; tconv_tile<0, 16>(s, 1024, 512, p.WBR + (size_t)j * 1024 * 512, (g - TC_WIN) & 127, tl); }
        else if (g < TC_WOUT) tconv_tile<0, 16>(p.w_out, 1024, 1024, p.WOUT, g - TC_WBR, tl);
        else if (g < TC_WMKV) tconv_tile<0, 16>(p.w_mkv, 1024, 1024, p.WMKV, g - TC_WOUT, tl);
        else if (g < TC_WEI) { const int e = (g - TC_WMKV) >> 8; tconv_tile<2, 16>(p.w_ei + (size_t)e * 1024 * 1024, 1024, 1024, p.WEI + (size_t)e * 1024 * 1024, (g - TC_WMKV) & 255, tl); }
        else { const int e = (g - TC_WEI) >> 7; tconv_tile<0, 16>(p.w_eo + (size_t)e * 512 * 1024, 1024, 512, p.WEO + (size_t)e * 1024 * 512, (g - TC_WEI) & 127, tl); }
    }
    const int lane = tidp & 63; const int gw = bid * 4 + (tidp >> 6), nw = nblk * 4;
    for (int row = gw; row < T_TOK + 1024; row += nw) {
        const float* src; const float* g; bf16_t* dst;
        if (row < T_TOK) { src = p.x + (size_t)row * DM; g = p.g_mix; dst = p.NBUF + (size_t)row * DM; }
        else { src = p.mem + (size_t)(row - T_TOK) * DM; g = p.g_mem; dst = p.MEMN + (size_t)(row - T_TOK) * DM; }
        float4 v[4]; float ss = 0.f;
#pragma unroll
        for (int i = 0; i < 4; ++i) { v[i] = *(const float4*)(src + i * 256 + lane * 4); ss += v[i].x * v[i].x + v[i].y * v[i].y + v[i].z * v[i].z + v[i].w * v[i].w; }
        ss = wave_sum(ss);
        const float r = rsqrtf(ss * (1.0f / DM) + 1e-6f);
#pragma unroll
        for (int i = 0; i < 4; ++i) { const float4 gg = *(const float4*)(g + i * 256 + lane * 4);
            uint2 o; o.x = cvt_pk_bf16(v[i].x * r * gg.x, v[i].y * r * gg.y); o.y = cvt_pk_bf16(v[i].z * r * gg.z, v[i].w * r * gg.w);
            *(uint2*)(dst + i * 256 + lane * 4) = o; }
    }
    for (int i = bid * NTHR + tidp; i < T_TOK * 8; i += nblk * NTHR) {
        const float inv = powf(500000.0f, -(float)(i & 7) / 8.0f);
        const float ang = (float)p.pos[i >> 3] * inv;
        float sn, cs; sincosf(ang, &sn, &cs);
        p.ROPEC[i] = cs; p.ROPES[i] = sn;
    }
    if (bid == 0 && tidp < 16) p.CNT[tidp * 64] = 0;
}


struct Sched { int x, j; };
struct XOrder {
    int x, j, J, nblk, bid;
    __device__ __forceinline__ XOrder(int bid_, int nblk_, const Sched& s) : x(s.x), j(s.j), J(nblk_ >> 3), nblk(nblk_), bid(bid_) {}
    __device__ __forceinline__ bool round(int r, int N, int& u) const {
        if ((nblk & 7) != 0) { u = r * nblk + bid; if (r * nblk >= N) return false; if (u >= N) u = -1; return true; }
        const int c = r * 8 + x; if (r * 8 * J >= N) return false; u = c * J + j; if (u >= N) u = -1; return true;
    }
};
__device__ __forceinline__ void tile_mn(int u, int NT, int& mt, int& nt) { const int g = u / (8 * NT), rem = u - g * 8 * NT; nt = rem >> 3; mt = g * 8 + (rem & 7); }

__device__ __forceinline__ int gl_row(int tid, int q) { return (tid >> 6) * 32 + q * 8 + ((tid & 63) >> 3); }
__device__ __forceinline__ unsigned gl_col(int tid, int row) { return (unsigned)(((tid & 7) ^ ((row >> 1) & 7)) * 8); }
__device__ __forceinline__ void gemm_mainloop(const bf16_t* __restrict__ Rb, unsigned or0, unsigned or1, unsigned or2, unsigned or3,
                                              const bf16_t* __restrict__ Lb, unsigned ol0, unsigned ol1, unsigned ol2, unsigned ol3, int K, f32x16 (&acc)[2][2], bf16_t* As, bf16_t* Bs) {
    const int tid = opaque_tid(), lane = tid & 63, wid = tid >> 6, wr = wid >> 1, wc = wid & 1;
    const int nk = K >> 6;
    LAS unsigned* ldsA = (LAS unsigned*)(As + wid * 32 * 64);
    LAS unsigned* ldsB = (LAS unsigned*)(Bs + wid * 32 * 64);
    const int sw = (lane >> 1) & 7;
    const bf16_t* ard = As + (wr * 64 + (lane & 31)) * 64;
    const bf16_t* brd = Bs + (wc * 64 + (lane & 31)) * 64;
    const int lh = lane >> 5;
#define GLDS_TILE(stage_, ko_) { \
    __builtin_amdgcn_global_load_lds((const unsigned*)(Rb + or0 + (ko_)), (LAS unsigned*)((LAS char*)ldsA + (stage_) * 32768), 16, 0, 0); \
    __builtin_amdgcn_global_load_lds((const unsigned*)(Rb + or1 + (ko_)), (LAS unsigned*)((LAS char*)ldsA + (stage_) * 32768 + 1024), 16, 0, 0); \
    __builtin_amdgcn_global_load_lds((const unsigned*)(Rb + or2 + (ko_)), (LAS unsigned*)((LAS char*)ldsA + (stage_) * 32768 + 2048), 16, 0, 0); \
    __builtin_amdgcn_global_load_lds((const unsigned*)(Rb + or3 + (ko_)), (LAS unsigned*)((LAS char*)ldsA + (stage_) * 32768 + 3072), 16, 0, 0); \
    __builtin_amdgcn_global_load_lds((const unsigned*)(Lb + ol0 + (ko_)), (LAS unsigned*)((LAS char*)ldsB + (stage_) * 32768), 16, 0, 0); \
    __builtin_amdgcn_global_load_lds((const unsigned*)(Lb + ol1 + (ko_)), (LAS unsigned*)((LAS char*)ldsB + (stage_) * 32768 + 1024), 16, 0, 0); \
    __builtin_amdgcn_global_load_lds((const unsigned*)(Lb + ol2 + (ko_)), (LAS unsigned*)((LAS char*)ldsB + (stage_) * 32768 + 2048), 16, 0, 0); \
    __builtin_amdgcn_global_load_lds((const unsigned*)(Lb + ol3 + (ko_)), (LAS unsigned*)((LAS char*)ldsB + (stage_) * 32768 + 3072), 16, 0, 0); }
    __syncthreads();
    GLDS_TILE(0, 0u)
    __syncthreads();
    for (int kt = 0; kt < nk; ++kt) {
        const int cur = (kt & 1) * 16384;
        if (kt + 1 < nk) { if (kt & 1) GLDS_TILE(0, (unsigned)(kt + 1) * 64u) else GLDS_TILE(1, (unsigned)(kt + 1) * 64u) }
#pragma unroll
        for (int ks = 0; ks < 4; ++ks) {
            const int cc = ((2 * ks + lh) ^ sw) * 8;
            const bf16x8 fa0 = *(const bf16x8*)(ard + cur + cc), fa1 = *(const bf16x8*)(ard + cur + 32 * 64 + cc);
            const bf16x8 fb0 = *(const bf16x8*)(brd + cur + cc), fb1 = *(const bf16x8*)(brd + cur + 32 * 64 + cc);
            acc[0][0] = __builtin_amdgcn_mfma_f32_32x32x16_bf16(fa0, fb0, acc[0][0], 0, 0, 0);
            acc[0][1] = __builtin_amdgcn_mfma_f32_32x32x16_bf16(fa0, fb1, acc[0][1], 0, 0, 0);
            acc[1][0] = __builtin_amdgcn_mfma_f32_32x32x16_bf16(fa1, fb0, acc[1][0], 0, 0, 0);
            acc[1][1] = __builtin_amdgcn_mfma_f32_32x32x16_bf16(fa1, fb1, acc[1][1], 0, 0, 0);
        }
        __syncthreads();
    }
#undef GLDS_TILE
}
#define ZERO_ACC(acc) { _Pragma("unroll") for (int i_ = 0; i_ < 2; ++i_) _Pragma("unroll") for (int j_ = 0; j_ < 2; ++j_) _Pragma("unroll") for (int r_ = 0; r_ < 16; ++r_) acc[i_][j_][r_] = 0.f; }
#define CSTR 136
__device__ __forceinline__ void cimg_write(const f32x16 (&acc)[2][2], bf16_t* Cs, int wr, int wc, int l31, int lh) {
#pragma unroll
    for (int i = 0; i < 2; ++i)
#pragma unroll
        for (int j = 0; j < 2; ++j)
#pragma unroll
            for (int g = 0; g < 4; ++g) { uint2 o; o.x = cvt_pk_bf16(acc[i][j][4 * g], acc[i][j][4 * g + 1]); o.y = cvt_pk_bf16(acc[i][j][4 * g + 2], acc[i][j][4 * g + 3]);
                *(uint2*)(Cs + (64 * wc + 32 * j + l31) * CSTR + 64 * wr + 32 * i + 8 * g + 4 * lh) = o; }
}

template <int NOEPI> __device__ void phase_inproj(const P& p, char* smem, int bid, int nblk, const Sched& sc) {
    bf16_t* As = (bf16_t*)smem; bf16_t* Bs = As + 128 * 64; bf16_t* Cs = (bf16_t*)smem;
    const int tid = opaque_tid(), lane = tid & 63, wid = tid >> 6, wr = wid >> 1, wc = wid & 1;
    const int l31 = lane & 31, lh = lane >> 5;
    const int NT = 33, NMAIN = 256 * NT;
    const XOrder xo(bid, nblk, sc);
    const bool xaware = false;
    for (int rr = 0; ; ++rr) {
        bool main_t; int mt, nt;
        if (xaware) {
            if (rr < 16) { main_t = true; mt = ((sc.x >> 2) * 16 + rr) * 8 + (sc.j & 7); nt = (sc.x & 3) * 8 + (sc.j >> 3); }
            else if (rr == 16) { if (bid >= 320) break; main_t = bid < 256; mt = main_t ? bid : (bid - 256) >> 3; nt = main_t ? 32 : (bid - 256) & 7; }
            else break;
        } else {
            int t; if (!xo.round(rr, NMAIN + 64, t)) break; if (t < 0) continue;
            main_t = t < NMAIN;
            if (main_t) tile_mn(t, NT, mt, nt); else { mt = (t - NMAIN) >> 3; nt = (t - NMAIN) & 7; }
        }
        const bf16_t* X = main_t ? p.NBUF : p.MEMN; const bf16_t* W = main_t ? p.WIN : p.WMKV;
        const int grp = main_t ? (nt >> 2) : (nt < 4 ? 7 : 2);
        const bool transposed = grp == 2 || grp == 5;
        const int g0 = gl_row(tid, 0); const unsigned to = (unsigned)g0 * 1024u + gl_col(tid, g0);
        const unsigned t1 = (unsigned)(g0 + 8) * 1024u + gl_col(tid, g0 + 8), t2 = (unsigned)(g0 + 16) * 1024u + gl_col(tid, g0 + 16), t3 = (unsigned)(g0 + 24) * 1024u + gl_col(tid, g0 + 24);
        const bf16_t* Xt = X + (size_t)mt * 128 * 1024; const bf16_t* Wt = W + (size_t)nt * 128 * 1024;
        f32x16 acc[2][2]; ZERO_ACC(acc);
        gemm_mainloop(transposed ? Xt : Wt, to, t1, t2, t3, transposed ? Wt : Xt, to, t1, t2, t3, 1024, acc, As, Bs);
        if (NOEPI) { float s_ = 0.f; for (int i_ = 0; i_ < 2; ++i_) for (int j_ = 0; j_ < 2; ++j_) for (int r_ = 0; r_ < 16; ++r_) s_ += acc[i_][j_][r_]; if (s_ == 1.2345e30f) p.IW[0] = s_; continue; }
        const int tok0 = mt * 128;
        if (main_t && !transposed && grp != 7) {
            if (grp != 8 || wr == 0) {
#pragma unroll
                for (int j = 0; j < 2; ++j) { const int tok = tok0 + 64 * wc + 32 * j + l31;
                    const float4 c4 = *(const float4*)(p.ROPEC + (size_t)tok * 8 + 4 * lh), s4 = *(const float4*)(p.ROPES + (size_t)tok * 8 + 4 * lh);
                    const float cc[4] = {c4.x, c4.y, c4.z, c4.w}, ss[4] = {s4.x, s4.y, s4.z, s4.w};
#pragma unroll
                    for (int r = 0; r < 4; ++r) { const float x1 = acc[0][j][r], x2 = acc[0][j][r + 4]; acc[0][j][r] = x1 * cc[r] - x2 * ss[r]; acc[0][j][r + 4] = x2 * cc[r] + x1 * ss[r]; } }
            }
        }
        if (grp == 8 && wr == 1) {
#pragma unroll
            for (int j = 0; j < 2; ++j) { const int tok = tok0 + 64 * wc + 32 * j + l31; *(float4*)(p.IW + (size_t)tok * 8 + 4 * lh) = make_float4(acc[0][j][0], acc[0][j][1], acc[0][j][2], acc[0][j][3]); }
        }
        __syncthreads();
        cimg_write(acc, Cs, wr, wc, l31, lh);
        __syncthreads();
        bf16_t* dbase; size_t dstride; int nch = 16;
        if (!main_t) {
            if (nt < 4) { dbase = p.MK + (size_t)tok0 * 512 + nt * 128; dstride = 512; }
            else { dbase = p.MVT + ((size_t)((mt >> 1) * 4 + (nt - 4)) * 128) * 256 + (mt & 1) * 128; dstride = 256; }
        } else if (grp == 2) { dbase = p.DVT + ((size_t)((mt >> 6) * 4 + (nt - 8)) * 128) * S_LEN + (mt & 63) * 128; dstride = S_LEN; }
        else if (grp == 5) { dbase = p.SVT + ((size_t)((mt >> 6) * 8 + (nt - 20) * 2) * 64) * S_LEN + (mt & 63) * 128; dstride = S_LEN; }
        else if (grp == 8) { dbase = p.IK + (size_t)tok0 * 64; dstride = 64; nch = 8; }
        else { bf16_t* d = grp == 0 ? p.DQ : grp == 1 ? p.DK : grp == 3 ? p.SQ : grp == 4 ? p.SK : grp == 6 ? p.IQ : p.MQ; dbase = d + (size_t)tok0 * 512 + (nt & 3) * 128; dstride = 512; }
        int te_ = tid; asm volatile("" : "+v"(te_));
#pragma unroll
        for (int k = 0; k < 8; ++k) { const int c = te_ + 256 * k; const int lrow = c >> 4, ch = c & 15;
            if (ch < nch) { const uint4 v = *(const uint4*)(Cs + lrow * CSTR + ch * 8); *(uint4*)(dbase + (size_t)lrow * dstride + ch * 8) = v; } }
    }
}
template <int REPS = 1> __device__ void phase_merge(const P& p, char* smem, int bid, int nblk, const Sched& sc) {
    bf16_t* As = (bf16_t*)smem; bf16_t* Bs = As + 128 * 64; bf16_t* Cs = (bf16_t*)smem;
    const int tid = opaque_tid(), lane = tid & 63, wid = tid >> 6, wr = wid >> 1, wc = wid & 1;
    const int l31 = lane & 31, lh = lane >> 5;
    const XOrder xo(bid, nblk, sc);
    const bool xaware = false;
#pragma unroll 1
    for (int rep = 0; rep < REPS; ++rep)
    for (int rr = 0; ; ++rr) {
        int mt, nt;
        if (xaware) { if (rr >= 4) break; nt = sc.x; mt = rr * 64 + sc.j; }
        else { int t; if (!xo.round(rr, 256 * 8, t)) break; if (t < 0) continue; tile_mn(t, 8, mt, nt); }
        f32x16 mg[2][2]; ZERO_ACC(mg);
#pragma unroll 1
        for (int br = 0; br < 3; ++br) {
            int tl_ = tid; asm volatile("" : "+v"(tl_));
            unsigned sgr[8][4];
            {
                const int g0 = gl_row(tl_, 0);
                const unsigned to = (unsigned)g0 * 1024u + gl_col(tl_, g0), t1 = (unsigned)(g0 + 8) * 1024u + gl_col(tl_, g0 + 8), t2 = (unsigned)(g0 + 16) * 1024u + gl_col(tl_, g0 + 16), t3 = (unsigned)(g0 + 24) * 1024u + gl_col(tl_, g0 + 24);
                f32x16 acc[2][2]; ZERO_ACC(acc);
                gemm_mainloop(p.WIN + (size_t)(4224 + br * 1024 + nt * 128) * 1024, to, t1, t2, t3, p.NBUF + (size_t)mt * 128 * 1024, to, t1, t2, t3, 1024, acc, As, Bs);
#pragma unroll
                for (int i = 0; i < 2; ++i)
#pragma unroll
                    for (int g = 0; g < 4; ++g) { const float4 b4 = *(const float4*)(p.b_gate + br * 1024 + nt * 128 + 64 * wr + 32 * i + 8 * g + 4 * lh);
                        const float bb[4] = {b4.x, b4.y, b4.z, b4.w};
#pragma unroll
                        for (int j = 0; j < 2; ++j) { float s[4];
#pragma unroll
                            for (int r = 0; r < 4; ++r) s[r] = __builtin_amdgcn_rcpf(1.0f + __expf(-(acc[i][j][4 * g + r] + bb[r])));
                            acc[i][j][4 * g] = __uint_as_float(cvt_pk_bf16_ord(s[0], s[1])); acc[i][j][4 * g + 1] = __uint_as_float(cvt_pk_bf16_ord(s[2], s[3])); } }
#pragma unroll
                for (int i = 0; i < 2; ++i)
#pragma unroll
                    for (int j = 0; j < 2; ++j)
#pragma unroll
                        for (int h2 = 0; h2 < 2; ++h2) {
                            sgr[(i * 2 + j) * 2 + h2][0] = __float_as_uint(acc[i][j][8 * h2]); sgr[(i * 2 + j) * 2 + h2][1] = __float_as_uint(acc[i][j][8 * h2 + 1]);
                            sgr[(i * 2 + j) * 2 + h2][2] = __float_as_uint(acc[i][j][8 * h2 + 4]); sgr[(i * 2 + j) * 2 + h2][3] = __float_as_uint(acc[i][j][8 * h2 + 5]); }
                asm volatile("" ::: "memory");
            }
            {
                const bf16_t* Y = br == 0 ? p.YD : br == 1 ? p.YS : p.YM;
                int tl2_ = tid; asm volatile("" : "+v"(tl2_));
                const int g0 = gl_row(tl2_, 0);
                const unsigned to = (unsigned)g0 * 512u + gl_col(tl2_, g0), t1 = (unsigned)(g0 + 8) * 512u + gl_col(tl2_, g0 + 8), t2 = (unsigned)(g0 + 16) * 512u + gl_col(tl2_, g0 + 16), t3 = (unsigned)(g0 + 24) * 512u + gl_col(tl2_, g0 + 24);
                f32x16 acc[2][2]; ZERO_ACC(acc);
                gemm_mainloop(p.WBR + (size_t)br * 1024 * 512 + (size_t)nt * 128 * 512, to, t1, t2, t3, Y + (size_t)mt * 128 * 512, to, t1, t2, t3, 512, acc, As, Bs);
                asm volatile("" ::: "memory");
#pragma unroll
                for (int i = 0; i < 2; ++i)
#pragma unroll
                    for (int j = 0; j < 2; ++j)
#pragma unroll
                        for (int h2 = 0; h2 < 2; ++h2) { const unsigned ww[4] = {sgr[(i * 2 + j) * 2 + h2][0], sgr[(i * 2 + j) * 2 + h2][1], sgr[(i * 2 + j) * 2 + h2][2], sgr[(i * 2 + j) * 2 + h2][3]};
#pragma unroll
                            for (int q = 0; q < 2; ++q) {
                                const int g = 2 * h2 + q;
                                mg[i][j][4 * g] += __uint_as_float(ww[2 * q] << 16) * acc[i][j][4 * g];
                                mg[i][j][4 * g + 1] += __uint_as_float(ww[2 * q] & 0xffff0000u) * acc[i][j][4 * g + 1];
                                mg[i][j][4 * g + 2] += __uint_as_float(ww[2 * q + 1] << 16) * acc[i][j][4 * g + 2];
                                mg[i][j][4 * g + 3] += __uint_as_float(ww[2 * q + 1] & 0xffff0000u) * acc[i][j][4 * g + 3]; } }
            }
        }
        __syncthreads();
        cimg_write(mg, Cs, wr, wc, l31, lh);
        __syncthreads();
        bf16_t* dbase = p.MERGED + (size_t)mt * 128 * 1024 + nt * 128;
        int te_ = tid; asm volatile("" : "+v"(te_));
#pragma unroll
        for (int k = 0; k < 8; ++k) { const int c = te_ + 256 * k; const int lrow = c >> 4, ch = c & 15;
            const uint4 v = *(const uint4*)(Cs + lrow * CSTR + ch * 8); *(uint4*)(dbase + (size_t)lrow * 1024 + ch * 8) = v; }
    }
}

#define CFS 132
__device__ void phase_outproj(const P& p, char* smem, int bid, int nblk, const Sched& sc) {
    bf16_t* As = (bf16_t*)smem; bf16_t* Bs = As + 128 * 64;
    const int tid = opaque_tid(), lane = tid & 63, wid = tid >> 6, wr = wid >> 1, wc = wid & 1;
    const int l31 = lane & 31, lh = lane >> 5;
    const XOrder xo(bid, nblk, sc);
    for (int rr = 0; ; ++rr) {
        int t; if (!xo.round(rr, 256 * 8, t)) break; if (t < 0) continue;
        int mt, nt; tile_mn(t, 8, mt, nt);
        const int g0 = gl_row(tid, 0);
        const unsigned to = (unsigned)g0 * 1024u + gl_col(tid, g0), t1 = (unsigned)(g0 + 8) * 1024u + gl_col(tid, g0 + 8), t2 = (unsigned)(g0 + 16) * 1024u + gl_col(tid, g0 + 16), t3 = (unsigned)(g0 + 24) * 1024u + gl_col(tid, g0 + 24);
        f32x16 acc[2][2]; ZERO_ACC(acc);
        gemm_mainloop(p.WOUT + (size_t)nt * 128 * 1024, to, t1, t2, t3, p.MERGED + (size_t)mt * 128 * 1024, to, t1, t2, t3, 1024, acc, As, Bs);
        float* Cf = (float*)smem;
#pragma unroll
        for (int i = 0; i < 2; ++i)
#pragma unroll
            for (int j = 0; j < 2; ++j)
#pragma unroll
                for (int g = 0; g < 4; ++g)
                    *(float4*)(Cf + (64 * wc + 32 * j + l31) * CFS + 64 * wr + 32 * i + 8 * g + 4 * lh) = make_float4(acc[i][j][4 * g], acc[i][j][4 * g + 1], acc[i][j][4 * g + 2], acc[i][j][4 * g + 3]);
        __syncthreads();
        int to_ = tid; asm volatile("" : "+v"(to_));
#pragma unroll
        for (int k = 0; k < 8; ++k) { const int c = to_ + 256 * k; const int lrow = c >> 4, ch = c & 15;
            const float4 a0 = *(const float4*)(Cf + lrow * CFS + ch * 8), a1 = *(const float4*)(Cf + lrow * CFS + ch * 8 + 4);
            const size_t go = (size_t)(mt * 128 + lrow) * 1024 + nt * 128 + ch * 8;
            const float4 x0 = *(const float4*)(p.x + go), x1 = *(const float4*)(p.x + go + 4);
            uint4 o; o.x = cvt_pk_bf16(x0.x + a0.x, x0.y + a0.y); o.y = cvt_pk_bf16(x0.z + a0.z, x0.w + a0.w); o.z = cvt_pk_bf16(x1.x + a1.x, x1.y + a1.y); o.w = cvt_pk_bf16(x1.z + a1.z, x1.w + a1.w);
            *(uint4*)(p.HB + go) = o; }
    }
}

template <int VAR = 0> __device__ void phase_route(const P& p, char* smem, int bid, int nblk) {
    float4* wre = (float4*)smem;
    const int tidp = opaque_tid();
    for (int idx = tidp; idx < 4096; idx += NTHR) { const int row = idx >> 2, g = idx & 3;
        wre[g * 1024 + (row >> 8) * 256 + (row & 3) * 64 + ((row & 255) >> 2)] = *(const float4*)(p.w_re + (size_t)row * 16 + g * 4); }
    constexpr int RCH = 64;
    int* lcnt = (int*)(smem + 65536); int* lbase = lcnt + 16; float* bre = (float*)(lcnt + 32); int* ent_e = lcnt + 48; int* ent_s = ent_e + 4 * RCH * 2; int* ent_v = ent_s + 4 * RCH * 2;
    if (tidp < 16) bre[tidp] = p.b_re[tidp];
    const int lane = tidp & 63; const int wv = tidp >> 6; const int nw = nblk * 4;
    float4 wg[16], gg[4];
#pragma unroll
    for (int i = 0; i < 4; ++i) { gg[i] = *(const float4*)(p.g_ffn + i * 256 + lane * 4);
#pragma unroll
        for (int j = 0; j < 4; ++j) wg[4 * i + j] = *(const float4*)(p.w_rg + (size_t)(i * 256 + lane * 4 + j) * 4); }
    const float brg0 = p.b_rg[0], brg1 = p.b_rg[1], brg2 = p.b_rg[2], brg3 = p.b_rg[3];
    const int tb = bid * 4;
    const int kmax = tb < T_TOK ? (T_TOK - tb + nw - 1) / nw : 0;
    uint2 nx[4];
    { const int t0 = tb + wv; const bf16_t* s0 = p.HB + (size_t)(t0 < T_TOK ? t0 : 0) * DM;
#pragma unroll
      for (int i = 0; i < 4; ++i) nx[i] = *(const uint2*)(s0 + i * 256 + lane * 4); }
    for (int k0 = 0; k0 < kmax; k0 += RCH) {
    __syncthreads();
    if (tidp < 16) lcnt[tidp] = 0;
    __syncthreads();
    for (int kk = 0; kk < RCH && k0 + kk < kmax; ++kk) {
        const int tok = tb + wv + (k0 + kk) * nw;
        if (tok >= T_TOK) break;
        float tv[16]; float ss = 0.f;
#pragma unroll
        for (int i = 0; i < 4; ++i) { const uint2 u = nx[i];
            float4 v; v.x = __uint_as_float(u.x << 16); v.y = __uint_as_float(u.x & 0xffff0000u); v.z = __uint_as_float(u.y << 16); v.w = __uint_as_float(u.y & 0xffff0000u);
            tv[4 * i] = v.x; tv[4 * i + 1] = v.y; tv[4 * i + 2] = v.z; tv[4 * i + 3] = v.w; ss += v.x * v.x + v.y * v.y + v.z * v.z + v.w * v.w; }
        { const int tn = tok + nw; const bf16_t* sn = p.HB + (size_t)(tn < T_TOK ? tn : tok) * DM;
#pragma unroll
          for (int i = 0; i < 4; ++i) nx[i] = *(const uint2*)(sn + i * 256 + lane * 4); }
        ss = wave_sum(ss);
        const float r = rsqrtf(ss * (1.0f / DM) + 1e-6f);
        float g0 = 0.f, g1 = 0.f, g2 = 0.f, g3 = 0.f;
#pragma unroll
        for (int i = 0; i < 4; ++i) {
            tv[4 * i] *= r * gg[i].x; tv[4 * i + 1] *= r * gg[i].y; tv[4 * i + 2] *= r * gg[i].z; tv[4 * i + 3] *= r * gg[i].w;
            uint2 o; o.x = cvt_pk_bf16(tv[4 * i], tv[4 * i + 1]); o.y = cvt_pk_bf16(tv[4 * i + 2], tv[4 * i + 3]);
            *(uint2*)((VAR ? (bf16_t*)p.SGS + (size_t)8 * 1024 * 1024 + (size_t)(tok & 16383) * DM : p.NBUF + (size_t)tok * DM) + i * 256 + lane * 4) = o;
#pragma unroll
            for (int j = 0; j < 4; ++j) { const float4 w = wg[4 * i + j]; const float x = tv[4 * i + j]; g0 += x * w.x; g1 += x * w.y; g2 += x * w.z; g3 += x * w.w; } }
        g0 = wave_sum(g0) + brg0; g1 = wave_sum(g1) + brg1; g2 = wave_sum(g2) + brg2; g3 = wave_sum(g3) + brg3;
        int grp = 0; float gm = g0;
        if (g1 > gm) { gm = g1; grp = 1; } if (g2 > gm) { gm = g2; grp = 2; } if (g3 > gm) { gm = g3; grp = 3; }
        const float pg = 1.0f / (expf(g0 - gm) + expf(g1 - gm) + expf(g2 - gm) + expf(g3 - gm));
        float e0 = 0.f, e1 = 0.f, e2 = 0.f, e3 = 0.f;
        const float4* wgp = wre + grp * 1024 + lane;
#pragma unroll
        for (int i = 0; i < 4; ++i)
#pragma unroll
            for (int j = 0; j < 4; ++j) { const float4 w = wgp[i * 256 + j * 64]; const float x = tv[4 * i + j]; e0 += x * w.x; e1 += x * w.y; e2 += x * w.z; e3 += x * w.w; }
        float el[4];
        el[0] = wave_sum(e0) + bre[grp * 4]; el[1] = wave_sum(e1) + bre[grp * 4 + 1]; el[2] = wave_sum(e2) + bre[grp * 4 + 2]; el[3] = wave_sum(e3) + bre[grp * 4 + 3];
        if (lane < 2 && VAR == 0) {
            int i0 = 0; float m0 = el[0];
            if (el[1] > m0) { m0 = el[1]; i0 = 1; } if (el[2] > m0) { m0 = el[2]; i0 = 2; } if (el[3] > m0) { m0 = el[3]; i0 = 3; }
            int i1 = -1; float m1 = -INFINITY;
            if (i0 != 0 && el[0] > m1) { m1 = el[0]; i1 = 0; } if (i0 != 1 && el[1] > m1) { m1 = el[1]; i1 = 1; }
            if (i0 != 2 && el[2] > m1) { m1 = el[2]; i1 = 2; } if (i0 != 3 && el[3] > m1) { m1 = el[3]; i1 = 3; }
            const float p1 = expf(m1 - m0);
            Route rt; rt.e0 = grp * 4 + i0; rt.e1 = grp * 4 + i1; rt.c0 = pg / (1.0f + p1); rt.c1 = pg * p1 / (1.0f + p1);
            if (lane == 0) p.ROUTE[tok] = rt;
            const int e = lane == 0 ? rt.e0 : rt.e1; const int idx = (wv * RCH + kk) * 2 + lane;
            ent_e[idx] = e; ent_s[idx] = atomicAdd(&lcnt[e], 1); ent_v[idx] = tok * 2 + lane;
        }
    }
    if (VAR == 0) {
        __syncthreads();
        if (tidp < 16) lbase[tidp] = lcnt[tidp] > 0 ? atomicAdd(&p.CNT[tidp * 64], lcnt[tidp]) : 0;
        __syncthreads();
#pragma unroll 1
        for (int i = tidp; i < 4 * RCH * 2; i += NTHR) { const int w_ = i / (RCH * 2), k_ = (i % (RCH * 2)) >> 1;
            if (k0 + k_ < kmax && tb + w_ + (k0 + k_) * nw < T_TOK) { const int e = ent_e[i]; p.LIST[e * LIST_CAP + lbase[e] + ent_s[i]] = ent_v[i]; } }
    }
    }
}

template <int DOWN> __device__ void phase_moe(const P& p, char* smem, int bid, int nblk, const Sched& sc) {
    bf16_t* As = (bf16_t*)smem; bf16_t* Bs = As + 128 * 64; bf16_t* Cs = (bf16_t*)smem;
    int* ents = (int*)(smem + 73728); float* cws = (float*)(ents + 128);
    const int tid = opaque_tid(), lane = tid & 63, wid = tid >> 6, wr = wid >> 1, wc = wid & 1;
    const int l31 = lane & 31, lh = lane >> 5;
    int cnt[16]; int total = 0;
#pragma unroll
    for (int e = 0; e < 16; ++e) { cnt[e] = p.CNT[e * 64]; total += ((cnt[e] + 127) >> 7) * 8; }
    const XOrder xo(bid, nblk, sc);
    for (int rr = 0; ; ++rr) {
        int u; if (!xo.round(rr, total, u)) break; if (u < 0) continue;
        int e = 0, base = 0, ce = 0;
#pragma unroll
        for (int k = 0; k < 16; ++k) { const int n = ((cnt[k] + 127) >> 7) * 8; if (u >= base + n && k == e) { base += n; e = k + 1; } if (k == e) ce = cnt[k]; }
        const int loc = u - base; const int mt = loc >> 3, nt = loc & 7;
        const int nrows = min(128, ce - mt * 128);
        __syncthreads();
        if (tid < 128) { const int ent = p.LIST[e * LIST_CAP + mt * 128 + (tid < nrows ? tid : 0)]; ents[tid] = ent;
            if (DOWN) { const Route rt = p.ROUTE[ent >> 1]; cws[tid] = (ent & 1) ? rt.c1 : rt.c0; } }
        __syncthreads();
        const int KK = DOWN ? 512 : 1024;
        const bf16_t* Xb = DOWN ? p.HID : p.NBUF;
        int tu_ = tid; asm volatile("" : "+v"(tu_));
        const int g0 = gl_row(tu_, 0);
        const unsigned ol0 = (unsigned)(DOWN ? ents[g0] : ents[g0] >> 1) * (unsigned)KK + gl_col(tu_, g0), ol1 = (unsigned)(DOWN ? ents[g0 + 8] : ents[g0 + 8] >> 1) * (unsigned)KK + gl_col(tu_, g0 + 8);
        const unsigned ol2 = (unsigned)(DOWN ? ents[g0 + 16] : ents[g0 + 16] >> 1) * (unsigned)KK + gl_col(tu_, g0 + 16), ol3 = (unsigned)(DOWN ? ents[g0 + 24] : ents[g0 + 24] >> 1) * (unsigned)KK + gl_col(tu_, g0 + 24);
        const bf16_t* Wb = (DOWN ? p.WEO + (size_t)e * 1024 * 512 : p.WEI + (size_t)e * 1024 * 1024) + (size_t)nt * 128 * KK;
        const unsigned w0 = (unsigned)g0 * (unsigned)KK + gl_col(tu_, g0), w1 = (unsigned)(g0 + 8) * (unsigned)KK + gl_col(tu_, g0 + 8), w2 = (unsigned)(g0 + 16) * (unsigned)KK + gl_col(tu_, g0 + 16), w3 = (unsigned)(g0 + 24) * (unsigned)KK + gl_col(tu_, g0 + 24);
        f32x16 acc[2][2]; ZERO_ACC(acc);
        gemm_mainloop(Wb, w0, w1, w2, w3, Xb, ol0, ol1, ol2, ol3, KK, acc, As, Bs);
        if (DOWN) {
#pragma unroll
            for (int j = 0; j < 2; ++j) { const float c = cws[64 * wc + 32 * j + l31];
#pragma unroll
                for (int i = 0; i < 2; ++i)
#pragma unroll
                    for (int r = 0; r < 16; ++r) acc[i][j][r] *= c; }
        } else {
#pragma unroll
            for (int j = 0; j < 2; ++j)
#pragma unroll
                for (int r = 0; r < 16; ++r) { const float g = acc[0][j][r]; acc[0][j][r] = g * __builtin_amdgcn_rcpf(1.0f + __expf(-g)) * acc[1][j][r]; }
        }
        __syncthreads();
        if (DOWN) cimg_write(acc, Cs, wr, wc, l31, lh);
        else {
#pragma unroll
            for (int j = 0; j < 2; ++j)
#pragma unroll
                for (int g = 0; g < 4; ++g) { uint2 o; o.x = cvt_pk_bf16(acc[0][j][4 * g], acc[0][j][4 * g + 1]); o.y = cvt_pk_bf16(acc[0][j][4 * g + 2], acc[0][j][4 * g + 3]);
                    *(uint2*)(Cs + (64 * wc + 32 * j + l31) * CSTR + 32 * wr + 8 * g + 4 * lh) = o; }
        }
        __syncthreads();
        int te_ = tid; asm volatile("" : "+v"(te_));
        if (DOWN) {
#pragma unroll
            for (int k = 0; k < 8; ++k) { const int c = te_ + 256 * k; const int lrow = c >> 4, ch = c & 15;
                if (lrow < nrows) { const uint4 v = *(const uint4*)(Cs + lrow * CSTR + ch * 8); *(uint4*)(p.YMOE + (size_t)ents[lrow] * 1024 + nt * 128 + ch * 8) = v; } }
        } else {
#pragma unroll
            for (int k = 0; k < 4; ++k) { const int c = te_ + 256 * k; const int lrow = c >> 3, ch = c & 7;
                if (lrow < nrows) { const uint4 v = *(const uint4*)(Cs + lrow * CSTR + ch * 8); *(uint4*)(p.HID + (size_t)ents[lrow] * 512 + nt * 64 + ch * 8) = v; } }
        }
    }
}

template <int VAR = 0> __device__ void phase_final(const P& p, int bid, int nblk) {
    const int tidp = opaque_tid();
    const int lane = tidp & 63; const int gw = bid * 4 + (tidp >> 6), nw = nblk * 4;
    for (int tok = gw; tok < T_TOK; tok += nw) {
        float* hp = p.out + (size_t)tok * DM; const bf16_t* hb = p.HB + (size_t)tok * DM; const bf16_t* y0 = p.YMOE + (size_t)tok * 2 * DM; const bf16_t* y1 = y0 + DM;
        float4 v[4]; float ss = 0.f;
#pragma unroll
        for (int i = 0; i < 4; ++i) { const uint2 hu = *(const uint2*)(hb + i * 256 + lane * 4);
            v[i].x = __uint_as_float(hu.x << 16); v[i].y = __uint_as_float(hu.x & 0xffff0000u); v[i].z = __uint_as_float(hu.y << 16); v[i].w = __uint_as_float(hu.y & 0xffff0000u);
            const uint2 a = *(const uint2*)(y0 + i * 256 + lane * 4), b = *(const uint2*)(y1 + i * 256 + lane * 4);
            v[i].x += __uint_as_float(a.x << 16) + __uint_as_float(b.x << 16); v[i].y += __uint_as_float(a.x & 0xffff0000u) + __uint_as_float(b.x & 0xffff0000u);
            v[i].z += __uint_as_float(a.y << 16) + __uint_as_float(b.y << 16); v[i].w += __uint_as_float(a.y & 0xffff0000u) + __uint_as_float(b.y & 0xffff0000u);
            ss += v[i].x * v[i].x + v[i].y * v[i].y + v[i].z * v[i].z + v[i].w * v[i].w; }
        ss = wave_sum(ss);
        const float r = rsqrtf(ss * (1.0f / DM) + 1e-6f);
#pragma unroll
        for (int i = 0; i < 4; ++i) { const float4 gg = *(const float4*)(p.g_fin + i * 256 + lane * 4);
            float4 o; o.x = v[i].x * r * gg.x; o.y = v[i].y * r * gg.y; o.z = v[i].z * r * gg.z; o.w = v[i].w * r * gg.w;
            *(float4*)((VAR ? (float*)p.SGS + (size_t)4 * 1024 * 1024 + (size_t)(tok & 8191) * DM : hp) + i * 256 + lane * 4) = o; }
    }
}
__device__ __forceinline__ float fast_exp2(float x) { return __builtin_amdgcn_exp2f(x); }
typedef float f32x2v __attribute__((ext_vector_type(2)));
template <int KIND, int VAR = 0> __device__ void phase_attn(const P& p, char* smem, int bid, int nblk, const Sched& sc) {
    constexpr int NM = 1, NMAPS = KIND == 0 ? 2 : 1, DQK = KIND == 2 ? 128 : 64, DV = KIND == 1 ? 64 : 128;
    constexpr int KROW = DQK, QROW = NMAPS * DQK, KSTR = KROW + 8, VSTR = 72, NDT = DV / 32, NKS = DQK / 16;
    constexpr int KCH = 64 * KROW / 8 / NTHR, VCH = DV * 8 / NTHR;
    constexpr int NH = KIND == 1 ? 8 : 4;
    constexpr int NUNITS = NBATCH * NH * 64;
    constexpr bool DB = KIND != 2;
    constexpr bool PF2 = KIND == 1;
    bf16_t* Ks = (bf16_t*)smem; bf16_t* Vs = Ks + (DB ? 2 : 1) * 64 * KSTR;
    const int tid = opaque_tid(), lane = tid & 63, wid = tid >> 6, l31 = lane & 31, lh = lane >> 5;
    const float c = (KIND == 2 ? 0.08838834764831845f : 0.125f) * 1.4426950408889634f;
    float lam = 0.f;
    if (KIND == 0) { float d1 = 0.f, d2 = 0.f; for (int i = 0; i < 64; ++i) { d1 += p.lq1[i] * p.lk1[i]; d2 += p.lq2[i] * p.lk2[i]; } lam = expf(d1) - expf(d2) + 0.2f; }
    const bf16_t* Qb = KIND == 0 ? p.DQ : KIND == 1 ? p.SQ : p.MQ;
    const bf16_t* Kb = KIND == 0 ? p.DK : KIND == 1 ? p.SK : p.MK;
    const bf16_t* Vb = KIND == 0 ? p.DVT : KIND == 1 ? p.SVT : p.MVT;
    bf16_t* Yb = VAR != 0 ? (bf16_t*)p.SGS + (size_t)16 * 1024 * 1024 : KIND == 0 ? p.YD : KIND == 1 ? p.YS : p.YM;
    constexpr int VLEN = KIND == 2 ? 256 : S_LEN;
    const bool xaware = false;
    for (int rnd = 0; xaware ? (rnd < NBATCH * NH / 8) : (rnd * nblk < NUNITS); ++rnd) {
        int qt, bh;
        if (xaware) { bh = sc.x * (NBATCH * NH / 8) + rnd; qt = (rnd & 1) ? sc.j : 63 - sc.j; }
        else { const int rank = rnd * nblk + ((rnd & 1) ? nblk - 1 - bid : bid); if (rank >= NUNITS) continue;
               qt = KIND == 2 ? rank % 64 : 63 - rank / (NBATCH * NH); bh = KIND == 2 ? rank / 64 : rank % (NBATCH * NH); }
        const int b = bh / NH, h = bh % NH;
        const int q0 = qt * 128, qw = q0 + 32 * wid;
        const int nkt = KIND == 2 ? 4 : 2 * (qt + 1);
        unsigned o1pk[NDT][8];
#pragma unroll 1
        for (int map = 0; map < NMAPS; ++map) {
        bf16x8 qf[NM][NKS];
        const bf16_t* qp = Qb + ((size_t)(b * S_LEN + qw + l31)) * 512 + h * QROW + map * DQK + lh * 8;
        if (KIND != 2) {
#pragma unroll
            for (int m = 0; m < NM; ++m)
#pragma unroll
                for (int ks = 0; ks < NKS; ++ks) qf[m][ks] = *(const bf16x8*)(qp + m * DQK + ks * 16);
        }
        f32x16 o[NM][NDT];
#pragma unroll
        for (int m = 0; m < NM; ++m)
#pragma unroll
            for (int dt = 0; dt < NDT; ++dt)
#pragma unroll
                for (int r = 0; r < 16; ++r) o[m][dt][r] = 0.f;
        float mrow[NM], lrow[NM];
#pragma unroll
        for (int m = 0; m < NM; ++m) { mrow[m] = -INFINITY; lrow[m] = 0.f; }
        int tid_l = tid; asm volatile("" : "+v"(tid_l));
        const bf16_t* ksrc = Kb + ((size_t)(KIND == 2 ? b * 256 : b * S_LEN) + (tid_l >> (KROW == 128 ? 4 : 3))) * 512 + h * QROW + map * DQK + (tid_l & (KROW / 8 - 1)) * 8;
        constexpr int KROWS_PER_PASS = NTHR / (KROW / 8);
        const int krow_ = tid_l >> (KROW == 128 ? 4 : 3);
        bf16_t* kdst = Ks + ((krow_ & ~12) | ((krow_ & 4) << 1) | ((krow_ & 8) >> 1)) * KSTR + (tid_l & (KROW / 8 - 1)) * 8;
        const bf16_t* vsrc = Vb + ((size_t)(bh * DV + (tid_l >> 3))) * VLEN + (tid_l & 7) * 8;
        bf16_t* vdst = Vs + (tid_l >> 3) * VSTR + (tid_l & 7) * 8;
        uint4 rk0, rk1, rk2 = make_uint4(0,0,0,0), rk3 = make_uint4(0,0,0,0), rv0, rv1, rv2 = make_uint4(0,0,0,0), rv3 = make_uint4(0,0,0,0);
        uint4 rk0b = make_uint4(0,0,0,0), rk1b = make_uint4(0,0,0,0), rv0b = make_uint4(0,0,0,0), rv1b = make_uint4(0,0,0,0);
        { const bf16_t* s_ = ksrc + (size_t)(0) * 512; rk0 = *(const uint4*)(s_); rk1 = *(const uint4*)(s_ + (size_t)KROWS_PER_PASS * 512); if (KCH > 2) { rk2 = *(const uint4*)(s_ + (size_t)2 * KROWS_PER_PASS * 512); rk3 = *(const uint4*)(s_ + (size_t)3 * KROWS_PER_PASS * 512); } }
        { const bf16_t* s_ = vsrc + ((size_t)0); rv0 = *(const uint4*)(s_); rv1 = *(const uint4*)(s_ + (size_t)32 * VLEN); if (VCH > 2) { rv2 = *(const uint4*)(s_ + (size_t)64 * VLEN); rv3 = *(const uint4*)(s_ + (size_t)96 * VLEN); } }
        __syncthreads();
        { *(uint4*)(kdst) = rk0; *(uint4*)(kdst + KROWS_PER_PASS * KSTR) = rk1; if (KCH > 2) { *(uint4*)(kdst + 2 * KROWS_PER_PASS * KSTR) = rk2; *(uint4*)(kdst + 3 * KROWS_PER_PASS * KSTR) = rk3; } }
        { *(uint4*)(vdst) = rv0; *(uint4*)(vdst + 32 * VSTR) = rv1; if (VCH > 2) { *(uint4*)(vdst + 64 * VSTR) = rv2; *(uint4*)(vdst + 96 * VSTR) = rv3; } }
        __syncthreads();
        if (PF2) { const int t1 = nkt > 1 ? 1 : 0;
                   { const bf16_t* s_ = ksrc + (size_t)(t1 * 64) * 512; rk0 = *(const uint4*)(s_); rk1 = *(const uint4*)(s_ + (size_t)KROWS_PER_PASS * 512); }
                   { const bf16_t* s_ = vsrc + (size_t)(t1 * 64); rv0 = *(const uint4*)(s_); rv1 = *(const uint4*)(s_ + (size_t)32 * VLEN); } }
        if (!DB && nkt > 1) { const bf16_t* s_ = ksrc + (size_t)(64) * 512; rk0 = *(const uint4*)(s_); rk1 = *(const uint4*)(s_ + (size_t)KROWS_PER_PASS * 512); if (KCH > 2) { rk2 = *(const uint4*)(s_ + (size_t)2 * KROWS_PER_PASS * 512); rk3 = *(const uint4*)(s_ + (size_t)3 * KROWS_PER_PASS * 512); } }
        uint2 mwn = make_uint2(0u, 0u);
        if (KIND == 1) mwn = *(const uint2*)(p.MASK + ((size_t)(b * S_LEN + qw + l31)) * 256);
        for (int kt = 0; kt < nkt; ++kt) {
            const bool active = KIND == 2 ? true : (kt * 64 <= qw + 31);
            const bf16_t* Kc = Ks + (DB ? (kt & 1) * 64 * KSTR : 0); const bf16_t* Vc = Vs + (DB ? (kt & 1) * DV * VSTR : 0);
            if (PF2) {
                const int t2 = kt + 2 < nkt ? kt + 2 : nkt - 1;
                { const bf16_t* s_ = ksrc + (size_t)(t2 * 64) * 512; rk0b = *(const uint4*)(s_); rk1b = *(const uint4*)(s_ + (size_t)KROWS_PER_PASS * 512); }
                { const bf16_t* s_ = vsrc + ((size_t)t2 * 64); rv0b = *(const uint4*)(s_); rv1b = *(const uint4*)(s_ + (size_t)32 * VLEN); }
            } else
            if (DB && kt + 1 < nkt && VAR != 6 && VAR != 7) {
                { const bf16_t* s_ = ksrc + (size_t)((kt + 1) * 64) * 512; rk0 = *(const uint4*)(s_); rk1 = *(const uint4*)(s_ + (size_t)KROWS_PER_PASS * 512); if (KCH > 2) { rk2 = *(const uint4*)(s_ + (size_t)2 * KROWS_PER_PASS * 512); rk3 = *(const uint4*)(s_ + (size_t)3 * KROWS_PER_PASS * 512); } }
                { const bf16_t* s_ = vsrc + ((size_t)(kt + 1) * 64); rv0 = *(const uint4*)(s_); rv1 = *(const uint4*)(s_ + (size_t)32 * VLEN); if (VCH > 2) { rv2 = *(const uint4*)(s_ + (size_t)64 * VLEN); rv3 = *(const uint4*)(s_ + (size_t)96 * VLEN); } }
            }
            uint2 mwc = mwn;
            if (KIND == 1) mwn = *(const uint2*)(p.MASK + ((size_t)(b * S_LEN + qw + l31)) * 256 + (kt + 1 < nkt ? kt + 1 : kt) * 2);
            __builtin_amdgcn_sched_barrier(0);
            unsigned pk[NM][2][2][4];
            if (active) {
                uint2 mw = mwc;
                if (KIND == 1) { mw.x >>= 8 * lh; mw.y >>= 8 * lh; }
#pragma unroll
                for (int m = 0; m < NM; ++m) {
                    f32x16 s[2];
#pragma unroll
                    for (int r = 0; r < 16; ++r) { s[0][r] = 0.f; s[1][r] = 0.f; }
#pragma unroll
                    for (int ks = 0; ks < NKS; ks += 2) {
                        const bf16x8 a00 = *(const bf16x8*)(Kc + l31 * KSTR + m * DQK + ks * 16 + lh * 8);
                        const bf16x8 a10 = *(const bf16x8*)(Kc + (32 + l31) * KSTR + m * DQK + ks * 16 + lh * 8);
                        const bf16x8 a01 = *(const bf16x8*)(Kc + l31 * KSTR + m * DQK + (ks + 1) * 16 + lh * 8);
                        const bf16x8 a11 = *(const bf16x8*)(Kc + (32 + l31) * KSTR + m * DQK + (ks + 1) * 16 + lh * 8);
                        const bf16x8 q0_ = KIND == 2 ? *(const bf16x8*)(qp + ks * 16) : qf[m][ks];
                        const bf16x8 q1_ = KIND == 2 ? *(const bf16x8*)(qp + (ks + 1) * 16) : qf[m][ks + 1];
                        __builtin_amdgcn_sched_barrier(0);
                        if (VAR != 5) {
                        s[0] = __builtin_amdgcn_mfma_f32_32x32x16_bf16(a00, q0_, s[0], 0, 0, 0);
                        s[1] = __builtin_amdgcn_mfma_f32_32x32x16_bf16(a10, q0_, s[1], 0, 0, 0);
                        s[0] = __builtin_amdgcn_mfma_f32_32x32x16_bf16(a01, q1_, s[0], 0, 0, 0);
                        s[1] = __builtin_amdgcn_mfma_f32_32x32x16_bf16(a11, q1_, s[1], 0, 0, 0);
                        } else { asm volatile("" :: "v"(a00), "v"(a10), "v"(a01), "v"(a11)); }
                    }
                    if (KIND == 0 && kt * 64 + 63 > qw) {
                        const int qi = qw + l31 - kt * 64 - 8 * lh;
#pragma unroll
                        for (int t = 0; t < 2; ++t)
#pragma unroll
                            for (int r = 0; r < 16; ++r) if (32 * t + (r & 7) + 16 * (r >> 3) > qi) s[t][r] = -INFINITY;
                    }
                    float mx = s[0][0];
#pragma unroll
                    for (int r = 1; r < 16; ++r) mx = fmaxf(mx, s[0][r]);
#pragma unroll
                    for (int r = 0; r < 16; ++r) mx = fmaxf(mx, s[1][r]);
                    mx = xhalf_max(mx);
                    const float mnew = fmaxf(mrow[m], mx * c);
                    const float corr = fast_exp2(mrow[m] - mnew);
                    mrow[m] = mnew;
                    f32x2v ps2 = {0.f, 0.f}; const f32x2v c2 = {c, c}, nm2 = {-mnew, -mnew};
#pragma unroll
                    for (int t = 0; t < 2; ++t)
#pragma unroll
                        for (int r = 0; r < 16; r += 2) {
                            const f32x2v sv = {s[t][r], s[t][r + 1]};
                            const f32x2v y = VAR == 3 ? sv : sv * c2 + nm2;
                            f32x2v pv = {(VAR == 1 || VAR == 3) ? y.x : fast_exp2(y.x), (VAR == 1 || VAR == 3) ? y.y : fast_exp2(y.y)};
                            if (KIND == 1) { int m0 = __builtin_amdgcn_sbfe((int)(t ? mw.y : mw.x), (r & 7) + 16 * (r >> 3), 1), m1 = __builtin_amdgcn_sbfe((int)(t ? mw.y : mw.x), ((r + 1) & 7) + 16 * ((r + 1) >> 3), 1);
                                             asm("" : "+v"(m0), "+v"(m1));
                                             pv.x = __uint_as_float(__float_as_uint(pv.x) & (unsigned)m0); pv.y = __uint_as_float(__float_as_uint(pv.y) & (unsigned)m1); }
                            ps2 += pv; s[t][r] = pv.x; s[t][r + 1] = pv.y;
                        }
                    const float psum = ps2.x + ps2.y;
                    lrow[m] = lrow[m] * corr + psum;
#pragma unroll
                    for (int t = 0; t < 2; ++t)
#pragma unroll
                        for (int s2 = 0; s2 < 2; ++s2)
#pragma unroll
                            for (int j = 0; j < 4; ++j) pk[m][t][s2][j] = cvt_pk_bf16(s[t][8 * s2 + 2 * j], s[t][8 * s2 + 2 * j + 1]);
                    if (__any(corr != 1.0f)) {
#pragma unroll
                        for (int dt = 0; dt < NDT; ++dt)
#pragma unroll
                            for (int r = 0; r < 16; ++r) o[m][dt][r] *= corr;
                    }
                }
            }
            if (!DB) {
            __syncthreads();
            if (kt + 1 < nkt) {
                { *(uint4*)(kdst) = rk0; *(uint4*)(kdst + KROWS_PER_PASS * KSTR) = rk1; if (KCH > 2) { *(uint4*)(kdst + 2 * KROWS_PER_PASS * KSTR) = rk2; *(uint4*)(kdst + 3 * KROWS_PER_PASS * KSTR) = rk3; } }
                { const bf16_t* s_ = vsrc + ((size_t)(kt + 1) * 64); rv0 = *(const uint4*)(s_); rv1 = *(const uint4*)(s_ + (size_t)32 * VLEN); if (VCH > 2) { rv2 = *(const uint4*)(s_ + (size_t)64 * VLEN); rv3 = *(const uint4*)(s_ + (size_t)96 * VLEN); } }
            }
            }
            if (active) {
                constexpr int GS = NDT == 4 ? 1 : 2;
#pragma unroll
                for (int ks2 = 0; ks2 < 4; ks2 += GS) {
                    bf16x8 va[GS][NDT];
#pragma unroll
                    for (int g = 0; g < GS; ++g)
#pragma unroll
                        for (int dt = 0; dt < NDT; ++dt) {
                            va[g][dt] = *(const bf16x8*)(Vc + (32 * dt + l31) * VSTR + 16 * (ks2 + g) + 8 * lh);
                        }
                    __builtin_amdgcn_sched_barrier(0);
#pragma unroll
                    for (int g = 0; g < GS; ++g)
#pragma unroll
                        for (int dt = 0; dt < NDT; ++dt)
#pragma unroll
                            for (int m = 0; m < NM; ++m) {
                                const int k2 = ks2 + g;
                                const uint4 pu = make_uint4(pk[m][k2 >> 1][k2 & 1][0], pk[m][k2 >> 1][k2 & 1][1], pk[m][k2 >> 1][k2 & 1][2], pk[m][k2 >> 1][k2 & 1][3]);
                                if (VAR != 2) o[m][dt] = __builtin_amdgcn_mfma_f32_32x32x16_bf16(va[g][dt], *(const bf16x8*)&pu, o[m][dt], 0, 0, 0); else { o[m][dt][0] += __uint_as_float(pu.x); asm volatile("" :: "v"(va[g][dt])); }
                            }
                }
            }
            if (DB) {
                if (kt + 1 < nkt && VAR != 6 && VAR != 7) {
                    bf16_t* kd = kdst + ((kt + 1) & 1) * 64 * KSTR; bf16_t* vd = vdst + ((kt + 1) & 1) * DV * VSTR;
                    { *(uint4*)(kd) = rk0; *(uint4*)(kd + KROWS_PER_PASS * KSTR) = rk1; if (KCH > 2) { *(uint4*)(kd + 2 * KROWS_PER_PASS * KSTR) = rk2; *(uint4*)(kd + 3 * KROWS_PER_PASS * KSTR) = rk3; } }
                    { *(uint4*)(vd) = rv0; *(uint4*)(vd + 32 * VSTR) = rv1; if (VCH > 2) { *(uint4*)(vd + 64 * VSTR) = rv2; *(uint4*)(vd + 96 * VSTR) = rv3; } }
                }
                if (VAR != 7) __syncthreads();
                if (PF2) { rk0 = rk0b; rk1 = rk1b; rv0 = rv0b; rv1 = rv1b; }
            } else {
            __syncthreads();
            if (kt + 1 < nkt) {
                { *(uint4*)(vdst) = rv0; *(uint4*)(vdst + 32 * VSTR) = rv1; if (VCH > 2) { *(uint4*)(vdst + 64 * VSTR) = rv2; *(uint4*)(vdst + 96 * VSTR) = rv3; } }
                if (kt + 2 < nkt) { const bf16_t* s_ = ksrc + (size_t)((kt + 2) * 64) * 512; rk0 = *(const uint4*)(s_); rk1 = *(const uint4*)(s_ + (size_t)KROWS_PER_PASS * 512); if (KCH > 2) { rk2 = *(const uint4*)(s_ + (size_t)2 * KROWS_PER_PASS * 512); rk3 = *(const uint4*)(s_ + (size_t)3 * KROWS_PER_PASS * 512); } }
            }
            }
        }
#pragma unroll
        for (int m = 0; m < NM; ++m) lrow[m] = xhalf_sum(lrow[m]);
        bf16_t* yp = Yb + ((size_t)(b * S_LEN + qw + l31)) * 512 + h * DV + 4 * lh;
        if (KIND == 0) {
            if (map == 0) {
                const float i1 = 1.0f / lrow[0];
#pragma unroll
                for (int dt = 0; dt < NDT; ++dt)
#pragma unroll
                    for (int j = 0; j < 8; ++j) o1pk[dt][j] = cvt_pk_bf16(o[0][dt][2 * j] * i1, o[0][dt][2 * j + 1] * i1);
            } else {
            const float i2 = lam / lrow[0];
            float ss = 0.f;
#pragma unroll
            for (int dt = 0; dt < NDT; ++dt)
#pragma unroll
                for (int r = 0; r < 16; ++r) { const float o1 = (r & 1) ? __uint_as_float(o1pk[dt][r >> 1] & 0xffff0000u) : __uint_as_float(o1pk[dt][r >> 1] << 16);
                    const float v = o1 - o[0][dt][r] * i2; o[0][dt][r] = v; ss += v * v; }
            ss = xhalf_sum(ss);
            const float rn = rsqrtf(ss * (1.0f / 128.0f) + 1e-6f) * 0.8f;
#pragma unroll
            for (int dt = 0; dt < NDT; ++dt)
#pragma unroll
                for (int g = 0; g < 4; ++g) { const int dv = 32 * dt + 8 * g + 4 * lh; const float4 gs = *(const float4*)(p.g_sub + dv);
                    uint2 w; w.x = cvt_pk_bf16(o[0][dt][4 * g] * rn * gs.x, o[0][dt][4 * g + 1] * rn * gs.y); w.y = cvt_pk_bf16(o[0][dt][4 * g + 2] * rn * gs.z, o[0][dt][4 * g + 3] * rn * gs.w);
                    *(uint2*)(yp + 32 * dt + 8 * g) = w; }
            }
        } else {
            const float i1 = 1.0f / lrow[0];
#pragma unroll
            for (int dt = 0; dt < NDT; ++dt)
#pragma unroll
                for (int g = 0; g < 4; ++g) {
                    uint2 w; w.x = cvt_pk_bf16(o[0][dt][4 * g] * i1, o[0][dt][4 * g + 1] * i1); w.y = cvt_pk_bf16(o[0][dt][4 * g + 2] * i1, o[0][dt][4 * g + 3] * i1);
                    *(uint2*)(yp + 32 * dt + 8 * g) = w; }
        }
        }
    }
}
template <int KIND> __device__ void phase_attn2(const P& p, char* smem, int bid, int nblk, const Sched& sc) {
    constexpr int NMAPS = KIND == 0 ? 2 : 1, DQK = 64, DV = KIND == 1 ? 64 : 128;
    constexpr int QROW = NMAPS * DQK, KSTR = 72, VSTR = 72, NDT = DV / 32, NKS = 4;
    constexpr int VCH = DV * 8 / NTHR;
    constexpr int NH = KIND == 1 ? 8 : 4;
    constexpr int NUNITS = NBATCH * NH * 64;
    bf16_t* Ks = (bf16_t*)smem; bf16_t* Vs = Ks + 2 * 64 * KSTR;
    const int tid = opaque_tid(), lane = tid & 63, wid = tid >> 6, l31 = lane & 31, lh = lane >> 5;
    const float c = 0.125f * 1.4426950408889634f;
    float lam = 0.f;
    if (KIND == 0) { float d1 = 0.f, d2 = 0.f; for (int i = 0; i < 64; ++i) { d1 += p.lq1[i] * p.lk1[i]; d2 += p.lq2[i] * p.lk2[i]; } lam = expf(d1) - expf(d2) + 0.2f; }
    const bf16_t* Qb = KIND == 0 ? p.DQ : p.SQ;
    const bf16_t* Kb = KIND == 0 ? p.DK : p.SK;
    const bf16_t* Vb = KIND == 0 ? p.DVT : p.SVT;
    bf16_t* Yb = KIND == 0 ? p.YD : p.YS;
    const bool xaware = false;
    for (int rnd = 0; xaware ? (rnd < NBATCH * NH / 8) : (rnd * nblk < NUNITS); ++rnd) {
        int qt, bh;
        if (xaware) { bh = sc.x * (NBATCH * NH / 8) + rnd; qt = (rnd & 1) ? sc.j : 63 - sc.j; }
        else { const int rank = rnd * nblk + ((rnd & 1) ? nblk - 1 - bid : bid); if (rank >= NUNITS) continue; qt = 63 - rank / (NBATCH * NH); bh = rank % (NBATCH * NH); }
        const int b = bh / NH, h = bh % NH;
        const int q0 = qt * 128, qw = q0 + 32 * wid;
        const int nkt = 2 * (qt + 1);
        const int last_act = min(nkt - 1, (qw + 31) >> 6);
#pragma unroll 1
        for (int map = 0; map < NMAPS; ++map) {
        bf16x8 qf[NKS];
        { const bf16_t* qp = Qb + ((size_t)(b * S_LEN + qw + l31)) * 512 + h * QROW + map * DQK + lh * 8;
#pragma unroll
          for (int ks = 0; ks < NKS; ++ks) qf[ks] = *(const bf16x8*)(qp + ks * 16); }
        f32x16 o[NDT];
#pragma unroll
        for (int dt = 0; dt < NDT; ++dt)
#pragma unroll
            for (int r = 0; r < 16; ++r) o[dt][r] = 0.f;
        float mrow = -INFINITY, lrow = 0.f;
        int tl_ = tid; asm volatile("" : "+v"(tl_));
        const bf16_t* ksrc = Kb + ((size_t)b * S_LEN + (tl_ >> 3)) * 512 + h * QROW + map * DQK + (tl_ & 7) * 8;
        bf16_t* kdst = Ks + (tl_ >> 3) * KSTR + (tl_ & 7) * 8;
        const bf16_t* vsrc = Vb + ((size_t)(bh * DV + (tl_ >> 3))) * S_LEN + (tl_ & 7) * 8;
        bf16_t* vdst = Vs + (tl_ >> 3) * VSTR + (tl_ & 7) * 8;
        uint4 rk0, rk1, rv0, rv1, rv2 = make_uint4(0, 0, 0, 0), rv3 = make_uint4(0, 0, 0, 0);
#define LDK(kt_) { const bf16_t* s_ = ksrc + (size_t)((kt_) * 64) * 512; rk0 = *(const uint4*)(s_); rk1 = *(const uint4*)(s_ + (size_t)32 * 512); }
#define LDV(kt_) { const bf16_t* s_ = vsrc + (size_t)(kt_) * 64; rv0 = *(const uint4*)(s_); rv1 = *(const uint4*)(s_ + (size_t)32 * S_LEN); if (VCH > 2) { rv2 = *(const uint4*)(s_ + (size_t)64 * S_LEN); rv3 = *(const uint4*)(s_ + (size_t)96 * S_LEN); } }
#define STK(buf_) { bf16_t* d_ = kdst + (buf_) * 64 * KSTR; *(uint4*)(d_) = rk0; *(uint4*)(d_ + 32 * KSTR) = rk1; }
#define STV(buf_) { bf16_t* d_ = vdst + (buf_) * DV * VSTR; *(uint4*)(d_) = rv0; *(uint4*)(d_ + 32 * VSTR) = rv1; if (VCH > 2) { *(uint4*)(d_ + 64 * VSTR) = rv2; *(uint4*)(d_ + 96 * VSTR) = rv3; } }
        LDK(0) LDV(0)
        __syncthreads();
        STK(0) STV(0)
        LDK(1)
        STK(1)
        __syncthreads();
        f32x16 s[2];
        auto qk = [&](int kt) {
            const bf16_t* Kc = Ks + (kt & 1) * 64 * KSTR;
#pragma unroll
            for (int r = 0; r < 16; ++r) { s[0][r] = 0.f; s[1][r] = 0.f; }
#pragma unroll
            for (int ks = 0; ks < NKS; ks += 2) {
                const bf16x8 a00 = *(const bf16x8*)(Kc + l31 * KSTR + ks * 16 + lh * 8), a10 = *(const bf16x8*)(Kc + (32 + l31) * KSTR + ks * 16 + lh * 8);
                const bf16x8 a01 = *(const bf16x8*)(Kc + l31 * KSTR + (ks + 1) * 16 + lh * 8), a11 = *(const bf16x8*)(Kc + (32 + l31) * KSTR + (ks + 1) * 16 + lh * 8);
                s[0] = __builtin_amdgcn_mfma_f32_32x32x16_bf16(a00, qf[ks], s[0], 0, 0, 0);
                s[1] = __builtin_amdgcn_mfma_f32_32x32x16_bf16(a10, qf[ks], s[1], 0, 0, 0);
                s[0] = __builtin_amdgcn_mfma_f32_32x32x16_bf16(a01, qf[ks + 1], s[0], 0, 0, 0);
                s[1] = __builtin_amdgcn_mfma_f32_32x32x16_bf16(a11, qf[ks + 1], s[1], 0, 0, 0);
            }
        };
        unsigned pkp[2][2][4], pkn[2][2][4];
        float corr = 1.0f;
        uint2 mw = make_uint2(0u, 0u);
        auto softmax = [&](int kt) {
            if (KIND == 0 && kt * 64 + 63 > qw) {
                const int qi = qw + l31 - kt * 64 - 4 * lh;
#pragma unroll
                for (int t = 0; t < 2; ++t)
#pragma unroll
                    for (int r = 0; r < 16; ++r) if (32 * t + (r & 3) + 8 * (r >> 2) > qi) s[t][r] = -INFINITY;
            }
            float mx = s[0][0];
#pragma unroll
            for (int r = 1; r < 16; ++r) mx = fmaxf(mx, s[0][r]);
#pragma unroll
            for (int r = 0; r < 16; ++r) mx = fmaxf(mx, s[1][r]);
            mx = xhalf_max(mx);
            const float mnew = fmaxf(mrow, mx * c);
            corr = fast_exp2(mrow - mnew);
            mrow = mnew;
            f32x2v ps2 = {0.f, 0.f}; const f32x2v c2 = {c, c}, nm2 = {-mnew, -mnew};
#pragma unroll
            for (int t = 0; t < 2; ++t)
#pragma unroll
                for (int r = 0; r < 16; r += 2) {
                    const f32x2v sv = {s[t][r], s[t][r + 1]};
                    const f32x2v y = sv * c2 + nm2;
                    f32x2v pv = {fast_exp2(y.x), fast_exp2(y.y)};
                    if (KIND == 1) { pv.x = __uint_as_float(__float_as_uint(pv.x) & (unsigned)__builtin_amdgcn_sbfe((int)(t ? mw.y : mw.x), (r & 3) + 8 * (r >> 2), 1));
                                     pv.y = __uint_as_float(__float_as_uint(pv.y) & (unsigned)__builtin_amdgcn_sbfe((int)(t ? mw.y : mw.x), ((r + 1) & 3) + 8 * ((r + 1) >> 2), 1)); }
                    ps2 += pv;
                    pkn[t][r >> 3][(r >> 1) & 3] = cvt_pk_bf16(pv.x, pv.y);
                }
            lrow = lrow * corr + (ps2.x + ps2.y);
        };
        auto pv_mma = [&](int kt) {
            const bf16_t* Vc = Vs + (kt % 3) * DV * VSTR;
            constexpr int GS = NDT == 4 ? 1 : 2;
#pragma unroll
            for (int ks2 = 0; ks2 < 4; ks2 += GS) {
                bf16x8 va[GS][NDT];
#pragma unroll
                for (int g = 0; g < GS; ++g)
#pragma unroll
                    for (int dt = 0; dt < NDT; ++dt) {
                        const bf16_t* vp = Vc + (32 * dt + l31) * VSTR + 16 * (ks2 + g) + 4 * lh;
                        const uint2 lo = *(const uint2*)vp, hi = *(const uint2*)(vp + 8);
                        const uint4 vv = make_uint4(lo.x, lo.y, hi.x, hi.y);
                        va[g][dt] = *(const bf16x8*)&vv;
                    }
#pragma unroll
                for (int g = 0; g < GS; ++g)
#pragma unroll
                    for (int dt = 0; dt < NDT; ++dt) {
                        const int k2 = ks2 + g;
                        const uint4 pu = make_uint4(pkp[k2 >> 1][k2 & 1][0], pkp[k2 >> 1][k2 & 1][1], pkp[k2 >> 1][k2 & 1][2], pkp[k2 >> 1][k2 & 1][3]);
                        o[dt] = __builtin_amdgcn_mfma_f32_32x32x16_bf16(va[g][dt], *(const bf16x8*)&pu, o[dt], 0, 0, 0);
                    }
            }
        };
        uint2 mwn = make_uint2(0u, 0u);
        if (KIND == 1) mwn = *(const uint2*)(p.MASK + ((size_t)(b * S_LEN + qw + l31)) * 256);
        qk(0);
        for (int kt = 0; kt <= nkt; ++kt) {
            if (kt + 2 < nkt) LDK(kt + 2)
            if (kt + 1 < nkt) LDV(kt + 1)
            const bool do_sm = kt <= last_act, do_pv = kt >= 1 && kt - 1 <= last_act;
            if (do_sm && KIND == 1) { mw = mwn; mw.x >>= 4 * lh; mw.y >>= 4 * lh; if (kt + 1 <= last_act) mwn = *(const uint2*)(p.MASK + ((size_t)(b * S_LEN + qw + l31)) * 256 + (kt + 1) * 2); }
            if (do_sm && do_pv) {
                softmax(kt); pv_mma(kt - 1);
            } else if (do_sm) softmax(kt);
            else if (do_pv) pv_mma(kt - 1);
            if (do_sm) {
                if (__any(corr != 1.0f)) {
#pragma unroll
                    for (int dt = 0; dt < NDT; ++dt)
#pragma unroll
                        for (int r = 0; r < 16; ++r) o[dt][r] *= corr;
                }
#pragma unroll
                for (int t = 0; t < 2; ++t)
#pragma unroll
                    for (int s2 = 0; s2 < 2; ++s2)
#pragma unroll
                        for (int j = 0; j < 4; ++j) pkp[t][s2][j] = pkn[t][s2][j];
            }
            if (kt + 1 <= last_act) qk(kt + 1);
            if (kt + 2 < nkt) STK(kt & 1)
            if (kt + 1 < nkt) STV((kt + 1) % 3)
            __syncthreads();
        }
#undef LDK
#undef LDV
#undef STK
#undef STV
        int te_ = tid; asm volatile("" : "+v"(te_));
        uint4* park = (uint4*)p.SGS + (size_t)bid * 2048 + te_;
        lrow = xhalf_sum(lrow);
        bf16_t* yp = Yb + ((size_t)(b * S_LEN + qw + l31)) * 512 + h * DV + 4 * lh;
        if (KIND == 0) {
            if (map == 0) {
                const float i1 = 1.0f / lrow;
#pragma unroll
                for (int dt = 0; dt < NDT; ++dt)
#pragma unroll
                    for (int h2 = 0; h2 < 2; ++h2)
                        park[(size_t)(dt * 2 + h2) * 256] = make_uint4(cvt_pk_bf16(o[dt][8 * h2] * i1, o[dt][8 * h2 + 1] * i1), cvt_pk_bf16(o[dt][8 * h2 + 2] * i1, o[dt][8 * h2 + 3] * i1),
                                                                      cvt_pk_bf16(o[dt][8 * h2 + 4] * i1, o[dt][8 * h2 + 5] * i1), cvt_pk_bf16(o[dt][8 * h2 + 6] * i1, o[dt][8 * h2 + 7] * i1));
                asm volatile("" ::: "memory");
            } else {
                const float i2 = lam / lrow;
                float ss = 0.f;
#pragma unroll
                for (int dt = 0; dt < NDT; ++dt)
#pragma unroll
                    for (int h2 = 0; h2 < 2; ++h2) { const uint4 w = park[(size_t)(dt * 2 + h2) * 256]; const unsigned ww[4] = {w.x, w.y, w.z, w.w};
#pragma unroll
                        for (int j = 0; j < 4; ++j) {
                            const float v0 = __uint_as_float(ww[j] << 16) - o[dt][8 * h2 + 2 * j] * i2, v1 = __uint_as_float(ww[j] & 0xffff0000u) - o[dt][8 * h2 + 2 * j + 1] * i2;
                            o[dt][8 * h2 + 2 * j] = v0; o[dt][8 * h2 + 2 * j + 1] = v1; ss += v0 * v0 + v1 * v1; } }
                ss = xhalf_sum(ss);
                const float rn = rsqrtf(ss * (1.0f / 128.0f) + 1e-6f) * 0.8f;
#pragma unroll
                for (int dt = 0; dt < NDT; ++dt)
#pragma unroll
                    for (int g = 0; g < 4; ++g) { const int dv = 32 * dt + 8 * g + 4 * lh; const float4 gs = *(const float4*)(p.g_sub + dv);
                        uint2 w; w.x = cvt_pk_bf16(o[dt][4 * g] * rn * gs.x, o[dt][4 * g + 1] * rn * gs.y); w.y = cvt_pk_bf16(o[dt][4 * g + 2] * rn * gs.z, o[dt][4 * g + 3] * rn * gs.w);
                        *(uint2*)(yp + 32 * dt + 8 * g) = w; }
            }
        } else {
            const float i1 = 1.0f / lrow;
#pragma unroll
            for (int dt = 0; dt < NDT; ++dt)
#pragma unroll
                for (int g = 0; g < 4; ++g) {
                    uint2 w; w.x = cvt_pk_bf16(o[dt][4 * g] * i1, o[dt][4 * g + 1] * i1); w.y = cvt_pk_bf16(o[dt][4 * g + 2] * i1, o[dt][4 * g + 3] * i1);
                    *(uint2*)(yp + 32 * dt + 8 * g) = w; }
        }
        }
    }
}
#define IDX_M 23
__device__ __forceinline__ float med3f(float a, float b, float c) { return __builtin_amdgcn_fmed3f(a, b, c); }
__device__ void phase_indexer(const P& p, char* smem, int bid, int nblk, const Sched& sc_) {
    bf16_t* Kb = (bf16_t*)smem;
    unsigned* mimg = (unsigned*)(smem + 18432);
    const int tid = opaque_tid(), lane = tid & 63, wid = tid >> 6, l31 = lane & 31, lh = lane >> 5;
    constexpr int NUNITS = NBATCH * 256;
    const bool xaware = false;
    for (int rnd = 0; xaware ? (rnd < 2) : (rnd * nblk < NUNITS); ++rnd) {
        int qu, b;
        if (xaware) { b = sc_.x >> 1; const int k = rnd == 0 ? 127 - sc_.j : sc_.j; qu = 2 * k + (sc_.x & 1); }
        else { const int rank = rnd * nblk + ((rnd & 1) ? nblk - 1 - bid : bid); if (rank >= NUNITS) continue; qu = 255 - (rank >> 2); b = rank & 3; }
        const int q0 = qu * 32;
        const size_t tok0 = (size_t)b * S_LEN + q0;
        if (q0 < 256) {
#pragma unroll 1
            for (int i = 0; i < 32; ++i) { const int q = q0 + i; const int w0 = tid * 32;
                p.MASK[(tok0 + i) * 256 + tid] = q >= w0 + 31 ? 0xffffffffu : (q < w0 ? 0u : ((2u << (q - w0)) - 1u)); }
            continue;
        }
        const int nkt = (q0 + 95) >> 6;
        const int qb = q0 + 8 * wid;
        bf16x8 aq[2][4]; float wq[2][2][8]; int qv[2][2];
#pragma unroll
        for (int rt = 0; rt < 2; ++rt) {
            const int qa = qb + 4 * rt + 2 * ((l31 >> 2) & 1) + (l31 >> 4), ha = 4 * ((l31 >> 3) & 1) + (l31 & 3);
            const bf16_t* ap = p.IQ + ((size_t)b * S_LEN + qa) * 512 + ha * 64 + lh * 8;
#pragma unroll
            for (int ks = 0; ks < 4; ++ks) aq[rt][ks] = *(const bf16x8*)(ap + ks * 16);
#pragma unroll
            for (int e = 0; e < 2; ++e) { const float* wp = p.IW + ((size_t)b * S_LEN + qb + 4 * rt + 2 * lh + e) * 8;
                const float4 w0 = *(const float4*)wp, w1 = *(const float4*)(wp + 4); const float sc = 0.125f * 0.35355339059327373f;
                wq[rt][e][0] = w0.x * sc; wq[rt][e][1] = w0.y * sc; wq[rt][e][2] = w0.z * sc; wq[rt][e][3] = w0.w * sc;
                wq[rt][e][4] = w1.x * sc; wq[rt][e][5] = w1.y * sc; wq[rt][e][6] = w1.z * sc; wq[rt][e][7] = w1.w * sc;
                qv[rt][e] = qb + 4 * rt + 2 * lh + e; }
        }
        const bf16_t* ksrc = p.IK + ((size_t)b * S_LEN + (tid >> 3)) * 64 + (tid & 7) * 8;
        bf16_t* kdst = Kb + (tid >> 3) * 72 + (tid & 7) * 8;
        auto tile_scores = [&](const bf16_t* kbuf, int t, float (&sc)[2][2]) {
            f32x16 acc[2];
#pragma unroll
            for (int r = 0; r < 16; ++r) { acc[0][r] = 0.f; acc[1][r] = 0.f; }
#pragma unroll
            for (int ks = 0; ks < 4; ++ks) {
                const bf16x8 kf = *(const bf16x8*)(kbuf + (32 * t + l31) * 72 + ks * 16 + lh * 8);
                acc[0] = __builtin_amdgcn_mfma_f32_32x32x16_bf16(aq[0][ks], kf, acc[0], 0, 0, 0);
                acc[1] = __builtin_amdgcn_mfma_f32_32x32x16_bf16(aq[1][ks], kf, acc[1], 0, 0, 0);
            }
#pragma unroll
            for (int rt = 0; rt < 2; ++rt)
#pragma unroll
                for (int e = 0; e < 2; ++e) { float s = 0.f;
#pragma unroll
                    for (int hd = 0; hd < 8; ++hd) s = __builtin_fmaf(wq[rt][e][hd], __int_as_float(max(__float_as_int(acc[rt][8 * e + hd]), 0)), s);
                    sc[rt][e] = s; }
        };
        float T[2][2]; int need[2][2];
        {
            float L[2][2][IDX_M];
#pragma unroll
            for (int rt = 0; rt < 2; ++rt)
#pragma unroll
                for (int e = 0; e < 2; ++e)
#pragma unroll
                    for (int i = 0; i < IDX_M; ++i) L[rt][e][i] = -INFINITY;
            __syncthreads();
            uint4 r0 = *(const uint4*)(ksrc), r1 = *(const uint4*)(ksrc + 32 * 64);
            *(uint4*)(kdst) = r0; *(uint4*)(kdst + 32 * 72) = r1;
            __syncthreads();
            for (int kt = 0; kt < nkt; ++kt) {
                const bf16_t* kbuf = Kb + (kt & 1) * 64 * 72;
                if (kt + 1 < nkt) { r0 = *(const uint4*)(ksrc + (size_t)(kt + 1) * 64 * 64); r1 = *(const uint4*)(ksrc + (size_t)(kt + 1) * 64 * 64 + 32 * 64); }
                __builtin_amdgcn_sched_barrier(0);
                const bool interior = kt * 64 + 63 <= qb;
#pragma unroll 1
                for (int t = 0; t < 2; ++t) {
                    float sc[2][2]; tile_scores(kbuf, t, sc);
                    const int key = kt * 64 + 32 * t + l31;
#pragma unroll
                    for (int rt = 0; rt < 2; ++rt)
#pragma unroll
                        for (int e = 0; e < 2; ++e) {
                            const float v = (interior || key <= qv[rt][e]) ? sc[rt][e] : -INFINITY;
#pragma unroll
                            for (int i = IDX_M - 1; i >= 1; --i) L[rt][e][i] = med3f(L[rt][e][i - 1], L[rt][e][i], v);
                            asm("v_max_f32 %0, %1, %2" : "=v"(L[rt][e][0]) : "v"(L[rt][e][0]), "v"(v));
                        }
                }
                if (kt + 1 < nkt) { bf16_t* d = kdst + ((kt + 1) & 1) * 64 * 72; *(uint4*)(d) = r0; *(uint4*)(d + 32 * 72) = r1; }
                __syncthreads();
            }
#pragma unroll
            for (int rt = 0; rt < 2; ++rt)
#pragma unroll
                for (int e = 0; e < 2; ++e) {
                    unsigned U[IDX_M];
#pragma unroll
                    for (int i = 0; i < IDX_M; ++i) { const unsigned bts = __float_as_uint(L[rt][e][i]); U[i] = bts ^ ((unsigned)((int)bts >> 31) | 0x80000000u); }
                    unsigned pre = 0u;
#pragma unroll 1
                    for (int bit = 31; bit >= 0; --bit) {
                        const unsigned cand = pre | (1u << bit);
                        int c0 = 0, c1 = 0;
#pragma unroll
                        for (int i = 0; i < IDX_M; ++i) { const unsigned long long m = __builtin_amdgcn_ballot_w64(U[i] >= cand); c0 += __popc((unsigned)m); c1 += __popc((unsigned)(m >> 32)); }
                        if ((lh ? c1 : c0) >= 256) pre = cand;
                    }
                    int g0 = 0, g1 = 0;
#pragma unroll
                    for (int i = 0; i < IDX_M; ++i) { const unsigned long long m = __builtin_amdgcn_ballot_w64(U[i] > pre); g0 += __popc((unsigned)m); g1 += __popc((unsigned)(m >> 32)); }
                    need[rt][e] = 256 - (lh ? g1 : g0);
                    T[rt][e] = __uint_as_float((pre & 0x80000000u) ? (pre ^ 0x80000000u) : ~pre);
                }
        }
        {
            int tcnt[2][2];
#pragma unroll
            for (int rt = 0; rt < 2; ++rt)
#pragma unroll
                for (int e = 0; e < 2; ++e) tcnt[rt][e] = 0;
            __syncthreads();
            uint4 r0 = *(const uint4*)(ksrc), r1 = *(const uint4*)(ksrc + 32 * 64);
#pragma unroll 1
            for (int i = tid; i < 32 * 256 / 4; i += NTHR) ((uint4*)mimg)[i] = make_uint4(0u, 0u, 0u, 0u);
            *(uint4*)(kdst) = r0; *(uint4*)(kdst + 32 * 72) = r1;
            __syncthreads();
            for (int kt = 0; kt < nkt; ++kt) {
                const bf16_t* kbuf = Kb + (kt & 1) * 64 * 72;
                if (kt + 1 < nkt) { r0 = *(const uint4*)(ksrc + (size_t)(kt + 1) * 64 * 64); r1 = *(const uint4*)(ksrc + (size_t)(kt + 1) * 64 * 64 + 32 * 64); }
                __builtin_amdgcn_sched_barrier(0);
                const bool interior = kt * 64 + 63 <= qb;
#pragma unroll 1
                for (int t = 0; t < 2; ++t) {
                    float sc[2][2]; tile_scores(kbuf, t, sc);
                    const int key = kt * 64 + 32 * t + l31;
#pragma unroll
                    for (int rt = 0; rt < 2; ++rt)
#pragma unroll
                        for (int e = 0; e < 2; ++e) {
                            const float sv = (interior || key <= qv[rt][e]) ? sc[rt][e] : -INFINITY;
                            unsigned long long bal = __builtin_amdgcn_ballot_w64(sv > T[rt][e]);
                            const unsigned long long tb = __builtin_amdgcn_ballot_w64(sv == T[rt][e]);
                            if (tb != 0ull) {
                                const unsigned half = (unsigned)(tb >> (32 * lh));
                                const int rk = tcnt[rt][e] + __popc(half & ((1u << l31) - 1u));
                                bal |= __builtin_amdgcn_ballot_w64(sv == T[rt][e] && rk < need[rt][e]);
                                tcnt[rt][e] += __popc(half);
                            }
                            if (l31 == 0) mimg[(8 * wid + 4 * rt + 2 * lh + e) * 256 + kt * 2 + t] = (unsigned)(bal >> (32 * lh));
                        }
                }
                if (kt + 1 < nkt) { bf16_t* d = kdst + ((kt + 1) & 1) * 64 * 72; *(uint4*)(d) = r0; *(uint4*)(d + 32 * 72) = r1; }
                __syncthreads();
            }
        }
#pragma unroll 1
        for (int i = tid; i < 32 * 64; i += NTHR) { const int row = i >> 6, c4 = i & 63; *(uint4*)(p.MASK + (tok0 + row) * 256 + c4 * 4) = ((const uint4*)mimg)[row * 64 + c4]; }
    }
}
#ifndef PROBE_REP
#define PROBE_REP -1
#endif
#define RUNPH(idx, call) { _Pragma("unroll 1") for (int rep_ = 0; rep_ < ((PROBE_REP == idx) ? 2 : 1); ++rep_) { call; if (rep_ == 0 && PROBE_REP == idx) xcd_barrier(bar); } }

__global__ void __launch_bounds__(NTHR, 2) k_forward(P p) {
    __shared__ __attribute__((aligned(16))) char smem[SMEM_BYTES];
    volatile LAS unsigned* xbw = (volatile LAS unsigned*)(smem + SMEM_BYTES - 16);
    if (threadIdx.x == 0) { xbw[0] = 0u; xbw[1] = 0u; xbw[2] = 0u; xbw[3] = 0u; }
    __syncthreads();
    XcdBarrier bar = xcd_barrier_post(p.bar, xbw);
    const int bid = blockIdx.x, nblk = gridDim.x;
    volatile LAS int* sw = (volatile LAS int*)(smem + SMEM_BYTES - 32);
    if (threadIdx.x == 0) { const int hx = (int)(xb_xcc_id() & 7u); sw[0] = hx; sw[1] = atomicAdd(&p.XC[hx * 64], 1); }
    RUNPH(0, phase_prologue(p, smem, bid, nblk))
    xcd_barrier(bar);
    Sched sc;
    {
        bool even = (nblk & 7) == 0;
#pragma unroll
        for (int i = 0; i < 8; ++i) even = even && (__hip_atomic_load(&p.XC[i * 64], __ATOMIC_RELAXED, __HIP_MEMORY_SCOPE_AGENT) == (nblk >> 3));
        sc.x = even ? sw[0] : (bid & 7); sc.j = even ? sw[1] : (bid >> 3);
        sc.x = __builtin_amdgcn_readfirstlane(sc.x); sc.j = __builtin_amdgcn_readfirstlane(sc.j);
    }
    RUNPH(1, phase_inproj<0>(p, smem, bid, nblk, sc))
    xcd_barrier(bar);
    RUNPH(2, phase_indexer(p, smem, bid, nblk, sc))
    xcd_split_arrive(bar);
    RUNPH(3, phase_attn<0>(p, smem, bid, nblk, sc))
    RUNPH(4, phase_attn<2>(p, smem, bid, nblk, sc))
    xcd_split_wait(bar);
    RUNPH(5, phase_attn<1>(p, smem, bid, nblk, sc))
    xcd_barrier(bar);
    RUNPH(6, phase_merge<1>(p, smem, bid, nblk, sc))
    xcd_barrier(bar);
    RUNPH(7, phase_outproj(p, smem, bid, nblk, sc))
    xcd_barrier(bar);
#if PROBE_REP == 10
    phase_route<1>(p, smem, bid, nblk);
    xcd_barrier(bar);
#endif
    phase_route<0>(p, smem, bid, nblk);
    xcd_barrier(bar);
    RUNPH(8, phase_moe<0>(p, smem, bid, nblk, sc))
    xcd_barrier(bar);
    RUNPH(9, phase_moe<1>(p, smem, bid, nblk, sc))
    xcd_barrier(bar);
#if PROBE_REP == 11
    phase_final<1>(p, bid, nblk);
    xcd_barrier(bar);
#endif
    phase_final<0>(p, bid, nblk);
}

#define MBYTES(x) ((size_t)(x) << 20)
extern "C" void kernel_launch(void* const* d_in, const int* in_sizes, int n_in, void* d_out, int out_size, void* d_ws, size_t ws_size, hipStream_t stream) {
    P p{};
    p.x = (const float*)d_in[0]; p.pos = (const int*)d_in[1]; p.mem = (const float*)d_in[2];
    p.g_mix = (const float*)d_in[3]; p.w_in = (const float*)d_in[4]; p.b_gate = (const float*)d_in[5];
    p.lq1 = (const float*)d_in[6]; p.lk1 = (const float*)d_in[7]; p.lq2 = (const float*)d_in[8]; p.lk2 = (const float*)d_in[9];
    p.g_sub = (const float*)d_in[10]; p.g_mem = (const float*)d_in[11]; p.w_mkv = (const float*)d_in[12];
    p.w_br0 = (const float*)d_in[13]; p.w_br1 = (const float*)d_in[14]; p.w_br2 = (const float*)d_in[15];
    p.w_out = (const float*)d_in[16]; p.g_ffn = (const float*)d_in[17];
    p.w_rg = (const float*)d_in[18]; p.b_rg = (const float*)d_in[19]; p.w_re = (const float*)d_in[20]; p.b_re = (const float*)d_in[21];
    p.w_ei = (const float*)d_in[22]; p.w_eo = (const float*)d_in[23]; p.g_fin = (const float*)d_in[24];
    char* ws = (char*)d_ws; p.out = (float*)d_out;
    p.bar = (unsigned*)ws; p.CNT = (int*)(ws + 65536); p.XC = (int*)(ws + 131072);
    p.NBUF = (bf16_t*)(ws + MBYTES(1));
    p.DQ = (bf16_t*)(ws + MBYTES(65)); p.DK = (bf16_t*)(ws + MBYTES(97)); p.MERGED = (bf16_t*)(ws + MBYTES(65));
    p.SQ = (bf16_t*)(ws + MBYTES(129)); p.SK = (bf16_t*)(ws + MBYTES(161)); p.HID = (bf16_t*)(ws + MBYTES(129));
    p.DVT = (bf16_t*)(ws + MBYTES(193)); p.SVT = (bf16_t*)(ws + MBYTES(225)); p.IQ = (bf16_t*)(ws + MBYTES(257)); p.MQ = (bf16_t*)(ws + MBYTES(289));
    p.YMOE = (bf16_t*)(ws + MBYTES(193));
    p.IK = (bf16_t*)(ws + MBYTES(321)); p.IW = (float*)(ws + MBYTES(325)); p.MASK = (unsigned*)(ws + MBYTES(326));
    p.MK = (bf16_t*)(ws + MBYTES(358)); p.MVT = (bf16_t*)(ws + MBYTES(359)); p.MEMN = (bf16_t*)(ws + MBYTES(360));
    p.ROPEC = (float*)(ws + MBYTES(362)); p.ROPES = (float*)(ws + MBYTES(363));
    p.ROUTE = (Route*)(ws + MBYTES(365)); p.LIST = (int*)(ws + MBYTES(366));
    p.WIN = (bf16_t*)(ws + MBYTES(368)); p.WMKV = (bf16_t*)(ws + MBYTES(383));
    p.WBR = (bf16_t*)(ws + MBYTES(385)); p.WOUT = (bf16_t*)(ws + MBYTES(388)); p.WEI = (bf16_t*)(ws + MBYTES(390)); p.WEO = (bf16_t*)(ws + MBYTES(422));
    p.SGS = (unsigned*)(ws + MBYTES(440));
    p.HB = (bf16_t*)(ws + MBYTES(440));
    p.YD = (bf16_t*)d_out; p.YS = p.YD + (size_t)T_TOK * 512; p.YM = p.YS + (size_t)T_TOK * 512;
    static int grid = 0;
    if (!grid) {
        int dev = 0, cus = 0, per_cu = 0;
        (void)hipGetDevice(&dev);
        (void)hipDeviceGetAttribute(&cus, hipDeviceAttributeMultiprocessorCount, dev);
        (void)hipOccupancyMaxActiveBlocksPerMultiprocessor(&per_cu, k_forward, NTHR, 0);
        if (cus <= 0) cus = 256;
        if (per_cu < 1) per_cu = 1;
        grid = cus * (per_cu < 2 ? per_cu : 2);
    }
    (void)hipMemsetAsync(p.bar, 0, 262144, stream);
    k_forward<<<grid, NTHR, 0, stream>>>(p);
}
```
